# Optimizing an MI355X kernel written in HIP

```python
import jax, jax.numpy as jnp
from jax import lax
import numpy as np

D_MODEL = 1024
BATCH = 8
SEQ = 2048
DEPTH = 1
DEC_BATCH = 128
DEC_SEQ = 1
PAST_LEN = 16384
PAGE_SIZE = 128

N_META = 16
D_CONV = D_MODEL
CONV_A_W = 3
D_RNN = D_MODEL
N_RNN_HEADS = 16
RNN_HEAD_DIM = D_RNN // N_RNN_HEADS
CONV_B_W = 4
RG_C = 8.0
D_FF = 2816
D_IN = 3 * D_CONV + 2 * D_RNN + 2 * D_MODEL
EPS = 1e-6

kernel_name = "hybrid_shortconv_rglru_macaron_step"


def _rmsnorm(x, g):
    xf = x.astype(jnp.float32)
    y = xf * lax.rsqrt(jnp.mean(xf * xf, axis=-1, keepdims=True) + EPS) * g.astype(jnp.float32)
    return y.astype(x.dtype)


def _swiglu(x, w_gate, w_up, w_down):
    return (jax.nn.silu(x @ w_gate) * (x @ w_up)) @ w_down


def _causal_dwconv(x, buf, w):
    T = x.shape[1]
    K = w.shape[0]
    xp = jnp.concatenate([buf.astype(x.dtype), x], axis=1)
    y = xp[:, 0:T] * w[0]
    for k in range(1, K):
        y = y + xp[:, k:k + T] * w[k]
    return y, xp[:, xp.shape[1] - (K - 1):]


def _rglru(x, h0, w_r, b_r, w_i, b_i, lam):
    Bsz, T, _ = x.shape
    xh = x.reshape(Bsz, T, N_RNN_HEADS, RNN_HEAD_DIM)
    r = jax.nn.sigmoid((jnp.einsum('bthi,hij->bthj', xh, w_r).reshape(Bsz, T, D_RNN) + b_r).astype(jnp.float32))
    i = jax.nn.sigmoid((jnp.einsum('bthi,hij->bthj', xh, w_i).reshape(Bsz, T, D_RNN) + b_i).astype(jnp.float32))
    log_a = -RG_C * r * jax.nn.softplus(-lam.astype(jnp.float32))
    a = jnp.exp(log_a)
    u = jnp.sqrt(-jnp.expm1(2.0 * log_a)) * (i * x.astype(jnp.float32))

    def step(h, au):
        a_t, u_t = au
        h = a_t * h + u_t
        return h, h

    h_last, hs = lax.scan(step, h0, (jnp.swapaxes(a, 0, 1), jnp.swapaxes(u, 0, 1)))
    return jnp.swapaxes(hs, 0, 1).astype(x.dtype), h_last


def _mixer(h, buf_a, buf_b, h0, p):
    u = h @ p['w_in']
    idx = [D_CONV, 2 * D_CONV, 3 * D_CONV, 3 * D_CONV + D_RNN,
           3 * D_CONV + 2 * D_RNN, 3 * D_CONV + 2 * D_RNN + D_MODEL]
    a_b, a_c, a_x, b_x, b_gate, g_a, g_b = jnp.split(u, idx, axis=-1)
    conv_a, new_buf_a = _causal_dwconv(a_c * a_x, buf_a, p['conv_a_w'])
    y_a = (a_b * conv_a) @ p['w_out_a']
    conv_b, new_buf_b = _causal_dwconv(b_x, buf_b, p['conv_b_w'])
    conv_b = conv_b + p['conv_b_b']
    rg, h_last = _rglru(conv_b, h0, p['w_rg_r'], p['b_rg_r'], p['w_rg_i'], p['b_rg_i'], p['rg_lambda'])
    y_b = (jax.nn.gelu(b_gate, approximate=True) * rg) @ p['w_out_b']
    merged = jax.nn.sigmoid(g_a) * y_a + jax.nn.sigmoid(g_b) * y_b
    return merged @ p['w_o'], new_buf_a, new_buf_b, h_last


def _layer(x, buf_a, buf_b, h0, p):
    x = x + 0.5 * _rmsnorm(_swiglu(_rmsnorm(x, p['g_ffn1_pre']), p['w_ffn1_gate'], p['w_ffn1_up'], p['w_ffn1_down']), p['g_ffn1_post'])
    m, nba, nbb, hl = _mixer(_rmsnorm(x, p['g_mix_pre']), buf_a, buf_b, h0, p)
    x = x + _rmsnorm(m, p['g_mix_post'])
    x = x + 0.5 * _rmsnorm(_swiglu(_rmsnorm(x, p['g_ffn2_pre']), p['w_ffn2_gate'], p['w_ffn2_up'], p['w_ffn2_down']), p['g_ffn2_post'])
    return x, nba, nbb, hl


def setup_inputs(seed: int = 0) -> dict:
    key = jax.random.key(seed)
    ks = iter(jax.random.split(key, 40))
    f32 = jnp.float32

    def nrm(shape, scale):
        return jax.random.normal(next(ks), shape, f32) * scale

    def gain(shape):
        return 1.0 + 0.05 * jax.random.normal(next(ks), shape, f32)

    L = DEPTH
    ac = jax.random.uniform(next(ks), (L, D_RNN), f32, 0.9, 0.999)
    a0 = ac ** (1.0 / RG_C)
    lam = jnp.log(a0) - jnp.log1p(-a0)
    return {
        'x_prompt': nrm((BATCH, SEQ, D_MODEL), 1.0),
        'x_sample': nrm((DEC_BATCH, DEC_SEQ, D_MODEL), 1.0),
        'state_conv_a': nrm((L, DEC_BATCH, CONV_A_W - 1, D_CONV), 1.0),
        'state_conv_b': nrm((L, DEC_BATCH, CONV_B_W - 1, D_RNN), 1.0),
        'state_rglru': nrm((L, DEC_BATCH, D_RNN), 0.5),
        'meta_tokens': nrm((N_META, D_MODEL), 1.0),
        'g_ffn1_pre': gain((L, D_MODEL)),
        'g_ffn1_post': gain((L, D_MODEL)),
        'w_ffn1_gate': nrm((L, D_MODEL, D_FF), D_MODEL ** -0.5),
        'w_ffn1_up': nrm((L, D_MODEL, D_FF), D_MODEL ** -0.5),
        'w_ffn1_down': nrm((L, D_FF, D_MODEL), D_FF ** -0.5),
        'g_mix_pre': gain((L, D_MODEL)),
        'g_mix_post': gain((L, D_MODEL)),
        'w_in': nrm((L, D_MODEL, D_IN), D_MODEL ** -0.5),
        'conv_a_w': nrm((L, CONV_A_W, D_CONV), CONV_A_W ** -0.5),
        'w_out_a': nrm((L, D_CONV, D_MODEL), D_CONV ** -0.5),
        'conv_b_w': nrm((L, CONV_B_W, D_RNN), CONV_B_W ** -0.5),
        'conv_b_b': nrm((L, D_RNN), 0.02),
        'w_rg_r': nrm((L, N_RNN_HEADS, RNN_HEAD_DIM, RNN_HEAD_DIM), RNN_HEAD_DIM ** -0.5),
        'b_rg_r': nrm((L, D_RNN), 0.02),
        'w_rg_i': nrm((L, N_RNN_HEADS, RNN_HEAD_DIM, RNN_HEAD_DIM), RNN_HEAD_DIM ** -0.5),
        'b_rg_i': nrm((L, D_RNN), 0.02),
        'rg_lambda': lam,
        'w_out_b': nrm((L, D_RNN, D_MODEL), D_RNN ** -0.5),
        'w_o': nrm((L, D_MODEL, D_MODEL), D_MODEL ** -0.5),
        'g_ffn2_pre': gain((L, D_MODEL)),
        'g_ffn2_post': gain((L, D_MODEL)),
        'w_ffn2_gate': nrm((L, D_MODEL, D_FF), D_MODEL ** -0.5),
        'w_ffn2_up': nrm((L, D_MODEL, D_FF), D_MODEL ** -0.5),
        'w_ffn2_down': nrm((L, D_FF, D_MODEL), D_FF ** -0.5),
    }


def reference(x_prompt, x_sample, state_conv_a, state_conv_b, state_rglru, meta_tokens,
              g_ffn1_pre, g_ffn1_post, w_ffn1_gate, w_ffn1_up, w_ffn1_down,
              g_mix_pre, g_mix_post, w_in, conv_a_w, w_out_a, conv_b_w, conv_b_b,
              w_rg_r, b_rg_r, w_rg_i, b_rg_i, rg_lambda, w_out_b, w_o,
              g_ffn2_pre, g_ffn2_post, w_ffn2_gate, w_ffn2_up, w_ffn2_down):
    Bp = x_prompt.shape[0]
    meta = jnp.broadcast_to(meta_tokens.astype(x_prompt.dtype)[None], (Bp, N_META, D_MODEL))
    xp = jnp.concatenate([meta, x_prompt], axis=1)
    xs = x_sample
    pa, pb, ph, sa, sb, sh = [], [], [], [], [], []
    for l in range(DEPTH):
        p = {
            'g_ffn1_pre': g_ffn1_pre[l], 'g_ffn1_post': g_ffn1_post[l],
            'w_ffn1_gate': w_ffn1_gate[l], 'w_ffn1_up': w_ffn1_up[l], 'w_ffn1_down': w_ffn1_down[l],
            'g_mix_pre': g_mix_pre[l], 'g_mix_post': g_mix_post[l], 'w_in': w_in[l],
            'conv_a_w': conv_a_w[l], 'w_out_a': w_out_a[l], 'conv_b_w': conv_b_w[l], 'conv_b_b': conv_b_b[l],
            'w_rg_r': w_rg_r[l], 'b_rg_r': b_rg_r[l], 'w_rg_i': w_rg_i[l], 'b_rg_i': b_rg_i[l],
            'rg_lambda': rg_lambda[l], 'w_out_b': w_out_b[l], 'w_o': w_o[l],
            'g_ffn2_pre': g_ffn2_pre[l], 'g_ffn2_post': g_ffn2_post[l],
            'w_ffn2_gate': w_ffn2_gate[l], 'w_ffn2_up': w_ffn2_up[l], 'w_ffn2_down': w_ffn2_down[l],
        }
        za = jnp.zeros((Bp, CONV_A_W - 1, D_CONV), xp.dtype)
        zb = jnp.zeros((Bp, CONV_B_W - 1, D_RNN), xp.dtype)
        zh = jnp.zeros((Bp, D_RNN), jnp.float32)
        xp, nba, nbb, nh = _layer(xp, za, zb, zh, p)
        pa.append(nba.astype(state_conv_a.dtype))
        pb.append(nbb.astype(state_conv_b.dtype))
        ph.append(nh.astype(state_rglru.dtype))
        xs, nba, nbb, nh = _layer(xs, state_conv_a[l], state_conv_b[l], state_rglru[l].astype(jnp.float32), p)
        sa.append(nba.astype(state_conv_a.dtype))
        sb.append(nbb.astype(state_conv_b.dtype))
        sh.append(nh.astype(state_rglru.dtype))
    y_prompt = xp[:, N_META:]
    y_sample = xs
    return (y_prompt, y_sample, jnp.stack(pa), jnp.stack(pb), jnp.stack(ph), jnp.stack(sa), jnp.stack(sb), jnp.stack(sh))
```

```cpp
#include <hip/hip_runtime.h>
#include <hip/hip_cooperative_groups.h>
#include <cstdio>
namespace cg = cooperative_groups;

#ifndef SINGLE_LAUNCH
#define SINGLE_LAUNCH 1
#endif

#define LAS __attribute__((address_space(3)))
typedef unsigned short bf16_t;
typedef short bf16x8 __attribute__((ext_vector_type(8)));
typedef float f32x4 __attribute__((ext_vector_type(4)));
typedef unsigned u32x4 __attribute__((ext_vector_type(4)));
typedef unsigned u32x2 __attribute__((ext_vector_type(2)));

constexpr int D = 1024, DFF = 2816, DIN = 7168;
constexpr int NB = 8, SEQ = 2048, NMETA = 16, TP = SEQ + NMETA;
constexpr int MP = NB * TP;
constexpr int NS = 128;
constexpr int M = MP + NS;
constexpr int CHUNK = 48, NCH = TP / CHUNK;
constexpr float EPS = 1e-6f;

constexpr size_t O_YP = 0, O_YS = 16777216, O_CAP = O_YS + 131072, O_CBP = O_CAP + 16384, O_RGP = O_CBP + 24576,
                 O_CAS = O_RGP + 8192, O_CBS = O_CAS + 262144, O_RGS = O_CBS + 393216;

constexpr size_t SLOT = (size_t)M * D;
constexpr size_t SB = SLOT * 2;
constexpr size_t WS_U = 0;
constexpr size_t WS_ACT = 0;
constexpr size_t WS_Y = 3 * SB;
constexpr size_t WS_TMP = 1 * SB;
constexpr size_t WS_WGU = 5 * SB;
constexpr size_t WS_WD = WS_WGU + (size_t)5632 * 1024 * 2;
constexpr size_t WS_H = 6 * SB;
constexpr size_t WS_WIN = 7 * SB;
constexpr size_t WS_WOAB = WS_WIN + (size_t)7168 * 1024 * 2;
constexpr size_t WS_WO = WS_WOAB + (size_t)2 * 1024 * 1024 * 2;
constexpr size_t WS_WRG = WS_WO + (size_t)1024 * 1024 * 2;
constexpr size_t WS_SUMM = WS_WRG + (size_t)2 * 16 * 64 * 64 * 2;
constexpr size_t WS_XMETA = WS_SUMM + (size_t)NB * NCH * D * 2 * 4;
constexpr size_t WS_END = WS_XMETA + (size_t)NB * NMETA * D * 4;
static_assert(WS_END <= (size_t)256 * 1024 * 1024, "workspace");

struct Params { const float* in[30]; float* out; unsigned char* ws; };

__device__ __forceinline__ unsigned cvt_pk_bf16(float lo, float hi) { unsigned r; asm volatile("v_cvt_pk_bf16_f32 %0, %1, %2" : "=v"(r) : "v"(lo), "v"(hi)); return r; }
__device__ __forceinline__ bf16_t f2bf(float f) { return (bf16_t)(cvt_pk_bf16(f, 0.f) & 0xffffu); }
__device__ __forceinline__ float bf2f(bf16_t b) { return __uint_as_float(((unsigned)b) << 16); }
__device__ __forceinline__ float bflo(unsigned w) { return __uint_as_float(w << 16); }
__device__ __forceinline__ float bfhi(unsigned w) { return __uint_as_float(w & 0xffff0000u); }
__device__ __forceinline__ float sigm(float x) { return __builtin_amdgcn_rcpf(1.0f + __expf(-x)); }
__device__ __forceinline__ float gelu_tanh(float x) { const float t = 1.5957691216057308f * (x + 0.044715f * x * x * x); return x * sigm(t); }
__device__ __forceinline__ float wave_sum(float v) {
#pragma unroll
    for (int o = 32; o >= 1; o >>= 1) v += __shfl_xor(v, o);
    return v;
}
__device__ __forceinline__ float* xrow(const Params& p, int r) {
    if (r >= MP) return p.out + O_YS + (size_t)(r - MP) * D;
    const int b = r / TP, t = r - b * TP;
    if (t < NMETA) return (float*)(p.ws + WS_XMETA) + (size_t)(b * NMETA + t) * D;
    return p.out + O_YP + ((size_t)b * SEQ + (t - NMETA)) * D;
}
__device__ __forceinline__ const float* x0row(const Params& p, int r) {
    if (r >= MP) return p.in[1] + (size_t)(r - MP) * D;
    const int b = r / TP, t = r - b * TP;
    if (t < NMETA) return p.in[5] + (size_t)t * D;
    return p.in[0] + ((size_t)b * SEQ + (t - NMETA)) * D;
}

namespace pg8 {
constexpr int BM = 256, BK = 64, HALF = 128, HTB = HALF * BK * 2, STAGE_BYTES = 8 * HTB, NXCD = 8, WGM = 8;
__host__ __device__ __forceinline__ int lds_byte(int r, int c) { const int st = (r >> 4) * 2 + (c >> 5), rr = r & 15, cc = c & 31, ob = rr * 64 + cc * 2; return st * 1024 + (ob ^ (((ob >> 9) & 1) << 5)); }
__host__ __device__ __forceinline__ void stage_rc(int b, int& R, int& C) { const int st = b / 1024, sb = b % 1024, swz = sb ^ (((sb >> 9) & 1) << 5); R = (st >> 1) * 16 + swz / 64; C = (st & 1) * 32 + (swz % 64) / 2; }
__host__ __device__ __forceinline__ int perm32(int rho) { const int n = rho >> 4, i = rho & 15; return 8 * (i >> 2) + 4 * n + (i & 3); }

struct Unit { int pm, pn, z; };
struct Gemm { const bf16_t* A; const bf16_t* Bt; int M, N, K; size_t zA, zB; };

struct StaticOrder {
    int nM, nN, nwg, G, c;
    __device__ void init(int M_, int N_, int G_, int c_) { nM = M_ / BM; nN = N_ / BM; nwg = nM * nN; G = G_; c = c_; }
    __device__ bool next(int i, Unit& u) const {
        const long L = (long)i * G + c; if (L >= nwg) return false;
        int wgid = (int)L; { const int q = nwg / NXCD, r = nwg % NXCD, xcd = wgid % NXCD, off = wgid / NXCD; wgid = (xcd < r ? xcd * (q + 1) : r * (q + 1) + (xcd - r) * q) + off; }
        const int nig = WGM * nN, gid = wgid / nig, fm = gid * WGM, gsz = (nM - fm) < WGM ? (nM - fm) : WGM;
        u.pm = fm + ((wgid % nig) % gsz); u.pn = (wgid % nig) / gsz; u.z = 0; return true;
    }
};
struct PairOrder : StaticOrder {
    __device__ bool next(int i, Unit& u) const { const bool ok = StaticOrder::next(i >> 1, u); u.z = i & 1; return ok; }
};

template <class Epi, class Sched>
__device__ __forceinline__ void gemm_phase(LAS unsigned char* lds, const Gemm g, const Sched& S, const Epi& E) {
    int tid_ = threadIdx.x; asm volatile("" : "+v"(tid_));
    const int tid = tid_, wid = __builtin_amdgcn_readfirstlane(tid >> 6), lane = tid & 63, wr = wid >> 2, wc = wid & 3, fr = lane & 15, fq = lane >> 4;
    const int K = g.K, nt = K / BK;
    unsigned voffA[2], voffB[2];
#pragma unroll
    for (int i = 0; i < 2; ++i) { int R, C; stage_rc(tid * 16 + i * 8192, R, C); const int Rb = Epi::PERM ? ((R & ~31) + perm32(R & 31)) : R;
        voffA[i] = (unsigned)(R * K + C) * 2u; voffB[i] = (unsigned)(Rb * K + C) * 2u; }
    const size_t kstep = (size_t)(BK * 2);
    const size_t hstep = (size_t)HALF * K * 2;
    const size_t tstep = 2 * hstep;
    const unsigned ldsw = (unsigned)wid * 1024u;
    const int aoff = lds_byte(wr * 64 + fr, fq * 8), boff = lds_byte(wc * 32 + fr, fq * 8);
#define PG8_SA(b, h) (((b) * 2 + (h)) * HTB)
#define PG8_SB(b, h) ((4 + (b) * 2 + (h)) * HTB)
#define PG8_STAGE(bufoff, gbase, voff) do { _Pragma("unroll") for (int _i = 0; _i < 2; ++_i) \
        __builtin_amdgcn_global_load_lds((const unsigned*)((const char*)(gbase) + (voff)[_i]), (LAS unsigned*)(lds + (bufoff) + ldsw + _i * 8192), 16, 0, 0); } while (0)
#define PG8_LDA(dst, b, h) do { _Pragma("unroll") for (int m = 0; m < 4; ++m) _Pragma("unroll") for (int k = 0; k < 2; ++k) dst[m][k] = *(const LAS bf16x8*)(lds + PG8_SA(b, h) + aoff + m * 2048 + k * 1024); } while (0)
#define PG8_LDB(dst, b, h) do { _Pragma("unroll") for (int n = 0; n < 2; ++n) _Pragma("unroll") for (int k = 0; k < 2; ++k) dst[n][k] = *(const LAS bf16x8*)(lds + PG8_SB(b, h) + boff + n * 2048 + k * 1024); } while (0)
#define PG8_MMA(ai, bj, At, Bt) do { __builtin_amdgcn_s_setprio(1); _Pragma("unroll") for (int m = 0; m < 4; ++m) _Pragma("unroll") for (int n = 0; n < 2; ++n) _Pragma("unroll") for (int k = 0; k < 2; ++k) \
        acc[ai][bj][m][n] = __builtin_amdgcn_mfma_f32_16x16x32_bf16(Bt[n][k], At[m][k], acc[ai][bj][m][n], 0, 0, 0); __builtin_amdgcn_s_setprio(0); } while (0)
#define PG8_WAIT_V(n) asm volatile("s_waitcnt vmcnt(" #n ")" ::: "memory")
#define PG8_WAIT_L(n) asm volatile("s_waitcnt lgkmcnt(" #n ")" ::: "memory")
#define PG8_BAR __builtin_amdgcn_s_barrier()
#define PG8_SCHED __builtin_amdgcn_sched_barrier(0)
    Unit cur, nxt; int ui = 0;
    if (!S.next(0, cur)) return;
    f32x4 acc[2][2][4][2];
#pragma unroll
    for (int a = 0; a < 2; ++a)
#pragma unroll
        for (int b = 0; b < 2; ++b)
#pragma unroll
            for (int m = 0; m < 4; ++m)
#pragma unroll
                for (int n = 0; n < 2; ++n) acc[a][b][m][n] = (f32x4){0.f, 0.f, 0.f, 0.f};
    bf16x8 At[4][2], B0[2][2], B1[2][2];
    const char* cA = (const char*)g.A + (size_t)cur.z * g.zA + (size_t)cur.pm * tstep; const char* cB = (const char*)g.Bt + (size_t)cur.z * g.zB + (size_t)cur.pn * tstep;
    PG8_STAGE(PG8_SB(0, 0), cB, voffB); PG8_STAGE(PG8_SA(0, 0), cA, voffA); PG8_STAGE(PG8_SB(0, 1), cB + hstep, voffB); PG8_STAGE(PG8_SA(0, 1), cA + hstep, voffA);
    if (wr == 1) PG8_BAR;
    PG8_WAIT_V(4); PG8_BAR;
    PG8_STAGE(PG8_SB(1, 0), cB + kstep, voffB); PG8_STAGE(PG8_SA(1, 0), cA + kstep, voffA); PG8_STAGE(PG8_SB(1, 1), cB + hstep + kstep, voffB);
    PG8_WAIT_V(6); PG8_BAR;
    for (;;) {
        const bool has_next = S.next(ui + 1, nxt);
        const char* nA = has_next ? (const char*)g.A + (size_t)nxt.z * g.zA + (size_t)nxt.pm * tstep : cA; const char* nB = has_next ? (const char*)g.Bt + (size_t)nxt.z * g.zB + (size_t)nxt.pn * tstep : cB;
        for (int t = 0; t < nt; t += 2) {
            const bool last = (t == nt - 2);
            const char* a1 = cA + (size_t)(t + 1) * kstep;
            const char* a2 = last ? nA : cA + (size_t)(t + 2) * kstep; const char* b2 = last ? nB : cB + (size_t)(t + 2) * kstep;
            const char* a3 = a2 + kstep; const char* b3 = b2 + kstep;
            PG8_LDB(B0, 0, 0); PG8_SCHED; PG8_LDA(At, 0, 0); PG8_STAGE(PG8_SA(1, 1), a1 + hstep, voffA);
            PG8_WAIT_L(8); PG8_BAR; PG8_WAIT_L(0); PG8_MMA(0, 0, At, B0); PG8_BAR; PG8_SCHED;
            PG8_LDB(B1, 0, 1); PG8_STAGE(PG8_SB(0, 0), b2, voffB);
            PG8_BAR; PG8_WAIT_L(0); PG8_MMA(0, 1, At, B1); PG8_BAR;
            PG8_LDA(At, 0, 1); PG8_STAGE(PG8_SA(0, 0), a2, voffA);
            PG8_BAR; PG8_WAIT_L(0); PG8_MMA(1, 0, At, B0); PG8_BAR; PG8_SCHED;
            PG8_STAGE(PG8_SB(0, 1), b2 + hstep, voffB);
            PG8_WAIT_V(6); PG8_BAR; PG8_MMA(1, 1, At, B1); PG8_BAR;
            PG8_LDB(B0, 1, 0); PG8_SCHED; PG8_LDA(At, 1, 0); PG8_STAGE(PG8_SA(0, 1), a2 + hstep, voffA);
            PG8_WAIT_L(8); PG8_BAR; PG8_WAIT_L(0); PG8_MMA(0, 0, At, B0); PG8_BAR; PG8_SCHED;
            PG8_LDB(B1, 1, 1); PG8_STAGE(PG8_SB(1, 0), b3, voffB);
            PG8_BAR; PG8_WAIT_L(0); PG8_MMA(0, 1, At, B1); PG8_BAR;
            PG8_LDA(At, 1, 1); PG8_STAGE(PG8_SA(1, 0), a3, voffA);
            PG8_BAR; PG8_WAIT_L(0); PG8_MMA(1, 0, At, B0); PG8_BAR; PG8_SCHED;
            PG8_STAGE(PG8_SB(1, 1), b3 + hstep, voffB);
            PG8_WAIT_V(6); PG8_BAR; PG8_MMA(1, 1, At, B1); PG8_BAR;
        }
        E(acc, cur, wr, wc, fr, fq);
        if (!has_next) break;
#pragma unroll
        for (int a = 0; a < 2; ++a)
#pragma unroll
            for (int b = 0; b < 2; ++b)
#pragma unroll
                for (int m = 0; m < 4; ++m)
#pragma unroll
                    for (int n = 0; n < 2; ++n) acc[a][b][m][n] = (f32x4){0.f, 0.f, 0.f, 0.f};
        cur = nxt; cA = nA; cB = nB; ++ui;
    }
    PG8_WAIT_V(0);
    if (wr == 0) PG8_BAR;
    PG8_BAR;
#undef PG8_SA
#undef PG8_SB
#undef PG8_STAGE
#undef PG8_LDA
#undef PG8_LDB
#undef PG8_MMA
#undef PG8_WAIT_V
#undef PG8_WAIT_L
#undef PG8_BAR
#undef PG8_SCHED
}

struct EpiF32 {
    static constexpr bool PERM = false;
    float* C;
    __device__ __forceinline__ void operator()(const f32x4 (&acc)[2][2][4][2], const Unit& u, int wr, int wc, int fr, int fq) const {
        const int row0 = u.pm * BM + wr * 64 + fr, col0 = u.pn * BM + wc * 32 + 4 * fq;
#pragma unroll
        for (int ai = 0; ai < 2; ++ai)
#pragma unroll
            for (int m = 0; m < 4; ++m) { float* rowp = C + (size_t)(row0 + ai * HALF + m * 16) * D + col0;
#pragma unroll
                for (int bj = 0; bj < 2; ++bj)
#pragma unroll
                    for (int n = 0; n < 2; ++n) *(f32x4*)(rowp + bj * HALF + n * 16) = acc[ai][bj][m][n]; }
    }
};
struct EpiGU {
    static constexpr bool PERM = true;
    bf16_t* O;
    __device__ __forceinline__ void operator()(const f32x4 (&acc)[2][2][4][2], const Unit& u, int wr, int wc, int fr, int fq) const {
        const int row0 = u.pm * BM + wr * 64 + fr, col0 = u.pn * HALF + wc * 32 + 8 * fq;
#pragma unroll
        for (int ai = 0; ai < 2; ++ai)
#pragma unroll
            for (int m = 0; m < 4; ++m) { bf16_t* rowp = O + (size_t)(row0 + ai * HALF + m * 16) * DFF + col0;
                float v[8];
#pragma unroll
                for (int n = 0; n < 2; ++n)
#pragma unroll
                    for (int j = 0; j < 4; ++j) { const float gt = acc[ai][0][m][n][j], up = acc[ai][1][m][n][j]; v[n * 4 + j] = gt * sigm(gt) * up; }
                u32x4 w; w.x = cvt_pk_bf16(v[0], v[1]); w.y = cvt_pk_bf16(v[2], v[3]); w.z = cvt_pk_bf16(v[4], v[5]); w.w = cvt_pk_bf16(v[6], v[7]);
                *(u32x4*)rowp = w; }
    }
};
struct EpiIN {
    static constexpr bool PERM = true;
    bf16_t* U;
    __device__ __forceinline__ void operator()(const f32x4 (&acc)[2][2][4][2], const Unit& u, int wr, int wc, int fr, int fq) const {
        const int row0 = u.pm * BM + wr * 64 + fr;
        if (u.pn >= 4 && u.pn < 12) {
            const int col0 = (u.pn - 4) * HALF + wc * 32 + 8 * fq; bf16_t* base = U + SLOT;
#pragma unroll
            for (int ai = 0; ai < 2; ++ai)
#pragma unroll
                for (int m = 0; m < 4; ++m) { bf16_t* rowp = base + (size_t)(row0 + ai * HALF + m * 16) * D + col0;
                    const f32x4 v0 = acc[ai][0][m][0] * acc[ai][1][m][0], v1 = acc[ai][0][m][1] * acc[ai][1][m][1];
                    u32x4 w; w.x = cvt_pk_bf16(v0[0], v0[1]); w.y = cvt_pk_bf16(v0[2], v0[3]); w.z = cvt_pk_bf16(v1[0], v1[1]); w.w = cvt_pk_bf16(v1[2], v1[3]);
                    *(u32x4*)rowp = w; }
        } else {
            int slot, ct; if (u.pn < 4) { slot = 0; ct = u.pn; } else { slot = 2 + ((u.pn - 12) >> 2); ct = (u.pn - 12) & 3; }
            const int col0 = ct * BM + wc * 32 + 8 * fq; bf16_t* base = U + (size_t)slot * SLOT;
#pragma unroll
            for (int ai = 0; ai < 2; ++ai)
#pragma unroll
                for (int m = 0; m < 4; ++m) { bf16_t* rowp = base + (size_t)(row0 + ai * HALF + m * 16) * D + col0;
#pragma unroll
                    for (int bj = 0; bj < 2; ++bj) { const f32x4 v0 = acc[ai][bj][m][0], v1 = acc[ai][bj][m][1];
                        u32x4 w; w.x = cvt_pk_bf16(v0[0], v0[1]); w.y = cvt_pk_bf16(v0[2], v0[3]); w.z = cvt_pk_bf16(v1[0], v1[1]); w.w = cvt_pk_bf16(v1[2], v1[3]);
                        *(u32x4*)(rowp + bj * HALF) = w; } }
        }
    }
};
struct EpiOAB {
    static constexpr bool PERM = false;
    const bf16_t* GA; const bf16_t* GB; float* TMP; bf16_t* MG;
    __device__ __forceinline__ void operator()(const f32x4 (&acc)[2][2][4][2], const Unit& u, int wr, int wc, int fr, int fq) const {
        const int row0 = u.pm * BM + wr * 64 + fr, col0 = u.pn * BM + wc * 32 + 4 * fq;
        const bf16_t* G = u.z ? GB : GA;
#pragma unroll
        for (int ai = 0; ai < 2; ++ai)
#pragma unroll
            for (int m = 0; m < 4; ++m) { const size_t off = (size_t)(row0 + ai * HALF + m * 16) * D + col0;
#pragma unroll
                for (int bj = 0; bj < 2; ++bj)
#pragma unroll
                    for (int n = 0; n < 2; ++n) { const size_t o = off + bj * HALF + n * 16;
                        const u32x2 gw = *(const u32x2*)(G + o);
                        f32x4 v = acc[ai][bj][m][n];
                        v[0] *= sigm(bflo(gw.x)); v[1] *= sigm(bfhi(gw.x)); v[2] *= sigm(bflo(gw.y)); v[3] *= sigm(bfhi(gw.y));
                        if (u.z == 0) { *(f32x4*)(TMP + o) = v; }
                        else { const f32x4 t = *(const f32x4*)(TMP + o); v += t; u32x2 w; w.x = cvt_pk_bf16(v[0], v[1]); w.y = cvt_pk_bf16(v[2], v[3]); *(u32x2*)(MG + o) = w; } } }
    }
};
}

__device__ __forceinline__ int conv_map(int mode, int n) {
    if (mode == 0) return n;
    if (mode == 1) return 256 * (n >> 7) + (n & 127);
    if (mode == 2) return 256 * (n >> 7) + 128 + (n & 127);
    const int seg = n >> 10, j = n & 1023;
    if (seg == 0) return j;
    if (seg == 1) return 1024 + 256 * (j >> 7) + (j & 127);
    if (seg == 2) return 1024 + 256 * (j >> 7) + 128 + (j & 127);
    return 3072 + (seg - 3) * 1024 + j;
}
__device__ __forceinline__ void conv_tile(const float* __restrict__ src, int K, int N, bf16_t* __restrict__ dst, int mode, int tile, LAS float* sl, int tid) {
    const int ntn = N >> 6; const int tk = tile / ntn, tn = tile - tk * ntn; const int k0 = tk * 64, n0 = tn * 64;
#pragma unroll
    for (int q = 0; q < 2; ++q) { const int kr = (tid >> 4) + 32 * q; const f32x4 v = *(const f32x4*)(src + (size_t)(k0 + kr) * N + n0 + (tid & 15) * 4);
        LAS float* d = sl + kr * 65 + (tid & 15) * 4; d[0] = v[0]; d[1] = v[1]; d[2] = v[2]; d[3] = v[3]; }
    __syncthreads();
    const int n = tid >> 3, ko = (tid & 7) * 8;
    float f[8];
#pragma unroll
    for (int i = 0; i < 8; ++i) f[i] = sl[(ko + i) * 65 + n];
    u32x4 w; w.x = cvt_pk_bf16(f[0], f[1]); w.y = cvt_pk_bf16(f[2], f[3]); w.z = cvt_pk_bf16(f[4], f[5]); w.w = cvt_pk_bf16(f[6], f[7]);
    *(u32x4*)(dst + (size_t)conv_map(mode, n0 + n) * K + k0 + ko) = w;
    __syncthreads();
}
template <int II, int K, int N, int MODE>
__device__ __forceinline__ void conv_mat(const Params& p, size_t dst, LAS unsigned char* lds, int tid) {
    constexpr int ntiles = (K >> 6) * (N >> 6);
    for (int t = blockIdx.x; t < ntiles; t += gridDim.x) conv_tile(p.in[II], K, N, (bf16_t*)(p.ws + dst), MODE, t, (LAS float*)lds, tid);
}
__device__ __forceinline__ void convert_set0(const Params& p, LAS unsigned char* lds, int tid) {
    conv_mat<8, 1024, 2816, 1>(p, WS_WGU, lds, tid);
    conv_mat<9, 1024, 2816, 2>(p, WS_WGU, lds, tid);
    conv_mat<10, 2816, 1024, 0>(p, WS_WD, lds, tid);
    conv_mat<13, 1024, 7168, 3>(p, WS_WIN, lds, tid);
    conv_mat<15, 1024, 1024, 0>(p, WS_WOAB, lds, tid);
    conv_mat<23, 1024, 1024, 0>(p, WS_WOAB + (size_t)1024 * 1024 * 2, lds, tid);
    conv_mat<24, 1024, 1024, 0>(p, WS_WO, lds, tid);
}
__device__ __forceinline__ void convert_set1(const Params& p, LAS unsigned char* lds, int tid) {
    conv_mat<27, 1024, 2816, 1>(p, WS_WGU, lds, tid);
    conv_mat<28, 1024, 2816, 2>(p, WS_WGU, lds, tid);
    conv_mat<29, 2816, 1024, 0>(p, WS_WD, lds, tid);
}

__device__ __forceinline__ void norm_phase(const Params& p, int mode, int tid) {
    const int lane = tid & 63, gw = blockIdx.x * 8 + (tid >> 6), nw = gridDim.x * 8;
    const float* gpost = mode == 1 ? p.in[7] : (mode == 2 ? p.in[12] : p.in[26]);
    const float* gpre = mode == 0 ? p.in[6] : (mode == 1 ? p.in[11] : p.in[25]);
    const float cc = mode == 2 ? 1.0f : 0.5f;
    f32x4 gpo[4], gpr[4];
#pragma unroll
    for (int q = 0; q < 4; ++q) { gpo[q] = mode > 0 ? *(const f32x4*)(gpost + lane * 4 + 256 * q) : (f32x4){0.f, 0.f, 0.f, 0.f}; gpr[q] = mode < 3 ? *(const f32x4*)(gpre + lane * 4 + 256 * q) : (f32x4){0.f, 0.f, 0.f, 0.f}; }
    const float* Y = (const float*)(p.ws + WS_Y); bf16_t* H = (bf16_t*)(p.ws + WS_H);
    for (int r = gw; r < M; r += nw) {
        const float* xin = mode <= 1 ? x0row(p, r) : xrow(p, r);
        f32x4 xv[4];
#pragma unroll
        for (int q = 0; q < 4; ++q) xv[q] = *(const f32x4*)(xin + lane * 4 + 256 * q);
        if (mode > 0) {
            f32x4 yv[4]; float ss = 0.f;
#pragma unroll
            for (int q = 0; q < 4; ++q) { yv[q] = *(const f32x4*)(Y + (size_t)r * D + lane * 4 + 256 * q); ss += yv[q][0] * yv[q][0] + yv[q][1] * yv[q][1] + yv[q][2] * yv[q][2] + yv[q][3] * yv[q][3]; }
            ss = wave_sum(ss);
            const float rs = cc * rsqrtf(ss * (1.0f / D) + EPS);
#pragma unroll
            for (int q = 0; q < 4; ++q) xv[q] += yv[q] * rs * gpo[q];
            float* xo = xrow(p, r);
#pragma unroll
            for (int q = 0; q < 4; ++q) *(f32x4*)(xo + lane * 4 + 256 * q) = xv[q];
        }
        if (mode < 3) {
            float ss = 0.f;
#pragma unroll
            for (int q = 0; q < 4; ++q) ss += xv[q][0] * xv[q][0] + xv[q][1] * xv[q][1] + xv[q][2] * xv[q][2] + xv[q][3] * xv[q][3];
            ss = wave_sum(ss);
            const float rs = rsqrtf(ss * (1.0f / D) + EPS);
#pragma unroll
            for (int q = 0; q < 4; ++q) { const f32x4 hv = xv[q] * rs * gpr[q]; u32x2 w; w.x = cvt_pk_bf16(hv[0], hv[1]); w.y = cvt_pk_bf16(hv[2], hv[3]);
                *(u32x2*)(H + (size_t)r * D + lane * 4 + 256 * q) = w; }
        }
    }
}

constexpr int WL_BYTES = 11264;
template <bool FINAL>
__device__ __forceinline__ void scan_item(const Params& p, int b, int j, int h, LAS unsigned char* wl, int lane) {
    bf16_t* U = (bf16_t*)(p.ws + WS_U);
    const bf16_t* bx = U + 2 * SLOT; bf16_t* bg = U + 3 * SLOT;
    float* summ = (float*)(p.ws + WS_SUMM);
    const int c = h * 64 + lane, fr = lane & 15, fq = lane >> 4;
    const size_t row0 = (size_t)b * TP + (size_t)j * CHUNK;
    const bf16_t* wt = (const bf16_t*)(p.ws + WS_WRG);
    bf16x8 wR[4][2], wI[4][2];
#pragma unroll
    for (int nt = 0; nt < 4; ++nt)
#pragma unroll
        for (int kk = 0; kk < 2; ++kk) { const size_t o = (size_t)(h * 64 + nt * 16 + fr) * 64 + kk * 32 + fq * 8; wR[nt][kk] = *(const bf16x8*)(wt + o); wI[nt][kk] = *(const bf16x8*)(wt + 65536 + o); }
    float brv[4], biv[4], lcv[4];
#pragma unroll
    for (int nt = 0; nt < 4; ++nt) { const int ch = h * 64 + nt * 16 + fr; brv[nt] = p.in[19][ch]; biv[nt] = p.in[21][ch]; lcv[nt] = -8.0f * log1pf(expf(-p.in[22][ch])); }
    const float w0 = p.in[16][c], w1 = p.in[16][D + c], w2 = p.in[16][2 * D + c], w3 = p.in[16][3 * D + c], cbias = p.in[17][c];
    float xm3 = 0.f, xm2 = 0.f, xm1 = 0.f;
    if (j > 0) { xm3 = bf2f(bx[(row0 - 3) * D + c]); xm2 = bf2f(bx[(row0 - 2) * D + c]); xm1 = bf2f(bx[(row0 - 1) * D + c]); }
    float hh = 0.f, ap = 1.f;
    if (FINAL) {
        const float* sp = summ + ((size_t)b * NCH * D + c) * 2;
        for (int i0 = 0; i0 < j; i0 += 16) {
            float va[16], vh[16];
#pragma unroll
            for (int k = 0; k < 16; ++k) { if (i0 + k < j) { const float2 v = *(const float2*)(sp + (size_t)(i0 + k) * D * 2); va[k] = v.x; vh[k] = v.y; } else { va[k] = 1.f; vh[k] = 0.f; } }
#pragma unroll
            for (int k = 0; k < 16; ++k) hh = va[k] * hh + vh[k];
        }
    }
    LAS unsigned short* cbT = (LAS unsigned short*)wl;
    LAS float* xu = (LAS float*)(wl + 2304);
    LAS float* aS = (LAS float*)(wl + 2304 + 4352);
    for (int g = 0; g < 3; ++g) {
        const size_t r0 = row0 + (size_t)g * 16;
        bf16_t xr[16], gr[16];
#pragma unroll
        for (int tt = 0; tt < 16; ++tt) xr[tt] = bx[(r0 + tt) * D + c];
        if (FINAL) {
#pragma unroll
            for (int tt = 0; tt < 16; ++tt) gr[tt] = bg[(r0 + tt) * D + c];
        }
#pragma unroll
        for (int tt = 0; tt < 16; ++tt) { const float x = bf2f(xr[tt]); const float cb = w0 * xm3 + w1 * xm2 + w2 * xm1 + w3 * x + cbias; xm3 = xm2; xm2 = xm1; xm1 = x;
            cbT[tt * 72 + lane] = f2bf(cb); xu[tt * 68 + lane] = cb; }
        __builtin_amdgcn_wave_barrier();
        const bf16x8 a0 = *(const LAS bf16x8*)(cbT + fr * 72 + fq * 8), a1 = *(const LAS bf16x8*)(cbT + fr * 72 + 32 + fq * 8);
        f32x4 accR[4], accI[4];
#pragma unroll
        for (int nt = 0; nt < 4; ++nt) {
            accR[nt] = __builtin_amdgcn_mfma_f32_16x16x32_bf16(a0, wR[nt][0], (f32x4){0.f, 0.f, 0.f, 0.f}, 0, 0, 0);
            accR[nt] = __builtin_amdgcn_mfma_f32_16x16x32_bf16(a1, wR[nt][1], accR[nt], 0, 0, 0);
            accI[nt] = __builtin_amdgcn_mfma_f32_16x16x32_bf16(a0, wI[nt][0], (f32x4){0.f, 0.f, 0.f, 0.f}, 0, 0, 0);
            accI[nt] = __builtin_amdgcn_mfma_f32_16x16x32_bf16(a1, wI[nt][1], accI[nt], 0, 0, 0);
        }
#pragma unroll
        for (int nt = 0; nt < 4; ++nt)
#pragma unroll
            for (int i = 0; i < 4; ++i) { const int idx = (fq * 4 + i) * 68 + nt * 16 + fr; const float x = xu[idx];
                const float r = sigm(accR[nt][i] + brv[nt]), ig = sigm(accI[nt][i] + biv[nt]);
                const float la = lcv[nt] * r; const float a = expf(la); const float mult = sqrtf(-expm1f(2.0f * la));
                xu[idx] = mult * ig * x; aS[idx] = a; }
        __builtin_amdgcn_wave_barrier();
#pragma unroll
        for (int tt = 0; tt < 16; ++tt) { const float a = aS[tt * 68 + lane], uu = xu[tt * 68 + lane]; hh = a * hh + uu;
            if (!FINAL) ap *= a; else bg[(r0 + tt) * D + c] = f2bf(gelu_tanh(bf2f(gr[tt])) * hh); }
        __builtin_amdgcn_wave_barrier();
    }
    if (!FINAL) { *(float2*)(summ + (((size_t)b * NCH + j) * D + c) * 2) = make_float2(ap, hh); }
    else if (j == NCH - 1) { p.out[O_RGP + (size_t)b * D + c] = hh; p.out[O_CBP + ((size_t)b * 3 + 0) * D + c] = xm3; p.out[O_CBP + ((size_t)b * 3 + 1) * D + c] = xm2; p.out[O_CBP + ((size_t)b * 3 + 2) * D + c] = xm1; }
}
template <bool FINAL>
__device__ __forceinline__ void scan_phase(const Params& p, LAS unsigned char* lds, int tid) {
    const int wid = tid >> 6, lane = tid & 63;
    LAS unsigned char* wl = lds + wid * WL_BYTES;
    for (int it = blockIdx.x * 8 + wid; it < NB * NCH * 16; it += gridDim.x * 8) { const int h = it & 15, bj = it >> 4; scan_item<FINAL>(p, bj / NCH, bj % NCH, h, wl, lane); }
}
__device__ __forceinline__ void za_phase(const Params& p, int tid) {
    bf16_t* U = (bf16_t*)(p.ws + WS_U); bf16_t* ab = U; const bf16_t* ca = U + SLOT;
    const float* cw = p.in[14];
    for (int idx = blockIdx.x * 512 + tid; idx < NB * 129 * 128; idx += gridDim.x * 512) {
        const int vc = idx & 127, tb = (idx >> 7) % 129, b = idx / (128 * 129); const int c0 = vc * 8;
        float w[3][8];
#pragma unroll
        for (int k = 0; k < 3; ++k) { const f32x4 a = *(const f32x4*)(cw + k * D + c0), bq = *(const f32x4*)(cw + k * D + c0 + 4);
#pragma unroll
            for (int e = 0; e < 4; ++e) { w[k][e] = a[e]; w[k][4 + e] = bq[e]; } }
        const size_t r0 = (size_t)b * TP + (size_t)tb * 16;
        float p2[8], p1[8];
        if (tb > 0) { const u32x4 q2 = *(const u32x4*)(ca + (r0 - 2) * D + c0), q1 = *(const u32x4*)(ca + (r0 - 1) * D + c0);
#pragma unroll
            for (int e = 0; e < 4; ++e) { p2[2 * e] = bflo(q2[e]); p2[2 * e + 1] = bfhi(q2[e]); p1[2 * e] = bflo(q1[e]); p1[2 * e + 1] = bfhi(q1[e]); } }
        else {
#pragma unroll
            for (int e = 0; e < 8; ++e) { p2[e] = 0.f; p1[e] = 0.f; } }
#pragma unroll 4
        for (int tt = 0; tt < 16; ++tt) {
            const u32x4 qc = *(const u32x4*)(ca + (r0 + tt) * D + c0), qa = *(const u32x4*)(ab + (r0 + tt) * D + c0);
            float cv[8], av[8], zv[8];
#pragma unroll
            for (int e = 0; e < 4; ++e) { cv[2 * e] = bflo(qc[e]); cv[2 * e + 1] = bfhi(qc[e]); av[2 * e] = bflo(qa[e]); av[2 * e + 1] = bfhi(qa[e]); }
#pragma unroll
            for (int e = 0; e < 8; ++e) { zv[e] = av[e] * (w[0][e] * p2[e] + w[1][e] * p1[e] + w[2][e] * cv[e]); p2[e] = p1[e]; p1[e] = cv[e]; }
            u32x4 o; o.x = cvt_pk_bf16(zv[0], zv[1]); o.y = cvt_pk_bf16(zv[2], zv[3]); o.z = cvt_pk_bf16(zv[4], zv[5]); o.w = cvt_pk_bf16(zv[6], zv[7]);
            *(u32x4*)(ab + (r0 + tt) * D + c0) = o;
        }
        if (tb == 128) {
            float* o2 = p.out + O_CAP + ((size_t)b * 2 + 0) * D + c0; float* o1 = p.out + O_CAP + ((size_t)b * 2 + 1) * D + c0;
            *(f32x4*)o2 = (f32x4){p2[0], p2[1], p2[2], p2[3]}; *(f32x4*)(o2 + 4) = (f32x4){p2[4], p2[5], p2[6], p2[7]};
            *(f32x4*)o1 = (f32x4){p1[0], p1[1], p1[2], p1[3]}; *(f32x4*)(o1 + 4) = (f32x4){p1[4], p1[5], p1[6], p1[7]};
        }
    }
}
__device__ __forceinline__ void sample_phase(const Params& p, LAS unsigned char* lds, int tid) {
    bf16_t* U = (bf16_t*)(p.ws + WS_U);
    LAS float* cbs = (LAS float*)lds;
    for (int it = blockIdx.x; it < NS / 4; it += gridDim.x) {
        for (int e = tid; e < 4 * D; e += 512) {
            const int s = it * 4 + (e >> 10), c = e & 1023; const size_t ro = (size_t)(MP + s) * D + c;
            const float cav = bf2f(U[SLOT + ro]), abv = bf2f(U[ro]);
            const float s0 = p.in[2][((size_t)s * 2 + 0) * D + c], s1 = p.in[2][((size_t)s * 2 + 1) * D + c];
            const float cva = p.in[14][c] * s0 + p.in[14][D + c] * s1 + p.in[14][2 * D + c] * cav;
            U[ro] = f2bf(abv * cva);
            p.out[O_CAS + ((size_t)s * 2 + 0) * D + c] = s1; p.out[O_CAS + ((size_t)s * 2 + 1) * D + c] = cav;
            const float bxv = bf2f(U[2 * SLOT + ro]);
            const float t0 = p.in[3][((size_t)s * 3 + 0) * D + c], t1 = p.in[3][((size_t)s * 3 + 1) * D + c], t2 = p.in[3][((size_t)s * 3 + 2) * D + c];
            const float cb = p.in[16][c] * t0 + p.in[16][D + c] * t1 + p.in[16][2 * D + c] * t2 + p.in[16][3 * D + c] * bxv + p.in[17][c];
            p.out[O_CBS + ((size_t)s * 3 + 0) * D + c] = t1; p.out[O_CBS + ((size_t)s * 3 + 1) * D + c] = t2; p.out[O_CBS + ((size_t)s * 3 + 2) * D + c] = bxv;
            cbs[e] = cb;
        }
        __syncthreads();
#pragma unroll 1
        for (int cq = 0; cq < 2; ++cq) {
            const int c = tid + cq * 512, h = c >> 6, jj = c & 63;
            float ar[4] = {0.f, 0.f, 0.f, 0.f}, ai[4] = {0.f, 0.f, 0.f, 0.f};
            const float* wr_ = p.in[18] + (size_t)h * 4096 + jj; const float* wi_ = p.in[20] + (size_t)h * 4096 + jj;
#pragma unroll 8
            for (int i = 0; i < 64; ++i) { const float wrv = wr_[i * 64], wiv = wi_[i * 64];
#pragma unroll
                for (int s = 0; s < 4; ++s) { const float x = cbs[s * D + h * 64 + i]; ar[s] += x * wrv; ai[s] += x * wiv; } }
            const float lc = -8.0f * log1pf(expf(-p.in[22][c])), brc = p.in[19][c], bic = p.in[21][c];
#pragma unroll
            for (int s = 0; s < 4; ++s) { const int sg = it * 4 + s; const size_t ro = (size_t)(MP + sg) * D + c;
                const float r = sigm(ar[s] + brc), ig = sigm(ai[s] + bic); const float la = lc * r; const float a = expf(la); const float mult = sqrtf(-expm1f(2.0f * la));
                const float hn = a * p.in[4][(size_t)sg * D + c] + mult * ig * cbs[s * D + c];
                p.out[O_RGS + (size_t)sg * D + c] = hn;
                U[3 * SLOT + ro] = f2bf(gelu_tanh(bf2f(U[3 * SLOT + ro])) * hn); }
        }
        __syncthreads();
    }
}

constexpr int NPHASE = 13;
constexpr int LDS_BYTES = 131072;
__global__ void __launch_bounds__(512, 2) mk_fwd(Params p, int ph_lo, int ph_hi) {
    extern __shared__ __attribute__((aligned(16))) unsigned char shm[];
    LAS unsigned char* lds = (LAS unsigned char*)shm;
    cg::grid_group grid = cg::this_grid();
    for (int ph = ph_lo; ph < ph_hi; ++ph) {
        int tid = threadIdx.x; asm volatile("" : "+v"(tid));
        if (ph == 0) {
            convert_set0(p, lds, tid);
            bf16_t* wt = (bf16_t*)(p.ws + WS_WRG);
            for (int o = blockIdx.x * 512 + tid; o < 2 * 65536; o += gridDim.x * 512) { const int g = o >> 16, h = (o >> 12) & 15, j = (o >> 6) & 63, i = o & 63;
                wt[o] = f2bf((g ? p.in[20] : p.in[18])[(size_t)(h * 64 + i) * 64 + j]); }
            norm_phase(p, 0, tid);
        } else if (ph == 1 || ph == 10) {
            pg8::Gemm g{(const bf16_t*)(p.ws + WS_H), (const bf16_t*)(p.ws + WS_WGU), M, 2 * DFF, D, 0, 0};
            pg8::StaticOrder S; S.init(M, 2 * DFF, gridDim.x, blockIdx.x);
            pg8::EpiGU E{(bf16_t*)(p.ws + WS_ACT)};
            pg8::gemm_phase(lds, g, S, E);
        } else if (ph == 2 || ph == 11 || ph == 8) {
            pg8::Gemm g{(const bf16_t*)(p.ws + (ph == 8 ? WS_H : WS_ACT)), (const bf16_t*)(p.ws + (ph == 8 ? WS_WO : WS_WD)), M, D, ph == 8 ? D : DFF, 0, 0};
            pg8::StaticOrder S; S.init(M, D, gridDim.x, blockIdx.x);
            pg8::EpiF32 E{(float*)(p.ws + WS_Y)};
            pg8::gemm_phase(lds, g, S, E);
        } else if (ph == 3) {
            norm_phase(p, 1, tid);
        } else if (ph == 4) {
            pg8::Gemm g{(const bf16_t*)(p.ws + WS_H), (const bf16_t*)(p.ws + WS_WIN), M, DIN, D, 0, 0};
            pg8::StaticOrder S; S.init(M, DIN, gridDim.x, blockIdx.x);
            pg8::EpiIN E{(bf16_t*)(p.ws + WS_U)};
            pg8::gemm_phase(lds, g, S, E);
        } else if (ph == 5) {
            scan_phase<false>(p, lds, tid);
            za_phase(p, tid);
        } else if (ph == 6) {
            sample_phase(p, lds, tid);
            scan_phase<true>(p, lds, tid);
        } else if (ph == 7) {
            pg8::Gemm g{(const bf16_t*)(p.ws + WS_U), (const bf16_t*)(p.ws + WS_WOAB), M, D, D, 3 * SB, (size_t)1024 * 1024 * 2};
            pg8::PairOrder S; S.init(M, D, gridDim.x, blockIdx.x);
            pg8::EpiOAB E{(const bf16_t*)(p.ws + WS_U) + 4 * SLOT, (const bf16_t*)(p.ws + WS_U) + 5 * SLOT, (float*)(p.ws + WS_TMP), (bf16_t*)(p.ws + WS_H)};
            pg8::gemm_phase(lds, g, S, E);
        } else if (ph == 9) {
            convert_set1(p, lds, tid);
            norm_phase(p, 2, tid);
        } else if (ph == 12) {
            norm_phase(p, 3, tid);
        }
        if (ph + 1 < ph_hi) grid.sync();
    }
}

extern "C" void kernel_launch(void* const* d_in, const int* in_sizes, int n_in, void* d_out, int out_size, void* d_ws, size_t ws_size, hipStream_t stream) {
    if (n_in != 30 || ws_size < WS_END) { fprintf(stderr, "kernel_launch: unexpected n_in %d / ws_size %zu (need %zu)\n", n_in, ws_size, (size_t)WS_END); return; }
    Params p{};
    for (int i = 0; i < 30; ++i) p.in[i] = (const float*)d_in[i];
    p.out = (float*)d_out; p.ws = (unsigned char*)d_ws;
    (void)hipFuncSetAttribute((const void*)mk_fwd, hipFuncAttributeMaxDynamicSharedMemorySize, LDS_BYTES);
    static int grid_blocks = 0;
    if (!grid_blocks) {
        int dev = 0, cus = 0, per_cu = 0;
        (void)hipGetDevice(&dev);
        (void)hipDeviceGetAttribute(&cus, hipDeviceAttributeMultiprocessorCount, dev);
        (void)hipOccupancyMaxActiveBlocksPerMultiprocessor(&per_cu, (const void*)mk_fwd, 512, LDS_BYTES);
        if (per_cu < 1) { fprintf(stderr, "kernel_launch: occupancy query says %d blocks/CU\n", per_cu); per_cu = 1; }
        grid_blocks = cus;
    }
#if SINGLE_LAUNCH
    int lo = 0, hi = NPHASE;
    void* args[] = {&p, &lo, &hi};
    hipError_t e = hipLaunchCooperativeKernel((const void*)mk_fwd, dim3(grid_blocks), dim3(512), args, LDS_BYTES, stream);
    if (e != hipSuccess) fprintf(stderr, "cooperative launch failed: %s (grid %d)\n", hipGetErrorString(e), grid_blocks);
#else
    for (int ph = 0; ph < NPHASE; ++ph) hipLaunchKernelGGL(mk_fwd, dim3(grid_blocks), dim3(512), LDS_BYTES, stream, p, ph, ph + 1);
#endif
}
```

```cpp
#include <hip/hip_runtime.h>
#include <hip/hip_cooperative_groups.h>
#include <cstdio>
namespace cg = cooperative_groups;

#ifndef REP_MASK
#define REP_MASK 0
#endif
#ifndef SINGLE_LAUNCH
#define SINGLE_LAUNCH 1
#endif

#define LAS __attribute__((address_space(3)))
typedef unsigned short bf16_t;
typedef short bf16x8 __attribute__((ext_vector_type(8)));
typedef float f32x4 __attribute__((ext_vector_type(4)));
typedef unsigned u32x4 __attribute__((ext_vector_type(4)));
typedef unsigned u32x2 __attribute__((ext_vector_type(2)));

constexpr int D = 1024, DFF = 2816, DIN = 7168;
constexpr int NB = 8, SEQ = 2048, NMETA = 16, TP = SEQ + NMETA;
constexpr int MP = NB * TP;
constexpr int NS = 128;
constexpr int M = MP + NS;
constexpr int CHUNK = 48, NCH = TP / CHUNK;
constexpr float EPS = 1e-6f;

constexpr size_t O_YP = 0, O_YS = 16777216, O_CAP = O_YS + 131072, O_CBP = O_CAP + 16384, O_RGP = O_CBP + 24576,
                 O_CAS = O_RGP + 8192, O_CBS = O_CAS + 262144, O_RGS = O_CBS + 393216;

constexpr size_t SLOT = (size_t)M * D;
constexpr size_t SB = SLOT * 2;
constexpr size_t WS_U = 0;
constexpr size_t WS_ACT = 0;
constexpr size_t WS_Y = 3 * SB;
constexpr size_t WS_WGU = 5 * SB;
constexpr size_t WS_WD = WS_WGU + (size_t)5632 * 1024 * 2;
constexpr size_t WS_H = 6 * SB;
constexpr size_t WS_WIN = 7 * SB;
constexpr size_t WS_WOAB = WS_WIN + (size_t)7168 * 1024 * 2;
constexpr size_t WS_WO = WS_WOAB + (size_t)2 * 1024 * 1024 * 2;
constexpr size_t WS_WRG = WS_WO + (size_t)1024 * 1024 * 2;
constexpr size_t WS_SUMM = WS_WRG + (size_t)2 * 16 * 64 * 64 * 2;
constexpr size_t WS_XMETA = WS_SUMM + (size_t)NB * NCH * D * 2 * 4;
constexpr size_t WS_END = WS_XMETA + (size_t)NB * NMETA * D * 4;
static_assert(WS_END <= (size_t)256 * 1024 * 1024, "workspace");

struct Params { const float* in[30]; float* out; unsigned char* ws; };

__device__ __forceinline__ unsigned cvt_pk_bf16(float lo, float hi) { unsigned r; asm volatile("v_cvt_pk_bf16_f32 %0, %1, %2" : "=v"(r) : "v"(lo), "v"(hi)); return r; }
__device__ __forceinline__ bf16_t f2bf(float f) { return (bf16_t)(cvt_pk_bf16(f, 0.f) & 0xffffu); }
__device__ __forceinline__ float bf2f(bf16_t b) { return __uint_as_float(((unsigned)b) << 16); }
__device__ __forceinline__ float bflo(unsigned w) { return __uint_as_float(w << 16); }
__device__ __forceinline__ float bfhi(unsigned w) { return __uint_as_float(w & 0xffff0000u); }
__device__ __forceinline__ float sigm(float x) { return __builtin_amdgcn_rcpf(1.0f + __expf(-x)); }
__device__ __forceinline__ float gelu_tanh(float x) { const float t = 1.5957691216057308f * (x + 0.044715f * x * x * x); return x * sigm(t); }
__device__ __forceinline__ float wave_sum(float v) {
#pragma unroll
    for (int o = 32; o >= 1; o >>= 1) v += __shfl_xor(v, o);
    return v;
}
__device__ __forceinline__ float* xrow(const Params& p, int r) {
    if (r >= MP) return p.out + O_YS + (size_t)(r - MP) * D;
    const int b = r / TP, t = r - b * TP;
    if (t < NMETA) return (float*)(p.ws + WS_XMETA) + (size_t)(b * NMETA + t) * D;
    return p.out + O_YP + ((size_t)b * SEQ + (t - NMETA)) * D;
}
__device__ __forceinline__ const float* x0row(const Params& p, int r) {
    if (r >= MP) return p.in[1] + (size_t)(r - MP) * D;
    const int b = r / TP, t = r - b * TP;
    if (t < NMETA) return p.in[5] + (size_t)t * D;
    return p.in[0] + ((size_t)b * SEQ + (t - NMETA)) * D;
}

namespace pg8 {
constexpr int BM = 256, BK = 64, HALF = 128, HTB = HALF * BK * 2, STAGE_BYTES = 8 * HTB, NXCD = 8, WGM = 8;
__host__ __device__ __forceinline__ int lds_byte(int r, int c) { const int st = (r >> 4) * 2 + (c >> 5), rr = r & 15, cc = c & 31, ob = rr * 64 + cc * 2; return st * 1024 + (ob ^ (((ob >> 9) & 1) << 5)); }
__host__ __device__ __forceinline__ void stage_rc(int b, int& R, int& C) { const int st = b / 1024, sb = b % 1024, swz = sb ^ (((sb >> 9) & 1) << 5); R = (st >> 1) * 16 + swz / 64; C = (st & 1) * 32 + (swz % 64) / 2; }
__host__ __device__ __forceinline__ int perm32(int rho) { const int n = rho >> 4, i = rho & 15; return 8 * (i >> 2) + 4 * n + (i & 3); }

struct Unit { int pm, pn, z; };
struct Gemm { const bf16_t* A; const bf16_t* Bt; int M, N, K; size_t zA, zB; };

struct StaticOrder {
    int nM, nN, nwg, G, c;
    __device__ void init(int M_, int N_, int G_, int c_) { nM = M_ / BM; nN = N_ / BM; nwg = nM * nN; G = G_; c = c_; }
    __device__ bool next(int i, Unit& u) const {
        const long L = (long)i * G + c; if (L >= nwg) return false;
        int wgid = (int)L; { const int q = nwg / NXCD, r = nwg % NXCD, xcd = wgid % NXCD, off = wgid / NXCD; wgid = (xcd < r ? xcd * (q + 1) : r * (q + 1) + (xcd - r) * q) + off; }
        const int nig = WGM * nN, gid = wgid / nig, fm = gid * WGM, gsz = (nM - fm) < WGM ? (nM - fm) : WGM;
        u.pm = fm + ((wgid % nig) % gsz); u.pn = (wgid % nig) / gsz; u.z = 0; return true;
    }
};
struct VirtOrder : StaticOrder {
    __device__ bool next(int i, Unit& u) const { const bool ok = StaticOrder::next(i, u); u.z = u.pn >> 2; u.pn &= 3; return ok; }
};

template <class Epi, class Sched>
__device__ __forceinline__ void gemm_phase(LAS unsigned char* lds, const Gemm g, const Sched& S, const Epi& E) {
    int tid_ = threadIdx.x; asm volatile("" : "+v"(tid_));
    const int tid = tid_, wid = __builtin_amdgcn_readfirstlane(tid >> 6), lane = tid & 63, wr = wid >> 2, wc = wid & 3, fr = lane & 15, fq = lane >> 4;
    const int K = g.K, nt = K / BK;
    unsigned voffA[2], voffB[2];
#pragma unroll
    for (int i = 0; i < 2; ++i) { int R, C; stage_rc(tid * 16 + i * 8192, R, C); const int Rb = Epi::PERM ? ((R & ~31) + perm32(R & 31)) : R;
        voffA[i] = (unsigned)(R * K + C) * 2u; voffB[i] = (unsigned)(Rb * K + C) * 2u; }
    const size_t kstep = (size_t)(BK * 2);
    const size_t hstep = (size_t)HALF * K * 2;
    const size_t tstep = 2 * hstep;
    const unsigned ldsw = (unsigned)wid * 1024u;
    const int aoff = lds_byte(wr * 64 + fr, fq * 8), boff = lds_byte(wc * 32 + fr, fq * 8);
#define PG8_SA(b, h) (((b) * 2 + (h)) * HTB)
#define PG8_SB(b, h) ((4 + (b) * 2 + (h)) * HTB)
#define PG8_STAGE(bufoff, gbase, voff) do { _Pragma("unroll") for (int _i = 0; _i < 2; ++_i) \
        __builtin_amdgcn_global_load_lds((const unsigned*)((const char*)(gbase) + (voff)[_i]), (LAS unsigned*)(lds + (bufoff) + ldsw + _i * 8192), 16, 0, 0); } while (0)
#define PG8_LDA(dst, b, h) do { _Pragma("unroll") for (int m = 0; m < 4; ++m) _Pragma("unroll") for (int k = 0; k < 2; ++k) dst[m][k] = *(const LAS bf16x8*)(lds + PG8_SA(b, h) + aoff + m * 2048 + k * 1024); } while (0)
#define PG8_LDB(dst, b, h) do { _Pragma("unroll") for (int n = 0; n < 2; ++n) _Pragma("unroll") for (int k = 0; k < 2; ++k) dst[n][k] = *(const LAS bf16x8*)(lds + PG8_SB(b, h) + boff + n * 2048 + k * 1024); } while (0)
#define PG8_MMA(ai, bj, At, Bt) do { __builtin_amdgcn_s_setprio(1); _Pragma("unroll") for (int m = 0; m < 4; ++m) _Pragma("unroll") for (int n = 0; n < 2; ++n) _Pragma("unroll") for (int k = 0; k < 2; ++k) \
        acc[ai][bj][m][n] = __builtin_amdgcn_mfma_f32_16x16x32_bf16(Bt[n][k], At[m][k], acc[ai][bj][m][n], 0, 0, 0); __builtin_amdgcn_s_setprio(0); } while (0)
#define PG8_WAIT_V(n) asm volatile("s_waitcnt vmcnt(" #n ")" ::: "memory")
#define PG8_WAIT_L(n) asm volatile("s_waitcnt lgkmcnt(" #n ")" ::: "memory")
#define PG8_BAR __builtin_amdgcn_s_barrier()
#define PG8_SCHED __builtin_amdgcn_sched_barrier(0)
    Unit cur, nxt; int ui = 0;
    if (!S.next(0, cur)) return;
    f32x4 acc[2][2][4][2];
#pragma unroll
    for (int a = 0; a < 2; ++a)
#pragma unroll
        for (int b = 0; b < 2; ++b)
#pragma unroll
            for (int m = 0; m < 4; ++m)
#pragma unroll
                for (int n = 0; n < 2; ++n) acc[a][b][m][n] = (f32x4){0.f, 0.f, 0.f, 0.f};
    bf16x8 At[4][2], B0[2][2], B1[2][2];
    const char* cA = (const char*)g.A + (size_t)cur.z * g.zA + (size_t)cur.pm * tstep; const char* cB = (const char*)g.Bt + (size_t)cur.z * g.zB + (size_t)cur.pn * tstep;
    PG8_STAGE(PG8_SB(0, 0), cB, voffB); PG8_STAGE(PG8_SA(0, 0), cA, voffA); PG8_STAGE(PG8_SB(0, 1), cB + hstep, voffB); PG8_STAGE(PG8_SA(0, 1), cA + hstep, voffA);
    if (wr == 1) PG8_BAR;
    PG8_WAIT_V(4); PG8_BAR;
    PG8_STAGE(PG8_SB(1, 0), cB + kstep, voffB); PG8_STAGE(PG8_SA(1, 0), cA + kstep, voffA); PG8_STAGE(PG8_SB(1, 1), cB + hstep + kstep, voffB);
    PG8_WAIT_V(6); PG8_BAR;
    for (;;) {
        const bool has_next = S.next(ui + 1, nxt);
        const char* nA = has_next ? (const char*)g.A + (size_t)nxt.z * g.zA + (size_t)nxt.pm * tstep : cA; const char* nB = has_next ? (const char*)g.Bt + (size_t)nxt.z * g.zB + (size_t)nxt.pn * tstep : cB;
        for (int t = 0; t < nt; t += 2) {
            const bool last = (t == nt - 2);
            const char* a1 = cA + (size_t)(t + 1) * kstep;
            const char* a2 = last ? nA : cA + (size_t)(t + 2) * kstep; const char* b2 = last ? nB : cB + (size_t)(t + 2) * kstep;
            const char* a3 = a2 + kstep; const char* b3 = b2 + kstep;
            PG8_LDB(B0, 0, 0); PG8_SCHED; PG8_LDA(At, 0, 0); PG8_STAGE(PG8_SA(1, 1), a1 + hstep, voffA);
            PG8_WAIT_L(8); PG8_BAR; PG8_WAIT_L(0); PG8_MMA(0, 0, At, B0); PG8_BAR; PG8_SCHED;
            PG8_LDB(B1, 0, 1); PG8_STAGE(PG8_SB(0, 0), b2, voffB);
            PG8_BAR; PG8_WAIT_L(0); PG8_MMA(0, 1, At, B1); PG8_BAR;
            PG8_LDA(At, 0, 1); PG8_STAGE(PG8_SA(0, 0), a2, voffA);
            PG8_BAR; PG8_WAIT_L(0); PG8_MMA(1, 0, At, B0); PG8_BAR; PG8_SCHED;
            PG8_STAGE(PG8_SB(0, 1), b2 + hstep, voffB);
            PG8_WAIT_V(6); PG8_BAR; PG8_MMA(1, 1, At, B1); PG8_BAR;
            PG8_LDB(B0, 1, 0); PG8_SCHED; PG8_LDA(At, 1, 0); PG8_STAGE(PG8_SA(0, 1), a2 + hstep, voffA);
            PG8_WAIT_L(8); PG8_BAR; PG8_WAIT_L(0); PG8_MMA(0, 0, At, B0); PG8_BAR; PG8_SCHED;
            PG8_LDB(B1, 1, 1); PG8_STAGE(PG8_SB(1, 0), b3, voffB);
            PG8_BAR; PG8_WAIT_L(0); PG8_MMA(0, 1, At, B1); PG8_BAR;
            PG8_LDA(At, 1, 1); PG8_STAGE(PG8_SA(1, 0), a3, voffA);
            PG8_BAR; PG8_WAIT_L(0); PG8_MMA(1, 0, At, B0); PG8_BAR; PG8_SCHED;
            PG8_STAGE(PG8_SB(1, 1), b3 + hstep, voffB);
            PG8_WAIT_V(6); PG8_BAR; PG8_MMA(1, 1, At, B1); PG8_BAR;
        }
        E(acc, cur, wr, wc, fr, fq);
        if (!has_next) break;
#pragma unroll
        for (int a = 0; a < 2; ++a)
#pragma unroll
            for (int b = 0; b < 2; ++b)
#pragma unroll
                for (int m = 0; m < 4; ++m)
#pragma unroll
                    for (int n = 0; n < 2; ++n) acc[a][b][m][n] = (f32x4){0.f, 0.f, 0.f, 0.f};
        cur = nxt; cA = nA; cB = nB; ++ui;
    }
    PG8_WAIT_V(0);
    if (wr == 0) PG8_BAR;
    PG8_BAR;
#undef PG8_SA
#undef PG8_SB
#undef PG8_STAGE
#undef PG8_LDA
#undef PG8_LDB
#undef PG8_MMA
#undef PG8_WAIT_V
#undef PG8_WAIT_L
#undef PG8_BAR
#undef PG8_SCHED
}

struct EpiF32 {
    static constexpr bool PERM = false;
    float* C;
    __device__ __forceinline__ void operator()(const f32x4 (&acc)[2][2][4][2], const Unit& u, int wr, int wc, int fr, int fq) const {
        const int row0 = u.pm * BM + wr * 64 + fr, col0 = u.pn * BM + wc * 32 + 4 * fq;
#pragma unroll
        for (int ai = 0; ai < 2; ++ai)
#pragma unroll
            for (int m = 0; m < 4; ++m) { float* rowp = C + (size_t)(row0 + ai * HALF + m * 16) * D + col0;
#pragma unroll
                for (int bj = 0; bj < 2; ++bj)
#pragma unroll
                    for (int n = 0; n < 2; ++n) *(f32x4*)(rowp + bj * HALF + n * 16) = acc[ai][bj][m][n]; }
    }
};
struct EpiGU {
    static constexpr bool PERM = true;
    bf16_t* O;
    __device__ __forceinline__ void operator()(const f32x4 (&acc)[2][2][4][2], const Unit& u, int wr, int wc, int fr, int fq) const {
        const int row0 = u.pm * BM + wr * 64 + fr, col0 = u.pn * HALF + wc * 32 + 8 * fq;
#pragma unroll
        for (int ai = 0; ai < 2; ++ai)
#pragma unroll
            for (int m = 0; m < 4; ++m) { bf16_t* rowp = O + (size_t)(row0 + ai * HALF + m * 16) * DFF + col0;
                float v[8];
#pragma unroll
                for (int n = 0; n < 2; ++n)
#pragma unroll
                    for (int j = 0; j < 4; ++j) { const float gt = acc[ai][0][m][n][j], up = acc[ai][1][m][n][j]; v[n * 4 + j] = gt * sigm(gt) * up; }
                u32x4 w; w.x = cvt_pk_bf16(v[0], v[1]); w.y = cvt_pk_bf16(v[2], v[3]); w.z = cvt_pk_bf16(v[4], v[5]); w.w = cvt_pk_bf16(v[6], v[7]);
                *(u32x4*)rowp = w; }
    }
};
struct EpiIN {
    static constexpr bool PERM = true;
    bf16_t* U;
    __device__ __forceinline__ void operator()(const f32x4 (&acc)[2][2][4][2], const Unit& u, int wr, int wc, int fr, int fq) const {
        const int row0 = u.pm * BM + wr * 64 + fr;
        if (u.pn >= 4 && u.pn < 12) {
            const int col0 = (u.pn - 4) * HALF + wc * 32 + 8 * fq; bf16_t* base = U + 2 * SLOT;
#pragma unroll
            for (int ai = 0; ai < 2; ++ai)
#pragma unroll
                for (int m = 0; m < 4; ++m) { bf16_t* rowp = base + (size_t)(row0 + ai * HALF + m * 16) * D + col0;
                    const f32x4 v0 = acc[ai][0][m][0] * acc[ai][1][m][0], v1 = acc[ai][0][m][1] * acc[ai][1][m][1];
                    u32x4 w; w.x = cvt_pk_bf16(v0[0], v0[1]); w.y = cvt_pk_bf16(v0[2], v0[3]); w.z = cvt_pk_bf16(v1[0], v1[1]); w.w = cvt_pk_bf16(v1[2], v1[3]);
                    *(u32x4*)rowp = w; }
        } else {
            int slot, ct; if (u.pn < 4) { slot = 0; ct = u.pn; } else { const int sg = (u.pn - 12) >> 2; slot = sg == 0 ? 3 : (sg == 1 ? 1 : sg + 2); ct = (u.pn - 12) & 3; }
            const int col0 = ct * BM + wc * 32 + 8 * fq; bf16_t* base = U + (size_t)slot * SLOT;
#pragma unroll
            for (int ai = 0; ai < 2; ++ai)
#pragma unroll
                for (int m = 0; m < 4; ++m) { bf16_t* rowp = base + (size_t)(row0 + ai * HALF + m * 16) * D + col0;
#pragma unroll
                    for (int bj = 0; bj < 2; ++bj) { const f32x4 v0 = acc[ai][bj][m][0], v1 = acc[ai][bj][m][1];
                        u32x4 w; w.x = cvt_pk_bf16(v0[0], v0[1]); w.y = cvt_pk_bf16(v0[2], v0[3]); w.z = cvt_pk_bf16(v1[0], v1[1]); w.w = cvt_pk_bf16(v1[2], v1[3]);
                        *(u32x4*)(rowp + bj * HALF) = w; } }
        }
    }
};
struct EpiBF {
    static constexpr bool PERM = true;
    bf16_t* O; size_t zO;
    __device__ __forceinline__ void operator()(const f32x4 (&acc)[2][2][4][2], const Unit& u, int wr, int wc, int fr, int fq) const {
        const int row0 = u.pm * BM + wr * 64 + fr, col0 = u.pn * BM + wc * 32 + 8 * fq; bf16_t* base = O + (size_t)u.z * zO;
#pragma unroll
        for (int ai = 0; ai < 2; ++ai)
#pragma unroll
            for (int m = 0; m < 4; ++m) { bf16_t* rowp = base + (size_t)(row0 + ai * HALF + m * 16) * D + col0;
#pragma unroll
                for (int bj = 0; bj < 2; ++bj) { const f32x4 v0 = acc[ai][bj][m][0], v1 = acc[ai][bj][m][1];
                    u32x4 w; w.x = cvt_pk_bf16(v0[0], v0[1]); w.y = cvt_pk_bf16(v0[2], v0[3]); w.z = cvt_pk_bf16(v1[0], v1[1]); w.w = cvt_pk_bf16(v1[2], v1[3]);
                    *(u32x4*)(rowp + bj * HALF) = w; } }
    }
};
}

__device__ __forceinline__ int conv_map(int mode, int n) {
    if (mode == 0) return n;
    if (mode == 1) return 256 * (n >> 7) + (n & 127);
    if (mode == 2) return 256 * (n >> 7) + 128 + (n & 127);
    const int seg = n >> 10, j = n & 1023;
    if (seg == 0) return j;
    if (seg == 1) return 1024 + 256 * (j >> 7) + (j & 127);
    if (seg == 2) return 1024 + 256 * (j >> 7) + 128 + (j & 127);
    return 3072 + (seg - 3) * 1024 + j;
}
__device__ __forceinline__ void conv_tile(const float* __restrict__ src, int K, int N, bf16_t* __restrict__ dst, int mode, int tile, LAS float* sl, int tid) {
    const int ntn = N >> 6; const int tk = tile / ntn, tn = tile - tk * ntn; const int k0 = tk * 64, n0 = tn * 64;
#pragma unroll
    for (int q = 0; q < 2; ++q) { const int kr = (tid >> 4) + 32 * q; const f32x4 v = *(const f32x4*)(src + (size_t)(k0 + kr) * N + n0 + (tid & 15) * 4);
        LAS float* d = sl + kr * 65 + (tid & 15) * 4; d[0] = v[0]; d[1] = v[1]; d[2] = v[2]; d[3] = v[3]; }
    __syncthreads();
    const int n = tid >> 3, ko = (tid & 7) * 8;
    float f[8];
#pragma unroll
    for (int i = 0; i < 8; ++i) f[i] = sl[(ko + i) * 65 + n];
    u32x4 w; w.x = cvt_pk_bf16(f[0], f[1]); w.y = cvt_pk_bf16(f[2], f[3]); w.z = cvt_pk_bf16(f[4], f[5]); w.w = cvt_pk_bf16(f[6], f[7]);
    *(u32x4*)(dst + (size_t)conv_map(mode, n0 + n) * K + k0 + ko) = w;
    __syncthreads();
}
template <int II, int K, int N, int MODE>
__device__ __forceinline__ void conv_mat(const Params& p, size_t dst, LAS unsigned char* lds, int tid) {
    constexpr int ntiles = (K >> 6) * (N >> 6);
    for (int t = blockIdx.x; t < ntiles; t += gridDim.x) conv_tile(p.in[II], K, N, (bf16_t*)(p.ws + dst), MODE, t, (LAS float*)lds, tid);
}
__device__ __forceinline__ void convert_set0(const Params& p, LAS unsigned char* lds, int tid) {
    conv_mat<8, 1024, 2816, 1>(p, WS_WGU, lds, tid);
    conv_mat<9, 1024, 2816, 2>(p, WS_WGU, lds, tid);
    conv_mat<10, 2816, 1024, 0>(p, WS_WD, lds, tid);
    conv_mat<13, 1024, 7168, 3>(p, WS_WIN, lds, tid);
    conv_mat<15, 1024, 1024, 0>(p, WS_WOAB, lds, tid);
    conv_mat<23, 1024, 1024, 0>(p, WS_WOAB + (size_t)1024 * 1024 * 2, lds, tid);
    conv_mat<24, 1024, 1024, 0>(p, WS_WO, lds, tid);
}
__device__ __forceinline__ void convert_set1(const Params& p, LAS unsigned char* lds, int tid) {
    conv_mat<27, 1024, 2816, 1>(p, WS_WGU, lds, tid);
    conv_mat<28, 1024, 2816, 2>(p, WS_WGU, lds, tid);
    conv_mat<29, 2816, 1024, 0>(p, WS_WD, lds, tid);
}

__device__ __forceinline__ void norm_phase(const Params& p, int mode, int tid, bool dry) {
    const int lane = tid & 63, gw = blockIdx.x * 8 + (tid >> 6), nw = gridDim.x * 8;
    const float* gpost = mode == 1 ? p.in[7] : (mode == 2 ? p.in[12] : p.in[26]);
    const float* gpre = mode == 0 ? p.in[6] : (mode == 1 ? p.in[11] : p.in[25]);
    const float cc = mode == 2 ? 1.0f : 0.5f;
    f32x4 gpo[4], gpr[4];
#pragma unroll
    for (int q = 0; q < 4; ++q) { gpo[q] = mode > 0 ? *(const f32x4*)(gpost + lane * 4 + 256 * q) : (f32x4){0.f, 0.f, 0.f, 0.f}; gpr[q] = mode < 3 ? *(const f32x4*)(gpre + lane * 4 + 256 * q) : (f32x4){0.f, 0.f, 0.f, 0.f}; }
    const float* Y = (const float*)(p.ws + WS_Y); bf16_t* H = (bf16_t*)(p.ws + WS_H);
    for (int r = gw; r < M; r += nw) {
        const float* xin = mode <= 1 ? x0row(p, r) : xrow(p, r);
        f32x4 xv[4];
#pragma unroll
        for (int q = 0; q < 4; ++q) xv[q] = *(const f32x4*)(xin + lane * 4 + 256 * q);
        if (mode > 0) {
            f32x4 yv[4]; float ss = 0.f;
#pragma unroll
            for (int q = 0; q < 4; ++q) { yv[q] = *(const f32x4*)(Y + (size_t)r * D + lane * 4 + 256 * q); ss += yv[q][0] * yv[q][0] + yv[q][1] * yv[q][1] + yv[q][2] * yv[q][2] + yv[q][3] * yv[q][3]; }
            ss = wave_sum(ss);
            const float rs = cc * rsqrtf(ss * (1.0f / D) + EPS);
#pragma unroll
            for (int q = 0; q < 4; ++q) xv[q] += yv[q] * rs * gpo[q];
            float* xo = xrow(p, r);
            if (!dry) {
#pragma unroll
                for (int q = 0; q < 4; ++q) *(f32x4*)(xo + lane * 4 + 256 * q) = xv[q];
            }
        }
        if (mode < 3) {
            float ss = 0.f;
#pragma unroll
            for (int q = 0; q < 4; ++q) ss += xv[q][0] * xv[q][0] + xv[q][1] * xv[q][1] + xv[q][2] * xv[q][2] + xv[q][3] * xv[q][3];
            ss = wave_sum(ss);
            const float rs = rsqrtf(ss * (1.0f / D) + EPS);
#pragma unroll
            for (int q = 0; q < 4; ++q) { const f32x4 hv = xv[q] * rs * gpr[q]; u32x2 w; w.x = cvt_pk_bf16(hv[0], hv[1]); w.y = cvt_pk_bf16(hv[2], hv[3]);
                *(u32x2*)(H + (size_t)r * D + lane * 4 + 256 * q) = w; }
        }
    }
}

constexpr int WL_BYTES = 11264;
template <bool FINAL>
__device__ __forceinline__ void scan_item(const Params& p, int b, int j, int h, LAS unsigned char* wl, int lane, bool dry) {
    bf16_t* U = (bf16_t*)(p.ws + WS_U);
    const bf16_t* bx = U + 3 * SLOT; bf16_t* bg = U + 1 * SLOT; bf16_t* bgo = dry ? (bf16_t*)(p.ws + WS_H) : bg;
    float* summ = (float*)(p.ws + WS_SUMM);
    const int c = h * 64 + lane, fr = lane & 15, fq = lane >> 4;
    const size_t row0 = (size_t)b * TP + (size_t)j * CHUNK;
    const bf16_t* wt = (const bf16_t*)(p.ws + WS_WRG);
    bf16x8 wR[4][2], wI[4][2];
#pragma unroll
    for (int nt = 0; nt < 4; ++nt)
#pragma unroll
        for (int kk = 0; kk < 2; ++kk) { const size_t o = (size_t)(h * 64 + nt * 16 + fr) * 64 + kk * 32 + fq * 8; wR[nt][kk] = *(const bf16x8*)(wt + o); wI[nt][kk] = *(const bf16x8*)(wt + 65536 + o); }
    float brv[4], biv[4], lcv[4];
#pragma unroll
    for (int nt = 0; nt < 4; ++nt) { const int ch = h * 64 + nt * 16 + fr; brv[nt] = p.in[19][ch]; biv[nt] = p.in[21][ch]; lcv[nt] = -8.0f * log1pf(expf(-p.in[22][ch])); }
    const float w0 = p.in[16][c], w1 = p.in[16][D + c], w2 = p.in[16][2 * D + c], w3 = p.in[16][3 * D + c], cbias = p.in[17][c];
    float xm3 = 0.f, xm2 = 0.f, xm1 = 0.f;
    if (j > 0) { xm3 = bf2f(bx[(row0 - 3) * D + c]); xm2 = bf2f(bx[(row0 - 2) * D + c]); xm1 = bf2f(bx[(row0 - 1) * D + c]); }
    float hh = 0.f, ap = 1.f;
    if (FINAL) {
        const float* sp = summ + ((size_t)b * NCH * D + c) * 2;
        for (int i0 = 0; i0 < j; i0 += 16) {
            float va[16], vh[16];
#pragma unroll
            for (int k = 0; k < 16; ++k) { if (i0 + k < j) { const float2 v = *(const float2*)(sp + (size_t)(i0 + k) * D * 2); va[k] = v.x; vh[k] = v.y; } else { va[k] = 1.f; vh[k] = 0.f; } }
#pragma unroll
            for (int k = 0; k < 16; ++k) hh = va[k] * hh + vh[k];
        }
    }
    LAS unsigned short* cbT = (LAS unsigned short*)wl;
    LAS float* xu = (LAS float*)(wl + 2304);
    LAS float* aS = (LAS float*)(wl + 2304 + 4352);
    bf16_t xr[16], gr[16], xn[16];
#pragma unroll
    for (int tt = 0; tt < 16; ++tt) xr[tt] = bx[(row0 + tt) * D + c];
#pragma unroll
    for (int g = 0; g < 3; ++g) {
        const size_t r0 = row0 + (size_t)g * 16;
        if (FINAL) {
#pragma unroll
            for (int tt = 0; tt < 16; ++tt) gr[tt] = bg[(r0 + tt) * D + c];
        }
        if (g < 2) {
#pragma unroll
            for (int tt = 0; tt < 16; ++tt) xn[tt] = bx[(r0 + 16 + tt) * D + c];
        }
#pragma unroll
        for (int tt = 0; tt < 16; ++tt) { const float x = bf2f(xr[tt]); const float cb = w0 * xm3 + w1 * xm2 + w2 * xm1 + w3 * x + cbias; xm3 = xm2; xm2 = xm1; xm1 = x;
            cbT[tt * 72 + lane] = f2bf(cb); xu[tt * 68 + lane] = cb; }
        __builtin_amdgcn_wave_barrier();
        const bf16x8 a0 = *(const LAS bf16x8*)(cbT + fr * 72 + fq * 8), a1 = *(const LAS bf16x8*)(cbT + fr * 72 + 32 + fq * 8);
        f32x4 accR[4], accI[4];
#pragma unroll
        for (int nt = 0; nt < 4; ++nt) {
            accR[nt] = __builtin_amdgcn_mfma_f32_16x16x32_bf16(a0, wR[nt][0], (f32x4){0.f, 0.f, 0.f, 0.f}, 0, 0, 0);
            accR[nt] = __builtin_amdgcn_mfma_f32_16x16x32_bf16(a1, wR[nt][1], accR[nt], 0, 0, 0);
            accI[nt] = __builtin_amdgcn_mfma_f32_16x16x32_bf16(a0, wI[nt][0], (f32x4){0.f, 0.f, 0.f, 0.f}, 0, 0, 0);
            accI[nt] = __builtin_amdgcn_mfma_f32_16x16x32_bf16(a1, wI[nt][1], accI[nt], 0, 0, 0);
        }
#pragma unroll
        for (int nt = 0; nt < 4; ++nt)
#pragma unroll
            for (int i = 0; i < 4; ++i) { const int idx = (fq * 4 + i) * 68 + nt * 16 + fr; const float x = xu[idx];
                const float r = sigm(accR[nt][i] + brv[nt]), ig = sigm(accI[nt][i] + biv[nt]);
                const float la = lcv[nt] * r; const float a = __expf(la);
                const float z2 = 2.0f * la;
                const float m2s = -z2 * (1.0f + z2 * (0.5f + z2 * (0.16666667f + z2 * (0.041666668f + z2 * (0.0083333338f + z2 * 0.0013888889f)))));
                const float m2 = z2 > -0.25f ? m2s : 1.0f - a * a;
                xu[idx] = __builtin_amdgcn_sqrtf(m2) * ig * x; aS[idx] = a; }
        __builtin_amdgcn_wave_barrier();
#pragma unroll
        for (int tt = 0; tt < 16; ++tt) { const float a = aS[tt * 68 + lane], uu = xu[tt * 68 + lane]; hh = a * hh + uu;
            if (!FINAL) ap *= a; else bgo[(r0 + tt) * D + c] = f2bf(gelu_tanh(bf2f(gr[tt])) * hh); }
        __builtin_amdgcn_wave_barrier();
        if (g < 2) {
#pragma unroll
            for (int tt = 0; tt < 16; ++tt) xr[tt] = xn[tt];
        }
    }
    if (!FINAL) { *(float2*)(summ + (((size_t)b * NCH + j) * D + c) * 2) = make_float2(ap, hh); }
    else if (j == NCH - 1) { p.out[O_RGP + (size_t)b * D + c] = hh; p.out[O_CBP + ((size_t)b * 3 + 0) * D + c] = xm3; p.out[O_CBP + ((size_t)b * 3 + 1) * D + c] = xm2; p.out[O_CBP + ((size_t)b * 3 + 2) * D + c] = xm1; }
}
template <bool FINAL>
__device__ __forceinline__ void scan_phase(const Params& p, LAS unsigned char* lds, int tid, bool dry) {
    const int wid = tid >> 6, lane = tid & 63;
    LAS unsigned char* wl = lds + wid * WL_BYTES;
    for (int it = blockIdx.x * 8 + wid; it < NB * NCH * 16; it += gridDim.x * 8) { const int h = it & 15, bj = it >> 4; scan_item<FINAL>(p, bj / NCH, bj % NCH, h, wl, lane, dry); }
}
__device__ __forceinline__ void za_phase(const Params& p, int tid, bool dry) {
    bf16_t* U = (bf16_t*)(p.ws + WS_U); bf16_t* ab = U; bf16_t* abo = dry ? (bf16_t*)(p.ws + WS_H) : ab; const bf16_t* ca = U + 2 * SLOT;
    const float* cw = p.in[14];
    for (int idx = blockIdx.x * 512 + tid; idx < NB * 129 * 128; idx += gridDim.x * 512) {
        const int vc = idx & 127, tb = (idx >> 7) % 129, b = idx / (128 * 129); const int c0 = vc * 8;
        float w[3][8];
#pragma unroll
        for (int k = 0; k < 3; ++k) { const f32x4 a = *(const f32x4*)(cw + k * D + c0), bq = *(const f32x4*)(cw + k * D + c0 + 4);
#pragma unroll
            for (int e = 0; e < 4; ++e) { w[k][e] = a[e]; w[k][4 + e] = bq[e]; } }
        const size_t r0 = (size_t)b * TP + (size_t)tb * 16;
        float p2[8], p1[8];
        if (tb > 0) { const u32x4 q2 = *(const u32x4*)(ca + (r0 - 2) * D + c0), q1 = *(const u32x4*)(ca + (r0 - 1) * D + c0);
#pragma unroll
            for (int e = 0; e < 4; ++e) { p2[2 * e] = bflo(q2[e]); p2[2 * e + 1] = bfhi(q2[e]); p1[2 * e] = bflo(q1[e]); p1[2 * e + 1] = bfhi(q1[e]); } }
        else {
#pragma unroll
            for (int e = 0; e < 8; ++e) { p2[e] = 0.f; p1[e] = 0.f; } }
#pragma unroll 4
        for (int tt = 0; tt < 16; ++tt) {
            const u32x4 qc = *(const u32x4*)(ca + (r0 + tt) * D + c0), qa = *(const u32x4*)(ab + (r0 + tt) * D + c0);
            float cv[8], av[8], zv[8];
#pragma unroll
            for (int e = 0; e < 4; ++e) { cv[2 * e] = bflo(qc[e]); cv[2 * e + 1] = bfhi(qc[e]); av[2 * e] = bflo(qa[e]); av[2 * e + 1] = bfhi(qa[e]); }
#pragma unroll
            for (int e = 0; e < 8; ++e) { zv[e] = av[e] * (w[0][e] * p2[e] + w[1][e] * p1[e] + w[2][e] * cv[e]); p2[e] = p1[e]; p1[e] = cv[e]; }
            u32x4 o; o.x = cvt_pk_bf16(zv[0], zv[1]); o.y = cvt_pk_bf16(zv[2], zv[3]); o.z = cvt_pk_bf16(zv[4], zv[5]); o.w = cvt_pk_bf16(zv[6], zv[7]);
            *(u32x4*)(abo + (r0 + tt) * D + c0) = o;
        }
        if (tb == 128) {
            float* o2 = p.out + O_CAP + ((size_t)b * 2 + 0) * D + c0; float* o1 = p.out + O_CAP + ((size_t)b * 2 + 1) * D + c0;
            *(f32x4*)o2 = (f32x4){p2[0], p2[1], p2[2], p2[3]}; *(f32x4*)(o2 + 4) = (f32x4){p2[4], p2[5], p2[6], p2[7]};
            *(f32x4*)o1 = (f32x4){p1[0], p1[1], p1[2], p1[3]}; *(f32x4*)(o1 + 4) = (f32x4){p1[4], p1[5], p1[6], p1[7]};
        }
    }
}
__device__ __forceinline__ void sample_phase(const Params& p, LAS unsigned char* lds, int tid) {
    bf16_t* U = (bf16_t*)(p.ws + WS_U);
    LAS float* cbs = (LAS float*)lds;
    for (int it = blockIdx.x; it < NS / 4; it += gridDim.x) {
        for (int e = tid; e < 4 * D; e += 512) {
            const int s = it * 4 + (e >> 10), c = e & 1023; const size_t ro = (size_t)(MP + s) * D + c;
            const float cav = bf2f(U[2 * SLOT + ro]), abv = bf2f(U[ro]);
            const float s0 = p.in[2][((size_t)s * 2 + 0) * D + c], s1 = p.in[2][((size_t)s * 2 + 1) * D + c];
            const float cva = p.in[14][c] * s0 + p.in[14][D + c] * s1 + p.in[14][2 * D + c] * cav;
            U[ro] = f2bf(abv * cva);
            p.out[O_CAS + ((size_t)s * 2 + 0) * D + c] = s1; p.out[O_CAS + ((size_t)s * 2 + 1) * D + c] = cav;
            const float bxv = bf2f(U[3 * SLOT + ro]);
            const float t0 = p.in[3][((size_t)s * 3 + 0) * D + c], t1 = p.in[3][((size_t)s * 3 + 1) * D + c], t2 = p.in[3][((size_t)s * 3 + 2) * D + c];
            const float cb = p.in[16][c] * t0 + p.in[16][D + c] * t1 + p.in[16][2 * D + c] * t2 + p.in[16][3 * D + c] * bxv + p.in[17][c];
            p.out[O_CBS + ((size_t)s * 3 + 0) * D + c] = t1; p.out[O_CBS + ((size_t)s * 3 + 1) * D + c] = t2; p.out[O_CBS + ((size_t)s * 3 + 2) * D + c] = bxv;
            cbs[e] = cb;
        }
        __syncthreads();
#pragma unroll 1
        for (int cq = 0; cq < 2; ++cq) {
            const int c = tid + cq * 512, h = c >> 6, jj = c & 63;
            float ar[4] = {0.f, 0.f, 0.f, 0.f}, ai[4] = {0.f, 0.f, 0.f, 0.f};
            const float* wr_ = p.in[18] + (size_t)h * 4096 + jj; const float* wi_ = p.in[20] + (size_t)h * 4096 + jj;
#pragma unroll 8
            for (int i = 0; i < 64; ++i) { const float wrv = wr_[i * 64], wiv = wi_[i * 64];
#pragma unroll
                for (int s = 0; s < 4; ++s) { const float x = cbs[s * D + h * 64 + i]; ar[s] += x * wrv; ai[s] += x * wiv; } }
            const float lc = -8.0f * log1pf(expf(-p.in[22][c])), brc = p.in[19][c], bic = p.in[21][c];
#pragma unroll
            for (int s = 0; s < 4; ++s) { const int sg = it * 4 + s; const size_t ro = (size_t)(MP + sg) * D + c;
                const float r = sigm(ar[s] + brc), ig = sigm(ai[s] + bic); const float la = lc * r; const float a = expf(la); const float mult = sqrtf(-expm1f(2.0f * la));
                const float hn = a * p.in[4][(size_t)sg * D + c] + mult * ig * cbs[s * D + c];
                p.out[O_RGS + (size_t)sg * D + c] = hn;
                U[1 * SLOT + ro] = f2bf(gelu_tanh(bf2f(U[1 * SLOT + ro])) * hn); }
        }
        __syncthreads();
    }
}

__device__ __forceinline__ void merge_phase(const Params& p, int tid) {
    const bf16_t* U = (const bf16_t*)(p.ws + WS_U); bf16_t* H = (bf16_t*)(p.ws + WS_H);
    for (size_t i = (size_t)blockIdx.x * 512 + tid; i < SLOT / 8; i += (size_t)gridDim.x * 512) {
        const u32x4 ya = *(const u32x4*)(U + 2 * SLOT + i * 8), yb = *(const u32x4*)(U + 3 * SLOT + i * 8), ga = *(const u32x4*)(U + 4 * SLOT + i * 8), gb = *(const u32x4*)(U + 5 * SLOT + i * 8);
        u32x4 o;
#pragma unroll
        for (int e = 0; e < 4; ++e) { const float lo = sigm(bflo(ga[e])) * bflo(ya[e]) + sigm(bflo(gb[e])) * bflo(yb[e]), hi = sigm(bfhi(ga[e])) * bfhi(ya[e]) + sigm(bfhi(gb[e])) * bfhi(yb[e]); o[e] = cvt_pk_bf16(lo, hi); }
        *(u32x4*)(H + i * 8) = o;
    }
}

constexpr int NPHASE = 14;
constexpr int LDS_BYTES = 131072;
__global__ void __launch_bounds__(512, 2) mk_fwd(Params p, int ph_lo, int ph_hi) {
    extern __shared__ __attribute__((aligned(16))) unsigned char shm[];
    LAS unsigned char* lds = (LAS unsigned char*)shm;
    cg::grid_group grid = cg::this_grid();
    for (int ph2 = ph_lo * 2; ph2 < ph_hi * 2; ++ph2) {
        const int ph = ph2 >> 1; const bool dry = !(ph2 & 1);
        if (dry && !((REP_MASK >> ph) & 1)) continue;
        int tid = threadIdx.x; asm volatile("" : "+v"(tid));
        if (ph == 0) {
            convert_set0(p, lds, tid);
            bf16_t* wt = (bf16_t*)(p.ws + WS_WRG);
            for (int o = blockIdx.x * 512 + tid; o < 2 * 65536; o += gridDim.x * 512) { const int g = o >> 16, h = (o >> 12) & 15, j = (o >> 6) & 63, i = o & 63;
                wt[o] = f2bf((g ? p.in[20] : p.in[18])[(size_t)(h * 64 + i) * 64 + j]); }
            norm_phase(p, 0, tid, dry);
        } else if (ph == 1 || ph == 11) {
            pg8::Gemm g{(const bf16_t*)(p.ws + WS_H), (const bf16_t*)(p.ws + WS_WGU), M, 2 * DFF, D, 0, 0};
            pg8::StaticOrder S; S.init(M, 2 * DFF, gridDim.x, blockIdx.x);
            pg8::EpiGU E{(bf16_t*)(p.ws + WS_ACT)};
            pg8::gemm_phase(lds, g, S, E);
        } else if (ph == 2 || ph == 12 || ph == 9) {
            pg8::Gemm g{(const bf16_t*)(p.ws + (ph == 9 ? WS_H : WS_ACT)), (const bf16_t*)(p.ws + (ph == 9 ? WS_WO : WS_WD)), M, D, ph == 9 ? D : DFF, 0, 0};
            pg8::StaticOrder S; S.init(M, D, gridDim.x, blockIdx.x);
            pg8::EpiF32 E{(float*)(p.ws + WS_Y)};
            pg8::gemm_phase(lds, g, S, E);
        } else if (ph == 3) {
            norm_phase(p, 1, tid, dry);
        } else if (ph == 4) {
            pg8::Gemm g{(const bf16_t*)(p.ws + WS_H), (const bf16_t*)(p.ws + WS_WIN), M, DIN, D, 0, 0};
            pg8::StaticOrder S; S.init(M, DIN, gridDim.x, blockIdx.x);
            pg8::EpiIN E{(bf16_t*)(p.ws + WS_U)};
            pg8::gemm_phase(lds, g, S, E);
        } else if (ph == 5) {
            scan_phase<false>(p, lds, tid, dry);
            za_phase(p, tid, dry);
        } else if (ph == 6) {
            if (!dry) sample_phase(p, lds, tid);
            scan_phase<true>(p, lds, tid, dry);
        } else if (ph == 7) {
            pg8::Gemm g{(const bf16_t*)(p.ws + WS_U), (const bf16_t*)(p.ws + WS_WOAB), M, 2 * D, D, SB, (size_t)1024 * 1024 * 2};
            pg8::VirtOrder S; S.init(M, 2 * D, gridDim.x, blockIdx.x);
            pg8::EpiBF E{(bf16_t*)(p.ws + WS_U) + 2 * SLOT, SLOT};
            pg8::gemm_phase(lds, g, S, E);
        } else if (ph == 8) {
            merge_phase(p, tid);
        } else if (ph == 10) {
            convert_set1(p, lds, tid);
            norm_phase(p, 2, tid, dry);
        } else if (ph == 13) {
            norm_phase(p, 3, tid, dry);
        }
        if (ph2 + 1 < ph_hi * 2) grid.sync();
    }
}

extern "C" void kernel_launch(void* const* d_in, const int* in_sizes, int n_in, void* d_out, int out_size, void* d_ws, size_t ws_size, hipStream_t stream) {
    if (n_in != 30 || ws_size < WS_END) { fprintf(stderr, "kernel_launch: unexpected n_in %d / ws_size %zu (need %zu)\n", n_in, ws_size, (size_t)WS_END); return; }
    Params p{};
    for (int i = 0; i < 30; ++i) p.in[i] = (const float*)d_in[i];
    p.out = (float*)d_out; p.ws = (unsigned char*)d_ws;
    (void)hipFuncSetAttribute((const void*)mk_fwd, hipFuncAttributeMaxDynamicSharedMemorySize, LDS_BYTES);
    static int grid_blocks = 0;
    if (!grid_blocks) {
        int dev = 0, cus = 0, per_cu = 0;
        (void)hipGetDevice(&dev);
        (void)hipDeviceGetAttribute(&cus, hipDeviceAttributeMultiprocessorCount, dev);
        (void)hipOccupancyMaxActiveBlocksPerMultiprocessor(&per_cu, (const void*)mk_fwd, 512, LDS_BYTES);
        if (per_cu < 1) { fprintf(stderr, "kernel_launch: occupancy query says %d blocks/CU\n", per_cu); per_cu = 1; }
        grid_blocks = cus;
    }
#if SINGLE_LAUNCH
    int lo = 0, hi = NPHASE;
    void* args[] = {&p, &lo, &hi};
    hipError_t e = hipLaunchCooperativeKernel((const void*)mk_fwd, dim3(grid_blocks), dim3(512), args, LDS_BYTES, stream);
    if (e != hipSuccess) fprintf(stderr, "cooperative launch failed: %s (grid %d)\n", hipGetErrorString(e), grid_blocks);
#else
    for (int ph = 0; ph < NPHASE; ++ph) hipLaunchKernelGGL(mk_fwd, dim3(grid_blocks), dim3(512), LDS_BYTES, stream, p, ph, ph + 1);
#endif
}
```

```cpp
#include <hip/hip_runtime.h>
#include <hip/hip_cooperative_groups.h>
#include <cstdio>
namespace cg = cooperative_groups;

#ifndef REP_MASK
#define REP_MASK 0
#endif
#ifndef SINGLE_LAUNCH
#define SINGLE_LAUNCH 1
#endif

#define LAS __attribute__((address_space(3)))
typedef unsigned short bf16_t;
typedef short bf16x8 __attribute__((ext_vector_type(8)));
typedef float f32x4 __attribute__((ext_vector_type(4)));
typedef unsigned u32x4 __attribute__((ext_vector_type(4)));
typedef unsigned u32x2 __attribute__((ext_vector_type(2)));

constexpr int D = 1024, DFF = 2816, DIN = 7168;
constexpr int NB = 8, SEQ = 2048, NMETA = 16, TP = SEQ + NMETA;
constexpr int MP = NB * TP;
constexpr int NS = 128;
constexpr int M = MP + NS;
constexpr int CHUNK = 48, NCH = TP / CHUNK;
constexpr float EPS = 1e-6f;

constexpr size_t O_YP = 0, O_YS = 16777216, O_CAP = O_YS + 131072, O_CBP = O_CAP + 16384, O_RGP = O_CBP + 24576,
                 O_CAS = O_RGP + 8192, O_CBS = O_CAS + 262144, O_RGS = O_CBS + 393216;

constexpr size_t SLOT = (size_t)M * D;
constexpr size_t SB = SLOT * 2;
constexpr size_t WS_U = 0;
constexpr size_t WS_ACT = 0;
constexpr size_t WS_Y = 3 * SB;
constexpr size_t WS_PY = 4 * SB;
constexpr int MAINR = 64 * 256;
constexpr size_t WS_WGU = 5 * SB;
constexpr size_t WS_WD = WS_WGU + (size_t)5632 * 1024 * 2;
constexpr size_t WS_H = 6 * SB;
constexpr size_t WS_WIN = 7 * SB;
constexpr size_t WS_POAB = WS_WIN;
constexpr size_t WS_WOAB = WS_WIN + (size_t)7168 * 1024 * 2;
constexpr size_t WS_WO = WS_WOAB + (size_t)2 * 1024 * 1024 * 2;
constexpr size_t WS_WRG = WS_WO + (size_t)1024 * 1024 * 2;
constexpr size_t WS_SUMM = WS_WRG + (size_t)2 * 16 * 64 * 64 * 2;
constexpr size_t WS_XMETA = WS_SUMM + (size_t)NB * NCH * D * 2 * 4;
constexpr size_t WS_END = WS_XMETA + (size_t)NB * NMETA * D * 4;
static_assert(WS_END <= (size_t)256 * 1024 * 1024, "workspace");

struct Params { const float* in[30]; float* out; unsigned char* ws; };

__device__ __forceinline__ unsigned cvt_pk_bf16(float lo, float hi) { unsigned r; asm volatile("v_cvt_pk_bf16_f32 %0, %1, %2" : "=v"(r) : "v"(lo), "v"(hi)); return r; }
__device__ __forceinline__ bf16_t f2bf(float f) { return (bf16_t)(cvt_pk_bf16(f, 0.f) & 0xffffu); }
__device__ __forceinline__ float bf2f(bf16_t b) { return __uint_as_float(((unsigned)b) << 16); }
__device__ __forceinline__ float bflo(unsigned w) { return __uint_as_float(w << 16); }
__device__ __forceinline__ float bfhi(unsigned w) { return __uint_as_float(w & 0xffff0000u); }
__device__ __forceinline__ float sigm(float x) { return __builtin_amdgcn_rcpf(1.0f + __expf(-x)); }
__device__ __forceinline__ float gelu_tanh(float x) { const float t = 1.5957691216057308f * (x + 0.044715f * x * x * x); return x * sigm(t); }
__device__ __forceinline__ float wave_sum(float v, int lane) {
#pragma unroll
    for (int o = 32; o >= 1; o >>= 1) v += __int_as_float(__builtin_amdgcn_ds_bpermute((lane ^ o) << 2, __float_as_int(v)));
    return v;
}
__device__ __forceinline__ float* xrow(const Params& p, int r) {
    if (r >= MP) return p.out + O_YS + (size_t)(r - MP) * D;
    const int b = r / TP, t = r - b * TP;
    if (t < NMETA) return (float*)(p.ws + WS_XMETA) + (size_t)(b * NMETA + t) * D;
    return p.out + O_YP + ((size_t)b * SEQ + (t - NMETA)) * D;
}
__device__ __forceinline__ const float* x0row(const Params& p, int r) {
    if (r >= MP) return p.in[1] + (size_t)(r - MP) * D;
    const int b = r / TP, t = r - b * TP;
    if (t < NMETA) return p.in[5] + (size_t)t * D;
    return p.in[0] + ((size_t)b * SEQ + (t - NMETA)) * D;
}

namespace pg8 {
constexpr int BM = 256, BK = 64, HALF = 128, HTB = HALF * BK * 2, STAGE_BYTES = 8 * HTB, NXCD = 8, WGM = 8;
__host__ __device__ __forceinline__ int lds_byte(int r, int c) { const int st = (r >> 4) * 2 + (c >> 5), rr = r & 15, cc = c & 31, ob = rr * 64 + cc * 2; return st * 1024 + (ob ^ (((ob >> 9) & 1) << 5)); }
__host__ __device__ __forceinline__ void stage_rc(int b, int& R, int& C) { const int st = b / 1024, sb = b % 1024, swz = sb ^ (((sb >> 9) & 1) << 5); R = (st >> 1) * 16 + swz / 64; C = (st & 1) * 32 + (swz % 64) / 2; }
__host__ __device__ __forceinline__ int perm32(int rho) { const int n = rho >> 4, i = rho & 15; return 8 * (i >> 2) + 4 * n + (i & 3); }

struct Unit { int pm, pn, z, k0, nk, part; };
struct Gemm { const bf16_t* A; const bf16_t* Bt; int M, N, K; size_t zA, zB; };

struct StaticOrder {
    int nM, nN, nwg, G, c, ntf;
    __device__ void init(int M_, int N_, int K_, int G_, int c_) { nM = M_ / BM; nN = N_ / BM; nwg = nM * nN; G = G_; c = c_; ntf = K_ / BK; }
    __device__ bool map(long L, Unit& u) const {
        if (L >= nwg) return false;
        int wgid = (int)L; { const int q = nwg / NXCD, r = nwg % NXCD, xcd = wgid % NXCD, off = wgid / NXCD; wgid = (xcd < r ? xcd * (q + 1) : r * (q + 1) + (xcd - r) * q) + off; }
        const int nig = WGM * nN, gid = wgid / nig, fm = gid * WGM, gsz = (nM - fm) < WGM ? (nM - fm) : WGM;
        u.pm = fm + ((wgid % nig) % gsz); u.pn = (wgid % nig) / gsz; u.z = 0; u.k0 = 0; u.nk = ntf; u.part = -1; return true;
    }
    __device__ bool next(int i, Unit& u) const { return map((long)i * G + c, u); }
};
struct SplitOrder : StaticOrder {
    int nsplit, nkm;
    __device__ void init(int N_, int K_, int G_, int c_, int nsplit_, int nkm_) { StaticOrder::init(64 * BM, N_, K_, G_, c_); nsplit = nsplit_; nkm = nkm_; }
    __device__ bool next(int i, Unit& u) const {
        const long L = (long)i * G + c; bool ok;
        if (L < nwg) ok = map(L, u);
        else { const int L2 = (int)(L - nwg); ok = L2 < nN * nsplit; const int ks = L2 / nN; u.pm = 64; u.pn = L2 - ks * nN; u.k0 = ks * nkm; u.nk = nkm; u.part = ks; }
        u.z = u.pn >> 2; u.pn &= 3; return ok;
    }
};

template <class Epi, class Sched>
__device__ __forceinline__ void gemm_phase(LAS unsigned char* lds, const Gemm g, const Sched& S, const Epi& E) {
    int tid_ = threadIdx.x; asm volatile("" : "+v"(tid_));
    const int tid = tid_, wid = __builtin_amdgcn_readfirstlane(tid >> 6), lane = tid & 63, wr = wid >> 2, wc = wid & 3, fr = lane & 15, fq = lane >> 4;
    const int K = g.K;
    unsigned voffA[2], voffB[2];
#pragma unroll
    for (int i = 0; i < 2; ++i) { int R, C; stage_rc(tid * 16 + i * 8192, R, C); const int Rb = Epi::PERM ? ((R & ~31) + perm32(R & 31)) : R;
        voffA[i] = (unsigned)(R * K + C) * 2u; voffB[i] = (unsigned)(Rb * K + C) * 2u; }
    const size_t kstep = (size_t)(BK * 2);
    const size_t hstep = (size_t)HALF * K * 2;
    const size_t tstep = 2 * hstep;
    const unsigned ldsw = (unsigned)wid * 1024u;
    const int aoff = lds_byte(wr * 64 + fr, fq * 8), boff = lds_byte(wc * 32 + fr, fq * 8);
#define PG8_SA(b, h) (((b) * 2 + (h)) * HTB)
#define PG8_SB(b, h) ((4 + (b) * 2 + (h)) * HTB)
#define PG8_STAGE(bufoff, gbase, voff) do { _Pragma("unroll") for (int _i = 0; _i < 2; ++_i) \
        __builtin_amdgcn_global_load_lds((const unsigned*)((const char*)(gbase) + (voff)[_i]), (LAS unsigned*)(lds + (bufoff) + ldsw + _i * 8192), 16, 0, 0); } while (0)
#define PG8_LDA(dst, b, h) do { _Pragma("unroll") for (int m = 0; m < 4; ++m) _Pragma("unroll") for (int k = 0; k < 2; ++k) dst[m][k] = *(const LAS bf16x8*)(lds + PG8_SA(b, h) + aoff + m * 2048 + k * 1024); } while (0)
#define PG8_LDB(dst, b, h) do { _Pragma("unroll") for (int n = 0; n < 2; ++n) _Pragma("unroll") for (int k = 0; k < 2; ++k) dst[n][k] = *(const LAS bf16x8*)(lds + PG8_SB(b, h) + boff + n * 2048 + k * 1024); } while (0)
#define PG8_MMA(ai, bj, At, Bt) do { __builtin_amdgcn_s_setprio(1); _Pragma("unroll") for (int m = 0; m < 4; ++m) _Pragma("unroll") for (int n = 0; n < 2; ++n) _Pragma("unroll") for (int k = 0; k < 2; ++k) \
        acc[ai][bj][m][n] = __builtin_amdgcn_mfma_f32_16x16x32_bf16(Bt[n][k], At[m][k], acc[ai][bj][m][n], 0, 0, 0); __builtin_amdgcn_s_setprio(0); } while (0)
#define PG8_WAIT_V(n) asm volatile("s_waitcnt vmcnt(" #n ")" ::: "memory")
#define PG8_WAIT_L(n) asm volatile("s_waitcnt lgkmcnt(" #n ")" ::: "memory")
#define PG8_BAR __builtin_amdgcn_s_barrier()
#define PG8_SCHED __builtin_amdgcn_sched_barrier(0)
    Unit cur, nxt; int ui = 0;
    if (!S.next(0, cur)) return;
    f32x4 acc[2][2][4][2];
#pragma unroll
    for (int a = 0; a < 2; ++a)
#pragma unroll
        for (int b = 0; b < 2; ++b)
#pragma unroll
            for (int m = 0; m < 4; ++m)
#pragma unroll
                for (int n = 0; n < 2; ++n) acc[a][b][m][n] = (f32x4){0.f, 0.f, 0.f, 0.f};
    bf16x8 At[4][2], B0[2][2], B1[2][2];
    const char* cA = (const char*)g.A + (size_t)cur.z * g.zA + (size_t)cur.pm * tstep + (size_t)cur.k0 * kstep; const char* cB = (const char*)g.Bt + (size_t)cur.z * g.zB + (size_t)cur.pn * tstep + (size_t)cur.k0 * kstep;
    int nt = cur.nk;
    PG8_STAGE(PG8_SB(0, 0), cB, voffB); PG8_STAGE(PG8_SA(0, 0), cA, voffA); PG8_STAGE(PG8_SB(0, 1), cB + hstep, voffB); PG8_STAGE(PG8_SA(0, 1), cA + hstep, voffA);
    if (wr == 1) PG8_BAR;
    PG8_WAIT_V(4); PG8_BAR;
    PG8_STAGE(PG8_SB(1, 0), cB + kstep, voffB); PG8_STAGE(PG8_SA(1, 0), cA + kstep, voffA); PG8_STAGE(PG8_SB(1, 1), cB + hstep + kstep, voffB);
    PG8_WAIT_V(6); PG8_BAR;
    for (;;) {
        const bool has_next = S.next(ui + 1, nxt);
        const char* nA = has_next ? (const char*)g.A + (size_t)nxt.z * g.zA + (size_t)nxt.pm * tstep + (size_t)nxt.k0 * kstep : cA; const char* nB = has_next ? (const char*)g.Bt + (size_t)nxt.z * g.zB + (size_t)nxt.pn * tstep + (size_t)nxt.k0 * kstep : cB;
        for (int t = 0; t < nt; t += 2) {
            const bool last = (t == nt - 2);
            const char* a1 = cA + (size_t)(t + 1) * kstep;
            const char* a2 = last ? nA : cA + (size_t)(t + 2) * kstep; const char* b2 = last ? nB : cB + (size_t)(t + 2) * kstep;
            const char* a3 = a2 + kstep; const char* b3 = b2 + kstep;
            PG8_LDB(B0, 0, 0); PG8_SCHED; PG8_LDA(At, 0, 0); PG8_STAGE(PG8_SA(1, 1), a1 + hstep, voffA);
            PG8_WAIT_L(8); PG8_BAR; PG8_WAIT_L(0); PG8_MMA(0, 0, At, B0); PG8_BAR; PG8_SCHED;
            PG8_LDB(B1, 0, 1); PG8_STAGE(PG8_SB(0, 0), b2, voffB);
            PG8_BAR; PG8_WAIT_L(0); PG8_MMA(0, 1, At, B1); PG8_BAR;
            PG8_LDA(At, 0, 1); PG8_STAGE(PG8_SA(0, 0), a2, voffA);
            PG8_BAR; PG8_WAIT_L(0); PG8_MMA(1, 0, At, B0); PG8_BAR; PG8_SCHED;
            PG8_STAGE(PG8_SB(0, 1), b2 + hstep, voffB);
            PG8_WAIT_V(6); PG8_BAR; PG8_MMA(1, 1, At, B1); PG8_BAR;
            PG8_LDB(B0, 1, 0); PG8_SCHED; PG8_LDA(At, 1, 0); PG8_STAGE(PG8_SA(0, 1), a2 + hstep, voffA);
            PG8_WAIT_L(8); PG8_BAR; PG8_WAIT_L(0); PG8_MMA(0, 0, At, B0); PG8_BAR; PG8_SCHED;
            PG8_LDB(B1, 1, 1); PG8_STAGE(PG8_SB(1, 0), b3, voffB);
            PG8_BAR; PG8_WAIT_L(0); PG8_MMA(0, 1, At, B1); PG8_BAR;
            PG8_LDA(At, 1, 1); PG8_STAGE(PG8_SA(1, 0), a3, voffA);
            PG8_BAR; PG8_WAIT_L(0); PG8_MMA(1, 0, At, B0); PG8_BAR; PG8_SCHED;
            PG8_STAGE(PG8_SB(1, 1), b3 + hstep, voffB);
            PG8_WAIT_V(6); PG8_BAR; PG8_MMA(1, 1, At, B1); PG8_BAR;
        }
        E(acc, cur, wr, wc, fr, fq);
        if (!has_next) break;
#pragma unroll
        for (int a = 0; a < 2; ++a)
#pragma unroll
            for (int b = 0; b < 2; ++b)
#pragma unroll
                for (int m = 0; m < 4; ++m)
#pragma unroll
                    for (int n = 0; n < 2; ++n) acc[a][b][m][n] = (f32x4){0.f, 0.f, 0.f, 0.f};
        cur = nxt; cA = nA; cB = nB; nt = cur.nk; ++ui;
    }
    PG8_WAIT_V(0);
    if (wr == 0) PG8_BAR;
    PG8_BAR;
#undef PG8_SA
#undef PG8_SB
#undef PG8_STAGE
#undef PG8_LDA
#undef PG8_LDB
#undef PG8_MMA
#undef PG8_WAIT_V
#undef PG8_WAIT_L
#undef PG8_BAR
#undef PG8_SCHED
}

struct EpiBF {
    static constexpr bool PERM = true;
    bf16_t* O; size_t zO; float* P; int nz;
    __device__ __forceinline__ void operator()(const f32x4 (&acc)[2][2][4][2], const Unit& u, int wr, int wc, int fr, int fq) const {
        const int col0 = u.pn * BM + wc * 32 + 8 * fq;
        if (u.part < 0) {
            const int row0 = u.pm * BM + wr * 64 + fr; bf16_t* base = O + (size_t)u.z * zO;
#pragma unroll
            for (int ai = 0; ai < 2; ++ai)
#pragma unroll
                for (int m = 0; m < 4; ++m) { bf16_t* rowp = base + (size_t)(row0 + ai * HALF + m * 16) * D + col0;
#pragma unroll
                    for (int bj = 0; bj < 2; ++bj) { const f32x4 v0 = acc[ai][bj][m][0], v1 = acc[ai][bj][m][1];
                        u32x4 w; w.x = cvt_pk_bf16(v0[0], v0[1]); w.y = cvt_pk_bf16(v0[2], v0[3]); w.z = cvt_pk_bf16(v1[0], v1[1]); w.w = cvt_pk_bf16(v1[2], v1[3]);
                        *(u32x4*)(rowp + bj * HALF) = w; } }
        } else {
            const int row0 = wr * 64 + fr; float* base = P + (size_t)(u.part * nz + u.z) * (BM * D);
#pragma unroll
            for (int ai = 0; ai < 2; ++ai)
#pragma unroll
                for (int m = 0; m < 4; ++m) { float* rowp = base + (size_t)(row0 + ai * HALF + m * 16) * D + col0;
#pragma unroll
                    for (int bj = 0; bj < 2; ++bj) { *(f32x4*)(rowp + bj * HALF) = acc[ai][bj][m][0]; *(f32x4*)(rowp + bj * HALF + 4) = acc[ai][bj][m][1]; } }
        }
    }
};
struct EpiGU {
    static constexpr bool PERM = true;
    bf16_t* O;
    __device__ __forceinline__ void operator()(const f32x4 (&acc)[2][2][4][2], const Unit& u, int wr, int wc, int fr, int fq) const {
        const int row0 = u.pm * BM + wr * 64 + fr, col0 = u.pn * HALF + wc * 32 + 8 * fq;
#pragma unroll
        for (int ai = 0; ai < 2; ++ai)
#pragma unroll
            for (int m = 0; m < 4; ++m) { bf16_t* rowp = O + (size_t)(row0 + ai * HALF + m * 16) * DFF + col0;
                float v[8];
#pragma unroll
                for (int n = 0; n < 2; ++n)
#pragma unroll
                    for (int j = 0; j < 4; ++j) { const float gt = acc[ai][0][m][n][j], up = acc[ai][1][m][n][j]; v[n * 4 + j] = gt * sigm(gt) * up; }
                u32x4 w; w.x = cvt_pk_bf16(v[0], v[1]); w.y = cvt_pk_bf16(v[2], v[3]); w.z = cvt_pk_bf16(v[4], v[5]); w.w = cvt_pk_bf16(v[6], v[7]);
                *(u32x4*)rowp = w; }
    }
};
struct EpiIN {
    static constexpr bool PERM = true;
    bf16_t* U;
    __device__ __forceinline__ void operator()(const f32x4 (&acc)[2][2][4][2], const Unit& u, int wr, int wc, int fr, int fq) const {
        const int row0 = u.pm * BM + wr * 64 + fr;
        if (u.pn >= 4 && u.pn < 12) {
            const int col0 = (u.pn - 4) * HALF + wc * 32 + 8 * fq; bf16_t* base = U + 2 * SLOT;
#pragma unroll
            for (int ai = 0; ai < 2; ++ai)
#pragma unroll
                for (int m = 0; m < 4; ++m) { bf16_t* rowp = base + (size_t)(row0 + ai * HALF + m * 16) * D + col0;
                    const f32x4 v0 = acc[ai][0][m][0] * acc[ai][1][m][0], v1 = acc[ai][0][m][1] * acc[ai][1][m][1];
                    u32x4 w; w.x = cvt_pk_bf16(v0[0], v0[1]); w.y = cvt_pk_bf16(v0[2], v0[3]); w.z = cvt_pk_bf16(v1[0], v1[1]); w.w = cvt_pk_bf16(v1[2], v1[3]);
                    *(u32x4*)rowp = w; }
        } else {
            int slot, ct; if (u.pn < 4) { slot = 0; ct = u.pn; } else { const int sg = (u.pn - 12) >> 2; slot = sg == 0 ? 3 : (sg == 1 ? 1 : sg + 2); ct = (u.pn - 12) & 3; }
            const int col0 = ct * BM + wc * 32 + 8 * fq; bf16_t* base = U + (size_t)slot * SLOT;
#pragma unroll
            for (int ai = 0; ai < 2; ++ai)
#pragma unroll
                for (int m = 0; m < 4; ++m) { bf16_t* rowp = base + (size_t)(row0 + ai * HALF + m * 16) * D + col0;
#pragma unroll
                    for (int bj = 0; bj < 2; ++bj) { const f32x4 v0 = acc[ai][bj][m][0], v1 = acc[ai][bj][m][1];
                        u32x4 w; w.x = cvt_pk_bf16(v0[0], v0[1]); w.y = cvt_pk_bf16(v0[2], v0[3]); w.z = cvt_pk_bf16(v1[0], v1[1]); w.w = cvt_pk_bf16(v1[2], v1[3]);
                        *(u32x4*)(rowp + bj * HALF) = w; } }
        }
    }
};
}

__device__ __forceinline__ int conv_map(int mode, int n) {
    if (mode == 0) return n;
    if (mode == 1) return 256 * (n >> 7) + (n & 127);
    if (mode == 2) return 256 * (n >> 7) + 128 + (n & 127);
    const int seg = n >> 10, j = n & 1023;
    if (seg == 0) return j;
    if (seg == 1) return 1024 + 256 * (j >> 7) + (j & 127);
    if (seg == 2) return 1024 + 256 * (j >> 7) + 128 + (j & 127);
    return 3072 + (seg - 3) * 1024 + j;
}
__device__ __forceinline__ void conv_tile(const float* __restrict__ src, int K, int N, bf16_t* __restrict__ dst, int mode, int tile, LAS float* sl, int tid) {
    const int ntn = N >> 6; const int tk = tile / ntn, tn = tile - tk * ntn; const int k0 = tk * 64, n0 = tn * 64;
#pragma unroll
    for (int q = 0; q < 2; ++q) { const int kr = (tid >> 4) + 32 * q; const f32x4 v = *(const f32x4*)(src + (size_t)(k0 + kr) * N + n0 + (tid & 15) * 4);
        LAS float* d = sl + kr * 65 + (tid & 15) * 4; d[0] = v[0]; d[1] = v[1]; d[2] = v[2]; d[3] = v[3]; }
    __syncthreads();
    const int n = tid >> 3, ko = (tid & 7) * 8;
    float f[8];
#pragma unroll
    for (int i = 0; i < 8; ++i) f[i] = sl[(ko + i) * 65 + n];
    u32x4 w; w.x = cvt_pk_bf16(f[0], f[1]); w.y = cvt_pk_bf16(f[2], f[3]); w.z = cvt_pk_bf16(f[4], f[5]); w.w = cvt_pk_bf16(f[6], f[7]);
    *(u32x4*)(dst + (size_t)conv_map(mode, n0 + n) * K + k0 + ko) = w;
    __syncthreads();
}
template <int II, int K, int N, int MODE>
__device__ __forceinline__ void conv_mat(const Params& p, size_t dst, LAS unsigned char* lds, int tid) {
    constexpr int ntiles = (K >> 6) * (N >> 6);
    for (int t = blockIdx.x; t < ntiles; t += gridDim.x) conv_tile(p.in[II], K, N, (bf16_t*)(p.ws + dst), MODE, t, (LAS float*)lds, tid);
}
__device__ __forceinline__ void convert_set0(const Params& p, LAS unsigned char* lds, int tid) {
    conv_mat<8, 1024, 2816, 1>(p, WS_WGU, lds, tid);
    conv_mat<9, 1024, 2816, 2>(p, WS_WGU, lds, tid);
    conv_mat<10, 2816, 1024, 0>(p, WS_WD, lds, tid);
    conv_mat<13, 1024, 7168, 3>(p, WS_WIN, lds, tid);
    conv_mat<15, 1024, 1024, 0>(p, WS_WOAB, lds, tid);
    conv_mat<23, 1024, 1024, 0>(p, WS_WOAB + (size_t)1024 * 1024 * 2, lds, tid);
    conv_mat<24, 1024, 1024, 0>(p, WS_WO, lds, tid);
}
__device__ __forceinline__ void convert_set1(const Params& p, LAS unsigned char* lds, int tid) {
    conv_mat<27, 1024, 2816, 1>(p, WS_WGU, lds, tid);
    conv_mat<28, 1024, 2816, 2>(p, WS_WGU, lds, tid);
    conv_mat<29, 2816, 1024, 0>(p, WS_WD, lds, tid);
}

__device__ __forceinline__ void norm_phase(const Params& p, int mode, int tid, bool dry, int nsplit) {
    const int lane = tid & 63, gw = blockIdx.x * 8 + (tid >> 6), nw = gridDim.x * 8;
    const float* gpost = mode == 1 ? p.in[7] : (mode == 2 ? p.in[12] : p.in[26]);
    const float* gpre = mode == 0 ? p.in[6] : (mode == 1 ? p.in[11] : p.in[25]);
    const float cc = mode == 2 ? 1.0f : 0.5f;
    const bf16_t* Yb = (const bf16_t*)(p.ws + WS_Y); const float* PY = (const float*)(p.ws + WS_PY); bf16_t* H = (bf16_t*)(p.ws + WS_H);
    for (int r = gw; r < M; r += nw) {
        const float* xin = mode <= 1 ? x0row(p, r) : xrow(p, r);
        f32x4 xv[4];
#pragma unroll
        for (int q = 0; q < 4; ++q) xv[q] = *(const f32x4*)(xin + lane * 4 + 256 * q);
        if (mode > 0) {
            f32x4 yv[4]; float ss = 0.f;
            if (r < MAINR) {
#pragma unroll
                for (int q = 0; q < 4; ++q) { const u32x2 w = *(const u32x2*)(Yb + (size_t)r * D + lane * 4 + 256 * q); yv[q] = (f32x4){bflo(w.x), bfhi(w.x), bflo(w.y), bfhi(w.y)}; }
            } else {
#pragma unroll
                for (int q = 0; q < 4; ++q) yv[q] = (f32x4){0.f, 0.f, 0.f, 0.f};
                for (int ks = 0; ks < nsplit; ++ks) {
#pragma unroll
                    for (int q = 0; q < 4; ++q) yv[q] += *(const f32x4*)(PY + ((size_t)ks * 256 + (r - MAINR)) * D + lane * 4 + 256 * q);
                }
            }
#pragma unroll
            for (int q = 0; q < 4; ++q) ss += yv[q][0] * yv[q][0] + yv[q][1] * yv[q][1] + yv[q][2] * yv[q][2] + yv[q][3] * yv[q][3];
            ss = wave_sum(ss, lane);
            const float rs = cc * rsqrtf(ss * (1.0f / D) + EPS);
#pragma unroll
            for (int q = 0; q < 4; ++q) xv[q] += yv[q] * rs * *(const f32x4*)(gpost + lane * 4 + 256 * q);
            float* xo = xrow(p, r);
            if (!dry) {
#pragma unroll
                for (int q = 0; q < 4; ++q) *(f32x4*)(xo + lane * 4 + 256 * q) = xv[q];
            }
        }
        if (mode < 3) {
            float ss = 0.f;
#pragma unroll
            for (int q = 0; q < 4; ++q) ss += xv[q][0] * xv[q][0] + xv[q][1] * xv[q][1] + xv[q][2] * xv[q][2] + xv[q][3] * xv[q][3];
            ss = wave_sum(ss, lane);
            const float rs = rsqrtf(ss * (1.0f / D) + EPS);
#pragma unroll
            for (int q = 0; q < 4; ++q) { const f32x4 hv = xv[q] * rs * *(const f32x4*)(gpre + lane * 4 + 256 * q); u32x2 w; w.x = cvt_pk_bf16(hv[0], hv[1]); w.y = cvt_pk_bf16(hv[2], hv[3]);
                *(u32x2*)(H + (size_t)r * D + lane * 4 + 256 * q) = w; }
        }
    }
}

constexpr int WL_BYTES = 11264;
template <bool FINAL>
__device__ __forceinline__ void scan_item(const Params& p, int b, int j, int h, LAS unsigned char* wl, const LAS unsigned char* wlds, int lane, bool dry) {
    bf16_t* U = (bf16_t*)(p.ws + WS_U);
    const bf16_t* bx = U + 3 * SLOT; bf16_t* bg = U + 1 * SLOT; bf16_t* bgo = dry ? (bf16_t*)(p.ws + WS_H) : bg;
    float* summ = (float*)(p.ws + WS_SUMM);
    const int c = h * 64 + lane, fr = lane & 15, fq = lane >> 4;
    const size_t row0 = (size_t)b * TP + (size_t)j * CHUNK;
    const LAS unsigned char* wq = wlds + fr * 144 + fq * 16;
    float brv[4], biv[4], lcv[4];
#pragma unroll
    for (int nt = 0; nt < 4; ++nt) { const int ch = h * 64 + nt * 16 + fr; brv[nt] = p.in[19][ch]; biv[nt] = p.in[21][ch]; lcv[nt] = -8.0f * log1pf(expf(-p.in[22][ch])); }
    const float w0 = p.in[16][c], w1 = p.in[16][D + c], w2 = p.in[16][2 * D + c], w3 = p.in[16][3 * D + c], cbias = p.in[17][c];
    float xm3 = 0.f, xm2 = 0.f, xm1 = 0.f;
    if (j > 0) { xm3 = bf2f(bx[(row0 - 3) * D + c]); xm2 = bf2f(bx[(row0 - 2) * D + c]); xm1 = bf2f(bx[(row0 - 1) * D + c]); }
    float hh = 0.f, ap = 1.f;
    if (FINAL) {
        const float* sp = summ + ((size_t)b * NCH * D + c) * 2;
        for (int i0 = 0; i0 < j; i0 += 16) {
            float va[16], vh[16];
#pragma unroll
            for (int k = 0; k < 16; ++k) { if (i0 + k < j) { const float2 v = *(const float2*)(sp + (size_t)(i0 + k) * D * 2); va[k] = v.x; vh[k] = v.y; } else { va[k] = 1.f; vh[k] = 0.f; } }
#pragma unroll
            for (int k = 0; k < 16; ++k) hh = va[k] * hh + vh[k];
        }
    }
    LAS unsigned short* cbT = (LAS unsigned short*)wl;
    LAS float* xu = (LAS float*)(wl + 2304);
    LAS float* aS = (LAS float*)(wl + 2304 + 4352);
    bf16_t xr[16], gr[16], xn[16];
#pragma unroll
    for (int tt = 0; tt < 16; ++tt) xr[tt] = bx[(row0 + tt) * D + c];
#pragma unroll
    for (int g = 0; g < 3; ++g) {
        const size_t r0 = row0 + (size_t)g * 16;
        if (FINAL) {
#pragma unroll
            for (int tt = 0; tt < 16; ++tt) gr[tt] = bg[(r0 + tt) * D + c];
        }
        if (g < 2) {
#pragma unroll
            for (int tt = 0; tt < 16; ++tt) xn[tt] = bx[(r0 + 16 + tt) * D + c];
        }
#pragma unroll
        for (int tt = 0; tt < 16; ++tt) { const float x = bf2f(xr[tt]); const float cb = w0 * xm3 + w1 * xm2 + w2 * xm1 + w3 * x + cbias; xm3 = xm2; xm2 = xm1; xm1 = x;
            cbT[tt * 72 + lane] = f2bf(cb); xu[tt * 68 + lane] = cb; }
        __builtin_amdgcn_wave_barrier();
        const bf16x8 a0 = *(const LAS bf16x8*)(cbT + fr * 72 + fq * 8), a1 = *(const LAS bf16x8*)(cbT + fr * 72 + 32 + fq * 8);
        f32x4 accR[4], accI[4];
#pragma unroll
        for (int nt = 0; nt < 4; ++nt) {
            const bf16x8 r0w = *(const LAS bf16x8*)(wq + nt * 2304), r1w = *(const LAS bf16x8*)(wq + nt * 2304 + 64);
            const bf16x8 i0w = *(const LAS bf16x8*)(wq + 9216 + nt * 2304), i1w = *(const LAS bf16x8*)(wq + 9216 + nt * 2304 + 64);
            accR[nt] = __builtin_amdgcn_mfma_f32_16x16x32_bf16(a0, r0w, (f32x4){0.f, 0.f, 0.f, 0.f}, 0, 0, 0);
            accR[nt] = __builtin_amdgcn_mfma_f32_16x16x32_bf16(a1, r1w, accR[nt], 0, 0, 0);
            accI[nt] = __builtin_amdgcn_mfma_f32_16x16x32_bf16(a0, i0w, (f32x4){0.f, 0.f, 0.f, 0.f}, 0, 0, 0);
            accI[nt] = __builtin_amdgcn_mfma_f32_16x16x32_bf16(a1, i1w, accI[nt], 0, 0, 0);
        }
#pragma unroll
        for (int nt = 0; nt < 4; ++nt)
#pragma unroll
            for (int i = 0; i < 4; ++i) { const int idx = (fq * 4 + i) * 68 + nt * 16 + fr; const float x = xu[idx];
                const float r = sigm(accR[nt][i] + brv[nt]), ig = sigm(accI[nt][i] + biv[nt]);
                const float la = lcv[nt] * r; const float a = __expf(la);
                const float z2 = 2.0f * la;
                const float m2s = -z2 * (1.0f + z2 * (0.5f + z2 * (0.16666667f + z2 * (0.041666668f + z2 * (0.0083333338f + z2 * 0.0013888889f)))));
                const float m2 = z2 > -0.25f ? m2s : 1.0f - a * a;
                xu[idx] = __builtin_amdgcn_sqrtf(m2) * ig * x; aS[idx] = a; }
        __builtin_amdgcn_wave_barrier();
#pragma unroll
        for (int tt = 0; tt < 16; ++tt) { const float a = aS[tt * 68 + lane], uu = xu[tt * 68 + lane]; hh = a * hh + uu;
            if (!FINAL) ap *= a; else bgo[(r0 + tt) * D + c] = f2bf(gelu_tanh(bf2f(gr[tt])) * hh); }
        __builtin_amdgcn_wave_barrier();
        if (g < 2) {
#pragma unroll
            for (int tt = 0; tt < 16; ++tt) xr[tt] = xn[tt];
        }
    }
    if (!FINAL) { *(float2*)(summ + (((size_t)b * NCH + j) * D + c) * 2) = make_float2(ap, hh); }
    else if (j == NCH - 1) { p.out[O_RGP + (size_t)b * D + c] = hh; p.out[O_CBP + ((size_t)b * 3 + 0) * D + c] = xm3; p.out[O_CBP + ((size_t)b * 3 + 1) * D + c] = xm2; p.out[O_CBP + ((size_t)b * 3 + 2) * D + c] = xm1; }
}
template <bool FINAL>
__device__ __forceinline__ void scan_phase(const Params& p, LAS unsigned char* lds, int tid, bool dry) {
    const int wid = tid >> 6, lane = tid & 63;
    LAS unsigned char* wl = lds + wid * WL_BYTES;
    LAS unsigned char* wlds = lds + 8 * WL_BYTES;
    const int h = blockIdx.x & 15;
    {
        const bf16_t* wt = (const bf16_t*)(p.ws + WS_WRG);
#pragma unroll
        for (int q = 0; q < 2; ++q) { const int e = tid + q * 512, g = e >> 9, jrow = (e >> 3) & 63, pc = e & 7;
            *(LAS u32x4*)(wlds + g * 9216 + jrow * 144 + pc * 16) = *(const u32x4*)(wt + (size_t)g * 65536 + (size_t)(h * 64 + jrow) * 64 + pc * 8); }
    }
    __syncthreads();
    const int nbh = gridDim.x >> 4;
    for (int it = (blockIdx.x >> 4) * 8 + wid; it < NB * NCH; it += nbh * 8) scan_item<FINAL>(p, it / NCH, it % NCH, h, wl, wlds, lane, dry);
    __syncthreads();
}
__device__ __forceinline__ void za_phase(const Params& p, int tid, bool dry) {
    bf16_t* U = (bf16_t*)(p.ws + WS_U); bf16_t* ab = U; bf16_t* abo = dry ? (bf16_t*)(p.ws + WS_H) : ab; const bf16_t* ca = U + 2 * SLOT;
    const float* cw = p.in[14];
    for (int idx = blockIdx.x * 512 + tid; idx < NB * 129 * 128; idx += gridDim.x * 512) {
        const int vc = idx & 127, tb = (idx >> 7) % 129, b = idx / (128 * 129); const int c0 = vc * 8;
        float w[3][8];
#pragma unroll
        for (int k = 0; k < 3; ++k) { const f32x4 a = *(const f32x4*)(cw + k * D + c0), bq = *(const f32x4*)(cw + k * D + c0 + 4);
#pragma unroll
            for (int e = 0; e < 4; ++e) { w[k][e] = a[e]; w[k][4 + e] = bq[e]; } }
        const size_t r0 = (size_t)b * TP + (size_t)tb * 16;
        float p2[8], p1[8];
        if (tb > 0) { const u32x4 q2 = *(const u32x4*)(ca + (r0 - 2) * D + c0), q1 = *(const u32x4*)(ca + (r0 - 1) * D + c0);
#pragma unroll
            for (int e = 0; e < 4; ++e) { p2[2 * e] = bflo(q2[e]); p2[2 * e + 1] = bfhi(q2[e]); p1[2 * e] = bflo(q1[e]); p1[2 * e + 1] = bfhi(q1[e]); } }
        else {
#pragma unroll
            for (int e = 0; e < 8; ++e) { p2[e] = 0.f; p1[e] = 0.f; } }
#pragma unroll 4
        for (int tt = 0; tt < 16; ++tt) {
            const u32x4 qc = *(const u32x4*)(ca + (r0 + tt) * D + c0), qa = *(const u32x4*)(ab + (r0 + tt) * D + c0);
            float cv[8], av[8], zv[8];
#pragma unroll
            for (int e = 0; e < 4; ++e) { cv[2 * e] = bflo(qc[e]); cv[2 * e + 1] = bfhi(qc[e]); av[2 * e] = bflo(qa[e]); av[2 * e + 1] = bfhi(qa[e]); }
#pragma unroll
            for (int e = 0; e < 8; ++e) { zv[e] = av[e] * (w[0][e] * p2[e] + w[1][e] * p1[e] + w[2][e] * cv[e]); p2[e] = p1[e]; p1[e] = cv[e]; }
            u32x4 o; o.x = cvt_pk_bf16(zv[0], zv[1]); o.y = cvt_pk_bf16(zv[2], zv[3]); o.z = cvt_pk_bf16(zv[4], zv[5]); o.w = cvt_pk_bf16(zv[6], zv[7]);
            *(u32x4*)(abo + (r0 + tt) * D + c0) = o;
        }
        if (tb == 128) {
            float* o2 = p.out + O_CAP + ((size_t)b * 2 + 0) * D + c0; float* o1 = p.out + O_CAP + ((size_t)b * 2 + 1) * D + c0;
            *(f32x4*)o2 = (f32x4){p2[0], p2[1], p2[2], p2[3]}; *(f32x4*)(o2 + 4) = (f32x4){p2[4], p2[5], p2[6], p2[7]};
            *(f32x4*)o1 = (f32x4){p1[0], p1[1], p1[2], p1[3]}; *(f32x4*)(o1 + 4) = (f32x4){p1[4], p1[5], p1[6], p1[7]};
        }
    }
}
__device__ __forceinline__ void sample_phase(const Params& p, LAS unsigned char* lds, int tid) {
    bf16_t* U = (bf16_t*)(p.ws + WS_U);
    LAS float* cbs = (LAS float*)lds;
    for (int it = blockIdx.x; it < NS / 4; it += gridDim.x) {
        for (int e = tid; e < 4 * D; e += 512) {
            const int s = it * 4 + (e >> 10), c = e & 1023; const size_t ro = (size_t)(MP + s) * D + c;
            const float cav = bf2f(U[2 * SLOT + ro]), abv = bf2f(U[ro]);
            const float s0 = p.in[2][((size_t)s * 2 + 0) * D + c], s1 = p.in[2][((size_t)s * 2 + 1) * D + c];
            const float cva = p.in[14][c] * s0 + p.in[14][D + c] * s1 + p.in[14][2 * D + c] * cav;
            U[ro] = f2bf(abv * cva);
            p.out[O_CAS + ((size_t)s * 2 + 0) * D + c] = s1; p.out[O_CAS + ((size_t)s * 2 + 1) * D + c] = cav;
            const float bxv = bf2f(U[3 * SLOT + ro]);
            const float t0 = p.in[3][((size_t)s * 3 + 0) * D + c], t1 = p.in[3][((size_t)s * 3 + 1) * D + c], t2 = p.in[3][((size_t)s * 3 + 2) * D + c];
            const float cb = p.in[16][c] * t0 + p.in[16][D + c] * t1 + p.in[16][2 * D + c] * t2 + p.in[16][3 * D + c] * bxv + p.in[17][c];
            p.out[O_CBS + ((size_t)s * 3 + 0) * D + c] = t1; p.out[O_CBS + ((size_t)s * 3 + 1) * D + c] = t2; p.out[O_CBS + ((size_t)s * 3 + 2) * D + c] = bxv;
            cbs[e] = cb;
        }
        __syncthreads();
#pragma unroll 1
        for (int cq = 0; cq < 2; ++cq) {
            const int c = tid + cq * 512, h = c >> 6, jj = c & 63;
            float ar[4] = {0.f, 0.f, 0.f, 0.f}, ai[4] = {0.f, 0.f, 0.f, 0.f};
            const float* wr_ = p.in[18] + (size_t)h * 4096 + jj; const float* wi_ = p.in[20] + (size_t)h * 4096 + jj;
#pragma unroll 8
            for (int i = 0; i < 64; ++i) { const float wrv = wr_[i * 64], wiv = wi_[i * 64];
#pragma unroll
                for (int s = 0; s < 4; ++s) { const float x = cbs[s * D + h * 64 + i]; ar[s] += x * wrv; ai[s] += x * wiv; } }
            const float lc = -8.0f * log1pf(expf(-p.in[22][c])), brc = p.in[19][c], bic = p.in[21][c];
#pragma unroll
            for (int s = 0; s < 4; ++s) { const int sg = it * 4 + s; const size_t ro = (size_t)(MP + sg) * D + c;
                const float r = sigm(ar[s] + brc), ig = sigm(ai[s] + bic); const float la = lc * r; const float a = expf(la); const float mult = sqrtf(-expm1f(2.0f * la));
                const float hn = a * p.in[4][(size_t)sg * D + c] + mult * ig * cbs[s * D + c];
                p.out[O_RGS + (size_t)sg * D + c] = hn;
                U[1 * SLOT + ro] = f2bf(gelu_tanh(bf2f(U[1 * SLOT + ro])) * hn); }
        }
        __syncthreads();
    }
}

__device__ __forceinline__ void merge_phase(const Params& p, int tid) {
    const bf16_t* U = (const bf16_t*)(p.ws + WS_U); bf16_t* H = (bf16_t*)(p.ws + WS_H); const float* PO = (const float*)(p.ws + WS_POAB);
    for (size_t i = (size_t)blockIdx.x * 512 + tid; i < SLOT / 8; i += (size_t)gridDim.x * 512) {
        const u32x4 ga = *(const u32x4*)(U + 4 * SLOT + i * 8), gb = *(const u32x4*)(U + 5 * SLOT + i * 8);
        float ya[8], yb[8];
        const int row = (int)(i >> 7);
        if (row < MAINR) {
            const u32x4 a = *(const u32x4*)(U + 2 * SLOT + i * 8), b = *(const u32x4*)(U + 3 * SLOT + i * 8);
#pragma unroll
            for (int e = 0; e < 4; ++e) { ya[2 * e] = bflo(a[e]); ya[2 * e + 1] = bfhi(a[e]); yb[2 * e] = bflo(b[e]); yb[2 * e + 1] = bfhi(b[e]); }
        } else {
            const size_t o = (size_t)(row - MAINR) * D + (size_t)(i & 127) * 8;
#pragma unroll
            for (int e = 0; e < 8; ++e) { ya[e] = 0.f; yb[e] = 0.f; }
#pragma unroll
            for (int ks = 0; ks < 4; ++ks) {
                const f32x4 a0 = *(const f32x4*)(PO + (size_t)(ks * 2 + 0) * (256 * D) + o), a1 = *(const f32x4*)(PO + (size_t)(ks * 2 + 0) * (256 * D) + o + 4);
                const f32x4 b0 = *(const f32x4*)(PO + (size_t)(ks * 2 + 1) * (256 * D) + o), b1 = *(const f32x4*)(PO + (size_t)(ks * 2 + 1) * (256 * D) + o + 4);
#pragma unroll
                for (int e = 0; e < 4; ++e) { ya[e] += a0[e]; ya[4 + e] += a1[e]; yb[e] += b0[e]; yb[4 + e] += b1[e]; }
            }
        }
        u32x4 o4;
#pragma unroll
        for (int e = 0; e < 4; ++e) { const float lo = sigm(bflo(ga[e])) * ya[2 * e] + sigm(bflo(gb[e])) * yb[2 * e], hi = sigm(bfhi(ga[e])) * ya[2 * e + 1] + sigm(bfhi(gb[e])) * yb[2 * e + 1]; o4[e] = cvt_pk_bf16(lo, hi); }
        *(u32x4*)(H + i * 8) = o4;
    }
}

constexpr int NPHASE = 14;
constexpr int LDS_BYTES = 131072;
__global__ void __launch_bounds__(512, 2) mk_fwd(Params p, int ph_lo, int ph_hi) {
    extern __shared__ __attribute__((aligned(16))) unsigned char shm[];
    LAS unsigned char* lds = (LAS unsigned char*)shm;
    cg::grid_group grid = cg::this_grid();
    for (int ph2 = ph_lo * 2; ph2 < ph_hi * 2; ++ph2) {
        const int ph = ph2 >> 1; const bool dry = !(ph2 & 1);
        if (dry && !((REP_MASK >> ph) & 1)) continue;
        int tid = threadIdx.x; asm volatile("" : "+v"(tid));
        if (ph == 0) {
            convert_set0(p, lds, tid);
            bf16_t* wt = (bf16_t*)(p.ws + WS_WRG);
            for (int o = blockIdx.x * 512 + tid; o < 2 * 65536; o += gridDim.x * 512) { const int g = o >> 16, h = (o >> 12) & 15, j = (o >> 6) & 63, i = o & 63;
                wt[o] = f2bf((g ? p.in[20] : p.in[18])[(size_t)(h * 64 + i) * 64 + j]); }
            norm_phase(p, 0, tid, dry, 0);
        } else if (ph == 1 || ph == 11) {
            pg8::Gemm g{(const bf16_t*)(p.ws + WS_H), (const bf16_t*)(p.ws + WS_WGU), M, 2 * DFF, D, 0, 0};
            pg8::StaticOrder S; S.init(M, 2 * DFF, D, gridDim.x, blockIdx.x);
            pg8::EpiGU E{(bf16_t*)(p.ws + WS_ACT)};
            pg8::gemm_phase(lds, g, S, E);
        } else if (ph == 2 || ph == 12 || ph == 9 || ph == 7) {
            const bool dn = (ph == 2 || ph == 12), oab = (ph == 7);
            pg8::Gemm g{(const bf16_t*)(p.ws + (dn ? WS_ACT : (oab ? WS_U : WS_H))), (const bf16_t*)(p.ws + (dn ? WS_WD : (oab ? WS_WOAB : WS_WO))), M, D, dn ? DFF : D, SB, (size_t)1024 * 1024 * 2};
            pg8::SplitOrder S; S.init(oab ? 2 * D : D, dn ? DFF : D, gridDim.x, blockIdx.x, dn ? 11 : 4, 4);
            pg8::EpiBF E{(bf16_t*)(p.ws + (oab ? WS_U + 2 * SB : WS_Y)), SLOT, (float*)(p.ws + (oab ? WS_POAB : WS_PY)), oab ? 2 : 1};
            pg8::gemm_phase(lds, g, S, E);
        } else if (ph == 3) {
            norm_phase(p, 1, tid, dry, 11);
        } else if (ph == 4) {
            pg8::Gemm g{(const bf16_t*)(p.ws + WS_H), (const bf16_t*)(p.ws + WS_WIN), M, DIN, D, 0, 0};
            pg8::StaticOrder S; S.init(M, DIN, D, gridDim.x, blockIdx.x);
            pg8::EpiIN E{(bf16_t*)(p.ws + WS_U)};
            pg8::gemm_phase(lds, g, S, E);
        } else if (ph == 5) {
            scan_phase<false>(p, lds, tid, dry);
            za_phase(p, tid, dry);
        } else if (ph == 6) {
            if (!dry) sample_phase(p, lds, tid);
            scan_phase<true>(p, lds, tid, dry);
        } else if (ph == 8) {
            merge_phase(p, tid);
        } else if (ph == 10) {
            convert_set1(p, lds, tid);
            norm_phase(p, 2, tid, dry, 4);
        } else if (ph == 13) {
            norm_phase(p, 3, tid, dry, 11);
        }
        if (ph2 + 1 < ph_hi * 2) grid.sync();
    }
}

extern "C" void kernel_launch(void* const* d_in, const int* in_sizes, int n_in, void* d_out, int out_size, void* d_ws, size_t ws_size, hipStream_t stream) {
    if (n_in != 30 || ws_size < WS_END) { fprintf(stderr, "kernel_launch: unexpected n_in %d / ws_size %zu (need %zu)\n", n_in, ws_size, (size_t)WS_END); return; }
    Params p{};
    for (int i = 0; i < 30; ++i) p.in[i] = (const float*)d_in[i];
    p.out = (float*)d_out; p.ws = (unsigned char*)d_ws;
    (void)hipFuncSetAttribute((const void*)mk_fwd, hipFuncAttributeMaxDynamicSharedMemorySize, LDS_BYTES);
    static int grid_blocks = 0;
    if (!grid_blocks) {
        int dev = 0, cus = 0, per_cu = 0;
        (void)hipGetDevice(&dev);
        (void)hipDeviceGetAttribute(&cus, hipDeviceAttributeMultiprocessorCount, dev);
        (void)hipOccupancyMaxActiveBlocksPerMultiprocessor(&per_cu, (const void*)mk_fwd, 512, LDS_BYTES);
        if (per_cu < 1) { fprintf(stderr, "kernel_launch: occupancy query says %d blocks/CU\n", per_cu); per_cu = 1; }
        grid_blocks = cus;
    }
#if SINGLE_LAUNCH
    int lo = 0, hi = NPHASE;
    void* args[] = {&p, &lo, &hi};
    hipError_t e = hipLaunchCooperativeKernel((const void*)mk_fwd, dim3(grid_blocks), dim3(512), args, LDS_BYTES, stream);
    if (e != hipSuccess) fprintf(stderr, "cooperative launch failed: %s (grid %d)\n", hipGetErrorString(e), grid_blocks);
#else
    for (int ph = 0; ph < NPHASE; ++ph) hipLaunchKernelGGL(mk_fwd, dim3(grid_blocks), dim3(512), LDS_BYTES, stream, p, ph, ph + 1);
#endif
}
```

```cpp
#include <hip/hip_runtime.h>
#include <hip/hip_cooperative_groups.h>
#include <cstdio>
namespace cg = cooperative_groups;

#ifndef REP_MASK
#define REP_MASK 0
#endif
#ifndef SINGLE_LAUNCH
#define SINGLE_LAUNCH 1
#endif

#define LAS __attribute__((address_space(3)))
typedef unsigned short bf16_t;
typedef short bf16x8 __attribute__((ext_vector_type(8)));
typedef float f32x4 __attribute__((ext_vector_type(4)));
typedef unsigned u32x4 __attribute__((ext_vector_type(4)));
typedef unsigned u32x2 __attribute__((ext_vector_type(2)));

constexpr int D = 1024, DFF = 2816, DIN = 7168;
constexpr int NB = 8, SEQ = 2048, NMETA = 16, TP = SEQ + NMETA;
constexpr int MP = NB * TP;
constexpr int NS = 128;
constexpr int M = MP + NS;
constexpr int CHUNK = 48, NCH = TP / CHUNK;
constexpr float EPS = 1e-6f;

constexpr size_t O_YP = 0, O_YS = 16777216, O_CAP = O_YS + 131072, O_CBP = O_CAP + 16384, O_RGP = O_CBP + 24576,
                 O_CAS = O_RGP + 8192, O_CBS = O_CAS + 262144, O_RGS = O_CBS + 393216;

constexpr size_t SLOT = (size_t)M * D;
constexpr size_t SB = SLOT * 2;
constexpr size_t WS_U = 0;
constexpr size_t WS_ACT = 0;
constexpr size_t WS_Y = 3 * SB;
constexpr size_t WS_PY = 4 * SB;
constexpr int MAINR = 64 * 256;
constexpr size_t WS_WGU = 5 * SB;
constexpr size_t WS_WD = WS_WGU + (size_t)5632 * 1024 * 2;
constexpr size_t WS_H = 6 * SB;
constexpr size_t WS_WIN = 7 * SB;
constexpr size_t WS_POAB = WS_WIN;
constexpr size_t WS_WOAB = WS_WIN + (size_t)7168 * 1024 * 2;
constexpr size_t WS_WO = WS_WOAB + (size_t)2 * 1024 * 1024 * 2;
constexpr size_t WS_WRG = WS_WO + (size_t)1024 * 1024 * 2;
constexpr size_t WS_SUMM = WS_WRG + (size_t)2 * 16 * 64 * 64 * 2;
constexpr size_t WS_XMETA = WS_SUMM + (size_t)NB * NCH * D * 2 * 4;
constexpr size_t WS_BAR = WS_XMETA + (size_t)NB * NMETA * D * 4;
constexpr size_t WS_END = WS_BAR + 16384;
static_assert(WS_END <= (size_t)256 * 1024 * 1024, "workspace");

struct Params { const float* in[30]; float* out; unsigned char* ws; };

__device__ __forceinline__ unsigned cvt_pk_bf16(float lo, float hi) { unsigned r; asm volatile("v_cvt_pk_bf16_f32 %0, %1, %2" : "=v"(r) : "v"(lo), "v"(hi)); return r; }
__device__ __forceinline__ bf16_t f2bf(float f) { return (bf16_t)(cvt_pk_bf16(f, 0.f) & 0xffffu); }
__device__ __forceinline__ float bf2f(bf16_t b) { return __uint_as_float(((unsigned)b) << 16); }
__device__ __forceinline__ float bflo(unsigned w) { return __uint_as_float(w << 16); }
__device__ __forceinline__ float bfhi(unsigned w) { return __uint_as_float(w & 0xffff0000u); }
__device__ __forceinline__ float sigm(float x) { return __builtin_amdgcn_rcpf(1.0f + __expf(-x)); }
__device__ __forceinline__ float gelu_tanh(float x) { const float t = 1.5957691216057308f * (x + 0.044715f * x * x * x); return x * sigm(t); }
__device__ __forceinline__ float wave_sum(float v, int lane) {
#pragma unroll
    for (int o = 32; o >= 1; o >>= 1) v += __int_as_float(__builtin_amdgcn_ds_bpermute((lane ^ o) << 2, __float_as_int(v)));
    return v;
}
__device__ __forceinline__ float* xrow(const Params& p, int r) {
    if (r >= MP) return p.out + O_YS + (size_t)(r - MP) * D;
    const int b = r / TP, t = r - b * TP;
    if (t < NMETA) return (float*)(p.ws + WS_XMETA) + (size_t)(b * NMETA + t) * D;
    return p.out + O_YP + ((size_t)b * SEQ + (t - NMETA)) * D;
}
__device__ __forceinline__ const float* x0row(const Params& p, int r) {
    if (r >= MP) return p.in[1] + (size_t)(r - MP) * D;
    const int b = r / TP, t = r - b * TP;
    if (t < NMETA) return p.in[5] + (size_t)t * D;
    return p.in[0] + ((size_t)b * SEQ + (t - NMETA)) * D;
}

namespace pg8 {
constexpr int BM = 256, BK = 64, HALF = 128, HTB = HALF * BK * 2, STAGE_BYTES = 8 * HTB, NXCD = 8, WGM = 8;
__host__ __device__ __forceinline__ int lds_byte(int r, int c) { const int st = (r >> 4) * 2 + (c >> 5), rr = r & 15, cc = c & 31, ob = rr * 64 + cc * 2; return st * 1024 + (ob ^ (((ob >> 9) & 1) << 5)); }
__host__ __device__ __forceinline__ void stage_rc(int b, int& R, int& C) { const int st = b / 1024, sb = b % 1024, swz = sb ^ (((sb >> 9) & 1) << 5); R = (st >> 1) * 16 + swz / 64; C = (st & 1) * 32 + (swz % 64) / 2; }
__host__ __device__ __forceinline__ int perm32(int rho) { const int n = rho >> 4, i = rho & 15; return 8 * (i >> 2) + 4 * n + (i & 3); }

struct Unit { int pm, pn, z, k0, nk, part; };
struct Gemm { const bf16_t* A; const bf16_t* Bt; int M, N, K; size_t zA, zB; };

struct StaticOrder {
    int nM, nN, nwg, G, c, ntf;
    __device__ void init(int M_, int N_, int K_, int G_, int c_) { nM = M_ / BM; nN = N_ / BM; nwg = nM * nN; G = G_; c = c_; ntf = K_ / BK; }
    __device__ bool map(long L, Unit& u) const {
        if (L >= nwg) return false;
        int wgid = (int)L; { const int q = nwg / NXCD, r = nwg % NXCD, xcd = wgid % NXCD, off = wgid / NXCD; wgid = (xcd < r ? xcd * (q + 1) : r * (q + 1) + (xcd - r) * q) + off; }
        const int nig = WGM * nN, gid = wgid / nig, fm = gid * WGM, gsz = (nM - fm) < WGM ? (nM - fm) : WGM;
        u.pm = fm + ((wgid % nig) % gsz); u.pn = (wgid % nig) / gsz; u.z = 0; u.k0 = 0; u.nk = ntf; u.part = -1; return true;
    }
    __device__ bool next(int i, Unit& u) const { return map((long)i * G + c, u); }
};
struct SplitOrder : StaticOrder {
    int nsplit, nkm;
    __device__ void init(int N_, int K_, int G_, int c_, int nsplit_, int nkm_) { StaticOrder::init(64 * BM, N_, K_, G_, c_); nsplit = nsplit_; nkm = nkm_; }
    __device__ bool next(int i, Unit& u) const {
        const long L = (long)i * G + c; bool ok;
        if (L < nwg) ok = map(L, u);
        else { const int L2 = (int)(L - nwg); ok = L2 < nN * nsplit; const int ks = L2 / nN; u.pm = 64; u.pn = L2 - ks * nN; u.k0 = ks * nkm; u.nk = nkm; u.part = ks; }
        u.z = u.pn >> 2; u.pn &= 3; return ok;
    }
};

template <class Epi, class Sched>
__device__ __forceinline__ void gemm_phase(LAS unsigned char* lds, const Gemm g, const Sched& S, const Epi& E) {
    int tid_ = threadIdx.x; asm volatile("" : "+v"(tid_));
    const int tid = tid_, wid = __builtin_amdgcn_readfirstlane(tid >> 6), lane = tid & 63, wr = wid >> 2, wc = wid & 3, fr = lane & 15, fq = lane >> 4;
    const int K = g.K;
    unsigned voffA[2], voffB[2];
#pragma unroll
    for (int i = 0; i < 2; ++i) { int R, C; stage_rc(tid * 16 + i * 8192, R, C); const int Rb = Epi::PERM ? ((R & ~31) + perm32(R & 31)) : R;
        voffA[i] = (unsigned)(R * K + C) * 2u; voffB[i] = (unsigned)(Rb * K + C) * 2u; }
    const size_t kstep = (size_t)(BK * 2);
    const size_t hstep = (size_t)HALF * K * 2;
    const size_t tstep = 2 * hstep;
    const unsigned ldsw = (unsigned)wid * 1024u;
    const int aoff = lds_byte(wr * 64 + fr, fq * 8), boff = lds_byte(wc * 32 + fr, fq * 8);
#define PG8_SA(b, h) (((b) * 2 + (h)) * HTB)
#define PG8_SB(b, h) ((4 + (b) * 2 + (h)) * HTB)
#define PG8_STAGE(bufoff, gbase, voff) do { _Pragma("unroll") for (int _i = 0; _i < 2; ++_i) \
        __builtin_amdgcn_global_load_lds((const unsigned*)((const char*)(gbase) + (voff)[_i]), (LAS unsigned*)(lds + (bufoff) + ldsw + _i * 8192), 16, 0, 0); } while (0)
#define PG8_LDA(dst, b, h) do { _Pragma("unroll") for (int m = 0; m < 4; ++m) _Pragma("unroll") for (int k = 0; k < 2; ++k) dst[m][k] = *(const LAS bf16x8*)(lds + PG8_SA(b, h) + aoff + m * 2048 + k * 1024); } while (0)
#define PG8_LDB(dst, b, h) do { _Pragma("unroll") for (int n = 0; n < 2; ++n) _Pragma("unroll") for (int k = 0; k < 2; ++k) dst[n][k] = *(const LAS bf16x8*)(lds + PG8_SB(b, h) + boff + n * 2048 + k * 1024); } while (0)
#define PG8_MMA(ai, bj, At, Bt) do { __builtin_amdgcn_s_setprio(1); _Pragma("unroll") for (int m = 0; m < 4; ++m) _Pragma("unroll") for (int n = 0; n < 2; ++n) _Pragma("unroll") for (int k = 0; k < 2; ++k) \
        acc[ai][bj][m][n] = __builtin_amdgcn_mfma_f32_16x16x32_bf16(Bt[n][k], At[m][k], acc[ai][bj][m][n], 0, 0, 0); __builtin_amdgcn_s_setprio(0); } while (0)
#define PG8_WAIT_V(n) asm volatile("s_waitcnt vmcnt(" #n ")" ::: "memory")
#define PG8_WAIT_L(n) asm volatile("s_waitcnt lgkmcnt(" #n ")" ::: "memory")
#define PG8_BAR __builtin_amdgcn_s_barrier()
#define PG8_SCHED __builtin_amdgcn_sched_barrier(0)
    Unit cur, nxt; int ui = 0;
    if (!S.next(0, cur)) return;
    f32x4 acc[2][2][4][2];
#pragma unroll
    for (int a = 0; a < 2; ++a)
#pragma unroll
        for (int b = 0; b < 2; ++b)
#pragma unroll
            for (int m = 0; m < 4; ++m)
#pragma unroll
                for (int n = 0; n < 2; ++n) acc[a][b][m][n] = (f32x4){0.f, 0.f, 0.f, 0.f};
    bf16x8 At[4][2], B0[2][2], B1[2][2];
    const char* cA = (const char*)g.A + (size_t)cur.z * g.zA + (size_t)cur.pm * tstep + (size_t)cur.k0 * kstep; const char* cB = (const char*)g.Bt + (size_t)cur.z * g.zB + (size_t)cur.pn * tstep + (size_t)cur.k0 * kstep;
    int nt = cur.nk;
    PG8_STAGE(PG8_SB(0, 0), cB, voffB); PG8_STAGE(PG8_SA(0, 0), cA, voffA); PG8_STAGE(PG8_SB(0, 1), cB + hstep, voffB); PG8_STAGE(PG8_SA(0, 1), cA + hstep, voffA);
    if (wr == 1) PG8_BAR;
    PG8_WAIT_V(4); PG8_BAR;
    PG8_STAGE(PG8_SB(1, 0), cB + kstep, voffB); PG8_STAGE(PG8_SA(1, 0), cA + kstep, voffA); PG8_STAGE(PG8_SB(1, 1), cB + hstep + kstep, voffB);
    PG8_WAIT_V(6); PG8_BAR;
    for (;;) {
        const bool has_next = S.next(ui + 1, nxt);
        const char* nA = has_next ? (const char*)g.A + (size_t)nxt.z * g.zA + (size_t)nxt.pm * tstep + (size_t)nxt.k0 * kstep : cA; const char* nB = has_next ? (const char*)g.Bt + (size_t)nxt.z * g.zB + (size_t)nxt.pn * tstep + (size_t)nxt.k0 * kstep : cB;
        for (int t = 0; t < nt; t += 2) {
            const bool last = (t == nt - 2);
            const char* a1 = cA + (size_t)(t + 1) * kstep;
            const char* a2 = last ? nA : cA + (size_t)(t + 2) * kstep; const char* b2 = last ? nB : cB + (size_t)(t + 2) * kstep;
            const char* a3 = a2 + kstep; const char* b3 = b2 + kstep;
            PG8_LDB(B0, 0, 0); PG8_SCHED; PG8_LDA(At, 0, 0); PG8_STAGE(PG8_SA(1, 1), a1 + hstep, voffA);
            PG8_WAIT_L(8); PG8_BAR; PG8_WAIT_L(0); PG8_MMA(0, 0, At, B0); PG8_BAR; PG8_SCHED;
            PG8_LDB(B1, 0, 1); PG8_STAGE(PG8_SB(0, 0), b2, voffB);
            PG8_BAR; PG8_WAIT_L(0); PG8_MMA(0, 1, At, B1); PG8_BAR;
            PG8_LDA(At, 0, 1); PG8_STAGE(PG8_SA(0, 0), a2, voffA);
            PG8_BAR; PG8_WAIT_L(0); PG8_MMA(1, 0, At, B0); PG8_BAR; PG8_SCHED;
            PG8_STAGE(PG8_SB(0, 1), b2 + hstep, voffB);
            PG8_WAIT_V(6); PG8_BAR; PG8_MMA(1, 1, At, B1); PG8_BAR;
            PG8_LDB(B0, 1, 0); PG8_SCHED; PG8_LDA(At, 1, 0); PG8_STAGE(PG8_SA(0, 1), a2 + hstep, voffA);
            PG8_WAIT_L(8); PG8_BAR; PG8_WAIT_L(0); PG8_MMA(0, 0, At, B0); PG8_BAR; PG8_SCHED;
            PG8_LDB(B1, 1, 1); PG8_STAGE(PG8_SB(1, 0), b3, voffB);
            PG8_BAR; PG8_WAIT_L(0); PG8_MMA(0, 1, At, B1); PG8_BAR;
            PG8_LDA(At, 1, 1); PG8_STAGE(PG8_SA(1, 0), a3, voffA);
            PG8_BAR; PG8_WAIT_L(0); PG8_MMA(1, 0, At, B0); PG8_BAR; PG8_SCHED;
            PG8_STAGE(PG8_SB(1, 1), b3 + hstep, voffB);
            PG8_WAIT_V(6); PG8_BAR; PG8_MMA(1, 1, At, B1); PG8_BAR;
        }
        E(acc, cur, wr, wc, fr, fq);
        if (!has_next) break;
#pragma unroll
        for (int a = 0; a < 2; ++a)
#pragma unroll
            for (int b = 0; b < 2; ++b)
#pragma unroll
                for (int m = 0; m < 4; ++m)
#pragma unroll
                    for (int n = 0; n < 2; ++n) acc[a][b][m][n] = (f32x4){0.f, 0.f, 0.f, 0.f};
        cur = nxt; cA = nA; cB = nB; nt = cur.nk; ++ui;
    }
    PG8_WAIT_V(0);
    if (wr == 0) PG8_BAR;
    PG8_BAR;
#undef PG8_SA
#undef PG8_SB
#undef PG8_STAGE
#undef PG8_LDA
#undef PG8_LDB
#undef PG8_MMA
#undef PG8_WAIT_V
#undef PG8_WAIT_L
#undef PG8_BAR
#undef PG8_SCHED
}

struct EpiBF {
    static constexpr bool PERM = true;
    bf16_t* O; size_t zO; float* P; int nz;
    __device__ __forceinline__ void operator()(const f32x4 (&acc)[2][2][4][2], const Unit& u, int wr, int wc, int fr, int fq) const {
        const int col0 = u.pn * BM + wc * 32 + 8 * fq;
        if (u.part < 0) {
            const int row0 = u.pm * BM + wr * 64 + fr; bf16_t* base = O + (size_t)u.z * zO;
#pragma unroll
            for (int ai = 0; ai < 2; ++ai)
#pragma unroll
                for (int m = 0; m < 4; ++m) { bf16_t* rowp = base + (size_t)(row0 + ai * HALF + m * 16) * D + col0;
#pragma unroll
                    for (int bj = 0; bj < 2; ++bj) { const f32x4 v0 = acc[ai][bj][m][0], v1 = acc[ai][bj][m][1];
                        u32x4 w; w.x = cvt_pk_bf16(v0[0], v0[1]); w.y = cvt_pk_bf16(v0[2], v0[3]); w.z = cvt_pk_bf16(v1[0], v1[1]); w.w = cvt_pk_bf16(v1[2], v1[3]);
                        *(u32x4*)(rowp + bj * HALF) = w; } }
        } else {
            const int row0 = wr * 64 + fr; float* base = P + (size_t)(u.part * nz + u.z) * (BM * D);
#pragma unroll
            for (int ai = 0; ai < 2; ++ai)
#pragma unroll
                for (int m = 0; m < 4; ++m) { float* rowp = base + (size_t)(row0 + ai * HALF + m * 16) * D + col0;
#pragma unroll
                    for (int bj = 0; bj < 2; ++bj) { *(f32x4*)(rowp + bj * HALF) = acc[ai][bj][m][0]; *(f32x4*)(rowp + bj * HALF + 4) = acc[ai][bj][m][1]; } }
        }
    }
};
struct EpiGU {
    static constexpr bool PERM = true;
    bf16_t* O;
    __device__ __forceinline__ void operator()(const f32x4 (&acc)[2][2][4][2], const Unit& u, int wr, int wc, int fr, int fq) const {
        const int row0 = u.pm * BM + wr * 64 + fr, col0 = u.pn * HALF + wc * 32 + 8 * fq;
#pragma unroll
        for (int ai = 0; ai < 2; ++ai)
#pragma unroll
            for (int m = 0; m < 4; ++m) { bf16_t* rowp = O + (size_t)(row0 + ai * HALF + m * 16) * DFF + col0;
                float v[8];
#pragma unroll
                for (int n = 0; n < 2; ++n)
#pragma unroll
                    for (int j = 0; j < 4; ++j) { const float gt = acc[ai][0][m][n][j], up = acc[ai][1][m][n][j]; v[n * 4 + j] = gt * sigm(gt) * up; }
                u32x4 w; w.x = cvt_pk_bf16(v[0], v[1]); w.y = cvt_pk_bf16(v[2], v[3]); w.z = cvt_pk_bf16(v[4], v[5]); w.w = cvt_pk_bf16(v[6], v[7]);
                *(u32x4*)rowp = w; }
    }
};
struct EpiIN {
    static constexpr bool PERM = true;
    bf16_t* U;
    __device__ __forceinline__ void operator()(const f32x4 (&acc)[2][2][4][2], const Unit& u, int wr, int wc, int fr, int fq) const {
        const int row0 = u.pm * BM + wr * 64 + fr;
        if (u.pn >= 4 && u.pn < 12) {
            const int col0 = (u.pn - 4) * HALF + wc * 32 + 8 * fq; bf16_t* base = U + 2 * SLOT;
#pragma unroll
            for (int ai = 0; ai < 2; ++ai)
#pragma unroll
                for (int m = 0; m < 4; ++m) { bf16_t* rowp = base + (size_t)(row0 + ai * HALF + m * 16) * D + col0;
                    const f32x4 v0 = acc[ai][0][m][0] * acc[ai][1][m][0], v1 = acc[ai][0][m][1] * acc[ai][1][m][1];
                    u32x4 w; w.x = cvt_pk_bf16(v0[0], v0[1]); w.y = cvt_pk_bf16(v0[2], v0[3]); w.z = cvt_pk_bf16(v1[0], v1[1]); w.w = cvt_pk_bf16(v1[2], v1[3]);
                    *(u32x4*)rowp = w; }
        } else {
            int slot, ct; if (u.pn < 4) { slot = 0; ct = u.pn; } else { const int sg = (u.pn - 12) >> 2; slot = sg == 0 ? 3 : (sg == 1 ? 1 : sg + 2); ct = (u.pn - 12) & 3; }
            const int col0 = ct * BM + wc * 32 + 8 * fq; bf16_t* base = U + (size_t)slot * SLOT;
#pragma unroll
            for (int ai = 0; ai < 2; ++ai)
#pragma unroll
                for (int m = 0; m < 4; ++m) { bf16_t* rowp = base + (size_t)(row0 + ai * HALF + m * 16) * D + col0;
#pragma unroll
                    for (int bj = 0; bj < 2; ++bj) { const f32x4 v0 = acc[ai][bj][m][0], v1 = acc[ai][bj][m][1];
                        u32x4 w; w.x = cvt_pk_bf16(v0[0], v0[1]); w.y = cvt_pk_bf16(v0[2], v0[3]); w.z = cvt_pk_bf16(v1[0], v1[1]); w.w = cvt_pk_bf16(v1[2], v1[3]);
                        *(u32x4*)(rowp + bj * HALF) = w; } }
        }
    }
};
}

__device__ __forceinline__ int conv_map(int mode, int n) {
    if (mode == 0) return n;
    if (mode == 1) return 256 * (n >> 7) + (n & 127);
    if (mode == 2) return 256 * (n >> 7) + 128 + (n & 127);
    const int seg = n >> 10, j = n & 1023;
    if (seg == 0) return j;
    if (seg == 1) return 1024 + 256 * (j >> 7) + (j & 127);
    if (seg == 2) return 1024 + 256 * (j >> 7) + 128 + (j & 127);
    return 3072 + (seg - 3) * 1024 + j;
}
__device__ __forceinline__ void conv_tile(const float* __restrict__ src, int K, int N, bf16_t* __restrict__ dst, int mode, int tile, LAS float* sl, int tid) {
    const int ntn = N >> 6; const int tk = tile / ntn, tn = tile - tk * ntn; const int k0 = tk * 64, n0 = tn * 64;
#pragma unroll
    for (int q = 0; q < 2; ++q) { const int kr = (tid >> 4) + 32 * q; const f32x4 v = *(const f32x4*)(src + (size_t)(k0 + kr) * N + n0 + (tid & 15) * 4);
        LAS float* d = sl + kr * 65 + (tid & 15) * 4; d[0] = v[0]; d[1] = v[1]; d[2] = v[2]; d[3] = v[3]; }
    __syncthreads();
    const int n = tid >> 3, ko = (tid & 7) * 8;
    float f[8];
#pragma unroll
    for (int i = 0; i < 8; ++i) f[i] = sl[(ko + i) * 65 + n];
    u32x4 w; w.x = cvt_pk_bf16(f[0], f[1]); w.y = cvt_pk_bf16(f[2], f[3]); w.z = cvt_pk_bf16(f[4], f[5]); w.w = cvt_pk_bf16(f[6], f[7]);
    *(u32x4*)(dst + (size_t)conv_map(mode, n0 + n) * K + k0 + ko) = w;
    __syncthreads();
}
template <int II, int K, int N, int MODE>
__device__ __forceinline__ void conv_mat(const Params& p, size_t dst, LAS unsigned char* lds, int tid) {
    constexpr int ntiles = (K >> 6) * (N >> 6);
    for (int t = blockIdx.x; t < ntiles; t += gridDim.x) conv_tile(p.in[II], K, N, (bf16_t*)(p.ws + dst), MODE, t, (LAS float*)lds, tid);
}
__device__ __forceinline__ void convert_set0(const Params& p, LAS unsigned char* lds, int tid) {
    conv_mat<8, 1024, 2816, 1>(p, WS_WGU, lds, tid);
    conv_mat<9, 1024, 2816, 2>(p, WS_WGU, lds, tid);
    conv_mat<10, 2816, 1024, 0>(p, WS_WD, lds, tid);
    conv_mat<13, 1024, 7168, 3>(p, WS_WIN, lds, tid);
    conv_mat<15, 1024, 1024, 0>(p, WS_WOAB, lds, tid);
    conv_mat<23, 1024, 1024, 0>(p, WS_WOAB + (size_t)1024 * 1024 * 2, lds, tid);
    conv_mat<24, 1024, 1024, 0>(p, WS_WO, lds, tid);
}
__device__ __forceinline__ void convert_set1(const Params& p, LAS unsigned char* lds, int tid) {
    conv_mat<27, 1024, 2816, 1>(p, WS_WGU, lds, tid);
    conv_mat<28, 1024, 2816, 2>(p, WS_WGU, lds, tid);
    conv_mat<29, 2816, 1024, 0>(p, WS_WD, lds, tid);
}

__device__ __forceinline__ void norm_phase(const Params& p, int mode, int tid, bool dry, int nsplit) {
    const int lane = tid & 63, gw = blockIdx.x * 8 + (tid >> 6), nw = gridDim.x * 8;
    const float* gpost = mode == 1 ? p.in[7] : (mode == 2 ? p.in[12] : p.in[26]);
    const float* gpre = mode == 0 ? p.in[6] : (mode == 1 ? p.in[11] : p.in[25]);
    const float cc = mode == 2 ? 1.0f : 0.5f;
    const bf16_t* Yb = (const bf16_t*)(p.ws + WS_Y); const float* PY = (const float*)(p.ws + WS_PY); bf16_t* H = (bf16_t*)(p.ws + WS_H);
    for (int r = gw; r < M; r += nw) {
        const float* xin = mode <= 1 ? x0row(p, r) : xrow(p, r);
        f32x4 xv[4];
#pragma unroll
        for (int q = 0; q < 4; ++q) xv[q] = *(const f32x4*)(xin + lane * 4 + 256 * q);
        if (mode > 0) {
            f32x4 yv[4]; float ss = 0.f;
            if (r < MAINR) {
#pragma unroll
                for (int q = 0; q < 4; ++q) { const u32x2 w = *(const u32x2*)(Yb + (size_t)r * D + lane * 4 + 256 * q); yv[q] = (f32x4){bflo(w.x), bfhi(w.x), bflo(w.y), bfhi(w.y)}; }
            } else {
#pragma unroll
                for (int q = 0; q < 4; ++q) yv[q] = (f32x4){0.f, 0.f, 0.f, 0.f};
                for (int ks = 0; ks < nsplit; ++ks) {
#pragma unroll
                    for (int q = 0; q < 4; ++q) yv[q] += *(const f32x4*)(PY + ((size_t)ks * 256 + (r - MAINR)) * D + lane * 4 + 256 * q);
                }
            }
#pragma unroll
            for (int q = 0; q < 4; ++q) ss += yv[q][0] * yv[q][0] + yv[q][1] * yv[q][1] + yv[q][2] * yv[q][2] + yv[q][3] * yv[q][3];
            ss = wave_sum(ss, lane);
            const float rs = cc * rsqrtf(ss * (1.0f / D) + EPS);
#pragma unroll
            for (int q = 0; q < 4; ++q) xv[q] += yv[q] * rs * *(const f32x4*)(gpost + lane * 4 + 256 * q);
            float* xo = xrow(p, r);
            if (!dry) {
#pragma unroll
                for (int q = 0; q < 4; ++q) *(f32x4*)(xo + lane * 4 + 256 * q) = xv[q];
            }
        }
        if (mode < 3) {
            float ss = 0.f;
#pragma unroll
            for (int q = 0; q < 4; ++q) ss += xv[q][0] * xv[q][0] + xv[q][1] * xv[q][1] + xv[q][2] * xv[q][2] + xv[q][3] * xv[q][3];
            ss = wave_sum(ss, lane);
            const float rs = rsqrtf(ss * (1.0f / D) + EPS);
#pragma unroll
            for (int q = 0; q < 4; ++q) { const f32x4 hv = xv[q] * rs * *(const f32x4*)(gpre + lane * 4 + 256 * q); u32x2 w; w.x = cvt_pk_bf16(hv[0], hv[1]); w.y = cvt_pk_bf16(hv[2], hv[3]);
                *(u32x2*)(H + (size_t)r * D + lane * 4 + 256 * q) = w; }
        }
    }
}

constexpr int WL_BYTES = 11264;
template <bool FINAL>
__device__ __forceinline__ void scan_item(const Params& p, int b, int j, int h, LAS unsigned char* wl, const LAS unsigned char* wlds, int lane, bool dry) {
    bf16_t* U = (bf16_t*)(p.ws + WS_U);
    const bf16_t* bx = U + 3 * SLOT; bf16_t* bg = U + 1 * SLOT; bf16_t* bgo = dry ? (bf16_t*)(p.ws + WS_H) : bg;
    float* summ = (float*)(p.ws + WS_SUMM);
    const int c = h * 64 + lane, fr = lane & 15, fq = lane >> 4;
    const size_t row0 = (size_t)b * TP + (size_t)j * CHUNK;
    const LAS unsigned char* wq = wlds + fr * 144 + fq * 16;
    float brv[4], biv[4], lcv[4];
#pragma unroll
    for (int nt = 0; nt < 4; ++nt) { const int ch = h * 64 + nt * 16 + fr; brv[nt] = p.in[19][ch]; biv[nt] = p.in[21][ch]; lcv[nt] = -8.0f * log1pf(expf(-p.in[22][ch])); }
    const float w0 = p.in[16][c], w1 = p.in[16][D + c], w2 = p.in[16][2 * D + c], w3 = p.in[16][3 * D + c], cbias = p.in[17][c];
    float xm3 = 0.f, xm2 = 0.f, xm1 = 0.f;
    if (j > 0) { xm3 = bf2f(bx[(row0 - 3) * D + c]); xm2 = bf2f(bx[(row0 - 2) * D + c]); xm1 = bf2f(bx[(row0 - 1) * D + c]); }
    float hh = 0.f, ap = 1.f;
    if (FINAL) {
        const float* sp = summ + ((size_t)b * NCH * D + c) * 2;
        for (int i0 = 0; i0 < j; i0 += 16) {
            float va[16], vh[16];
#pragma unroll
            for (int k = 0; k < 16; ++k) { if (i0 + k < j) { const float2 v = *(const float2*)(sp + (size_t)(i0 + k) * D * 2); va[k] = v.x; vh[k] = v.y; } else { va[k] = 1.f; vh[k] = 0.f; } }
#pragma unroll
            for (int k = 0; k < 16; ++k) hh = va[k] * hh + vh[k];
        }
    }
    LAS unsigned short* cbT = (LAS unsigned short*)wl;
    LAS float* xu = (LAS float*)(wl + 2304);
    LAS float* aS = (LAS float*)(wl + 2304 + 4352);
    bf16_t xr[16], gr[16], xn[16];
#pragma unroll
    for (int tt = 0; tt < 16; ++tt) xr[tt] = bx[(row0 + tt) * D + c];
#pragma unroll
    for (int g = 0; g < 3; ++g) {
        const size_t r0 = row0 + (size_t)g * 16;
        if (FINAL) {
#pragma unroll
            for (int tt = 0; tt < 16; ++tt) gr[tt] = bg[(r0 + tt) * D + c];
        }
        if (g < 2) {
#pragma unroll
            for (int tt = 0; tt < 16; ++tt) xn[tt] = bx[(r0 + 16 + tt) * D + c];
        }
#pragma unroll
        for (int tt = 0; tt < 16; ++tt) { const float x = bf2f(xr[tt]); const float cb = w0 * xm3 + w1 * xm2 + w2 * xm1 + w3 * x + cbias; xm3 = xm2; xm2 = xm1; xm1 = x;
            cbT[tt * 72 + lane] = f2bf(cb); xu[tt * 68 + lane] = cb; }
        __builtin_amdgcn_wave_barrier();
        const bf16x8 a0 = *(const LAS bf16x8*)(cbT + fr * 72 + fq * 8), a1 = *(const LAS bf16x8*)(cbT + fr * 72 + 32 + fq * 8);
        f32x4 accR[4], accI[4];
#pragma unroll
        for (int nt = 0; nt < 4; ++nt) {
            const bf16x8 r0w = *(const LAS bf16x8*)(wq + nt * 2304), r1w = *(const LAS bf16x8*)(wq + nt * 2304 + 64);
            const bf16x8 i0w = *(const LAS bf16x8*)(wq + 9216 + nt * 2304), i1w = *(const LAS bf16x8*)(wq + 9216 + nt * 2304 + 64);
            accR[nt] = __builtin_amdgcn_mfma_f32_16x16x32_bf16(a0, r0w, (f32x4){0.f, 0.f, 0.f, 0.f}, 0, 0, 0);
            accR[nt] = __builtin_amdgcn_mfma_f32_16x16x32_bf16(a1, r1w, accR[nt], 0, 0, 0);
            accI[nt] = __builtin_amdgcn_mfma_f32_16x16x32_bf16(a0, i0w, (f32x4){0.f, 0.f, 0.f, 0.f}, 0, 0, 0);
            accI[nt] = __builtin_amdgcn_mfma_f32_16x16x32_bf16(a1, i1w, accI[nt], 0, 0, 0);
        }
#pragma unroll
        for (int nt = 0; nt < 4; ++nt)
#pragma unroll
            for (int i = 0; i < 4; ++i) { const int idx = (fq * 4 + i) * 68 + nt * 16 + fr; const float x = xu[idx];
                const float r = sigm(accR[nt][i] + brv[nt]), ig = sigm(accI[nt][i] + biv[nt]);
                const float la = lcv[nt] * r; const float a = __expf(la);
                const float z2 = 2.0f * la;
                const float m2s = -z2 * (1.0f + z2 * (0.5f + z2 * (0.16666667f + z2 * (0.041666668f + z2 * (0.0083333338f + z2 * 0.0013888889f)))));
                const float m2 = z2 > -0.25f ? m2s : 1.0f - a * a;
                xu[idx] = __builtin_amdgcn_sqrtf(m2) * ig * x; aS[idx] = a; }
        __builtin_amdgcn_wave_barrier();
#pragma unroll
        for (int tt = 0; tt < 16; ++tt) { const float a = aS[tt * 68 + lane], uu = xu[tt * 68 + lane]; hh = a * hh + uu;
            if (!FINAL) ap *= a; else bgo[(r0 + tt) * D + c] = f2bf(gelu_tanh(bf2f(gr[tt])) * hh); }
        __builtin_amdgcn_wave_barrier();
        if (g < 2) {
#pragma unroll
            for (int tt = 0; tt < 16; ++tt) xr[tt] = xn[tt];
        }
    }
    if (!FINAL) { *(float2*)(summ + (((size_t)b * NCH + j) * D + c) * 2) = make_float2(ap, hh); }
    else if (j == NCH - 1) { p.out[O_RGP + (size_t)b * D + c] = hh; p.out[O_CBP + ((size_t)b * 3 + 0) * D + c] = xm3; p.out[O_CBP + ((size_t)b * 3 + 1) * D + c] = xm2; p.out[O_CBP + ((size_t)b * 3 + 2) * D + c] = xm1; }
}
template <bool FINAL>
__device__ __forceinline__ void scan_phase(const Params& p, LAS unsigned char* lds, int tid, bool dry) {
    const int wid = tid >> 6, lane = tid & 63;
    LAS unsigned char* wl = lds + wid * WL_BYTES;
    LAS unsigned char* wlds = lds + 8 * WL_BYTES;
    const int h = blockIdx.x & 15;
    {
        const bf16_t* wt = (const bf16_t*)(p.ws + WS_WRG);
#pragma unroll
        for (int q = 0; q < 2; ++q) { const int e = tid + q * 512, g = e >> 9, jrow = (e >> 3) & 63, pc = e & 7;
            *(LAS u32x4*)(wlds + g * 9216 + jrow * 144 + pc * 16) = *(const u32x4*)(wt + (size_t)g * 65536 + (size_t)(h * 64 + jrow) * 64 + pc * 8); }
    }
    __syncthreads();
    const int nbh = gridDim.x >> 4;
    for (int it = (blockIdx.x >> 4) * 8 + wid; it < NB * NCH; it += nbh * 8) scan_item<FINAL>(p, it / NCH, it % NCH, h, wl, wlds, lane, dry);
    __syncthreads();
}
__device__ __forceinline__ void za_phase(const Params& p, int tid, bool dry) {
    bf16_t* U = (bf16_t*)(p.ws + WS_U); bf16_t* ab = U; bf16_t* abo = dry ? (bf16_t*)(p.ws + WS_H) : ab; const bf16_t* ca = U + 2 * SLOT;
    const float* cw = p.in[14];
    for (int idx = blockIdx.x * 512 + tid; idx < NB * 129 * 128; idx += gridDim.x * 512) {
        const int vc = idx & 127, tb = (idx >> 7) % 129, b = idx / (128 * 129); const int c0 = vc * 8;
        float w[3][8];
#pragma unroll
        for (int k = 0; k < 3; ++k) { const f32x4 a = *(const f32x4*)(cw + k * D + c0), bq = *(const f32x4*)(cw + k * D + c0 + 4);
#pragma unroll
            for (int e = 0; e < 4; ++e) { w[k][e] = a[e]; w[k][4 + e] = bq[e]; } }
        const size_t r0 = (size_t)b * TP + (size_t)tb * 16;
        float p2[8], p1[8];
        if (tb > 0) { const u32x4 q2 = *(const u32x4*)(ca + (r0 - 2) * D + c0), q1 = *(const u32x4*)(ca + (r0 - 1) * D + c0);
#pragma unroll
            for (int e = 0; e < 4; ++e) { p2[2 * e] = bflo(q2[e]); p2[2 * e + 1] = bfhi(q2[e]); p1[2 * e] = bflo(q1[e]); p1[2 * e + 1] = bfhi(q1[e]); } }
        else {
#pragma unroll
            for (int e = 0; e < 8; ++e) { p2[e] = 0.f; p1[e] = 0.f; } }
#pragma unroll 4
        for (int tt = 0; tt < 16; ++tt) {
            const u32x4 qc = *(const u32x4*)(ca + (r0 + tt) * D + c0), qa = *(const u32x4*)(ab + (r0 + tt) * D + c0);
            float cv[8], av[8], zv[8];
#pragma unroll
            for (int e = 0; e < 4; ++e) { cv[2 * e] = bflo(qc[e]); cv[2 * e + 1] = bfhi(qc[e]); av[2 * e] = bflo(qa[e]); av[2 * e + 1] = bfhi(qa[e]); }
#pragma unroll
            for (int e = 0; e < 8; ++e) { zv[e] = av[e] * (w[0][e] * p2[e] + w[1][e] * p1[e] + w[2][e] * cv[e]); p2[e] = p1[e]; p1[e] = cv[e]; }
            u32x4 o; o.x = cvt_pk_bf16(zv[0], zv[1]); o.y = cvt_pk_bf16(zv[2], zv[3]); o.z = cvt_pk_bf16(zv[4], zv[5]); o.w = cvt_pk_bf16(zv[6], zv[7]);
            *(u32x4*)(abo + (r0 + tt) * D + c0) = o;
        }
        if (tb == 128) {
            float* o2 = p.out + O_CAP + ((size_t)b * 2 + 0) * D + c0; float* o1 = p.out + O_CAP + ((size_t)b * 2 + 1) * D + c0;
            *(f32x4*)o2 = (f32x4){p2[0], p2[1], p2[2], p2[3]}; *(f32x4*)(o2 + 4) = (f32x4){p2[4], p2[5], p2[6], p2[7]};
            *(f32x4*)o1 = (f32x4){p1[0], p1[1], p1[2], p1[3]}; *(f32x4*)(o1 + 4) = (f32x4){p1[4], p1[5], p1[6], p1[7]};
        }
    }
}
__device__ __forceinline__ void sample_phase(const Params& p, LAS unsigned char* lds, int tid) {
    bf16_t* U = (bf16_t*)(p.ws + WS_U);
    LAS float* cbs = (LAS float*)lds;
    for (int it = blockIdx.x; it < NS / 4; it += gridDim.x) {
        for (int e = tid; e < 4 * D; e += 512) {
            const int s = it * 4 + (e >> 10), c = e & 1023; const size_t ro = (size_t)(MP + s) * D + c;
            const float cav = bf2f(U[2 * SLOT + ro]), abv = bf2f(U[ro]);
            const float s0 = p.in[2][((size_t)s * 2 + 0) * D + c], s1 = p.in[2][((size_t)s * 2 + 1) * D + c];
            const float cva = p.in[14][c] * s0 + p.in[14][D + c] * s1 + p.in[14][2 * D + c] * cav;
            U[ro] = f2bf(abv * cva);
            p.out[O_CAS + ((size_t)s * 2 + 0) * D + c] = s1; p.out[O_CAS + ((size_t)s * 2 + 1) * D + c] = cav;
            const float bxv = bf2f(U[3 * SLOT + ro]);
            const float t0 = p.in[3][((size_t)s * 3 + 0) * D + c], t1 = p.in[3][((size_t)s * 3 + 1) * D + c], t2 = p.in[3][((size_t)s * 3 + 2) * D + c];
            const float cb = p.in[16][c] * t0 + p.in[16][D + c] * t1 + p.in[16][2 * D + c] * t2 + p.in[16][3 * D + c] * bxv + p.in[17][c];
            p.out[O_CBS + ((size_t)s * 3 + 0) * D + c] = t1; p.out[O_CBS + ((size_t)s * 3 + 1) * D + c] = t2; p.out[O_CBS + ((size_t)s * 3 + 2) * D + c] = bxv;
            cbs[e] = cb;
        }
        __syncthreads();
#pragma unroll 1
        for (int cq = 0; cq < 2; ++cq) {
            const int c = tid + cq * 512, h = c >> 6, jj = c & 63;
            float ar[4] = {0.f, 0.f, 0.f, 0.f}, ai[4] = {0.f, 0.f, 0.f, 0.f};
            const float* wr_ = p.in[18] + (size_t)h * 4096 + jj; const float* wi_ = p.in[20] + (size_t)h * 4096 + jj;
#pragma unroll 8
            for (int i = 0; i < 64; ++i) { const float wrv = wr_[i * 64], wiv = wi_[i * 64];
#pragma unroll
                for (int s = 0; s < 4; ++s) { const float x = cbs[s * D + h * 64 + i]; ar[s] += x * wrv; ai[s] += x * wiv; } }
            const float lc = -8.0f * log1pf(expf(-p.in[22][c])), brc = p.in[19][c], bic = p.in[21][c];
#pragma unroll
            for (int s = 0; s < 4; ++s) { const int sg = it * 4 + s; const size_t ro = (size_t)(MP + sg) * D + c;
                const float r = sigm(ar[s] + brc), ig = sigm(ai[s] + bic); const float la = lc * r; const float a = expf(la); const float mult = sqrtf(-expm1f(2.0f * la));
                const float hn = a * p.in[4][(size_t)sg * D + c] + mult * ig * cbs[s * D + c];
                p.out[O_RGS + (size_t)sg * D + c] = hn;
                U[1 * SLOT + ro] = f2bf(gelu_tanh(bf2f(U[1 * SLOT + ro])) * hn); }
        }
        __syncthreads();
    }
}

__device__ __forceinline__ void merge_phase(const Params& p, int tid) {
    const bf16_t* U = (const bf16_t*)(p.ws + WS_U); bf16_t* H = (bf16_t*)(p.ws + WS_H); const float* PO = (const float*)(p.ws + WS_POAB);
    for (size_t i = (size_t)blockIdx.x * 512 + tid; i < SLOT / 8; i += (size_t)gridDim.x * 512) {
        const u32x4 ga = *(const u32x4*)(U + 4 * SLOT + i * 8), gb = *(const u32x4*)(U + 5 * SLOT + i * 8);
        float ya[8], yb[8];
        const int row = (int)(i >> 7);
        if (row < MAINR) {
            const u32x4 a = *(const u32x4*)(U + 2 * SLOT + i * 8), b = *(const u32x4*)(U + 3 * SLOT + i * 8);
#pragma unroll
            for (int e = 0; e < 4; ++e) { ya[2 * e] = bflo(a[e]); ya[2 * e + 1] = bfhi(a[e]); yb[2 * e] = bflo(b[e]); yb[2 * e + 1] = bfhi(b[e]); }
        } else {
            const size_t o = (size_t)(row - MAINR) * D + (size_t)(i & 127) * 8;
#pragma unroll
            for (int e = 0; e < 8; ++e) { ya[e] = 0.f; yb[e] = 0.f; }
#pragma unroll
            for (int ks = 0; ks < 4; ++ks) {
                const f32x4 a0 = *(const f32x4*)(PO + (size_t)(ks * 2 + 0) * (256 * D) + o), a1 = *(const f32x4*)(PO + (size_t)(ks * 2 + 0) * (256 * D) + o + 4);
                const f32x4 b0 = *(const f32x4*)(PO + (size_t)(ks * 2 + 1) * (256 * D) + o), b1 = *(const f32x4*)(PO + (size_t)(ks * 2 + 1) * (256 * D) + o + 4);
#pragma unroll
                for (int e = 0; e < 4; ++e) { ya[e] += a0[e]; ya[4 + e] += a1[e]; yb[e] += b0[e]; yb[4 + e] += b1[e]; }
            }
        }
        u32x4 o4;
#pragma unroll
        for (int e = 0; e < 4; ++e) { const float lo = sigm(bflo(ga[e])) * ya[2 * e] + sigm(bflo(gb[e])) * yb[2 * e], hi = sigm(bfhi(ga[e])) * ya[2 * e + 1] + sigm(bfhi(gb[e])) * yb[2 * e + 1]; o4[e] = cvt_pk_bf16(lo, hi); }
        *(u32x4*)(H + i * 8) = o4;
    }
}

#define XB_TMO      128
#define XB_XCNT(j)  (256  + 64 * (j))
#define XB_XSUB(j)  (1280 + 64 * (j))
#define XB_XGEN(j)  (2304 + 64 * (j))
#define XB_TOP      3328
#define XB_TOPGEN   3392
#define XCD_BAR_WORDS 3456
#define XB_SPIN_CAP (1u << 18)
__device__ __forceinline__ unsigned xb_ld(unsigned* p)              { return __hip_atomic_load(p, __ATOMIC_RELAXED, __HIP_MEMORY_SCOPE_AGENT); }
__device__ __forceinline__ unsigned xb_add(unsigned* p, unsigned v) { return __hip_atomic_fetch_add(p, v, __ATOMIC_RELAXED, __HIP_MEMORY_SCOPE_AGENT); }
__device__ __forceinline__ unsigned xb_xcc_id() { return (unsigned)__builtin_amdgcn_s_getreg((3 << 11) | 20) & 0xFu; }
#define XB_SPIN(cond, bar) do { unsigned _sp = 0; while (cond) { __builtin_amdgcn_s_sleep(1); \
    if ((++_sp & 255u) == 0u) { if (xb_ld(&(bar)[XB_TMO])) break; if (_sp > XB_SPIN_CAP) { atomicAdd(&(bar)[XB_TMO], 1u); break; } } } } while (0)
struct XcdBarrier { unsigned* bar; unsigned x; volatile LAS unsigned* st; };
__device__ __forceinline__ XcdBarrier xcd_barrier_post(unsigned* bar, volatile LAS unsigned* st) {
    XcdBarrier b; b.bar = bar; b.x = xb_xcc_id(); b.st = st;
    if (threadIdx.x == 0) (void)xb_add(&bar[XB_XCNT(b.x)], 1u);
    return b;
}
__device__ __forceinline__ void xcd_barrier_complete(unsigned* bar, unsigned x, unsigned& nloc, unsigned& nx) {
    const unsigned G = gridDim.x * gridDim.y * gridDim.z;
    unsigned sum, cnt, mine, sp = 0u;
    for (;;) {
        sum = 0u; cnt = 0u; mine = 0u;
#pragma unroll
        for (unsigned j = 0; j < 16; ++j) { const unsigned c = xb_ld(&bar[XB_XCNT(j)]); sum += c; cnt += (c > 0u) ? 1u : 0u; mine = (j == x) ? c : mine; }
        if (sum == G) break;
        __builtin_amdgcn_s_sleep(1);
        if ((++sp & 255u) == 0u) { if (xb_ld(&bar[XB_TMO])) break; if (sp > XB_SPIN_CAP) { atomicAdd(&bar[XB_TMO], 1u); break; } }
    }
    nloc = mine > 0u ? mine : 1u; nx = cnt > 0u ? cnt : 1u;
}
__device__ __forceinline__ void xcd_barrier(const XcdBarrier& b) {
    asm volatile("s_waitcnt vmcnt(0)" ::: "memory");
    __syncthreads();
    if (threadIdx.x == 0) {
        unsigned* bar = b.bar;
        __builtin_amdgcn_s_waitcnt(0);
        unsigned nloc = b.st[0], nx = b.st[1];
        if (nloc == 0u) { xcd_barrier_complete(bar, b.x, nloc, nx); b.st[0] = nloc; b.st[1] = nx; }
        const unsigned old = xb_add(&bar[XB_XSUB(b.x)], 1u);
        const unsigned gen = old / nloc;
        if (old + 1u == (gen + 1u) * nloc) {
            __builtin_amdgcn_fence(__ATOMIC_RELEASE, "agent");
            asm volatile("s_waitcnt vmcnt(0)" ::: "memory");
            const unsigned og = xb_add(&bar[XB_TOP], 1u);
            const unsigned tg = og / nx;
            if (og + 1u == (tg + 1u) * nx) xb_add(&bar[XB_TOPGEN], 1u);
            else XB_SPIN(xb_ld(&bar[XB_TOPGEN]) == tg, bar);
            __builtin_amdgcn_fence(__ATOMIC_ACQUIRE, "agent");
            xb_add(&bar[XB_XGEN(b.x)], 1u);
            asm volatile("s_waitcnt vmcnt(0)" ::: "memory");
        } else {
            XB_SPIN(xb_ld(&bar[XB_XGEN(b.x)]) == gen, bar);
            __builtin_amdgcn_fence(__ATOMIC_ACQUIRE, "agent");
            asm volatile("s_waitcnt vmcnt(0)" ::: "memory");
        }
    }
    __syncthreads();
}

constexpr int NPHASE = 14;
constexpr int LDS_BYTES = 131072 + 16;
__global__ void __launch_bounds__(512, 2) mk_fwd(Params p, int ph_lo, int ph_hi) {
    extern __shared__ __attribute__((aligned(16))) unsigned char shm[];
    LAS unsigned char* lds = (LAS unsigned char*)shm;
    cg::grid_group grid = cg::this_grid();
    if (threadIdx.x == 0) { *(LAS u32x4*)(lds + 131072) = (u32x4){0u, 0u, 0u, 0u}; }
    __syncthreads();
    const XcdBarrier xb = xcd_barrier_post((unsigned*)(p.ws + WS_BAR), (volatile LAS unsigned*)(lds + 131072));
    bool first_sync = true;
    for (int ph2 = ph_lo * 2; ph2 < ph_hi * 2; ++ph2) {
        const int ph = ph2 >> 1; const bool dry = !(ph2 & 1);
        if (dry && !((REP_MASK >> ph) & 1)) continue;
        int tid = threadIdx.x; asm volatile("" : "+v"(tid));
        if (ph == 0) {
            convert_set0(p, lds, tid);
            bf16_t* wt = (bf16_t*)(p.ws + WS_WRG);
            for (int o = blockIdx.x * 512 + tid; o < 2 * 65536; o += gridDim.x * 512) { const int g = o >> 16, h = (o >> 12) & 15, j = (o >> 6) & 63, i = o & 63;
                wt[o] = f2bf((g ? p.in[20] : p.in[18])[(size_t)(h * 64 + i) * 64 + j]); }
            norm_phase(p, 0, tid, dry, 0);
        } else if (ph == 1 || ph == 11) {
            pg8::Gemm g{(const bf16_t*)(p.ws + WS_H), (const bf16_t*)(p.ws + WS_WGU), M, 2 * DFF, D, 0, 0};
            pg8::StaticOrder S; S.init(M, 2 * DFF, D, gridDim.x, blockIdx.x);
            pg8::EpiGU E{(bf16_t*)(p.ws + WS_ACT)};
            pg8::gemm_phase(lds, g, S, E);
        } else if (ph == 2 || ph == 12 || ph == 9 || ph == 7) {
            const bool dn = (ph == 2 || ph == 12), oab = (ph == 7);
            pg8::Gemm g{(const bf16_t*)(p.ws + (dn ? WS_ACT : (oab ? WS_U : WS_H))), (const bf16_t*)(p.ws + (dn ? WS_WD : (oab ? WS_WOAB : WS_WO))), M, D, dn ? DFF : D, SB, (size_t)1024 * 1024 * 2};
            pg8::SplitOrder S; S.init(oab ? 2 * D : D, dn ? DFF : D, gridDim.x, blockIdx.x, dn ? 11 : 4, 4);
            pg8::EpiBF E{(bf16_t*)(p.ws + (oab ? WS_U + 2 * SB : WS_Y)), SLOT, (float*)(p.ws + (oab ? WS_POAB : WS_PY)), oab ? 2 : 1};
            pg8::gemm_phase(lds, g, S, E);
        } else if (ph == 3) {
            norm_phase(p, 1, tid, dry, 11);
        } else if (ph == 4) {
            pg8::Gemm g{(const bf16_t*)(p.ws + WS_H), (const bf16_t*)(p.ws + WS_WIN), M, DIN, D, 0, 0};
            pg8::StaticOrder S; S.init(M, DIN, D, gridDim.x, blockIdx.x);
            pg8::EpiIN E{(bf16_t*)(p.ws + WS_U)};
            pg8::gemm_phase(lds, g, S, E);
        } else if (ph == 5) {
            scan_phase<false>(p, lds, tid, dry);
            za_phase(p, tid, dry);
        } else if (ph == 6) {
            if (!dry) sample_phase(p, lds, tid);
            scan_phase<true>(p, lds, tid, dry);
        } else if (ph == 8) {
            merge_phase(p, tid);
        } else if (ph == 10) {
            convert_set1(p, lds, tid);
            norm_phase(p, 2, tid, dry, 4);
        } else if (ph == 13) {
            norm_phase(p, 3, tid, dry, 11);
        }
        if (ph2 + 1 < ph_hi * 2) { if (first_sync) { grid.sync(); first_sync = false; } else xcd_barrier(xb); }
    }
}

extern "C" void kernel_launch(void* const* d_in, const int* in_sizes, int n_in, void* d_out, int out_size, void* d_ws, size_t ws_size, hipStream_t stream) {
    if (n_in != 30 || ws_size < WS_END) { fprintf(stderr, "kernel_launch: unexpected n_in %d / ws_size %zu (need %zu)\n", n_in, ws_size, (size_t)WS_END); return; }
    Params p{};
    for (int i = 0; i < 30; ++i) p.in[i] = (const float*)d_in[i];
    p.out = (float*)d_out; p.ws = (unsigned char*)d_ws;
    (void)hipFuncSetAttribute((const void*)mk_fwd, hipFuncAttributeMaxDynamicSharedMemorySize, LDS_BYTES);
    static int grid_blocks = 0;
    if (!grid_blocks) {
        int dev = 0, cus = 0, per_cu = 0;
        (void)hipGetDevice(&dev);
        (void)hipDeviceGetAttribute(&cus, hipDeviceAttributeMultiprocessorCount, dev);
        (void)hipOccupancyMaxActiveBlocksPerMultiprocessor(&per_cu, (const void*)mk_fwd, 512, LDS_BYTES);
        if (per_cu < 1) { fprintf(stderr, "kernel_launch: occupancy query says %d blocks/CU\n", per_cu); per_cu = 1; }
        grid_blocks = cus;
    }
    (void)hipMemsetAsync((unsigned char*)d_ws + WS_BAR, 0, 16384, stream);
#if SINGLE_LAUNCH
    int lo = 0, hi = NPHASE;
    void* args[] = {&p, &lo, &hi};
    hipError_t e = hipLaunchCooperativeKernel((const void*)mk_fwd, dim3(grid_blocks), dim3(512), args, LDS_BYTES, stream);
    if (e != hipSuccess) fprintf(stderr, "cooperative launch failed: %s (grid %d)\n", hipGetErrorString(e), grid_blocks);
#else
    for (int ph = 0; ph < NPHASE; ++ph) hipLaunchKernelGGL(mk_fwd, dim3(grid_blocks), dim3(512), LDS_BYTES, stream, p, ph, ph + 1);
#endif
}
```

```cpp
#include <hip/hip_runtime.h>
#include <hip/hip_cooperative_groups.h>
#include <cstdio>
namespace cg = cooperative_groups;

#ifndef REP_MASK
#define REP_MASK 0
#endif
#ifndef SINGLE_LAUNCH
#define SINGLE_LAUNCH 1
#endif

#define LAS __attribute__((address_space(3)))
typedef unsigned short bf16_t;
typedef short bf16x8 __attribute__((ext_vector_type(8)));
typedef float f32x4 __attribute__((ext_vector_type(4)));
typedef unsigned u32x4 __attribute__((ext_vector_type(4)));
typedef unsigned u32x2 __attribute__((ext_vector_type(2)));

constexpr int D = 1024, DFF = 2816, DIN = 7168;
constexpr int NB = 8, SEQ = 2048, NMETA = 16, TP = SEQ + NMETA;
constexpr int MP = NB * TP;
constexpr int NS = 128;
constexpr int M = MP + NS;
constexpr int CHUNK = 48, NCH = TP / CHUNK;
constexpr float EPS = 1e-6f;

constexpr size_t O_YP = 0, O_YS = 16777216, O_CAP = O_YS + 131072, O_CBP = O_CAP + 16384, O_RGP = O_CBP + 24576,
                 O_CAS = O_RGP + 8192, O_CBS = O_CAS + 262144, O_RGS = O_CBS + 393216;

constexpr size_t SLOT = (size_t)M * D;
constexpr size_t SB = SLOT * 2;
constexpr size_t WS_U = 0;
constexpr size_t WS_ACT = 0;
constexpr size_t WS_Y = 3 * SB;
constexpr size_t WS_PY = 4 * SB;
constexpr int MAINR = 64 * 256;
constexpr size_t WS_WGU = 5 * SB;
constexpr size_t WS_WD = WS_WGU + (size_t)5632 * 1024 * 2;
constexpr size_t WS_H = 6 * SB;
constexpr size_t WS_WIN = 7 * SB;
constexpr size_t WS_POAB = WS_WIN;
constexpr size_t WS_WOAB = WS_WIN + (size_t)7168 * 1024 * 2;
constexpr size_t WS_WO = WS_WOAB + (size_t)2 * 1024 * 1024 * 2;
constexpr size_t WS_WRG = WS_WO + (size_t)1024 * 1024 * 2;
constexpr size_t WS_SUMM = WS_WRG + (size_t)2 * 16 * 64 * 64 * 2;
constexpr size_t WS_XMETA = WS_SUMM + (size_t)NB * NCH * D * 2 * 4;
constexpr size_t WS_BAR = WS_XMETA + (size_t)NB * NMETA * D * 4;
constexpr size_t WS_END = WS_BAR + 16384;
static_assert(WS_END <= (size_t)256 * 1024 * 1024, "workspace");

struct Params { const float* in[30]; float* out; unsigned char* ws; };

__device__ __forceinline__ unsigned cvt_pk_bf16(float lo, float hi) { unsigned r; asm volatile("v_cvt_pk_bf16_f32 %0, %1, %2" : "=v"(r) : "v"(lo), "v"(hi)); return r; }
__device__ __forceinline__ bf16_t f2bf(float f) { return (bf16_t)(cvt_pk_bf16(f, 0.f) & 0xffffu); }
__device__ __forceinline__ float bf2f(bf16_t b) { return __uint_as_float(((unsigned)b) << 16); }
__device__ __forceinline__ float bflo(unsigned w) { return __uint_as_float(w << 16); }
__device__ __forceinline__ float bfhi(unsigned w) { return __uint_as_float(w & 0xffff0000u); }
__device__ __forceinline__ float sigm(float x) { return __builtin_amdgcn_rcpf(1.0f + __expf(-x)); }
__device__ __forceinline__ float gelu_tanh(float x) { const float t = 1.5957691216057308f * (x + 0.044715f * x * x * x); return x * sigm(t); }
__device__ __forceinline__ float wave_sum(float v, int lane) {
#pragma unroll
    for (int o = 32; o >= 1; o >>= 1) v += __int_as_float(__builtin_amdgcn_ds_bpermute((lane ^ o) << 2, __float_as_int(v)));
    return v;
}
__device__ __forceinline__ float* xrow(const Params& p, int r) {
    if (r >= MP) return p.out + O_YS + (size_t)(r - MP) * D;
    const int b = r / TP, t = r - b * TP;
    if (t < NMETA) return (float*)(p.ws + WS_XMETA) + (size_t)(b * NMETA + t) * D;
    return p.out + O_YP + ((size_t)b * SEQ + (t - NMETA)) * D;
}
__device__ __forceinline__ const float* x0row(const Params& p, int r) {
    if (r >= MP) return p.in[1] + (size_t)(r - MP) * D;
    const int b = r / TP, t = r - b * TP;
    if (t < NMETA) return p.in[5] + (size_t)t * D;
    return p.in[0] + ((size_t)b * SEQ + (t - NMETA)) * D;
}

namespace pg8 {
constexpr int BM = 256, BK = 64, HALF = 128, HTB = HALF * BK * 2, STAGE_BYTES = 8 * HTB, NXCD = 8, WGM = 8;
__host__ __device__ __forceinline__ int lds_byte(int r, int c) { const int st = (r >> 4) * 2 + (c >> 5), rr = r & 15, cc = c & 31, ob = rr * 64 + cc * 2; return st * 1024 + (ob ^ (((ob >> 9) & 1) << 5)); }
__host__ __device__ __forceinline__ void stage_rc(int b, int& R, int& C) { const int st = b / 1024, sb = b % 1024, swz = sb ^ (((sb >> 9) & 1) << 5); R = (st >> 1) * 16 + swz / 64; C = (st & 1) * 32 + (swz % 64) / 2; }
__host__ __device__ __forceinline__ int perm32(int rho) { const int n = rho >> 4, i = rho & 15; return 8 * (i >> 2) + 4 * n + (i & 3); }

struct Unit { int pm, pn, z, k0, nk, part; };
struct Gemm { const bf16_t* A; const bf16_t* Bt; int M, N, K; size_t zA, zB; };

struct StaticOrder {
    int nM, nN, nwg, G, c, ntf;
    __device__ void init(int M_, int N_, int K_, int G_, int c_) { nM = M_ / BM; nN = N_ / BM; nwg = nM * nN; G = G_; c = c_; ntf = K_ / BK; }
    __device__ bool map(long L, Unit& u) const {
        if (L >= nwg) return false;
        int wgid = (int)L; { const int q = nwg / NXCD, r = nwg % NXCD, xcd = wgid % NXCD, off = wgid / NXCD; wgid = (xcd < r ? xcd * (q + 1) : r * (q + 1) + (xcd - r) * q) + off; }
        const int nig = WGM * nN, gid = wgid / nig, fm = gid * WGM, gsz = (nM - fm) < WGM ? (nM - fm) : WGM;
        u.pm = fm + ((wgid % nig) % gsz); u.pn = (wgid % nig) / gsz; u.z = 0; u.k0 = 0; u.nk = ntf; u.part = -1; return true;
    }
    __device__ bool next(int i, Unit& u) const { return map((long)i * G + c, u); }
};
struct SplitOrder : StaticOrder {
    int nsplit, nkm;
    __device__ void init(int N_, int K_, int G_, int c_, int nsplit_, int nkm_) { StaticOrder::init(64 * BM, N_, K_, G_, c_); nsplit = nsplit_; nkm = nkm_; }
    __device__ bool next(int i, Unit& u) const {
        const long L = (long)i * G + c; bool ok;
        if (L < nwg) ok = map(L, u);
        else { const int L2 = (int)(L - nwg); ok = L2 < nN * nsplit; const int ks = L2 / nN; u.pm = 64; u.pn = L2 - ks * nN; u.k0 = ks * nkm; u.nk = nkm; u.part = ks; }
        u.z = u.pn >> 2; u.pn &= 3; return ok;
    }
};

template <class Epi, class Sched>
__device__ __forceinline__ void gemm_phase(LAS unsigned char* lds, const Gemm g, const Sched& S, const Epi& E) {
    int tid_ = threadIdx.x; asm volatile("" : "+v"(tid_));
    const int tid = tid_, wid = __builtin_amdgcn_readfirstlane(tid >> 6), lane = tid & 63, wr = wid >> 2, wc = wid & 3, fr = lane & 15, fq = lane >> 4;
    const int K = g.K;
    unsigned voffA[2], voffB[2];
#pragma unroll
    for (int i = 0; i < 2; ++i) { int R, C; stage_rc(tid * 16 + i * 8192, R, C); const int Rb = Epi::PERM ? ((R & ~31) + perm32(R & 31)) : R;
        voffA[i] = (unsigned)(R * K + C) * 2u; voffB[i] = (unsigned)(Rb * K + C) * 2u; }
    const size_t kstep = (size_t)(BK * 2);
    const size_t hstep = (size_t)HALF * K * 2;
    const size_t tstep = 2 * hstep;
    const unsigned ldsw = (unsigned)wid * 1024u;
    const int aoff = lds_byte(wr * 64 + fr, fq * 8), boff = lds_byte(wc * 32 + fr, fq * 8);
#define PG8_SA(b, h) (((b) * 2 + (h)) * HTB)
#define PG8_SB(b, h) ((4 + (b) * 2 + (h)) * HTB)
#define PG8_STAGE(bufoff, gbase, voff) do { _Pragma("unroll") for (int _i = 0; _i < 2; ++_i) \
        __builtin_amdgcn_global_load_lds((const unsigned*)((const char*)(gbase) + (voff)[_i]), (LAS unsigned*)(lds + (bufoff) + ldsw + _i * 8192), 16, 0, 0); } while (0)
#define PG8_LDA(dst, b, h) do { _Pragma("unroll") for (int m = 0; m < 4; ++m) _Pragma("unroll") for (int k = 0; k < 2; ++k) dst[m][k] = *(const LAS bf16x8*)(lds + PG8_SA(b, h) + aoff + m * 2048 + k * 1024); } while (0)
#define PG8_LDB(dst, b, h) do { _Pragma("unroll") for (int n = 0; n < 2; ++n) _Pragma("unroll") for (int k = 0; k < 2; ++k) dst[n][k] = *(const LAS bf16x8*)(lds + PG8_SB(b, h) + boff + n * 2048 + k * 1024); } while (0)
#define PG8_MMA(ai, bj, At, Bt) do { __builtin_amdgcn_s_setprio(1); _Pragma("unroll") for (int m = 0; m < 4; ++m) _Pragma("unroll") for (int n = 0; n < 2; ++n) _Pragma("unroll") for (int k = 0; k < 2; ++k) \
        acc[ai][bj][m][n] = __builtin_amdgcn_mfma_f32_16x16x32_bf16(Bt[n][k], At[m][k], acc[ai][bj][m][n], 0, 0, 0); __builtin_amdgcn_s_setprio(0); } while (0)
#define PG8_WAIT_V(n) asm volatile("s_waitcnt vmcnt(" #n ")" ::: "memory")
#define PG8_WAIT_L(n) asm volatile("s_waitcnt lgkmcnt(" #n ")" ::: "memory")
#define PG8_BAR __builtin_amdgcn_s_barrier()
#define PG8_SCHED __builtin_amdgcn_sched_barrier(0)
    Unit cur, nxt; int ui = 0;
    if (!S.next(0, cur)) return;
    f32x4 acc[2][2][4][2];
#pragma unroll
    for (int a = 0; a < 2; ++a)
#pragma unroll
        for (int b = 0; b < 2; ++b)
#pragma unroll
            for (int m = 0; m < 4; ++m)
#pragma unroll
                for (int n = 0; n < 2; ++n) acc[a][b][m][n] = (f32x4){0.f, 0.f, 0.f, 0.f};
    bf16x8 At[4][2], B0[2][2], B1[2][2];
    const char* cA = (const char*)g.A + (size_t)cur.z * g.zA + (size_t)cur.pm * tstep + (size_t)cur.k0 * kstep; const char* cB = (const char*)g.Bt + (size_t)cur.z * g.zB + (size_t)cur.pn * tstep + (size_t)cur.k0 * kstep;
    int nt = cur.nk;
    PG8_STAGE(PG8_SB(0, 0), cB, voffB); PG8_STAGE(PG8_SA(0, 0), cA, voffA); PG8_STAGE(PG8_SB(0, 1), cB + hstep, voffB); PG8_STAGE(PG8_SA(0, 1), cA + hstep, voffA);
    if (wr == 1) PG8_BAR;
    PG8_WAIT_V(4); PG8_BAR;
    PG8_STAGE(PG8_SB(1, 0), cB + kstep, voffB); PG8_STAGE(PG8_SA(1, 0), cA + kstep, voffA); PG8_STAGE(PG8_SB(1, 1), cB + hstep + kstep, voffB);
    PG8_WAIT_V(6); PG8_BAR;
    for (;;) {
        const bool has_next = S.next(ui + 1, nxt);
        const char* nA = has_next ? (const char*)g.A + (size_t)nxt.z * g.zA + (size_t)nxt.pm * tstep + (size_t)nxt.k0 * kstep : cA; const char* nB = has_next ? (const char*)g.Bt + (size_t)nxt.z * g.zB + (size_t)nxt.pn * tstep + (size_t)nxt.k0 * kstep : cB;
        for (int t = 0; t < nt; t += 2) {
            const bool last = (t == nt - 2);
            const char* a1 = cA + (size_t)(t + 1) * kstep;
            const char* a2 = last ? nA : cA + (size_t)(t + 2) * kstep; const char* b2 = last ? nB : cB + (size_t)(t + 2) * kstep;
            const char* a3 = a2 + kstep; const char* b3 = b2 + kstep;
            PG8_LDB(B0, 0, 0); PG8_SCHED; PG8_LDA(At, 0, 0); PG8_STAGE(PG8_SA(1, 1), a1 + hstep, voffA);
            PG8_WAIT_L(8); PG8_BAR; PG8_WAIT_L(0); PG8_MMA(0, 0, At, B0); PG8_BAR; PG8_SCHED;
            PG8_LDB(B1, 0, 1); PG8_STAGE(PG8_SB(0, 0), b2, voffB);
            PG8_BAR; PG8_WAIT_L(0); PG8_MMA(0, 1, At, B1); PG8_BAR;
            PG8_LDA(At, 0, 1); PG8_STAGE(PG8_SA(0, 0), a2, voffA);
            PG8_BAR; PG8_WAIT_L(0); PG8_MMA(1, 0, At, B0); PG8_BAR; PG8_SCHED;
            PG8_STAGE(PG8_SB(0, 1), b2 + hstep, voffB);
            PG8_WAIT_V(6); PG8_BAR; PG8_MMA(1, 1, At, B1); PG8_BAR;
            PG8_LDB(B0, 1, 0); PG8_SCHED; PG8_LDA(At, 1, 0); PG8_STAGE(PG8_SA(0, 1), a2 + hstep, voffA);
            PG8_WAIT_L(8); PG8_BAR; PG8_WAIT_L(0); PG8_MMA(0, 0, At, B0); PG8_BAR; PG8_SCHED;
            PG8_LDB(B1, 1, 1); PG8_STAGE(PG8_SB(1, 0), b3, voffB);
            PG8_BAR; PG8_WAIT_L(0); PG8_MMA(0, 1, At, B1); PG8_BAR;
            PG8_LDA(At, 1, 1); PG8_STAGE(PG8_SA(1, 0), a3, voffA);
            PG8_BAR; PG8_WAIT_L(0); PG8_MMA(1, 0, At, B0); PG8_BAR; PG8_SCHED;
            PG8_STAGE(PG8_SB(1, 1), b3 + hstep, voffB);
            PG8_WAIT_V(6); PG8_BAR; PG8_MMA(1, 1, At, B1); PG8_BAR;
        }
        E(acc, cur, wr, wc, fr, fq);
        if (!has_next) break;
#pragma unroll
        for (int a = 0; a < 2; ++a)
#pragma unroll
            for (int b = 0; b < 2; ++b)
#pragma unroll
                for (int m = 0; m < 4; ++m)
#pragma unroll
                    for (int n = 0; n < 2; ++n) acc[a][b][m][n] = (f32x4){0.f, 0.f, 0.f, 0.f};
        cur = nxt; cA = nA; cB = nB; nt = cur.nk; ++ui;
    }
    PG8_WAIT_V(0);
    if (wr == 0) PG8_BAR;
    PG8_BAR;
#undef PG8_SA
#undef PG8_SB
#undef PG8_STAGE
#undef PG8_LDA
#undef PG8_LDB
#undef PG8_MMA
#undef PG8_WAIT_V
#undef PG8_WAIT_L
#undef PG8_BAR
#undef PG8_SCHED
}

struct EpiBF {
    static constexpr bool PERM = true;
    bf16_t* O; size_t zO; float* P; int nz;
    __device__ __forceinline__ void operator()(const f32x4 (&acc)[2][2][4][2], const Unit& u, int wr, int wc, int fr, int fq) const {
        const int col0 = u.pn * BM + wc * 32 + 8 * fq;
        if (u.part < 0) {
            const int row0 = u.pm * BM + wr * 64 + fr; bf16_t* base = O + (size_t)u.z * zO;
#pragma unroll
            for (int ai = 0; ai < 2; ++ai)
#pragma unroll
                for (int m = 0; m < 4; ++m) { bf16_t* rowp = base + (size_t)(row0 + ai * HALF + m * 16) * D + col0;
#pragma unroll
                    for (int bj = 0; bj < 2; ++bj) { const f32x4 v0 = acc[ai][bj][m][0], v1 = acc[ai][bj][m][1];
                        u32x4 w; w.x = cvt_pk_bf16(v0[0], v0[1]); w.y = cvt_pk_bf16(v0[2], v0[3]); w.z = cvt_pk_bf16(v1[0], v1[1]); w.w = cvt_pk_bf16(v1[2], v1[3]);
                        *(u32x4*)(rowp + bj * HALF) = w; } }
        } else {
            const int row0 = wr * 64 + fr; float* base = P + (size_t)(u.part * nz + u.z) * (BM * D);
#pragma unroll
            for (int ai = 0; ai < 2; ++ai)
#pragma unroll
                for (int m = 0; m < 4; ++m) { float* rowp = base + (size_t)(row0 + ai * HALF + m * 16) * D + col0;
#pragma unroll
                    for (int bj = 0; bj < 2; ++bj) { *(f32x4*)(rowp + bj * HALF) = acc[ai][bj][m][0]; *(f32x4*)(rowp + bj * HALF + 4) = acc[ai][bj][m][1]; } }
        }
    }
};
struct EpiGU {
    static constexpr bool PERM = true;
    bf16_t* O;
    __device__ __forceinline__ void operator()(const f32x4 (&acc)[2][2][4][2], const Unit& u, int wr, int wc, int fr, int fq) const {
        const int row0 = u.pm * BM + wr * 64 + fr, col0 = u.pn * HALF + wc * 32 + 8 * fq;
#pragma unroll
        for (int ai = 0; ai < 2; ++ai)
#pragma unroll
            for (int m = 0; m < 4; ++m) { bf16_t* rowp = O + (size_t)(row0 + ai * HALF + m * 16) * DFF + col0;
                float v[8];
#pragma unroll
                for (int n = 0; n < 2; ++n)
#pragma unroll
                    for (int j = 0; j < 4; ++j) { const float gt = acc[ai][0][m][n][j], up = acc[ai][1][m][n][j]; v[n * 4 + j] = gt * sigm(gt) * up; }
                u32x4 w; w.x = cvt_pk_bf16(v[0], v[1]); w.y = cvt_pk_bf16(v[2], v[3]); w.z = cvt_pk_bf16(v[4], v[5]); w.w = cvt_pk_bf16(v[6], v[7]);
                *(u32x4*)rowp = w; }
    }
};
struct EpiIN {
    static constexpr bool PERM = true;
    bf16_t* U;
    __device__ __forceinline__ void operator()(const f32x4 (&acc)[2][2][4][2], const Unit& u, int wr, int wc, int fr, int fq) const {
        const int row0 = u.pm * BM + wr * 64 + fr;
        if (u.pn >= 4 && u.pn < 12) {
            const int col0 = (u.pn - 4) * HALF + wc * 32 + 8 * fq; bf16_t* base = U + 2 * SLOT;
#pragma unroll
            for (int ai = 0; ai < 2; ++ai)
#pragma unroll
                for (int m = 0; m < 4; ++m) { bf16_t* rowp = base + (size_t)(row0 + ai * HALF + m * 16) * D + col0;
                    const f32x4 v0 = acc[ai][0][m][0] * acc[ai][1][m][0], v1 = acc[ai][0][m][1] * acc[ai][1][m][1];
                    u32x4 w; w.x = cvt_pk_bf16(v0[0], v0[1]); w.y = cvt_pk_bf16(v0[2], v0[3]); w.z = cvt_pk_bf16(v1[0], v1[1]); w.w = cvt_pk_bf16(v1[2], v1[3]);
                    *(u32x4*)rowp = w; }
        } else {
            int slot, ct; if (u.pn < 4) { slot = 0; ct = u.pn; } else { const int sg = (u.pn - 12) >> 2; slot = sg == 0 ? 3 : (sg == 1 ? 1 : sg + 2); ct = (u.pn - 12) & 3; }
            const int col0 = ct * BM + wc * 32 + 8 * fq; bf16_t* base = U + (size_t)slot * SLOT;
#pragma unroll
            for (int ai = 0; ai < 2; ++ai)
#pragma unroll
                for (int m = 0; m < 4; ++m) { bf16_t* rowp = base + (size_t)(row0 + ai * HALF + m * 16) * D + col0;
#pragma unroll
                    for (int bj = 0; bj < 2; ++bj) { const f32x4 v0 = acc[ai][bj][m][0], v1 = acc[ai][bj][m][1];
                        u32x4 w; w.x = cvt_pk_bf16(v0[0], v0[1]); w.y = cvt_pk_bf16(v0[2], v0[3]); w.z = cvt_pk_bf16(v1[0], v1[1]); w.w = cvt_pk_bf16(v1[2], v1[3]);
                        *(u32x4*)(rowp + bj * HALF) = w; } }
        }
    }
};
}

__device__ __forceinline__ int conv_map(int mode, int n) {
    if (mode == 0) return n;
    if (mode == 1) return 256 * (n >> 7) + (n & 127);
    if (mode == 2) return 256 * (n >> 7) + 128 + (n & 127);
    const int seg = n >> 10, j = n & 1023;
    if (seg == 0) return j;
    if (seg == 1) return 1024 + 256 * (j >> 7) + (j & 127);
    if (seg == 2) return 1024 + 256 * (j >> 7) + 128 + (j & 127);
    return 3072 + (seg - 3) * 1024 + j;
}
__device__ __forceinline__ void conv_tile(const float* __restrict__ src, int K, int N, bf16_t* __restrict__ dst, int mode, int tile, LAS float* sl, int tid) {
    const int ntn = N >> 6; const int tk = tile / ntn, tn = tile - tk * ntn; const int k0 = tk * 64, n0 = tn * 64;
#pragma unroll
    for (int q = 0; q < 2; ++q) { const int kr = (tid >> 4) + 32 * q; const f32x4 v = *(const f32x4*)(src + (size_t)(k0 + kr) * N + n0 + (tid & 15) * 4);
        LAS float* d = sl + kr * 65 + (tid & 15) * 4; d[0] = v[0]; d[1] = v[1]; d[2] = v[2]; d[3] = v[3]; }
    __syncthreads();
    const int n = tid >> 3, ko = (tid & 7) * 8;
    float f[8];
#pragma unroll
    for (int i = 0; i < 8; ++i) f[i] = sl[(ko + i) * 65 + n];
    u32x4 w; w.x = cvt_pk_bf16(f[0], f[1]); w.y = cvt_pk_bf16(f[2], f[3]); w.z = cvt_pk_bf16(f[4], f[5]); w.w = cvt_pk_bf16(f[6], f[7]);
    *(u32x4*)(dst + (size_t)conv_map(mode, n0 + n) * K + k0 + ko) = w;
    __syncthreads();
}
template <int II, int K, int N, int MODE>
__device__ __forceinline__ void conv_mat(const Params& p, size_t dst, LAS unsigned char* lds, int tid) {
    constexpr int ntiles = (K >> 6) * (N >> 6);
    for (int t = blockIdx.x; t < ntiles; t += gridDim.x) conv_tile(p.in[II], K, N, (bf16_t*)(p.ws + dst), MODE, t, (LAS float*)lds, tid);
}
__device__ __forceinline__ void convert_set0(const Params& p, LAS unsigned char* lds, int tid) {
    conv_mat<8, 1024, 2816, 1>(p, WS_WGU, lds, tid);
    conv_mat<9, 1024, 2816, 2>(p, WS_WGU, lds, tid);
    conv_mat<10, 2816, 1024, 0>(p, WS_WD, lds, tid);
    conv_mat<13, 1024, 7168, 3>(p, WS_WIN, lds, tid);
    conv_mat<15, 1024, 1024, 0>(p, WS_WOAB, lds, tid);
    conv_mat<23, 1024, 1024, 0>(p, WS_WOAB + (size_t)1024 * 1024 * 2, lds, tid);
    conv_mat<24, 1024, 1024, 0>(p, WS_WO, lds, tid);
}
__device__ __forceinline__ void convert_set1(const Params& p, LAS unsigned char* lds, int tid) {
    conv_mat<27, 1024, 2816, 1>(p, WS_WGU, lds, tid);
    conv_mat<28, 1024, 2816, 2>(p, WS_WGU, lds, tid);
    conv_mat<29, 2816, 1024, 0>(p, WS_WD, lds, tid);
}

__device__ __forceinline__ void norm_phase(const Params& p, int mode, int tid, bool dry, int nsplit) {
    const int lane = tid & 63, gw = blockIdx.x * 8 + (tid >> 6), nw = gridDim.x * 8;
    const float* gpost = mode == 1 ? p.in[7] : (mode == 2 ? p.in[12] : p.in[26]);
    const float* gpre = mode == 0 ? p.in[6] : (mode == 1 ? p.in[11] : p.in[25]);
    const float cc = mode == 2 ? 1.0f : 0.5f;
    const bf16_t* Yb = (const bf16_t*)(p.ws + WS_Y); const float* PY = (const float*)(p.ws + WS_PY); bf16_t* H = (bf16_t*)(p.ws + WS_H);
    for (int r = gw; r < M; r += nw) {
        const float* xin = mode <= 1 ? x0row(p, r) : xrow(p, r);
        f32x4 xv[4];
#pragma unroll
        for (int q = 0; q < 4; ++q) xv[q] = *(const f32x4*)(xin + lane * 4 + 256 * q);
        if (mode > 0) {
            f32x4 yv[4]; float ss = 0.f;
            if (r < MAINR) {
#pragma unroll
                for (int q = 0; q < 4; ++q) { const u32x2 w = *(const u32x2*)(Yb + (size_t)r * D + lane * 4 + 256 * q); yv[q] = (f32x4){bflo(w.x), bfhi(w.x), bflo(w.y), bfhi(w.y)}; }
            } else {
#pragma unroll
                for (int q = 0; q < 4; ++q) yv[q] = (f32x4){0.f, 0.f, 0.f, 0.f};
                for (int ks = 0; ks < nsplit; ++ks) {
#pragma unroll
                    for (int q = 0; q < 4; ++q) yv[q] += *(const f32x4*)(PY + ((size_t)ks * 256 + (r - MAINR)) * D + lane * 4 + 256 * q);
                }
            }
#pragma unroll
            for (int q = 0; q < 4; ++q) ss += yv[q][0] * yv[q][0] + yv[q][1] * yv[q][1] + yv[q][2] * yv[q][2] + yv[q][3] * yv[q][3];
            ss = wave_sum(ss, lane);
            const float rs = cc * rsqrtf(ss * (1.0f / D) + EPS);
#pragma unroll
            for (int q = 0; q < 4; ++q) xv[q] += yv[q] * rs * *(const f32x4*)(gpost + lane * 4 + 256 * q);
            float* xo = xrow(p, r);
            if (!dry) {
#pragma unroll
                for (int q = 0; q < 4; ++q) *(f32x4*)(xo + lane * 4 + 256 * q) = xv[q];
            }
        }
        if (mode < 3) {
            float ss = 0.f;
#pragma unroll
            for (int q = 0; q < 4; ++q) ss += xv[q][0] * xv[q][0] + xv[q][1] * xv[q][1] + xv[q][2] * xv[q][2] + xv[q][3] * xv[q][3];
            ss = wave_sum(ss, lane);
            const float rs = rsqrtf(ss * (1.0f / D) + EPS);
#pragma unroll
            for (int q = 0; q < 4; ++q) { const f32x4 hv = xv[q] * rs * *(const f32x4*)(gpre + lane * 4 + 256 * q); u32x2 w; w.x = cvt_pk_bf16(hv[0], hv[1]); w.y = cvt_pk_bf16(hv[2], hv[3]);
                *(u32x2*)(H + (size_t)r * D + lane * 4 + 256 * q) = w; }
        }
    }
}

constexpr int WL_BYTES = 11264;
__device__ __forceinline__ void scan_item(const Params& p, int b, int j, int h, LAS unsigned char* wl, const LAS unsigned char* wlds, int lane, bool dry) {
    bf16_t* U = (bf16_t*)(p.ws + WS_U);
    const bf16_t* bx = U + 3 * SLOT; bf16_t* bg = U + 1 * SLOT; bf16_t* pp = (bf16_t*)(p.ws + WS_H);
    float* summ = (float*)(p.ws + WS_SUMM);
    const int c = h * 64 + lane, fr = lane & 15, fq = lane >> 4;
    const size_t row0 = (size_t)b * TP + (size_t)j * CHUNK;
    const LAS unsigned char* wq = wlds + fr * 144 + fq * 16;
    float brv[4], biv[4], lcv[4];
#pragma unroll
    for (int nt = 0; nt < 4; ++nt) { const int ch = h * 64 + nt * 16 + fr; brv[nt] = p.in[19][ch]; biv[nt] = p.in[21][ch]; lcv[nt] = -8.0f * log1pf(expf(-p.in[22][ch])); }
    const float w0 = p.in[16][c], w1 = p.in[16][D + c], w2 = p.in[16][2 * D + c], w3 = p.in[16][3 * D + c], cbias = p.in[17][c];
    float xm3 = 0.f, xm2 = 0.f, xm1 = 0.f;
    if (j > 0) { xm3 = bf2f(bx[(row0 - 3) * D + c]); xm2 = bf2f(bx[(row0 - 2) * D + c]); xm1 = bf2f(bx[(row0 - 1) * D + c]); }
    float hh = 0.f, ap = 1.f;
    LAS unsigned short* cbT = (LAS unsigned short*)wl;
    LAS float* xu = (LAS float*)(wl + 2304);
    LAS float* aS = (LAS float*)(wl + 2304 + 4352);
    bf16_t xr[16], gr[16], xn[16];
#pragma unroll
    for (int tt = 0; tt < 16; ++tt) xr[tt] = bx[(row0 + tt) * D + c];
#pragma unroll
    for (int g = 0; g < 3; ++g) {
        const size_t r0 = row0 + (size_t)g * 16;
#pragma unroll
        for (int tt = 0; tt < 16; ++tt) gr[tt] = bg[(r0 + tt) * D + c];
        if (g < 2) {
#pragma unroll
            for (int tt = 0; tt < 16; ++tt) xn[tt] = bx[(r0 + 16 + tt) * D + c];
        }
#pragma unroll
        for (int tt = 0; tt < 16; ++tt) { const float x = bf2f(xr[tt]); const float cb = w0 * xm3 + w1 * xm2 + w2 * xm1 + w3 * x + cbias; xm3 = xm2; xm2 = xm1; xm1 = x;
            cbT[tt * 72 + lane] = f2bf(cb); xu[tt * 68 + lane] = cb; }
        __builtin_amdgcn_wave_barrier();
        const bf16x8 a0 = *(const LAS bf16x8*)(cbT + fr * 72 + fq * 8), a1 = *(const LAS bf16x8*)(cbT + fr * 72 + 32 + fq * 8);
        f32x4 accR[4], accI[4];
#pragma unroll
        for (int nt = 0; nt < 4; ++nt) {
            const bf16x8 r0w = *(const LAS bf16x8*)(wq + nt * 2304), r1w = *(const LAS bf16x8*)(wq + nt * 2304 + 64);
            const bf16x8 i0w = *(const LAS bf16x8*)(wq + 9216 + nt * 2304), i1w = *(const LAS bf16x8*)(wq + 9216 + nt * 2304 + 64);
            accR[nt] = __builtin_amdgcn_mfma_f32_16x16x32_bf16(a0, r0w, (f32x4){0.f, 0.f, 0.f, 0.f}, 0, 0, 0);
            accR[nt] = __builtin_amdgcn_mfma_f32_16x16x32_bf16(a1, r1w, accR[nt], 0, 0, 0);
            accI[nt] = __builtin_amdgcn_mfma_f32_16x16x32_bf16(a0, i0w, (f32x4){0.f, 0.f, 0.f, 0.f}, 0, 0, 0);
            accI[nt] = __builtin_amdgcn_mfma_f32_16x16x32_bf16(a1, i1w, accI[nt], 0, 0, 0);
        }
#pragma unroll
        for (int nt = 0; nt < 4; ++nt)
#pragma unroll
            for (int i = 0; i < 4; ++i) { const int idx = (fq * 4 + i) * 68 + nt * 16 + fr; const float x = xu[idx];
                const float r = sigm(accR[nt][i] + brv[nt]), ig = sigm(accI[nt][i] + biv[nt]);
                const float la = lcv[nt] * r; const float a = __expf(la);
                const float z2 = 2.0f * la;
                const float m2s = -z2 * (1.0f + z2 * (0.5f + z2 * (0.16666667f + z2 * (0.041666668f + z2 * (0.0083333338f + z2 * 0.0013888889f)))));
                const float m2 = z2 > -0.25f ? m2s : 1.0f - a * a;
                xu[idx] = __builtin_amdgcn_sqrtf(m2) * ig * x; aS[idx] = a; }
        __builtin_amdgcn_wave_barrier();
#pragma unroll
        for (int tt = 0; tt < 16; ++tt) { const float a = aS[tt * 68 + lane], uu = xu[tt * 68 + lane]; hh = a * hh + uu; ap *= a;
            const float gl = gelu_tanh(bf2f(gr[tt]));
            if (!dry) bg[(r0 + tt) * D + c] = f2bf(gl * hh);
            pp[(r0 + tt) * D + c] = f2bf(gl * ap); }
        __builtin_amdgcn_wave_barrier();
        if (g < 2) {
#pragma unroll
            for (int tt = 0; tt < 16; ++tt) xr[tt] = xn[tt];
        }
    }
    *(float2*)(summ + (((size_t)b * NCH + j) * D + c) * 2) = make_float2(ap, hh);
    if (j == NCH - 1) { p.out[O_CBP + ((size_t)b * 3 + 0) * D + c] = xm3; p.out[O_CBP + ((size_t)b * 3 + 1) * D + c] = xm2; p.out[O_CBP + ((size_t)b * 3 + 2) * D + c] = xm1; }
}
__device__ __forceinline__ void scan_phase(const Params& p, LAS unsigned char* lds, int tid, bool dry) {
    const int wid = tid >> 6, lane = tid & 63;
    LAS unsigned char* wl = lds + wid * WL_BYTES;
    LAS unsigned char* wlds = lds + 8 * WL_BYTES;
    const int h = blockIdx.x & 15;
    {
        const bf16_t* wt = (const bf16_t*)(p.ws + WS_WRG);
#pragma unroll
        for (int q = 0; q < 2; ++q) { const int e = tid + q * 512, g = e >> 9, jrow = (e >> 3) & 63, pc = e & 7;
            *(LAS u32x4*)(wlds + g * 9216 + jrow * 144 + pc * 16) = *(const u32x4*)(wt + (size_t)g * 65536 + (size_t)(h * 64 + jrow) * 64 + pc * 8); }
    }
    __syncthreads();
    const int nbh = gridDim.x >> 4;
    for (int it = (blockIdx.x >> 4) * 8 + wid; it < NB * NCH; it += nbh * 8) scan_item(p, it / NCH, it % NCH, h, wl, wlds, lane, dry);
    __syncthreads();
}
__device__ __forceinline__ void fix_phase(const Params& p, LAS unsigned char* lds, int tid, bool dry) {
    bf16_t* zb = (bf16_t*)(p.ws + WS_U) + 1 * SLOT; const bf16_t* pp = (const bf16_t*)(p.ws + WS_H);
    const float* summ = (const float*)(p.ws + WS_SUMM);
    LAS float* cs = (LAS float*)lds;
    for (int it = blockIdx.x; it < NB * (NCH - 1); it += gridDim.x) {
        const int b = it / (NCH - 1), j = it % (NCH - 1) + 1;
#pragma unroll
        for (int cq = 0; cq < 2; ++cq) {
            const int c = tid + cq * 512; const float* sp = summ + ((size_t)b * NCH * D + c) * 2; float hh = 0.f;
            for (int i0 = 0; i0 < j; i0 += 16) {
                float va[16], vh[16];
#pragma unroll
                for (int k = 0; k < 16; ++k) { if (i0 + k < j) { const float2 v = *(const float2*)(sp + (size_t)(i0 + k) * D * 2); va[k] = v.x; vh[k] = v.y; } else { va[k] = 1.f; vh[k] = 0.f; } }
#pragma unroll
                for (int k = 0; k < 16; ++k) hh = va[k] * hh + vh[k];
            }
            cs[c] = hh;
            if (j == NCH - 1) { const float2 v = *(const float2*)(sp + (size_t)j * D * 2); p.out[O_RGP + (size_t)b * D + c] = v.x * hh + v.y; }
        }
        __syncthreads();
        const size_t row0 = (size_t)b * TP + (size_t)j * CHUNK;
#pragma unroll 4
        for (int q = 0; q < CHUNK * 128 / 512; ++q) {
            const int e = tid + q * 512, tt = e >> 7, vc = e & 127; const size_t o = (row0 + tt) * D + vc * 8;
            const u32x4 zq = *(const u32x4*)(zb + o), pq = *(const u32x4*)(pp + o);
            const f32x4 c0 = *(const LAS f32x4*)(cs + vc * 8), c1 = *(const LAS f32x4*)(cs + vc * 8 + 4);
            u32x4 w;
            w.x = cvt_pk_bf16(bflo(zq.x) + bflo(pq.x) * c0[0], bfhi(zq.x) + bfhi(pq.x) * c0[1]); w.y = cvt_pk_bf16(bflo(zq.y) + bflo(pq.y) * c0[2], bfhi(zq.y) + bfhi(pq.y) * c0[3]);
            w.z = cvt_pk_bf16(bflo(zq.z) + bflo(pq.z) * c1[0], bfhi(zq.z) + bfhi(pq.z) * c1[1]); w.w = cvt_pk_bf16(bflo(zq.w) + bflo(pq.w) * c1[2], bfhi(zq.w) + bfhi(pq.w) * c1[3]);
            if (!dry) *(u32x4*)(zb + o) = w;
        }
        __syncthreads();
    }
}
__device__ __forceinline__ void za_phase(const Params& p, int tid, bool dry) {
    bf16_t* U = (bf16_t*)(p.ws + WS_U); bf16_t* ab = U; const bf16_t* ca = U + 2 * SLOT;
    const float* cw = p.in[14];
    for (int idx = blockIdx.x * 512 + tid; idx < NB * 129 * 128; idx += gridDim.x * 512) {
        const int vc = idx & 127, tb = (idx >> 7) % 129, b = idx / (128 * 129); const int c0 = vc * 8;
        float w[3][8];
#pragma unroll
        for (int k = 0; k < 3; ++k) { const f32x4 a = *(const f32x4*)(cw + k * D + c0), bq = *(const f32x4*)(cw + k * D + c0 + 4);
#pragma unroll
            for (int e = 0; e < 4; ++e) { w[k][e] = a[e]; w[k][4 + e] = bq[e]; } }
        const size_t r0 = (size_t)b * TP + (size_t)tb * 16;
        float p2[8], p1[8];
        if (tb > 0) { const u32x4 q2 = *(const u32x4*)(ca + (r0 - 2) * D + c0), q1 = *(const u32x4*)(ca + (r0 - 1) * D + c0);
#pragma unroll
            for (int e = 0; e < 4; ++e) { p2[2 * e] = bflo(q2[e]); p2[2 * e + 1] = bfhi(q2[e]); p1[2 * e] = bflo(q1[e]); p1[2 * e + 1] = bfhi(q1[e]); } }
        else {
#pragma unroll
            for (int e = 0; e < 8; ++e) { p2[e] = 0.f; p1[e] = 0.f; } }
#pragma unroll 4
        for (int tt = 0; tt < 16; ++tt) {
            const u32x4 qc = *(const u32x4*)(ca + (r0 + tt) * D + c0), qa = *(const u32x4*)(ab + (r0 + tt) * D + c0);
            float cv[8], av[8], zv[8];
#pragma unroll
            for (int e = 0; e < 4; ++e) { cv[2 * e] = bflo(qc[e]); cv[2 * e + 1] = bfhi(qc[e]); av[2 * e] = bflo(qa[e]); av[2 * e + 1] = bfhi(qa[e]); }
#pragma unroll
            for (int e = 0; e < 8; ++e) { zv[e] = av[e] * (w[0][e] * p2[e] + w[1][e] * p1[e] + w[2][e] * cv[e]); p2[e] = p1[e]; p1[e] = cv[e]; }
            u32x4 o; o.x = cvt_pk_bf16(zv[0], zv[1]); o.y = cvt_pk_bf16(zv[2], zv[3]); o.z = cvt_pk_bf16(zv[4], zv[5]); o.w = cvt_pk_bf16(zv[6], zv[7]);
            if (!dry) *(u32x4*)(ab + (r0 + tt) * D + c0) = o;
        }
        if (tb == 128) {
            float* o2 = p.out + O_CAP + ((size_t)b * 2 + 0) * D + c0; float* o1 = p.out + O_CAP + ((size_t)b * 2 + 1) * D + c0;
            *(f32x4*)o2 = (f32x4){p2[0], p2[1], p2[2], p2[3]}; *(f32x4*)(o2 + 4) = (f32x4){p2[4], p2[5], p2[6], p2[7]};
            *(f32x4*)o1 = (f32x4){p1[0], p1[1], p1[2], p1[3]}; *(f32x4*)(o1 + 4) = (f32x4){p1[4], p1[5], p1[6], p1[7]};
        }
    }
}
__device__ __forceinline__ void sample_phase(const Params& p, LAS unsigned char* lds, int tid) {
    bf16_t* U = (bf16_t*)(p.ws + WS_U);
    LAS float* cbs = (LAS float*)lds;
    for (int it = gridDim.x - 1 - blockIdx.x; it < NS / 4; it += gridDim.x) {
#pragma unroll 2
        for (int e = tid; e < 4 * D; e += 512) {
            const int s = it * 4 + (e >> 10), c = e & 1023; const size_t ro = (size_t)(MP + s) * D + c;
            const float cav = bf2f(U[2 * SLOT + ro]), abv = bf2f(U[ro]);
            const float s0 = p.in[2][((size_t)s * 2 + 0) * D + c], s1 = p.in[2][((size_t)s * 2 + 1) * D + c];
            const float cva = p.in[14][c] * s0 + p.in[14][D + c] * s1 + p.in[14][2 * D + c] * cav;
            U[ro] = f2bf(abv * cva);
            p.out[O_CAS + ((size_t)s * 2 + 0) * D + c] = s1; p.out[O_CAS + ((size_t)s * 2 + 1) * D + c] = cav;
            const float bxv = bf2f(U[3 * SLOT + ro]);
            const float t0 = p.in[3][((size_t)s * 3 + 0) * D + c], t1 = p.in[3][((size_t)s * 3 + 1) * D + c], t2 = p.in[3][((size_t)s * 3 + 2) * D + c];
            const float cb = p.in[16][c] * t0 + p.in[16][D + c] * t1 + p.in[16][2 * D + c] * t2 + p.in[16][3 * D + c] * bxv + p.in[17][c];
            p.out[O_CBS + ((size_t)s * 3 + 0) * D + c] = t1; p.out[O_CBS + ((size_t)s * 3 + 1) * D + c] = t2; p.out[O_CBS + ((size_t)s * 3 + 2) * D + c] = bxv;
            cbs[e] = cb;
        }
        __syncthreads();
#pragma unroll 1
        for (int cq = 0; cq < 2; ++cq) {
            const int c = tid + cq * 512, h = c >> 6, jj = c & 63;
            float ar[4] = {0.f, 0.f, 0.f, 0.f}, ai[4] = {0.f, 0.f, 0.f, 0.f};
            const float* wr_ = p.in[18] + (size_t)h * 4096 + jj; const float* wi_ = p.in[20] + (size_t)h * 4096 + jj;
#pragma unroll 16
            for (int i = 0; i < 64; ++i) { const float wrv = wr_[i * 64], wiv = wi_[i * 64];
#pragma unroll
                for (int s = 0; s < 4; ++s) { const float x = cbs[s * D + h * 64 + i]; ar[s] += x * wrv; ai[s] += x * wiv; } }
            const float lc = -8.0f * log1pf(expf(-p.in[22][c])), brc = p.in[19][c], bic = p.in[21][c];
#pragma unroll
            for (int s = 0; s < 4; ++s) { const int sg = it * 4 + s; const size_t ro = (size_t)(MP + sg) * D + c;
                const float r = sigm(ar[s] + brc), ig = sigm(ai[s] + bic); const float la = lc * r; const float a = expf(la); const float mult = sqrtf(-expm1f(2.0f * la));
                const float hn = a * p.in[4][(size_t)sg * D + c] + mult * ig * cbs[s * D + c];
                p.out[O_RGS + (size_t)sg * D + c] = hn;
                U[1 * SLOT + ro] = f2bf(gelu_tanh(bf2f(U[1 * SLOT + ro])) * hn); }
        }
        __syncthreads();
    }
}

__device__ __forceinline__ void merge_phase(const Params& p, int tid) {
    const bf16_t* U = (const bf16_t*)(p.ws + WS_U); bf16_t* H = (bf16_t*)(p.ws + WS_H); const float* PO = (const float*)(p.ws + WS_POAB);
    for (size_t i = (size_t)blockIdx.x * 512 + tid; i < SLOT / 8; i += (size_t)gridDim.x * 512) {
        const u32x4 ga = *(const u32x4*)(U + 4 * SLOT + i * 8), gb = *(const u32x4*)(U + 5 * SLOT + i * 8);
        float ya[8], yb[8];
        const int row = (int)(i >> 7);
        if (row < MAINR) {
            const u32x4 a = *(const u32x4*)(U + 2 * SLOT + i * 8), b = *(const u32x4*)(U + 3 * SLOT + i * 8);
#pragma unroll
            for (int e = 0; e < 4; ++e) { ya[2 * e] = bflo(a[e]); ya[2 * e + 1] = bfhi(a[e]); yb[2 * e] = bflo(b[e]); yb[2 * e + 1] = bfhi(b[e]); }
        } else {
            const size_t o = (size_t)(row - MAINR) * D + (size_t)(i & 127) * 8;
#pragma unroll
            for (int e = 0; e < 8; ++e) { ya[e] = 0.f; yb[e] = 0.f; }
#pragma unroll
            for (int ks = 0; ks < 4; ++ks) {
                const f32x4 a0 = *(const f32x4*)(PO + (size_t)(ks * 2 + 0) * (256 * D) + o), a1 = *(const f32x4*)(PO + (size_t)(ks * 2 + 0) * (256 * D) + o + 4);
                const f32x4 b0 = *(const f32x4*)(PO + (size_t)(ks * 2 + 1) * (256 * D) + o), b1 = *(const f32x4*)(PO + (size_t)(ks * 2 + 1) * (256 * D) + o + 4);
#pragma unroll
                for (int e = 0; e < 4; ++e) { ya[e] += a0[e]; ya[4 + e] += a1[e]; yb[e] += b0[e]; yb[4 + e] += b1[e]; }
            }
        }
        u32x4 o4;
#pragma unroll
        for (int e = 0; e < 4; ++e) { const float lo = sigm(bflo(ga[e])) * ya[2 * e] + sigm(bflo(gb[e])) * yb[2 * e], hi = sigm(bfhi(ga[e])) * ya[2 * e + 1] + sigm(bfhi(gb[e])) * yb[2 * e + 1]; o4[e] = cvt_pk_bf16(lo, hi); }
        *(u32x4*)(H + i * 8) = o4;
    }
}

#define XB_TMO      128
#define XB_XCNT(j)  (256  + 64 * (j))
#define XB_XSUB(j)  (1280 + 64 * (j))
#define XB_XGEN(j)  (2304 + 64 * (j))
#define XB_TOP      3328
#define XB_TOPGEN   3392
#define XCD_BAR_WORDS 3456
#define XB_SPIN_CAP (1u << 18)
__device__ __forceinline__ unsigned xb_ld(unsigned* p)              { return __hip_atomic_load(p, __ATOMIC_RELAXED, __HIP_MEMORY_SCOPE_AGENT); }
__device__ __forceinline__ unsigned xb_add(unsigned* p, unsigned v) { return __hip_atomic_fetch_add(p, v, __ATOMIC_RELAXED, __HIP_MEMORY_SCOPE_AGENT); }
__device__ __forceinline__ unsigned xb_xcc_id() { return (unsigned)__builtin_amdgcn_s_getreg((3 << 11) | 20) & 0xFu; }
#define XB_SPIN(cond, bar) do { unsigned _sp = 0; while (cond) { __builtin_amdgcn_s_sleep(1); \
    if ((++_sp & 255u) == 0u) { if (xb_ld(&(bar)[XB_TMO])) break; if (_sp > XB_SPIN_CAP) { atomicAdd(&(bar)[XB_TMO], 1u); break; } } } } while (0)
struct XcdBarrier { unsigned* bar; unsigned x; volatile LAS unsigned* st; };
__device__ __forceinline__ XcdBarrier xcd_barrier_post(unsigned* bar, volatile LAS unsigned* st) {
    XcdBarrier b; b.bar = bar; b.x = xb_xcc_id(); b.st = st;
    if (threadIdx.x == 0) (void)xb_add(&bar[XB_XCNT(b.x)], 1u);
    return b;
}
__device__ __forceinline__ void xcd_barrier_complete(unsigned* bar, unsigned x, unsigned& nloc, unsigned& nx) {
    const unsigned G = gridDim.x * gridDim.y * gridDim.z;
    unsigned sum, cnt, mine, sp = 0u;
    for (;;) {
        sum = 0u; cnt = 0u; mine = 0u;
#pragma unroll
        for (unsigned j = 0; j < 16; ++j) { const unsigned c = xb_ld(&bar[XB_XCNT(j)]); sum += c; cnt += (c > 0u) ? 1u : 0u; mine = (j == x) ? c : mine; }
        if (sum == G) break;
        __builtin_amdgcn_s_sleep(1);
        if ((++sp & 255u) == 0u) { if (xb_ld(&bar[XB_TMO])) break; if (sp > XB_SPIN_CAP) { atomicAdd(&bar[XB_TMO], 1u); break; } }
    }
    nloc = mine > 0u ? mine : 1u; nx = cnt > 0u ? cnt : 1u;
}
__device__ __forceinline__ void xcd_barrier(const XcdBarrier& b) {
    asm volatile("s_waitcnt vmcnt(0)" ::: "memory");
    __syncthreads();
    if (threadIdx.x == 0) {
        unsigned* bar = b.bar;
        __builtin_amdgcn_s_waitcnt(0);
        unsigned nloc = b.st[0], nx = b.st[1];
        if (nloc == 0u) { xcd_barrier_complete(bar, b.x, nloc, nx); b.st[0] = nloc; b.st[1] = nx; }
        const unsigned old = xb_add(&bar[XB_XSUB(b.x)], 1u);
        const unsigned gen = old / nloc;
        if (old + 1u == (gen + 1u) * nloc) {
            __builtin_amdgcn_fence(__ATOMIC_RELEASE, "agent");
            asm volatile("s_waitcnt vmcnt(0)" ::: "memory");
            const unsigned og = xb_add(&bar[XB_TOP], 1u);
            const unsigned tg = og / nx;
            if (og + 1u == (tg + 1u) * nx) xb_add(&bar[XB_TOPGEN], 1u);
            else XB_SPIN(xb_ld(&bar[XB_TOPGEN]) == tg, bar);
            __builtin_amdgcn_fence(__ATOMIC_ACQUIRE, "agent");
            xb_add(&bar[XB_XGEN(b.x)], 1u);
            asm volatile("s_waitcnt vmcnt(0)" ::: "memory");
        } else {
            XB_SPIN(xb_ld(&bar[XB_XGEN(b.x)]) == gen, bar);
            __builtin_amdgcn_fence(__ATOMIC_ACQUIRE, "agent");
            asm volatile("s_waitcnt vmcnt(0)" ::: "memory");
        }
    }
    __syncthreads();
}

constexpr int NPHASE = 14;
constexpr int LDS_BYTES = 131072 + 16;
__global__ void __launch_bounds__(512, 2) mk_fwd(Params p, int ph_lo, int ph_hi) {
    extern __shared__ __attribute__((aligned(16))) unsigned char shm[];
    LAS unsigned char* lds = (LAS unsigned char*)shm;
    cg::grid_group grid = cg::this_grid();
    if (threadIdx.x == 0) { *(LAS u32x4*)(lds + 131072) = (u32x4){0u, 0u, 0u, 0u}; }
    __syncthreads();
    const XcdBarrier xb = xcd_barrier_post((unsigned*)(p.ws + WS_BAR), (volatile LAS unsigned*)(lds + 131072));
    bool first_sync = true;
    for (int ph2 = ph_lo * 2; ph2 < ph_hi * 2; ++ph2) {
        const int ph = ph2 >> 1; const bool dry = !(ph2 & 1);
        if (dry && !((REP_MASK >> ph) & 1)) continue;
        int tid = threadIdx.x; asm volatile("" : "+v"(tid));
        if (ph == 0) {
            convert_set0(p, lds, tid);
            bf16_t* wt = (bf16_t*)(p.ws + WS_WRG);
            for (int o = blockIdx.x * 512 + tid; o < 2 * 65536; o += gridDim.x * 512) { const int g = o >> 16, h = (o >> 12) & 15, j = (o >> 6) & 63, i = o & 63;
                wt[o] = f2bf((g ? p.in[20] : p.in[18])[(size_t)(h * 64 + i) * 64 + j]); }
            norm_phase(p, 0, tid, dry, 0);
        } else if (ph == 1 || ph == 11) {
            pg8::Gemm g{(const bf16_t*)(p.ws + WS_H), (const bf16_t*)(p.ws + WS_WGU), M, 2 * DFF, D, 0, 0};
            pg8::StaticOrder S; S.init(M, 2 * DFF, D, gridDim.x, blockIdx.x);
            pg8::EpiGU E{(bf16_t*)(p.ws + WS_ACT)};
            pg8::gemm_phase(lds, g, S, E);
        } else if (ph == 2 || ph == 12 || ph == 9 || ph == 7) {
            const bool dn = (ph == 2 || ph == 12), oab = (ph == 7);
            pg8::Gemm g{(const bf16_t*)(p.ws + (dn ? WS_ACT : (oab ? WS_U : WS_H))), (const bf16_t*)(p.ws + (dn ? WS_WD : (oab ? WS_WOAB : WS_WO))), M, D, dn ? DFF : D, SB, (size_t)1024 * 1024 * 2};
            pg8::SplitOrder S; S.init(oab ? 2 * D : D, dn ? DFF : D, gridDim.x, blockIdx.x, dn ? 11 : 4, 4);
            pg8::EpiBF E{(bf16_t*)(p.ws + (oab ? WS_U + 2 * SB : WS_Y)), SLOT, (float*)(p.ws + (oab ? WS_POAB : WS_PY)), oab ? 2 : 1};
            pg8::gemm_phase(lds, g, S, E);
        } else if (ph == 3) {
            norm_phase(p, 1, tid, dry, 11);
        } else if (ph == 4) {
            pg8::Gemm g{(const bf16_t*)(p.ws + WS_H), (const bf16_t*)(p.ws + WS_WIN), M, DIN, D, 0, 0};
            pg8::StaticOrder S; S.init(M, DIN, D, gridDim.x, blockIdx.x);
            pg8::EpiIN E{(bf16_t*)(p.ws + WS_U)};
            pg8::gemm_phase(lds, g, S, E);
        } else if (ph == 5) {
            scan_phase(p, lds, tid, dry);
        } else if (ph == 6) {
            if (!dry) sample_phase(p, lds, tid);
            fix_phase(p, lds, tid, dry);
            za_phase(p, tid, dry);
        } else if (ph == 8) {
            merge_phase(p, tid);
        } else if (ph == 10) {
            convert_set1(p, lds, tid);
            norm_phase(p, 2, tid, dry, 4);
        } else if (ph == 13) {
            norm_phase(p, 3, tid, dry, 11);
        }
        if (ph2 + 1 < ph_hi * 2) { if (first_sync) { grid.sync(); first_sync = false; } else xcd_barrier(xb); }
    }
}

extern "C" void kernel_launch(void* const* d_in, const int* in_sizes, int n_in, void* d_out, int out_size, void* d_ws, size_t ws_size, hipStream_t stream) {
    if (n_in != 30 || ws_size < WS_END) { fprintf(stderr, "kernel_launch: unexpected n_in %d / ws_size %zu (need %zu)\n", n_in, ws_size, (size_t)WS_END); return; }
    Params p{};
    for (int i = 0; i < 30; ++i) p.in[i] = (const float*)d_in[i];
    p.out = (float*)d_out; p.ws = (unsigned char*)d_ws;
    (void)hipFuncSetAttribute((const void*)mk_fwd, hipFuncAttributeMaxDynamicSharedMemorySize, LDS_BYTES);
    static int grid_blocks = 0;
    if (!grid_blocks) {
        int dev = 0, cus = 0, per_cu = 0;
        (void)hipGetDevice(&dev);
        (void)hipDeviceGetAttribute(&cus, hipDeviceAttributeMultiprocessorCount, dev);
        (void)hipOccupancyMaxActiveBlocksPerMultiprocessor(&per_cu, (const void*)mk_fwd, 512, LDS_BYTES);
        if (per_cu < 1) { fprintf(stderr, "kernel_launch: occupancy query says %d blocks/CU\n", per_cu); per_cu = 1; }
        grid_blocks = cus;
    }
    (void)hipMemsetAsync((unsigned char*)d_ws + WS_BAR, 0, 16384, stream);
#if SINGLE_LAUNCH
    int lo = 0, hi = NPHASE;
    void* args[] = {&p, &lo, &hi};
    hipError_t e = hipLaunchCooperativeKernel((const void*)mk_fwd, dim3(grid_blocks), dim3(512), args, LDS_BYTES, stream);
    if (e != hipSuccess) fprintf(stderr, "cooperative launch failed: %s (grid %d)\n", hipGetErrorString(e), grid_blocks);
#else
    for (int ph = 0; ph < NPHASE; ++ph) hipLaunchKernelGGL(mk_fwd, dim3(grid_blocks), dim3(512), LDS_BYTES, stream, p, ph, ph + 1);
#endif
}
```

```cpp
#include <hip/hip_runtime.h>
#include <hip/hip_cooperative_groups.h>
#include <cstdio>
namespace cg = cooperative_groups;

#ifndef REP_MASK
#define REP_MASK 0
#endif
#ifndef SINGLE_LAUNCH
#define SINGLE_LAUNCH 1
#endif

#define LAS __attribute__((address_space(3)))
typedef unsigned short bf16_t;
typedef short bf16x8 __attribute__((ext_vector_type(8)));
typedef float f32x4 __attribute__((ext_vector_type(4)));
typedef unsigned u32x4 __attribute__((ext_vector_type(4)));
typedef unsigned u32x2 __attribute__((ext_vector_type(2)));

constexpr int D = 1024, DFF = 2816, DIN = 7168;
constexpr int NB = 8, SEQ = 2048, NMETA = 16, TP = SEQ + NMETA;
constexpr int MP = NB * TP;
constexpr int NS = 128;
constexpr int M = MP + NS;
constexpr int CHUNK = 48, NCH = TP / CHUNK;
constexpr float EPS = 1e-6f;

constexpr size_t O_YP = 0, O_YS = 16777216, O_CAP = O_YS + 131072, O_CBP = O_CAP + 16384, O_RGP = O_CBP + 24576,
                 O_CAS = O_RGP + 8192, O_CBS = O_CAS + 262144, O_RGS = O_CBS + 393216;

constexpr size_t SLOT = (size_t)M * D;
constexpr size_t SB = SLOT * 2;
constexpr size_t WS_U = 0;
constexpr size_t WS_ACT = 0;
constexpr size_t WS_Y = 3 * SB;
constexpr size_t WS_PY = 4 * SB;
constexpr int MAINR = 64 * 256;
constexpr size_t WS_WGU = 5 * SB;
constexpr size_t WS_WD = WS_WGU + (size_t)5632 * 1024 * 2;
constexpr size_t WS_H = 6 * SB;
constexpr size_t WS_WIN = 7 * SB;
constexpr size_t WS_POAB = WS_WIN;
constexpr size_t WS_WOAB = WS_WIN + (size_t)7168 * 1024 * 2;
constexpr size_t WS_WO = WS_WOAB + (size_t)2 * 1024 * 1024 * 2;
constexpr size_t WS_WRG = WS_WO + (size_t)1024 * 1024 * 2;
constexpr size_t WS_SUMM = WS_WRG + (size_t)2 * 16 * 64 * 64 * 2;
constexpr size_t WS_SC = WS_SUMM + (size_t)NB * NCH * D * 2 * 4;
constexpr size_t WS_BAR = WS_SC + 131072;
constexpr size_t WS_END = WS_BAR + 16384;
static_assert(WS_END <= (size_t)256 * 1024 * 1024, "workspace");

struct Params { const float* in[30]; float* out; unsigned char* ws; };

__device__ __forceinline__ unsigned cvt_pk_bf16(float lo, float hi) { unsigned r; asm volatile("v_cvt_pk_bf16_f32 %0, %1, %2" : "=v"(r) : "v"(lo), "v"(hi)); return r; }
__device__ __forceinline__ bf16_t f2bf(float f) { return (bf16_t)(cvt_pk_bf16(f, 0.f) & 0xffffu); }
__device__ __forceinline__ float bf2f(bf16_t b) { return __uint_as_float(((unsigned)b) << 16); }
__device__ __forceinline__ float bflo(unsigned w) { return __uint_as_float(w << 16); }
__device__ __forceinline__ float bfhi(unsigned w) { return __uint_as_float(w & 0xffff0000u); }
__device__ __forceinline__ float sigm(float x) { return __builtin_amdgcn_rcpf(1.0f + __expf(-x)); }
__device__ __forceinline__ float gelu_tanh(float x) { const float t = 1.5957691216057308f * (x + 0.044715f * x * x * x); return x * sigm(t); }
__device__ __forceinline__ float wave_sum(float v, int lane) {
#pragma unroll
    for (int o = 32; o >= 1; o >>= 1) v += __int_as_float(__builtin_amdgcn_ds_bpermute((lane ^ o) << 2, __float_as_int(v)));
    return v;
}
__device__ __forceinline__ const float* x0row(const Params& p, int r) {
    if (r >= MP) return p.in[1] + (size_t)(r - MP) * D;
    const int b = r / TP, t = r - b * TP;
    if (t < NMETA) return p.in[5] + (size_t)t * D;
    return p.in[0] + ((size_t)b * SEQ + (t - NMETA)) * D;
}

namespace pg8 {
constexpr int BM = 256, BK = 64, HALF = 128, HTB = HALF * BK * 2, STAGE_BYTES = 8 * HTB, NXCD = 8, WGM = 8;
__host__ __device__ __forceinline__ int lds_byte(int r, int c) { const int st = (r >> 4) * 2 + (c >> 5), rr = r & 15, cc = c & 31, ob = rr * 64 + cc * 2; return st * 1024 + (ob ^ (((ob >> 9) & 1) << 5)); }
__host__ __device__ __forceinline__ void stage_rc(int b, int& R, int& C) { const int st = b / 1024, sb = b % 1024, swz = sb ^ (((sb >> 9) & 1) << 5); R = (st >> 1) * 16 + swz / 64; C = (st & 1) * 32 + (swz % 64) / 2; }
__host__ __device__ __forceinline__ int perm32(int rho) { const int n = rho >> 4, i = rho & 15; return 8 * (i >> 2) + 4 * n + (i & 3); }

struct Unit { int pm, pn, z, k0, nk, part; };
struct Gemm { const bf16_t* A; const bf16_t* Bt; int M, N, K; size_t zA, zB; };

struct StaticOrder {
    int nM, nN, nwg, G, c, ntf;
    __device__ void init(int M_, int N_, int K_, int G_, int c_) { nM = M_ / BM; nN = N_ / BM; nwg = nM * nN; G = G_; c = c_; ntf = K_ / BK; }
    __device__ bool map(long L, Unit& u) const {
        if (L >= nwg) return false;
        int wgid = (int)L; { const int q = nwg / NXCD, r = nwg % NXCD, xcd = wgid % NXCD, off = wgid / NXCD; wgid = (xcd < r ? xcd * (q + 1) : r * (q + 1) + (xcd - r) * q) + off; }
        const int nig = WGM * nN, gid = wgid / nig, fm = gid * WGM, gsz = (nM - fm) < WGM ? (nM - fm) : WGM;
        u.pm = fm + ((wgid % nig) % gsz); u.pn = (wgid % nig) / gsz; u.z = 0; u.k0 = 0; u.nk = ntf; u.part = -1; return true;
    }
    __device__ bool next(int i, Unit& u) const { return map((long)i * G + c, u); }
};
struct SplitOrder : StaticOrder {
    int nsplit, nkm;
    __device__ void init(int N_, int K_, int G_, int c_, int nsplit_, int nkm_) { StaticOrder::init(64 * BM, N_, K_, G_, c_); nsplit = nsplit_; nkm = nkm_; }
    __device__ bool next(int i, Unit& u) const {
        const long L = (long)i * G + c; bool ok;
        if (L < nwg) ok = map(L, u);
        else { const int L2 = (int)(L - nwg); ok = L2 < nN * nsplit; const int ks = L2 / nN; u.pm = 64; u.pn = L2 - ks * nN; u.k0 = ks * nkm; u.nk = nkm; u.part = ks; }
        u.z = u.pn >> 2; u.pn &= 3; return ok;
    }
};

template <class Epi, class Sched>
__device__ __forceinline__ void gemm_phase(LAS unsigned char* lds, const Gemm g, const Sched& S, const Epi& E) {
    int tid_ = threadIdx.x; asm volatile("" : "+v"(tid_));
    const int tid = tid_, wid = __builtin_amdgcn_readfirstlane(tid >> 6), lane = tid & 63, wr = wid >> 2, wc = wid & 3, fr = lane & 15, fq = lane >> 4;
    const int K = g.K;
    unsigned voffA[2], voffB[2];
#pragma unroll
    for (int i = 0; i < 2; ++i) { int R, C; stage_rc(tid * 16 + i * 8192, R, C); const int Rb = Epi::PERM ? ((R & ~31) + perm32(R & 31)) : R;
        voffA[i] = (unsigned)(R * K + C) * 2u; voffB[i] = (unsigned)(Rb * K + C) * 2u; }
    const size_t kstep = (size_t)(BK * 2);
    const size_t hstep = (size_t)HALF * K * 2;
    const size_t tstep = 2 * hstep;
    const unsigned ldsw = (unsigned)wid * 1024u;
    const int aoff = lds_byte(wr * 64 + fr, fq * 8), boff = lds_byte(wc * 32 + fr, fq * 8);
#define PG8_SA(b, h) (((b) * 2 + (h)) * HTB)
#define PG8_SB(b, h) ((4 + (b) * 2 + (h)) * HTB)
#define PG8_STAGE(bufoff, gbase, voff) do { _Pragma("unroll") for (int _i = 0; _i < 2; ++_i) \
        __builtin_amdgcn_global_load_lds((const unsigned*)((const char*)(gbase) + (voff)[_i]), (LAS unsigned*)(lds + (bufoff) + ldsw + _i * 8192), 16, 0, 0); } while (0)
#define PG8_LDA(dst, b, h) do { _Pragma("unroll") for (int m = 0; m < 4; ++m) _Pragma("unroll") for (int k = 0; k < 2; ++k) dst[m][k] = *(const LAS bf16x8*)(lds + PG8_SA(b, h) + aoff + m * 2048 + k * 1024); } while (0)
#define PG8_LDB(dst, b, h) do { _Pragma("unroll") for (int n = 0; n < 2; ++n) _Pragma("unroll") for (int k = 0; k < 2; ++k) dst[n][k] = *(const LAS bf16x8*)(lds + PG8_SB(b, h) + boff + n * 2048 + k * 1024); } while (0)
#define PG8_MMA(ai, bj, At, Bt) do { __builtin_amdgcn_s_setprio(1); _Pragma("unroll") for (int m = 0; m < 4; ++m) _Pragma("unroll") for (int n = 0; n < 2; ++n) _Pragma("unroll") for (int k = 0; k < 2; ++k) \
        acc[ai][bj][m][n] = __builtin_amdgcn_mfma_f32_16x16x32_bf16(Bt[n][k], At[m][k], acc[ai][bj][m][n], 0, 0, 0); __builtin_amdgcn_s_setprio(0); } while (0)
#define PG8_WAIT_V(n) asm volatile("s_waitcnt vmcnt(" #n ")" ::: "memory")
#define PG8_WAIT_L(n) asm volatile("s_waitcnt lgkmcnt(" #n ")" ::: "memory")
#define PG8_BAR __builtin_amdgcn_s_barrier()
#define PG8_SCHED __builtin_amdgcn_sched_barrier(0)
    Unit cur, nxt; int ui = 0;
    if (!S.next(0, cur)) return;
    f32x4 acc[2][2][4][2];
#pragma unroll
    for (int a = 0; a < 2; ++a)
#pragma unroll
        for (int b = 0; b < 2; ++b)
#pragma unroll
            for (int m = 0; m < 4; ++m)
#pragma unroll
                for (int n = 0; n < 2; ++n) acc[a][b][m][n] = (f32x4){0.f, 0.f, 0.f, 0.f};
    bf16x8 At[4][2], B0[2][2], B1[2][2];
    const char* cA = (const char*)g.A + (size_t)cur.z * g.zA + (size_t)cur.pm * tstep + (size_t)cur.k0 * kstep; const char* cB = (const char*)g.Bt + (size_t)cur.z * g.zB + (size_t)cur.pn * tstep + (size_t)cur.k0 * kstep;
    int nt = cur.nk;
    PG8_STAGE(PG8_SB(0, 0), cB, voffB); PG8_STAGE(PG8_SA(0, 0), cA, voffA); PG8_STAGE(PG8_SB(0, 1), cB + hstep, voffB); PG8_STAGE(PG8_SA(0, 1), cA + hstep, voffA);
    if (wr == 1) PG8_BAR;
    PG8_WAIT_V(4); PG8_BAR;
    PG8_STAGE(PG8_SB(1, 0), cB + kstep, voffB); PG8_STAGE(PG8_SA(1, 0), cA + kstep, voffA); PG8_STAGE(PG8_SB(1, 1), cB + hstep + kstep, voffB);
    PG8_WAIT_V(6); PG8_BAR;
    for (;;) {
        const bool has_next = S.next(ui + 1, nxt);
        const char* nA = has_next ? (const char*)g.A + (size_t)nxt.z * g.zA + (size_t)nxt.pm * tstep + (size_t)nxt.k0 * kstep : cA; const char* nB = has_next ? (const char*)g.Bt + (size_t)nxt.z * g.zB + (size_t)nxt.pn * tstep + (size_t)nxt.k0 * kstep : cB;
        for (int t = 0; t < nt; t += 2) {
            const bool last = (t == nt - 2);
            const char* a1 = cA + (size_t)(t + 1) * kstep;
            const char* a2 = last ? nA : cA + (size_t)(t + 2) * kstep; const char* b2 = last ? nB : cB + (size_t)(t + 2) * kstep;
            const char* a3 = a2 + kstep; const char* b3 = b2 + kstep;
            PG8_LDB(B0, 0, 0); PG8_SCHED; PG8_LDA(At, 0, 0); PG8_STAGE(PG8_SA(1, 1), a1 + hstep, voffA);
            PG8_WAIT_L(8); PG8_BAR; PG8_WAIT_L(0); PG8_MMA(0, 0, At, B0); PG8_BAR; PG8_SCHED;
            PG8_LDB(B1, 0, 1); PG8_STAGE(PG8_SB(0, 0), b2, voffB);
            PG8_BAR; PG8_WAIT_L(0); PG8_MMA(0, 1, At, B1); PG8_BAR;
            PG8_LDA(At, 0, 1); PG8_STAGE(PG8_SA(0, 0), a2, voffA);
            PG8_BAR; PG8_WAIT_L(0); PG8_MMA(1, 0, At, B0); PG8_BAR; PG8_SCHED;
            PG8_STAGE(PG8_SB(0, 1), b2 + hstep, voffB);
            PG8_WAIT_V(6); PG8_BAR; PG8_MMA(1, 1, At, B1); PG8_BAR;
            PG8_LDB(B0, 1, 0); PG8_SCHED; PG8_LDA(At, 1, 0); PG8_STAGE(PG8_SA(0, 1), a2 + hstep, voffA);
            PG8_WAIT_L(8); PG8_BAR; PG8_WAIT_L(0); PG8_MMA(0, 0, At, B0); PG8_BAR; PG8_SCHED;
            PG8_LDB(B1, 1, 1); PG8_STAGE(PG8_SB(1, 0), b3, voffB);
            PG8_BAR; PG8_WAIT_L(0); PG8_MMA(0, 1, At, B1); PG8_BAR;
            PG8_LDA(At, 1, 1); PG8_STAGE(PG8_SA(1, 0), a3, voffA);
            PG8_BAR; PG8_WAIT_L(0); PG8_MMA(1, 0, At, B0); PG8_BAR; PG8_SCHED;
            PG8_STAGE(PG8_SB(1, 1), b3 + hstep, voffB);
            PG8_WAIT_V(6); PG8_BAR; PG8_MMA(1, 1, At, B1); PG8_BAR;
        }
        E(acc, cur, wr, wc, fr, fq);
        if (!has_next) break;
#pragma unroll
        for (int a = 0; a < 2; ++a)
#pragma unroll
            for (int b = 0; b < 2; ++b)
#pragma unroll
                for (int m = 0; m < 4; ++m)
#pragma unroll
                    for (int n = 0; n < 2; ++n) acc[a][b][m][n] = (f32x4){0.f, 0.f, 0.f, 0.f};
        cur = nxt; cA = nA; cB = nB; nt = cur.nk; ++ui;
    }
    PG8_WAIT_V(0);
    if (wr == 0) PG8_BAR;
    PG8_BAR;
#undef PG8_SA
#undef PG8_SB
#undef PG8_STAGE
#undef PG8_LDA
#undef PG8_LDB
#undef PG8_MMA
#undef PG8_WAIT_V
#undef PG8_WAIT_L
#undef PG8_BAR
#undef PG8_SCHED
}

struct EpiBF {
    static constexpr bool PERM = true;
    bf16_t* O; size_t zO; float* P; int nz;
    __device__ __forceinline__ void operator()(const f32x4 (&acc)[2][2][4][2], const Unit& u, int wr, int wc, int fr, int fq) const {
        const int col0 = u.pn * BM + wc * 32 + 8 * fq;
        if (u.part < 0) {
            const int row0 = u.pm * BM + wr * 64 + fr; bf16_t* base = O + (size_t)u.z * zO;
#pragma unroll
            for (int ai = 0; ai < 2; ++ai)
#pragma unroll
                for (int m = 0; m < 4; ++m) { bf16_t* rowp = base + (size_t)(row0 + ai * HALF + m * 16) * D + col0;
#pragma unroll
                    for (int bj = 0; bj < 2; ++bj) { const f32x4 v0 = acc[ai][bj][m][0], v1 = acc[ai][bj][m][1];
                        u32x4 w; w.x = cvt_pk_bf16(v0[0], v0[1]); w.y = cvt_pk_bf16(v0[2], v0[3]); w.z = cvt_pk_bf16(v1[0], v1[1]); w.w = cvt_pk_bf16(v1[2], v1[3]);
                        *(u32x4*)(rowp + bj * HALF) = w; } }
        } else {
            const int row0 = wr * 64 + fr; float* base = P + (size_t)(u.part * nz + u.z) * (BM * D);
#pragma unroll
            for (int ai = 0; ai < 2; ++ai)
#pragma unroll
                for (int m = 0; m < 4; ++m) { float* rowp = base + (size_t)(row0 + ai * HALF + m * 16) * D + col0;
#pragma unroll
                    for (int bj = 0; bj < 2; ++bj) { *(f32x4*)(rowp + bj * HALF) = acc[ai][bj][m][0]; *(f32x4*)(rowp + bj * HALF + 4) = acc[ai][bj][m][1]; } }
        }
    }
};
struct EpiGU {
    static constexpr bool PERM = true;
    bf16_t* O; bool dry;
    __device__ __forceinline__ void operator()(const f32x4 (&acc)[2][2][4][2], const Unit& u, int wr, int wc, int fr, int fq) const {
        if (dry) return;
        const int row0 = u.pm * BM + wr * 64 + fr, col0 = u.pn * HALF + wc * 32 + 8 * fq;
#pragma unroll
        for (int ai = 0; ai < 2; ++ai)
#pragma unroll
            for (int m = 0; m < 4; ++m) { bf16_t* rowp = O + (size_t)(row0 + ai * HALF + m * 16) * DFF + col0;
                float v[8];
#pragma unroll
                for (int n = 0; n < 2; ++n)
#pragma unroll
                    for (int j = 0; j < 4; ++j) { const float gt = acc[ai][0][m][n][j], up = acc[ai][1][m][n][j]; v[n * 4 + j] = gt * sigm(gt) * up; }
                u32x4 w; w.x = cvt_pk_bf16(v[0], v[1]); w.y = cvt_pk_bf16(v[2], v[3]); w.z = cvt_pk_bf16(v[4], v[5]); w.w = cvt_pk_bf16(v[6], v[7]);
                *(u32x4*)rowp = w; }
    }
};
struct EpiIN {
    static constexpr bool PERM = true;
    bf16_t* U;
    __device__ __forceinline__ void operator()(const f32x4 (&acc)[2][2][4][2], const Unit& u, int wr, int wc, int fr, int fq) const {
        const int row0 = u.pm * BM + wr * 64 + fr;
        if (u.pn >= 4 && u.pn < 12) {
            const int col0 = (u.pn - 4) * HALF + wc * 32 + 8 * fq; bf16_t* base = U + 2 * SLOT;
#pragma unroll
            for (int ai = 0; ai < 2; ++ai)
#pragma unroll
                for (int m = 0; m < 4; ++m) { bf16_t* rowp = base + (size_t)(row0 + ai * HALF + m * 16) * D + col0;
                    const f32x4 v0 = acc[ai][0][m][0] * acc[ai][1][m][0], v1 = acc[ai][0][m][1] * acc[ai][1][m][1];
                    u32x4 w; w.x = cvt_pk_bf16(v0[0], v0[1]); w.y = cvt_pk_bf16(v0[2], v0[3]); w.z = cvt_pk_bf16(v1[0], v1[1]); w.w = cvt_pk_bf16(v1[2], v1[3]);
                    *(u32x4*)rowp = w; }
        } else {
            int slot, ct; if (u.pn < 4) { slot = 0; ct = u.pn; } else { const int sg = (u.pn - 12) >> 2; slot = sg == 0 ? 3 : (sg == 1 ? 1 : sg + 2); ct = (u.pn - 12) & 3; }
            const int col0 = ct * BM + wc * 32 + 8 * fq; bf16_t* base = U + (size_t)slot * SLOT;
#pragma unroll
            for (int ai = 0; ai < 2; ++ai)
#pragma unroll
                for (int m = 0; m < 4; ++m) { bf16_t* rowp = base + (size_t)(row0 + ai * HALF + m * 16) * D + col0;
#pragma unroll
                    for (int bj = 0; bj < 2; ++bj) { const f32x4 v0 = acc[ai][bj][m][0], v1 = acc[ai][bj][m][1];
                        u32x4 w; w.x = cvt_pk_bf16(v0[0], v0[1]); w.y = cvt_pk_bf16(v0[2], v0[3]); w.z = cvt_pk_bf16(v1[0], v1[1]); w.w = cvt_pk_bf16(v1[2], v1[3]);
                        *(u32x4*)(rowp + bj * HALF) = w; } }
        }
    }
};
}

__device__ __forceinline__ int conv_map(int mode, int n) {
    if (mode == 0) return n;
    if (mode == 1) return 256 * (n >> 7) + (n & 127);
    if (mode == 2) return 256 * (n >> 7) + 128 + (n & 127);
    const int seg = n >> 10, j = n & 1023;
    if (seg == 0) return j;
    if (seg == 1) return 1024 + 256 * (j >> 7) + (j & 127);
    if (seg == 2) return 1024 + 256 * (j >> 7) + 128 + (j & 127);
    return 3072 + (seg - 3) * 1024 + j;
}
__device__ __forceinline__ void conv_tile(const float* __restrict__ src, int K, int N, bf16_t* __restrict__ dst, int mode, int tile, LAS float* sl, int tid, const float* __restrict__ gk) {
    const int ntn = N >> 6; const int tk = tile / ntn, tn = tile - tk * ntn; const int k0 = tk * 64, n0 = tn * 64;
#pragma unroll
    for (int q = 0; q < 2; ++q) { const int kr = (tid >> 4) + 32 * q; const f32x4 v = *(const f32x4*)(src + (size_t)(k0 + kr) * N + n0 + (tid & 15) * 4);
        LAS float* d = sl + kr * 65 + (tid & 15) * 4; d[0] = v[0]; d[1] = v[1]; d[2] = v[2]; d[3] = v[3]; }
    __syncthreads();
    const int n = tid >> 3, ko = (tid & 7) * 8;
    float f[8];
#pragma unroll
    for (int i = 0; i < 8; ++i) f[i] = sl[(ko + i) * 65 + n];
    if (gk) {
        const f32x4 g0 = *(const f32x4*)(gk + k0 + ko), g1 = *(const f32x4*)(gk + k0 + ko + 4);
#pragma unroll
        for (int i = 0; i < 4; ++i) { f[i] *= g0[i]; f[4 + i] *= g1[i]; }
    }
    u32x4 w; w.x = cvt_pk_bf16(f[0], f[1]); w.y = cvt_pk_bf16(f[2], f[3]); w.z = cvt_pk_bf16(f[4], f[5]); w.w = cvt_pk_bf16(f[6], f[7]);
    *(u32x4*)(dst + (size_t)conv_map(mode, n0 + n) * K + k0 + ko) = w;
    __syncthreads();
}
template <int II, int K, int N, int MODE, int GI>
__device__ __forceinline__ void conv_mat(const Params& p, size_t dst, LAS unsigned char* lds, int tid) {
    constexpr int ntiles = (K >> 6) * (N >> 6);
    for (int t = blockIdx.x; t < ntiles; t += gridDim.x) conv_tile(p.in[II], K, N, (bf16_t*)(p.ws + dst), MODE, t, (LAS float*)lds, tid, GI >= 0 ? p.in[GI >= 0 ? GI : 0] : nullptr);
}
__device__ __forceinline__ void convert_set0(const Params& p, LAS unsigned char* lds, int tid) {
    conv_mat<8, 1024, 2816, 1, 6>(p, WS_WGU, lds, tid);
    conv_mat<9, 1024, 2816, 2, 6>(p, WS_WGU, lds, tid);
    conv_mat<10, 2816, 1024, 0, -1>(p, WS_WD, lds, tid);
    conv_mat<13, 1024, 7168, 3, 11>(p, WS_WIN, lds, tid);
    conv_mat<15, 1024, 1024, 0, -1>(p, WS_WOAB, lds, tid);
    conv_mat<23, 1024, 1024, 0, -1>(p, WS_WOAB + (size_t)1024 * 1024 * 2, lds, tid);
    conv_mat<24, 1024, 1024, 0, -1>(p, WS_WO, lds, tid);
}
__device__ __forceinline__ void convert_set1(const Params& p, LAS unsigned char* lds, int tid) {
    conv_mat<27, 1024, 2816, 1, 25>(p, WS_WGU, lds, tid);
    conv_mat<28, 1024, 2816, 2, 25>(p, WS_WGU, lds, tid);
    conv_mat<29, 2816, 1024, 0, -1>(p, WS_WD, lds, tid);
}

__device__ __forceinline__ void norm_phase(const Params& p, int mode, int tid, bool dry, int nsplit) {
    const int lane = tid & 63, gw = blockIdx.x * 8 + (tid >> 6), nw = gridDim.x * 8;
    const float* gpost = mode == 1 ? p.in[7] : (mode == 2 ? p.in[12] : p.in[26]);
    const float cc = mode == 2 ? 1.0f : 0.5f;
    const bf16_t* Yb = (const bf16_t*)(p.ws + WS_Y); const float* PY = (const float*)(p.ws + WS_PY); bf16_t* H = (bf16_t*)(p.ws + WS_H); float* SC = (float*)(p.ws + WS_SC);
    for (int r = gw; r < M; r += nw) {
        f32x4 xv[4];
        if (mode == 0) {
            const float* xin = x0row(p, r);
#pragma unroll
            for (int q = 0; q < 4; ++q) xv[q] = *(const f32x4*)(xin + lane * 4 + 256 * q);
        } else {
            const float sc = SC[r];
#pragma unroll
            for (int q = 0; q < 4; ++q) { const u32x2 w = *(const u32x2*)(H + (size_t)r * D + lane * 4 + 256 * q); xv[q] = (f32x4){bflo(w.x), bfhi(w.x), bflo(w.y), bfhi(w.y)} * sc; }
            f32x4 yv[4]; float ss = 0.f;
            if (r < MAINR) {
#pragma unroll
                for (int q = 0; q < 4; ++q) { const u32x2 w = *(const u32x2*)(Yb + (size_t)r * D + lane * 4 + 256 * q); yv[q] = (f32x4){bflo(w.x), bfhi(w.x), bflo(w.y), bfhi(w.y)}; }
            } else {
#pragma unroll
                for (int q = 0; q < 4; ++q) yv[q] = (f32x4){0.f, 0.f, 0.f, 0.f};
                for (int ks = 0; ks < nsplit; ++ks) {
#pragma unroll
                    for (int q = 0; q < 4; ++q) yv[q] += *(const f32x4*)(PY + ((size_t)ks * 256 + (r - MAINR)) * D + lane * 4 + 256 * q);
                }
            }
#pragma unroll
            for (int q = 0; q < 4; ++q) ss += yv[q][0] * yv[q][0] + yv[q][1] * yv[q][1] + yv[q][2] * yv[q][2] + yv[q][3] * yv[q][3];
            ss = wave_sum(ss, lane);
            const float rs = cc * rsqrtf(ss * (1.0f / D) + EPS);
#pragma unroll
            for (int q = 0; q < 4; ++q) xv[q] += yv[q] * rs * *(const f32x4*)(gpost + lane * 4 + 256 * q);
        }
        if (mode == 3) {
            float* xo;
            if (r >= MP) xo = p.out + O_YS + (size_t)(r - MP) * D;
            else { const int b = r / TP, t = r - b * TP; if (t < NMETA) continue; xo = p.out + O_YP + ((size_t)b * SEQ + (t - NMETA)) * D; }
#pragma unroll
            for (int q = 0; q < 4; ++q) *(f32x4*)(xo + lane * 4 + 256 * q) = xv[q];
        } else {
            float ss = 0.f;
#pragma unroll
            for (int q = 0; q < 4; ++q) ss += xv[q][0] * xv[q][0] + xv[q][1] * xv[q][1] + xv[q][2] * xv[q][2] + xv[q][3] * xv[q][3];
            ss = wave_sum(ss, lane);
            const float ms = ss * (1.0f / D) + EPS; const float rs = rsqrtf(ms);
            if (!dry) {
#pragma unroll
                for (int q = 0; q < 4; ++q) { const f32x4 hv = xv[q] * rs; u32x2 w; w.x = cvt_pk_bf16(hv[0], hv[1]); w.y = cvt_pk_bf16(hv[2], hv[3]);
                    *(u32x2*)(H + (size_t)r * D + lane * 4 + 256 * q) = w; }
                if (lane == 0) SC[r] = ms * rs;
            }
        }
    }
}

constexpr int WL_BYTES = 11264;
__device__ __forceinline__ void scan_item(const Params& p, int b, int j, int h, LAS unsigned char* wl, const LAS unsigned char* wlds, int lane, bool dry) {
    bf16_t* U = (bf16_t*)(p.ws + WS_U);
    const bf16_t* bx = U + 3 * SLOT; bf16_t* bg = U + 1 * SLOT; bf16_t* pp = (bf16_t*)p.out;
    float* summ = (float*)(p.ws + WS_SUMM);
    const int c = h * 64 + lane, fr = lane & 15, fq = lane >> 4;
    const size_t row0 = (size_t)b * TP + (size_t)j * CHUNK;
    const LAS unsigned char* wq = wlds + fr * 144 + fq * 16;
    float brv[4], biv[4], lcv[4];
#pragma unroll
    for (int nt = 0; nt < 4; ++nt) { const int ch = h * 64 + nt * 16 + fr; brv[nt] = p.in[19][ch]; biv[nt] = p.in[21][ch]; lcv[nt] = -8.0f * log1pf(expf(-p.in[22][ch])); }
    const float w0 = p.in[16][c], w1 = p.in[16][D + c], w2 = p.in[16][2 * D + c], w3 = p.in[16][3 * D + c], cbias = p.in[17][c];
    float xm3 = 0.f, xm2 = 0.f, xm1 = 0.f;
    if (j > 0) { xm3 = bf2f(bx[(row0 - 3) * D + c]); xm2 = bf2f(bx[(row0 - 2) * D + c]); xm1 = bf2f(bx[(row0 - 1) * D + c]); }
    float hh = 0.f, ap = 1.f;
    LAS unsigned short* cbT = (LAS unsigned short*)wl;
    LAS float* xu = (LAS float*)(wl + 2304);
    LAS float* aS = (LAS float*)(wl + 2304 + 4352);
    bf16_t xr[16], gr[16], xn[16];
#pragma unroll
    for (int tt = 0; tt < 16; ++tt) xr[tt] = bx[(row0 + tt) * D + c];
#pragma unroll
    for (int g = 0; g < 3; ++g) {
        const size_t r0 = row0 + (size_t)g * 16;
#pragma unroll
        for (int tt = 0; tt < 16; ++tt) gr[tt] = bg[(r0 + tt) * D + c];
        if (g < 2) {
#pragma unroll
            for (int tt = 0; tt < 16; ++tt) xn[tt] = bx[(r0 + 16 + tt) * D + c];
        }
#pragma unroll
        for (int tt = 0; tt < 16; ++tt) { const float x = bf2f(xr[tt]); const float cb = w0 * xm3 + w1 * xm2 + w2 * xm1 + w3 * x + cbias; xm3 = xm2; xm2 = xm1; xm1 = x;
            cbT[tt * 72 + lane] = f2bf(cb); xu[tt * 68 + lane] = cb; }
        __builtin_amdgcn_wave_barrier();
        const bf16x8 a0 = *(const LAS bf16x8*)(cbT + fr * 72 + fq * 8), a1 = *(const LAS bf16x8*)(cbT + fr * 72 + 32 + fq * 8);
        f32x4 accR[4], accI[4];
#pragma unroll
        for (int nt = 0; nt < 4; ++nt) {
            const bf16x8 r0w = *(const LAS bf16x8*)(wq + nt * 2304), r1w = *(const LAS bf16x8*)(wq + nt * 2304 + 64);
            const bf16x8 i0w = *(const LAS bf16x8*)(wq + 9216 + nt * 2304), i1w = *(const LAS bf16x8*)(wq + 9216 + nt * 2304 + 64);
            accR[nt] = __builtin_amdgcn_mfma_f32_16x16x32_bf16(a0, r0w, (f32x4){0.f, 0.f, 0.f, 0.f}, 0, 0, 0);
            accR[nt] = __builtin_amdgcn_mfma_f32_16x16x32_bf16(a1, r1w, accR[nt], 0, 0, 0);
            accI[nt] = __builtin_amdgcn_mfma_f32_16x16x32_bf16(a0, i0w, (f32x4){0.f, 0.f, 0.f, 0.f}, 0, 0, 0);
            accI[nt] = __builtin_amdgcn_mfma_f32_16x16x32_bf16(a1, i1w, accI[nt], 0, 0, 0);
        }
#pragma unroll
        for (int nt = 0; nt < 4; ++nt)
#pragma unroll
            for (int i = 0; i < 4; ++i) { const int idx = (fq * 4 + i) * 68 + nt * 16 + fr; const float x = xu[idx];
                const float r = sigm(accR[nt][i] + brv[nt]), ig = sigm(accI[nt][i] + biv[nt]);
                const float la = lcv[nt] * r; const float a = __expf(la);
                const float z2 = 2.0f * la;
                const float m2s = -z2 * (1.0f + z2 * (0.5f + z2 * (0.16666667f + z2 * (0.041666668f + z2 * (0.0083333338f + z2 * 0.0013888889f)))));
                const float m2 = z2 > -0.25f ? m2s : 1.0f - a * a;
                xu[idx] = __builtin_amdgcn_sqrtf(m2) * ig * x; aS[idx] = a; }
        __builtin_amdgcn_wave_barrier();
#pragma unroll
        for (int tt = 0; tt < 16; ++tt) { const float a = aS[tt * 68 + lane], uu = xu[tt * 68 + lane]; hh = a * hh + uu; ap *= a;
            const float gl = gelu_tanh(bf2f(gr[tt]));
            if (!dry) bg[(r0 + tt) * D + c] = f2bf(gl * hh);
            pp[(r0 + tt) * D + c] = f2bf(gl * ap); }
        __builtin_amdgcn_wave_barrier();
        if (g < 2) {
#pragma unroll
            for (int tt = 0; tt < 16; ++tt) xr[tt] = xn[tt];
        }
    }
    *(float2*)(summ + (((size_t)b * NCH + j) * D + c) * 2) = make_float2(ap, hh);
    if (j == NCH - 1) { p.out[O_CBP + ((size_t)b * 3 + 0) * D + c] = xm3; p.out[O_CBP + ((size_t)b * 3 + 1) * D + c] = xm2; p.out[O_CBP + ((size_t)b * 3 + 2) * D + c] = xm1; }
}
__device__ __forceinline__ void scan_phase(const Params& p, LAS unsigned char* lds, int tid, bool dry) {
    const int wid = tid >> 6, lane = tid & 63;
    LAS unsigned char* wl = lds + wid * WL_BYTES;
    LAS unsigned char* wlds = lds + 8 * WL_BYTES;
    const int h = blockIdx.x & 15;
    {
        const bf16_t* wt = (const bf16_t*)(p.ws + WS_WRG);
#pragma unroll
        for (int q = 0; q < 2; ++q) { const int e = tid + q * 512, g = e >> 9, jrow = (e >> 3) & 63, pc = e & 7;
            *(LAS u32x4*)(wlds + g * 9216 + jrow * 144 + pc * 16) = *(const u32x4*)(wt + (size_t)g * 65536 + (size_t)(h * 64 + jrow) * 64 + pc * 8); }
    }
    __syncthreads();
    const int nbh = gridDim.x >> 4;
    for (int it = (blockIdx.x >> 4) * 8 + wid; it < NB * NCH; it += nbh * 8) scan_item(p, it / NCH, it % NCH, h, wl, wlds, lane, dry);
    __syncthreads();
}
__device__ __forceinline__ void fix_phase(const Params& p, LAS unsigned char* lds, int tid, bool dry) {
    bf16_t* zb = (bf16_t*)(p.ws + WS_U) + 1 * SLOT; const bf16_t* pp = (const bf16_t*)p.out;
    const float* summ = (const float*)(p.ws + WS_SUMM);
    LAS float* cs = (LAS float*)lds;
    for (int it = blockIdx.x; it < NB * (NCH - 1); it += gridDim.x) {
        const int b = it / (NCH - 1), j = it % (NCH - 1) + 1;
#pragma unroll
        for (int cq = 0; cq < 2; ++cq) {
            const int c = tid + cq * 512; const float* sp = summ + ((size_t)b * NCH * D + c) * 2; float hh = 0.f;
            for (int i0 = 0; i0 < j; i0 += 16) {
                float va[16], vh[16];
#pragma unroll
                for (int k = 0; k < 16; ++k) { if (i0 + k < j) { const float2 v = *(const float2*)(sp + (size_t)(i0 + k) * D * 2); va[k] = v.x; vh[k] = v.y; } else { va[k] = 1.f; vh[k] = 0.f; } }
#pragma unroll
                for (int k = 0; k < 16; ++k) hh = va[k] * hh + vh[k];
            }
            cs[c] = hh;
            if (j == NCH - 1) { const float2 v = *(const float2*)(sp + (size_t)j * D * 2); p.out[O_RGP + (size_t)b * D + c] = v.x * hh + v.y; }
        }
        __syncthreads();
        const size_t row0 = (size_t)b * TP + (size_t)j * CHUNK;
#pragma unroll 4
        for (int q = 0; q < CHUNK * 128 / 512; ++q) {
            const int e = tid + q * 512, tt = e >> 7, vc = e & 127; const size_t o = (row0 + tt) * D + vc * 8;
            const u32x4 zq = *(const u32x4*)(zb + o), pq = *(const u32x4*)(pp + o);
            const f32x4 c0 = *(const LAS f32x4*)(cs + vc * 8), c1 = *(const LAS f32x4*)(cs + vc * 8 + 4);
            u32x4 w;
            w.x = cvt_pk_bf16(bflo(zq.x) + bflo(pq.x) * c0[0], bfhi(zq.x) + bfhi(pq.x) * c0[1]); w.y = cvt_pk_bf16(bflo(zq.y) + bflo(pq.y) * c0[2], bfhi(zq.y) + bfhi(pq.y) * c0[3]);
            w.z = cvt_pk_bf16(bflo(zq.z) + bflo(pq.z) * c1[0], bfhi(zq.z) + bfhi(pq.z) * c1[1]); w.w = cvt_pk_bf16(bflo(zq.w) + bflo(pq.w) * c1[2], bfhi(zq.w) + bfhi(pq.w) * c1[3]);
            if (!dry) *(u32x4*)(zb + o) = w;
        }
        __syncthreads();
    }
}
__device__ __forceinline__ void za_phase(const Params& p, int tid, bool dry) {
    bf16_t* U = (bf16_t*)(p.ws + WS_U); bf16_t* ab = U; const bf16_t* ca = U + 2 * SLOT;
    const float* cw = p.in[14];
    for (int idx = blockIdx.x * 512 + tid; idx < NB * 129 * 128; idx += gridDim.x * 512) {
        const int vc = idx & 127, tb = (idx >> 7) % 129, b = idx / (128 * 129); const int c0 = vc * 8;
        float w[3][8];
#pragma unroll
        for (int k = 0; k < 3; ++k) { const f32x4 a = *(const f32x4*)(cw + k * D + c0), bq = *(const f32x4*)(cw + k * D + c0 + 4);
#pragma unroll
            for (int e = 0; e < 4; ++e) { w[k][e] = a[e]; w[k][4 + e] = bq[e]; } }
        const size_t r0 = (size_t)b * TP + (size_t)tb * 16;
        float p2[8], p1[8];
        if (tb > 0) { const u32x4 q2 = *(const u32x4*)(ca + (r0 - 2) * D + c0), q1 = *(const u32x4*)(ca + (r0 - 1) * D + c0);
#pragma unroll
            for (int e = 0; e < 4; ++e) { p2[2 * e] = bflo(q2[e]); p2[2 * e + 1] = bfhi(q2[e]); p1[2 * e] = bflo(q1[e]); p1[2 * e + 1] = bfhi(q1[e]); } }
        else {
#pragma unroll
            for (int e = 0; e < 8; ++e) { p2[e] = 0.f; p1[e] = 0.f; } }
#pragma unroll 4
        for (int tt = 0; tt < 16; ++tt) {
            const u32x4 qc = *(const u32x4*)(ca + (r0 + tt) * D + c0), qa = *(const u32x4*)(ab + (r0 + tt) * D + c0);
            float cv[8], av[8], zv[8];
#pragma unroll
            for (int e = 0; e < 4; ++e) { cv[2 * e] = bflo(qc[e]); cv[2 * e + 1] = bfhi(qc[e]); av[2 * e] = bflo(qa[e]); av[2 * e + 1] = bfhi(qa[e]); }
#pragma unroll
            for (int e = 0; e < 8; ++e) { zv[e] = av[e] * (w[0][e] * p2[e] + w[1][e] * p1[e] + w[2][e] * cv[e]); p2[e] = p1[e]; p1[e] = cv[e]; }
            u32x4 o; o.x = cvt_pk_bf16(zv[0], zv[1]); o.y = cvt_pk_bf16(zv[2], zv[3]); o.z = cvt_pk_bf16(zv[4], zv[5]); o.w = cvt_pk_bf16(zv[6], zv[7]);
            if (!dry) *(u32x4*)(ab + (r0 + tt) * D + c0) = o;
        }
        if (tb == 128) {
            float* o2 = p.out + O_CAP + ((size_t)b * 2 + 0) * D + c0; float* o1 = p.out + O_CAP + ((size_t)b * 2 + 1) * D + c0;
            *(f32x4*)o2 = (f32x4){p2[0], p2[1], p2[2], p2[3]}; *(f32x4*)(o2 + 4) = (f32x4){p2[4], p2[5], p2[6], p2[7]};
            *(f32x4*)o1 = (f32x4){p1[0], p1[1], p1[2], p1[3]}; *(f32x4*)(o1 + 4) = (f32x4){p1[4], p1[5], p1[6], p1[7]};
        }
    }
}
__device__ __forceinline__ void sample_phase(const Params& p, LAS unsigned char* lds, int tid) {
    bf16_t* U = (bf16_t*)(p.ws + WS_U);
    LAS float* cbs = (LAS float*)lds;
    for (int it = gridDim.x - 1 - blockIdx.x; it < NS / 4; it += gridDim.x) {
#pragma unroll 2
        for (int e = tid; e < 4 * D; e += 512) {
            const int s = it * 4 + (e >> 10), c = e & 1023; const size_t ro = (size_t)(MP + s) * D + c;
            const float cav = bf2f(U[2 * SLOT + ro]), abv = bf2f(U[ro]);
            const float s0 = p.in[2][((size_t)s * 2 + 0) * D + c], s1 = p.in[2][((size_t)s * 2 + 1) * D + c];
            const float cva = p.in[14][c] * s0 + p.in[14][D + c] * s1 + p.in[14][2 * D + c] * cav;
            U[ro] = f2bf(abv * cva);
            p.out[O_CAS + ((size_t)s * 2 + 0) * D + c] = s1; p.out[O_CAS + ((size_t)s * 2 + 1) * D + c] = cav;
            const float bxv = bf2f(U[3 * SLOT + ro]);
            const float t0 = p.in[3][((size_t)s * 3 + 0) * D + c], t1 = p.in[3][((size_t)s * 3 + 1) * D + c], t2 = p.in[3][((size_t)s * 3 + 2) * D + c];
            const float cb = p.in[16][c] * t0 + p.in[16][D + c] * t1 + p.in[16][2 * D + c] * t2 + p.in[16][3 * D + c] * bxv + p.in[17][c];
            p.out[O_CBS + ((size_t)s * 3 + 0) * D + c] = t1; p.out[O_CBS + ((size_t)s * 3 + 1) * D + c] = t2; p.out[O_CBS + ((size_t)s * 3 + 2) * D + c] = bxv;
            cbs[e] = cb;
        }
        __syncthreads();
#pragma unroll 1
        for (int cq = 0; cq < 2; ++cq) {
            const int c = tid + cq * 512, h = c >> 6, jj = c & 63;
            float ar[4] = {0.f, 0.f, 0.f, 0.f}, ai[4] = {0.f, 0.f, 0.f, 0.f};
            const float* wr_ = p.in[18] + (size_t)h * 4096 + jj; const float* wi_ = p.in[20] + (size_t)h * 4096 + jj;
#pragma unroll 16
            for (int i = 0; i < 64; ++i) { const float wrv = wr_[i * 64], wiv = wi_[i * 64];
#pragma unroll
                for (int s = 0; s < 4; ++s) { const float x = cbs[s * D + h * 64 + i]; ar[s] += x * wrv; ai[s] += x * wiv; } }
            const float lc = -8.0f * log1pf(expf(-p.in[22][c])), brc = p.in[19][c], bic = p.in[21][c];
#pragma unroll
            for (int s = 0; s < 4; ++s) { const int sg = it * 4 + s; const size_t ro = (size_t)(MP + sg) * D + c;
                const float r = sigm(ar[s] + brc), ig = sigm(ai[s] + bic); const float la = lc * r; const float a = expf(la); const float mult = sqrtf(-expm1f(2.0f * la));
                const float hn = a * p.in[4][(size_t)sg * D + c] + mult * ig * cbs[s * D + c];
                p.out[O_RGS + (size_t)sg * D + c] = hn;
                U[1 * SLOT + ro] = f2bf(gelu_tanh(bf2f(U[1 * SLOT + ro])) * hn); }
        }
        __syncthreads();
    }
}

__device__ __forceinline__ void merge_phase(const Params& p, int tid) {
    const bf16_t* U = (const bf16_t*)(p.ws + WS_U); bf16_t* H = (bf16_t*)p.out; const float* PO = (const float*)(p.ws + WS_POAB);
    for (size_t i = (size_t)blockIdx.x * 512 + tid; i < SLOT / 8; i += (size_t)gridDim.x * 512) {
        const u32x4 ga = *(const u32x4*)(U + 4 * SLOT + i * 8), gb = *(const u32x4*)(U + 5 * SLOT + i * 8);
        float ya[8], yb[8];
        const int row = (int)(i >> 7);
        if (row < MAINR) {
            const u32x4 a = *(const u32x4*)(U + 2 * SLOT + i * 8), b = *(const u32x4*)(U + 3 * SLOT + i * 8);
#pragma unroll
            for (int e = 0; e < 4; ++e) { ya[2 * e] = bflo(a[e]); ya[2 * e + 1] = bfhi(a[e]); yb[2 * e] = bflo(b[e]); yb[2 * e + 1] = bfhi(b[e]); }
        } else {
            const size_t o = (size_t)(row - MAINR) * D + (size_t)(i & 127) * 8;
#pragma unroll
            for (int e = 0; e < 8; ++e) { ya[e] = 0.f; yb[e] = 0.f; }
#pragma unroll
            for (int ks = 0; ks < 4; ++ks) {
                const f32x4 a0 = *(const f32x4*)(PO + (size_t)(ks * 2 + 0) * (256 * D) + o), a1 = *(const f32x4*)(PO + (size_t)(ks * 2 + 0) * (256 * D) + o + 4);
                const f32x4 b0 = *(const f32x4*)(PO + (size_t)(ks * 2 + 1) * (256 * D) + o), b1 = *(const f32x4*)(PO + (size_t)(ks * 2 + 1) * (256 * D) + o + 4);
#pragma unroll
                for (int e = 0; e < 4; ++e) { ya[e] += a0[e]; ya[4 + e] += a1[e]; yb[e] += b0[e]; yb[4 + e] += b1[e]; }
            }
        }
        u32x4 o4;
#pragma unroll
        for (int e = 0; e < 4; ++e) { const float lo = sigm(bflo(ga[e])) * ya[2 * e] + sigm(bflo(gb[e])) * yb[2 * e], hi = sigm(bfhi(ga[e])) * ya[2 * e + 1] + sigm(bfhi(gb[e])) * yb[2 * e + 1]; o4[e] = cvt_pk_bf16(lo, hi); }
        *(u32x4*)(H + i * 8) = o4;
    }
}

#define XB_TMO      128
#define XB_XCNT(j)  (256  + 64 * (j))
#define XB_XSUB(j)  (1280 + 64 * (j))
#define XB_XGEN(j)  (2304 + 64 * (j))
#define XB_TOP      3328
#define XB_TOPGEN   3392
#define XCD_BAR_WORDS 3456
#define XB_SPIN_CAP (1u << 18)
__device__ __forceinline__ unsigned xb_ld(unsigned* p)              { return __hip_atomic_load(p, __ATOMIC_RELAXED, __HIP_MEMORY_SCOPE_AGENT); }
__device__ __forceinline__ unsigned xb_add(unsigned* p, unsigned v) { return __hip_atomic_fetch_add(p, v, __ATOMIC_RELAXED, __HIP_MEMORY_SCOPE_AGENT); }
__device__ __forceinline__ unsigned xb_xcc_id() { return (unsigned)__builtin_amdgcn_s_getreg((3 << 11) | 20) & 0xFu; }
#define XB_SPIN(cond, bar) do { unsigned _sp = 0; while (cond) { __builtin_amdgcn_s_sleep(1); \
    if ((++_sp & 255u) == 0u) { if (xb_ld(&(bar)[XB_TMO])) break; if (_sp > XB_SPIN_CAP) { atomicAdd(&(bar)[XB_TMO], 1u); break; } } } } while (0)
struct XcdBarrier { unsigned* bar; unsigned x; volatile LAS unsigned* st; };
__device__ __forceinline__ XcdBarrier xcd_barrier_post(unsigned* bar, volatile LAS unsigned* st) {
    XcdBarrier b; b.bar = bar; b.x = xb_xcc_id(); b.st = st;
    if (threadIdx.x == 0) (void)xb_add(&bar[XB_XCNT(b.x)], 1u);
    return b;
}
__device__ __forceinline__ void xcd_barrier_complete(unsigned* bar, unsigned x, unsigned& nloc, unsigned& nx) {
    const unsigned G = gridDim.x * gridDim.y * gridDim.z;
    unsigned sum, cnt, mine, sp = 0u;
    for (;;) {
        sum = 0u; cnt = 0u; mine = 0u;
#pragma unroll
        for (unsigned j = 0; j < 16; ++j) { const unsigned c = xb_ld(&bar[XB_XCNT(j)]); sum += c; cnt += (c > 0u) ? 1u : 0u; mine = (j == x) ? c : mine; }
        if (sum == G) break;
        __builtin_amdgcn_s_sleep(1);
        if ((++sp & 255u) == 0u) { if (xb_ld(&bar[XB_TMO])) break; if (sp > XB_SPIN_CAP) { atomicAdd(&bar[XB_TMO], 1u); break; } }
    }
    nloc = mine > 0u ? mine : 1u; nx = cnt > 0u ? cnt : 1u;
}
__device__ __forceinline__ void xcd_barrier(const XcdBarrier& b) {
    asm volatile("s_waitcnt vmcnt(0)" ::: "memory");
    __syncthreads();
    if (threadIdx.x == 0) {
        unsigned* bar = b.bar;
        __builtin_amdgcn_s_waitcnt(0);
        unsigned nloc = b.st[0], nx = b.st[1];
        if (nloc == 0u) { xcd_barrier_complete(bar, b.x, nloc, nx); b.st[0] = nloc; b.st[1] = nx; }
        const unsigned old = xb_add(&bar[XB_XSUB(b.x)], 1u);
        const unsigned gen = old / nloc;
        if (old + 1u == (gen + 1u) * nloc) {
            __builtin_amdgcn_fence(__ATOMIC_RELEASE, "agent");
            asm volatile("s_waitcnt vmcnt(0)" ::: "memory");
            const unsigned og = xb_add(&bar[XB_TOP], 1u);
            const unsigned tg = og / nx;
            if (og + 1u == (tg + 1u) * nx) xb_add(&bar[XB_TOPGEN], 1u);
            else XB_SPIN(xb_ld(&bar[XB_TOPGEN]) == tg, bar);
            __builtin_amdgcn_fence(__ATOMIC_ACQUIRE, "agent");
            xb_add(&bar[XB_XGEN(b.x)], 1u);
            asm volatile("s_waitcnt vmcnt(0)" ::: "memory");
        } else {
            XB_SPIN(xb_ld(&bar[XB_XGEN(b.x)]) == gen, bar);
            __builtin_amdgcn_fence(__ATOMIC_ACQUIRE, "agent");
            asm volatile("s_waitcnt vmcnt(0)" ::: "memory");
        }
    }
    __syncthreads();
}

constexpr int NPHASE = 14;
constexpr int LDS_BYTES = 131072 + 16;
__global__ void __launch_bounds__(512, 2) mk_fwd(Params p, int ph_lo, int ph_hi) {
    extern __shared__ __attribute__((aligned(16))) unsigned char shm[];
    LAS unsigned char* lds = (LAS unsigned char*)shm;
    cg::grid_group grid = cg::this_grid();
    if (threadIdx.x == 0) { *(LAS u32x4*)(lds + 131072) = (u32x4){0u, 0u, 0u, 0u}; }
    __syncthreads();
    const XcdBarrier xb = xcd_barrier_post((unsigned*)(p.ws + WS_BAR), (volatile LAS unsigned*)(lds + 131072));
    for (int ph2 = ph_lo * 2; ph2 < ph_hi * 2; ++ph2) {
        const int ph = ph2 >> 1; const bool dry = !(ph2 & 1);
        if (dry && !((REP_MASK >> ph) & 1)) continue;
        int tid = threadIdx.x; asm volatile("" : "+v"(tid));
        if (ph == 0) {
            convert_set0(p, lds, tid);
            bf16_t* wt = (bf16_t*)(p.ws + WS_WRG);
            for (int o = blockIdx.x * 512 + tid; o < 2 * 65536; o += gridDim.x * 512) { const int g = o >> 16, h = (o >> 12) & 15, j = (o >> 6) & 63, i = o & 63;
                wt[o] = f2bf((g ? p.in[20] : p.in[18])[(size_t)(h * 64 + i) * 64 + j]); }
            norm_phase(p, 0, tid, dry, 0);
        } else if (ph == 1 || ph == 11) {
            pg8::Gemm g{(const bf16_t*)(p.ws + WS_H), (const bf16_t*)(p.ws + WS_WGU), M, 2 * DFF, D, 0, 0};
            pg8::StaticOrder S; S.init(M, 2 * DFF, D, gridDim.x, blockIdx.x);
            pg8::EpiGU E{(bf16_t*)(p.ws + WS_ACT), dry};
            pg8::gemm_phase(lds, g, S, E);
        } else if (ph == 2 || ph == 12 || ph == 9 || ph == 7) {
            const bool dn = (ph == 2 || ph == 12), oab = (ph == 7);
            pg8::Gemm g{dn ? (const bf16_t*)(p.ws + WS_ACT) : (oab ? (const bf16_t*)(p.ws + WS_U) : (const bf16_t*)p.out), (const bf16_t*)(p.ws + (dn ? WS_WD : (oab ? WS_WOAB : WS_WO))), M, D, dn ? DFF : D, SB, (size_t)1024 * 1024 * 2};
            pg8::SplitOrder S; S.init(oab ? 2 * D : D, dn ? DFF : D, gridDim.x, blockIdx.x, dn ? 11 : 4, 4);
            pg8::EpiBF E{(bf16_t*)(p.ws + (oab ? WS_U + 2 * SB : WS_Y)), SLOT, (float*)(p.ws + (oab ? WS_POAB : WS_PY)), oab ? 2 : 1};
            pg8::gemm_phase(lds, g, S, E);
        } else if (ph == 3) {
            norm_phase(p, 1, tid, dry, 11);
        } else if (ph == 4) {
            pg8::Gemm g{(const bf16_t*)(p.ws + WS_H), (const bf16_t*)(p.ws + WS_WIN), M, DIN, D, 0, 0};
            pg8::StaticOrder S; S.init(M, DIN, D, gridDim.x, blockIdx.x);
            pg8::EpiIN E{(bf16_t*)(p.ws + WS_U)};
            pg8::gemm_phase(lds, g, S, E);
        } else if (ph == 5) {
            scan_phase(p, lds, tid, dry);
        } else if (ph == 6) {
            if (!dry) sample_phase(p, lds, tid);
            fix_phase(p, lds, tid, dry);
            za_phase(p, tid, dry);
        } else if (ph == 8) {
            merge_phase(p, tid);
        } else if (ph == 10) {
            convert_set1(p, lds, tid);
            norm_phase(p, 2, tid, dry, 4);
        } else if (ph == 13) {
            norm_phase(p, 3, tid, dry, 11);
        }
        if (ph2 + 1 < ph_hi * 2) { if (ph_hi > NPHASE) grid.sync(); else xcd_barrier(xb); }
    }
}

extern "C" void kernel_launch(void* const* d_in, const int* in_sizes, int n_in, void* d_out, int out_size, void* d_ws, size_t ws_size, hipStream_t stream) {
    if (n_in != 30 || ws_size < WS_END) { fprintf(stderr, "kernel_launch: unexpected n_in %d / ws_size %zu (need %zu)\n", n_in, ws_size, (size_t)WS_END); return; }
    Params p{};
    for (int i = 0; i < 30; ++i) p.in[i] = (const float*)d_in[i];
    p.out = (float*)d_out; p.ws = (unsigned char*)d_ws;
    (void)hipFuncSetAttribute((const void*)mk_fwd, hipFuncAttributeMaxDynamicSharedMemorySize, LDS_BYTES);
    static int grid_blocks = 0;
    if (!grid_blocks) {
        int dev = 0, cus = 0, per_cu = 0;
        (void)hipGetDevice(&dev);
        (void)hipDeviceGetAttribute(&cus, hipDeviceAttributeMultiprocessorCount, dev);
        (void)hipOccupancyMaxActiveBlocksPerMultiprocessor(&per_cu, (const void*)mk_fwd, 512, LDS_BYTES);
        if (per_cu < 1) { fprintf(stderr, "kernel_launch: occupancy query says %d blocks/CU\n", per_cu); per_cu = 1; }
        grid_blocks = cus;
    }
    (void)hipMemsetAsync((unsigned char*)d_ws + WS_BAR, 0, 16384, stream);
#if SINGLE_LAUNCH
    int lo = 0, hi = NPHASE;
    void* args[] = {&p, &lo, &hi};
    hipError_t e = hipLaunchCooperativeKernel((const void*)mk_fwd, dim3(grid_blocks), dim3(512), args, LDS_BYTES, stream);
    if (e != hipSuccess) fprintf(stderr, "cooperative launch failed: %s (grid %d)\n", hipGetErrorString(e), grid_blocks);
#else
    for (int ph = 0; ph < NPHASE; ++ph) hipLaunchKernelGGL(mk_fwd, dim3(grid_blocks), dim3(512), LDS_BYTES, stream, p, ph, ph + 1);
#endif
}
```

```cpp
#include <hip/hip_runtime.h>
#include <hip/hip_cooperative_groups.h>
#include <cstdio>
namespace cg = cooperative_groups;

#ifndef REP_MASK
#define REP_MASK 0
#endif
#ifndef SINGLE_LAUNCH
#define SINGLE_LAUNCH 1
#endif

#define LAS __attribute__((address_space(3)))
typedef unsigned short bf16_t;
typedef short bf16x8 __attribute__((ext_vector_type(8)));
typedef float f32x4 __attribute__((ext_vector_type(4)));
typedef unsigned u32x4 __attribute__((ext_vector_type(4)));
typedef unsigned u32x2 __attribute__((ext_vector_type(2)));

constexpr int D = 1024, DFF = 2816, DIN = 7168;
constexpr int NB = 8, SEQ = 2048, NMETA = 16, TP = SEQ + NMETA;
constexpr int MP = NB * TP;
constexpr int NS = 128;
constexpr int M = MP + NS;
constexpr int CHUNK = 48, NCH = TP / CHUNK;
constexpr float EPS = 1e-6f;

constexpr size_t O_YP = 0, O_YS = 16777216, O_CAP = O_YS + 131072, O_CBP = O_CAP + 16384, O_RGP = O_CBP + 24576,
                 O_CAS = O_RGP + 8192, O_CBS = O_CAS + 262144, O_RGS = O_CBS + 393216;

constexpr size_t SLOT = (size_t)M * D;
constexpr size_t SB = SLOT * 2;
constexpr size_t WS_U = 0;
constexpr size_t WS_ACT = 0;
constexpr size_t WS_Y = 3 * SB;
constexpr size_t WS_PY = 4 * SB;
constexpr int MAINR = 64 * 256;
constexpr size_t WS_WGU = 5 * SB;
constexpr size_t WS_WD = WS_WGU + (size_t)5632 * 1024 * 2;
constexpr size_t WS_H = 6 * SB;
constexpr size_t WS_WIN = 7 * SB;
constexpr size_t WS_POAB = WS_WIN;
constexpr size_t WS_WOAB = WS_WIN + (size_t)7168 * 1024 * 2;
constexpr size_t WS_WO = WS_WOAB + (size_t)2 * 1024 * 1024 * 2;
constexpr size_t WS_WRG = WS_WO + (size_t)1024 * 1024 * 2;
constexpr size_t WS_SUMM = WS_WRG + (size_t)2 * 16 * 64 * 64 * 2;
constexpr size_t WS_SC = WS_SUMM + (size_t)NB * NCH * D * 2 * 4;
constexpr size_t WS_BAR = WS_SC + 131072;
constexpr size_t WS_END = WS_BAR + 16384;
static_assert(WS_END <= (size_t)256 * 1024 * 1024, "workspace");

struct Params { const float* in[30]; float* out; unsigned char* ws; };

__device__ __forceinline__ unsigned cvt_pk_bf16(float lo, float hi) { unsigned r; asm volatile("v_cvt_pk_bf16_f32 %0, %1, %2" : "=v"(r) : "v"(lo), "v"(hi)); return r; }
__device__ __forceinline__ bf16_t f2bf(float f) { return (bf16_t)(cvt_pk_bf16(f, 0.f) & 0xffffu); }
__device__ __forceinline__ float bf2f(bf16_t b) { return __uint_as_float(((unsigned)b) << 16); }
__device__ __forceinline__ float bflo(unsigned w) { return __uint_as_float(w << 16); }
__device__ __forceinline__ float bfhi(unsigned w) { return __uint_as_float(w & 0xffff0000u); }
__device__ __forceinline__ float sigm(float x) { return __builtin_amdgcn_rcpf(1.0f + __expf(-x)); }
__device__ __forceinline__ float gelu_tanh(float x) { const float t = 1.5957691216057308f * (x + 0.044715f * x * x * x); return x * sigm(t); }
__device__ __forceinline__ float wave_sum(float v, int lane) {
#pragma unroll
    for (int o = 32; o >= 1; o >>= 1) v += __int_as_float(__builtin_amdgcn_ds_bpermute((lane ^ o) << 2, __float_as_int(v)));
    return v;
}
__device__ __forceinline__ const float* x0row(const Params& p, int r) {
    if (r >= MP) return p.in[1] + (size_t)(r - MP) * D;
    const int b = r / TP, t = r - b * TP;
    if (t < NMETA) return p.in[5] + (size_t)t * D;
    return p.in[0] + ((size_t)b * SEQ + (t - NMETA)) * D;
}

namespace pg8 {
constexpr int BM = 256, BK = 64, HALF = 128, HTB = HALF * BK * 2, STAGE_BYTES = 8 * HTB, NXCD = 8, WGM = 8;
__host__ __device__ __forceinline__ int lds_byte(int r, int c) { const int st = (r >> 4) * 2 + (c >> 5), rr = r & 15, cc = c & 31, ob = rr * 64 + cc * 2; return st * 1024 + (ob ^ (((ob >> 9) & 1) << 5)); }
__host__ __device__ __forceinline__ void stage_rc(int b, int& R, int& C) { const int st = b / 1024, sb = b % 1024, swz = sb ^ (((sb >> 9) & 1) << 5); R = (st >> 1) * 16 + swz / 64; C = (st & 1) * 32 + (swz % 64) / 2; }
__host__ __device__ __forceinline__ int perm32(int rho) { const int n = rho >> 4, i = rho & 15; return 8 * (i >> 2) + 4 * n + (i & 3); }

struct Unit { int pm, pn, z, k0, nk, part; };
struct Gemm { const bf16_t* A; const bf16_t* Bt; int M, N, K; size_t zA, zB; };

struct StaticOrder {
    int nM, nN, nwg, G, c, ntf;
    __device__ void init(int M_, int N_, int K_, int G_, int c_) { nM = M_ / BM; nN = N_ / BM; nwg = nM * nN; G = G_; c = c_; ntf = K_ / BK; }
    __device__ bool map(long L, Unit& u) const {
        if (L >= nwg) return false;
        int wgid = (int)L; { const int q = nwg / NXCD, r = nwg % NXCD, xcd = wgid % NXCD, off = wgid / NXCD; wgid = (xcd < r ? xcd * (q + 1) : r * (q + 1) + (xcd - r) * q) + off; }
        const int nig = WGM * nN, gid = wgid / nig, fm = gid * WGM, gsz = (nM - fm) < WGM ? (nM - fm) : WGM;
        u.pm = fm + ((wgid % nig) % gsz); u.pn = (wgid % nig) / gsz; u.z = 0; u.k0 = 0; u.nk = ntf; u.part = -1; return true;
    }
    __device__ bool next(int i, Unit& u) const { return map((long)i * G + c, u); }
};
struct SplitOrder : StaticOrder {
    int nsplit, nkm;
    __device__ void init(int N_, int K_, int G_, int c_, int nsplit_, int nkm_) { StaticOrder::init(64 * BM, N_, K_, G_, c_); nsplit = nsplit_; nkm = nkm_; }
    __device__ bool next(int i, Unit& u) const {
        const long L = (long)i * G + c; bool ok;
        if (L < nwg) ok = map(L, u);
        else { const int L2 = (int)(L - nwg); ok = L2 < nN * nsplit; const int ks = L2 / nN; u.pm = 64; u.pn = L2 - ks * nN; u.k0 = ks * nkm; u.nk = nkm; u.part = ks; }
        u.z = u.pn >> 2; u.pn &= 3; return ok;
    }
};

template <class Epi, class Sched>
__device__ __forceinline__ void gemm_phase(LAS unsigned char* lds, const Gemm g, const Sched& S, const Epi& E) {
    int tid_ = threadIdx.x; asm volatile("" : "+v"(tid_));
    const int tid = tid_, wid = __builtin_amdgcn_readfirstlane(tid >> 6), lane = tid & 63, wr = wid >> 2, wc = wid & 3, fr = lane & 15, fq = lane >> 4;
    const int K = g.K;
    unsigned voffA[2], voffB[2];
#pragma unroll
    for (int i = 0; i < 2; ++i) { int R, C; stage_rc(tid * 16 + i * 8192, R, C); const int Rb = Epi::PERM ? ((R & ~31) + perm32(R & 31)) : R;
        voffA[i] = (unsigned)(R * K + C) * 2u; voffB[i] = (unsigned)(Rb * K + C) * 2u; }
    const size_t kstep = (size_t)(BK * 2);
    const size_t hstep = (size_t)HALF * K * 2;
    const size_t tstep = 2 * hstep;
    const unsigned ldsw = (unsigned)wid * 1024u;
    const int aoff = lds_byte(wr * 64 + fr, fq * 8), boff = lds_byte(wc * 32 + fr, fq * 8);
#define PG8_SA(b, h) (((b) * 2 + (h)) * HTB)
#define PG8_SB(b, h) ((4 + (b) * 2 + (h)) * HTB)
#define PG8_STAGE(bufoff, gbase, voff) do { _Pragma("unroll") for (int _i = 0; _i < 2; ++_i) \
        __builtin_amdgcn_global_load_lds((const unsigned*)((const char*)(gbase) + (voff)[_i]), (LAS unsigned*)(lds + (bufoff) + ldsw + _i * 8192), 16, 0, 0); } while (0)
#define PG8_LDA(dst, b, h) do { _Pragma("unroll") for (int m = 0; m < 4; ++m) _Pragma("unroll") for (int k = 0; k < 2; ++k) dst[m][k] = *(const LAS bf16x8*)(lds + PG8_SA(b, h) + aoff + m * 2048 + k * 1024); } while (0)
#define PG8_LDB(dst, b, h) do { _Pragma("unroll") for (int n = 0; n < 2; ++n) _Pragma("unroll") for (int k = 0; k < 2; ++k) dst[n][k] = *(const LAS bf16x8*)(lds + PG8_SB(b, h) + boff + n * 2048 + k * 1024); } while (0)
#define PG8_MMA(ai, bj, At, Bt) do { __builtin_amdgcn_s_setprio(1); _Pragma("unroll") for (int m = 0; m < 4; ++m) _Pragma("unroll") for (int n = 0; n < 2; ++n) _Pragma("unroll") for (int k = 0; k < 2; ++k) \
        acc[ai][bj][m][n] = __builtin_amdgcn_mfma_f32_16x16x32_bf16(Bt[n][k], At[m][k], acc[ai][bj][m][n], 0, 0, 0); __builtin_amdgcn_s_setprio(0); } while (0)
#define PG8_WAIT_V(n) asm volatile("s_waitcnt vmcnt(" #n ")" ::: "memory")
#define PG8_WAIT_L(n) asm volatile("s_waitcnt lgkmcnt(" #n ")" ::: "memory")
#define PG8_BAR __builtin_amdgcn_s_barrier()
#define PG8_SCHED __builtin_amdgcn_sched_barrier(0)
    Unit cur, nxt; int ui = 0;
    if (!S.next(0, cur)) return;
    f32x4 acc[2][2][4][2];
#pragma unroll
    for (int a = 0; a < 2; ++a)
#pragma unroll
        for (int b = 0; b < 2; ++b)
#pragma unroll
            for (int m = 0; m < 4; ++m)
#pragma unroll
                for (int n = 0; n < 2; ++n) acc[a][b][m][n] = (f32x4){0.f, 0.f, 0.f, 0.f};
    bf16x8 At[4][2], B0[2][2], B1[2][2];
    const char* cA = (const char*)g.A + (size_t)cur.z * g.zA + (size_t)cur.pm * tstep + (size_t)cur.k0 * kstep; const char* cB = (const char*)g.Bt + (size_t)cur.z * g.zB + (size_t)cur.pn * tstep + (size_t)cur.k0 * kstep;
    int nt = cur.nk;
    PG8_STAGE(PG8_SB(0, 0), cB, voffB); PG8_STAGE(PG8_SA(0, 0), cA, voffA); PG8_STAGE(PG8_SB(0, 1), cB + hstep, voffB); PG8_STAGE(PG8_SA(0, 1), cA + hstep, voffA);
    if (wr == 1) PG8_BAR;
    PG8_WAIT_V(4); PG8_BAR;
    PG8_STAGE(PG8_SB(1, 0), cB + kstep, voffB); PG8_STAGE(PG8_SA(1, 0), cA + kstep, voffA); PG8_STAGE(PG8_SB(1, 1), cB + hstep + kstep, voffB);
    PG8_WAIT_V(6); PG8_BAR;
    for (;;) {
        const bool has_next = S.next(ui + 1, nxt);
        const char* nA = has_next ? (const char*)g.A + (size_t)nxt.z * g.zA + (size_t)nxt.pm * tstep + (size_t)nxt.k0 * kstep : cA; const char* nB = has_next ? (const char*)g.Bt + (size_t)nxt.z * g.zB + (size_t)nxt.pn * tstep + (size_t)nxt.k0 * kstep : cB;
        for (int t = 0; t < nt; t += 2) {
            const bool last = (t == nt - 2);
            const char* a1 = cA + (size_t)(t + 1) * kstep;
            const char* a2 = last ? nA : cA + (size_t)(t + 2) * kstep; const char* b2 = last ? nB : cB + (size_t)(t + 2) * kstep;
            const char* a3 = a2 + kstep; const char* b3 = b2 + kstep;
            PG8_LDB(B0, 0, 0); PG8_SCHED; PG8_LDA(At, 0, 0); PG8_STAGE(PG8_SA(1, 1), a1 + hstep, voffA);
            PG8_WAIT_L(8); PG8_BAR; PG8_WAIT_L(0); PG8_MMA(0, 0, At, B0); PG8_BAR; PG8_SCHED;
            PG8_LDB(B1, 0, 1); PG8_STAGE(PG8_SB(0, 0), b2, voffB);
            PG8_BAR; PG8_WAIT_L(0); PG8_MMA(0, 1, At, B1); PG8_BAR;
            PG8_LDA(At, 0, 1); PG8_STAGE(PG8_SA(0, 0), a2, voffA);
            PG8_BAR; PG8_WAIT_L(0); PG8_MMA(1, 0, At, B0); PG8_BAR; PG8_SCHED;
            PG8_STAGE(PG8_SB(0, 1), b2 + hstep, voffB);
            PG8_WAIT_V(6); PG8_BAR; PG8_MMA(1, 1, At, B1); PG8_BAR;
            PG8_LDB(B0, 1, 0); PG8_SCHED; PG8_LDA(At, 1, 0); PG8_STAGE(PG8_SA(0, 1), a2 + hstep, voffA);
            PG8_WAIT_L(8); PG8_BAR; PG8_WAIT_L(0); PG8_MMA(0, 0, At, B0); PG8_BAR; PG8_SCHED;
            PG8_LDB(B1, 1, 1); PG8_STAGE(PG8_SB(1, 0), b3, voffB);
            PG8_BAR; PG8_WAIT_L(0); PG8_MMA(0, 1, At, B1); PG8_BAR;
            PG8_LDA(At, 1, 1); PG8_STAGE(PG8_SA(1, 0), a3, voffA);
            PG8_BAR; PG8_WAIT_L(0); PG8_MMA(1, 0, At, B0); PG8_BAR; PG8_SCHED;
            PG8_STAGE(PG8_SB(1, 1), b3 + hstep, voffB);
            PG8_WAIT_V(6); PG8_BAR; PG8_MMA(1, 1, At, B1); PG8_BAR;
        }
        E(acc, cur, wr, wc, fr, fq);
        if (!has_next) break;
#pragma unroll
        for (int a = 0; a < 2; ++a)
#pragma unroll
            for (int b = 0; b < 2; ++b)
#pragma unroll
                for (int m = 0; m < 4; ++m)
#pragma unroll
                    for (int n = 0; n < 2; ++n) acc[a][b][m][n] = (f32x4){0.f, 0.f, 0.f, 0.f};
        cur = nxt; cA = nA; cB = nB; nt = cur.nk; ++ui;
    }
    PG8_WAIT_V(0);
    if (wr == 0) PG8_BAR;
    PG8_BAR;
#undef PG8_SA
#undef PG8_SB
#undef PG8_STAGE
#undef PG8_LDA
#undef PG8_LDB
#undef PG8_MMA
#undef PG8_WAIT_V
#undef PG8_WAIT_L
#undef PG8_BAR
#undef PG8_SCHED
}

struct EpiBF {
    static constexpr bool PERM = true;
    bf16_t* O; size_t zO; float* P; int nz;
    __device__ __forceinline__ void operator()(const f32x4 (&acc)[2][2][4][2], const Unit& u, int wr, int wc, int fr, int fq) const {
        const int col0 = u.pn * BM + wc * 32 + 8 * fq;
        if (u.part < 0) {
            const int row0 = u.pm * BM + wr * 64 + fr; bf16_t* base = O + (size_t)u.z * zO;
#pragma unroll
            for (int ai = 0; ai < 2; ++ai)
#pragma unroll
                for (int m = 0; m < 4; ++m) { bf16_t* rowp = base + (size_t)(row0 + ai * HALF + m * 16) * D + col0;
#pragma unroll
                    for (int bj = 0; bj < 2; ++bj) { const f32x4 v0 = acc[ai][bj][m][0], v1 = acc[ai][bj][m][1];
                        u32x4 w; w.x = cvt_pk_bf16(v0[0], v0[1]); w.y = cvt_pk_bf16(v0[2], v0[3]); w.z = cvt_pk_bf16(v1[0], v1[1]); w.w = cvt_pk_bf16(v1[2], v1[3]);
                        *(u32x4*)(rowp + bj * HALF) = w; } }
        } else {
            const int row0 = wr * 64 + fr; float* base = P + (size_t)(u.part * nz + u.z) * (BM * D);
#pragma unroll
            for (int ai = 0; ai < 2; ++ai)
#pragma unroll
                for (int m = 0; m < 4; ++m) { float* rowp = base + (size_t)(row0 + ai * HALF + m * 16) * D + col0;
#pragma unroll
                    for (int bj = 0; bj < 2; ++bj) { *(f32x4*)(rowp + bj * HALF) = acc[ai][bj][m][0]; *(f32x4*)(rowp + bj * HALF + 4) = acc[ai][bj][m][1]; } }
        }
    }
};
struct EpiGU {
    static constexpr bool PERM = true;
    bf16_t* O; bool dry;
    __device__ __forceinline__ void operator()(const f32x4 (&acc)[2][2][4][2], const Unit& u, int wr, int wc, int fr, int fq) const {
        if (dry) return;
        const int row0 = u.pm * BM + wr * 64 + fr, col0 = u.pn * HALF + wc * 32 + 8 * fq;
#pragma unroll
        for (int ai = 0; ai < 2; ++ai)
#pragma unroll
            for (int m = 0; m < 4; ++m) { bf16_t* rowp = O + (size_t)(row0 + ai * HALF + m * 16) * DFF + col0;
                float v[8];
#pragma unroll
                for (int n = 0; n < 2; ++n)
#pragma unroll
                    for (int j = 0; j < 4; ++j) { const float gt = acc[ai][0][m][n][j], up = acc[ai][1][m][n][j]; v[n * 4 + j] = gt * sigm(gt) * up; }
                u32x4 w; w.x = cvt_pk_bf16(v[0], v[1]); w.y = cvt_pk_bf16(v[2], v[3]); w.z = cvt_pk_bf16(v[4], v[5]); w.w = cvt_pk_bf16(v[6], v[7]);
                *(u32x4*)rowp = w; }
    }
};
struct EpiIN {
    static constexpr bool PERM = true;
    bf16_t* U;
    __device__ __forceinline__ void operator()(const f32x4 (&acc)[2][2][4][2], const Unit& u, int wr, int wc, int fr, int fq) const {
        const int row0 = u.pm * BM + wr * 64 + fr;
        if (u.pn >= 4 && u.pn < 12) {
            const int col0 = (u.pn - 4) * HALF + wc * 32 + 8 * fq; bf16_t* base = U + 2 * SLOT;
#pragma unroll
            for (int ai = 0; ai < 2; ++ai)
#pragma unroll
                for (int m = 0; m < 4; ++m) { bf16_t* rowp = base + (size_t)(row0 + ai * HALF + m * 16) * D + col0;
                    const f32x4 v0 = acc[ai][0][m][0] * acc[ai][1][m][0], v1 = acc[ai][0][m][1] * acc[ai][1][m][1];
                    u32x4 w; w.x = cvt_pk_bf16(v0[0], v0[1]); w.y = cvt_pk_bf16(v0[2], v0[3]); w.z = cvt_pk_bf16(v1[0], v1[1]); w.w = cvt_pk_bf16(v1[2], v1[3]);
                    *(u32x4*)rowp = w; }
        } else {
            int slot, ct; if (u.pn < 4) { slot = 0; ct = u.pn; } else { const int sg = (u.pn - 12) >> 2; slot = sg == 0 ? 3 : (sg == 1 ? 1 : sg + 2); ct = (u.pn - 12) & 3; }
            const int col0 = ct * BM + wc * 32 + 8 * fq; bf16_t* base = U + (size_t)slot * SLOT;
#pragma unroll
            for (int ai = 0; ai < 2; ++ai)
#pragma unroll
                for (int m = 0; m < 4; ++m) { bf16_t* rowp = base + (size_t)(row0 + ai * HALF + m * 16) * D + col0;
#pragma unroll
                    for (int bj = 0; bj < 2; ++bj) { const f32x4 v0 = acc[ai][bj][m][0], v1 = acc[ai][bj][m][1];
                        u32x4 w; w.x = cvt_pk_bf16(v0[0], v0[1]); w.y = cvt_pk_bf16(v0[2], v0[3]); w.z = cvt_pk_bf16(v1[0], v1[1]); w.w = cvt_pk_bf16(v1[2], v1[3]);
                        *(u32x4*)(rowp + bj * HALF) = w; } }
        }
    }
};
}

__device__ __forceinline__ int conv_map(int mode, int n) {
    if (mode == 0) return n;
    if (mode == 1) return 256 * (n >> 7) + (n & 127);
    if (mode == 2) return 256 * (n >> 7) + 128 + (n & 127);
    const int seg = n >> 10, j = n & 1023;
    if (seg == 0) return j;
    if (seg == 1) return 1024 + 256 * (j >> 7) + (j & 127);
    if (seg == 2) return 1024 + 256 * (j >> 7) + 128 + (j & 127);
    return 3072 + (seg - 3) * 1024 + j;
}
struct ConvE { const float* src; bf16_t* dst; const float* gk; int K, N, mode, t; };
__device__ __forceinline__ bool conv_decode(const Params& p, int set, int T, ConvE& e) {
    if (set < 2) {
        const int a = set ? 27 : 8; const float* gk = p.in[set ? 25 : 6];
        if (T < 704)       { e.src = p.in[a];     e.dst = (bf16_t*)(p.ws + WS_WGU); e.gk = gk;      e.K = 1024; e.N = 2816; e.mode = 1; e.t = T; }
        else if (T < 1408) { e.src = p.in[a + 1]; e.dst = (bf16_t*)(p.ws + WS_WGU); e.gk = gk;      e.K = 1024; e.N = 2816; e.mode = 2; e.t = T - 704; }
        else if (T < 2112) { e.src = p.in[a + 2]; e.dst = (bf16_t*)(p.ws + WS_WD);  e.gk = nullptr; e.K = 2816; e.N = 1024; e.mode = 0; e.t = T - 1408; }
        else return false;
    } else {
        if (T < 1792)      { e.src = p.in[13]; e.dst = (bf16_t*)(p.ws + WS_WIN); e.gk = p.in[11]; e.K = 1024; e.N = 7168; e.mode = 3; e.t = T; }
        else if (T < 2048) { e.src = p.in[15]; e.dst = (bf16_t*)(p.ws + WS_WOAB); e.gk = nullptr; e.K = 1024; e.N = 1024; e.mode = 0; e.t = T - 1792; }
        else if (T < 2304) { e.src = p.in[23]; e.dst = (bf16_t*)(p.ws + WS_WOAB + (size_t)1024 * 1024 * 2); e.gk = nullptr; e.K = 1024; e.N = 1024; e.mode = 0; e.t = T - 2048; }
        else if (T < 2560) { e.src = p.in[24]; e.dst = (bf16_t*)(p.ws + WS_WO);  e.gk = nullptr;  e.K = 1024; e.N = 1024; e.mode = 0; e.t = T - 2304; }
        else return false;
    }
    return true;
}
__device__ __forceinline__ void conv_load(const ConvE& e, int tid, f32x4& v0, f32x4& v1) {
    const int ntn = e.N >> 6; const int tk = e.t / ntn, tn = e.t - tk * ntn;
    const float* s0 = e.src + (size_t)(tk * 64 + (tid >> 4)) * e.N + tn * 64 + (tid & 15) * 4;
    v0 = *(const f32x4*)s0; v1 = *(const f32x4*)(s0 + (size_t)32 * e.N);
}
__device__ __forceinline__ void conv_emit(const ConvE& e, int tid, const f32x4& v0, const f32x4& v1, LAS float* sl) {
    const int ntn = e.N >> 6; const int tk = e.t / ntn, tn = e.t - tk * ntn; const int k0 = tk * 64, n0 = tn * 64;
    { LAS float* d = sl + (tid >> 4) * 65 + (tid & 15) * 4; d[0] = v0[0]; d[1] = v0[1]; d[2] = v0[2]; d[3] = v0[3]; d += 32 * 65; d[0] = v1[0]; d[1] = v1[1]; d[2] = v1[2]; d[3] = v1[3]; }
    __syncthreads();
    const int n = tid >> 3, ko = (tid & 7) * 8;
    float f[8];
#pragma unroll
    for (int i = 0; i < 8; ++i) f[i] = sl[(ko + i) * 65 + n];
    if (e.gk) {
        const f32x4 g0 = *(const f32x4*)(e.gk + k0 + ko), g1 = *(const f32x4*)(e.gk + k0 + ko + 4);
#pragma unroll
        for (int i = 0; i < 4; ++i) { f[i] *= g0[i]; f[4 + i] *= g1[i]; }
    }
    u32x4 w; w.x = cvt_pk_bf16(f[0], f[1]); w.y = cvt_pk_bf16(f[2], f[3]); w.z = cvt_pk_bf16(f[4], f[5]); w.w = cvt_pk_bf16(f[6], f[7]);
    *(u32x4*)(e.dst + (size_t)conv_map(e.mode, n0 + n) * e.K + k0 + ko) = w;
    __syncthreads();
}
__device__ __forceinline__ void convert_set(const Params& p, int set, LAS unsigned char* lds, int tid) {
    ConvE e, en; f32x4 v0, v1, n0 = {0.f, 0.f, 0.f, 0.f}, n1 = {0.f, 0.f, 0.f, 0.f};
    int T = blockIdx.x;
    bool have = conv_decode(p, set, T, e);
    if (have) conv_load(e, tid, v0, v1);
    while (have) {
        T += gridDim.x;
        const bool hn = conv_decode(p, set, T, en);
        if (hn) conv_load(en, tid, n0, n1);
        conv_emit(e, tid, v0, v1, (LAS float*)lds);
        e = en; v0 = n0; v1 = n1; have = hn;
    }
}

__device__ __forceinline__ void norm_phase(const Params& p, int mode, int tid, bool dry, int nsplit) {
    const int lane = tid & 63, gw = blockIdx.x * 8 + (tid >> 6), nw = gridDim.x * 8;
    const float* gpost = mode == 1 ? p.in[7] : (mode == 2 ? p.in[12] : p.in[26]);
    const float cc = mode == 2 ? 1.0f : 0.5f;
    const bf16_t* Yb = (const bf16_t*)(p.ws + WS_Y); const float* PY = (const float*)(p.ws + WS_PY); bf16_t* H = (bf16_t*)(p.ws + WS_H); float* SC = (float*)(p.ws + WS_SC);
    for (int r = gw; r < M; r += nw) {
        f32x4 xv[4];
        if (mode == 0) {
            const float* xin = x0row(p, r);
#pragma unroll
            for (int q = 0; q < 4; ++q) xv[q] = *(const f32x4*)(xin + lane * 4 + 256 * q);
        } else {
            const float sc = SC[r];
#pragma unroll
            for (int q = 0; q < 4; ++q) { const u32x2 w = *(const u32x2*)(H + (size_t)r * D + lane * 4 + 256 * q); xv[q] = (f32x4){bflo(w.x), bfhi(w.x), bflo(w.y), bfhi(w.y)} * sc; }
            f32x4 yv[4]; float ss = 0.f;
            if (r < MAINR) {
#pragma unroll
                for (int q = 0; q < 4; ++q) { const u32x2 w = *(const u32x2*)(Yb + (size_t)r * D + lane * 4 + 256 * q); yv[q] = (f32x4){bflo(w.x), bfhi(w.x), bflo(w.y), bfhi(w.y)}; }
            } else {
#pragma unroll
                for (int q = 0; q < 4; ++q) yv[q] = (f32x4){0.f, 0.f, 0.f, 0.f};
                for (int ks = 0; ks < nsplit; ++ks) {
#pragma unroll
                    for (int q = 0; q < 4; ++q) yv[q] += *(const f32x4*)(PY + ((size_t)ks * 256 + (r - MAINR)) * D + lane * 4 + 256 * q);
                }
            }
#pragma unroll
            for (int q = 0; q < 4; ++q) ss += yv[q][0] * yv[q][0] + yv[q][1] * yv[q][1] + yv[q][2] * yv[q][2] + yv[q][3] * yv[q][3];
            ss = wave_sum(ss, lane);
            const float rs = cc * rsqrtf(ss * (1.0f / D) + EPS);
#pragma unroll
            for (int q = 0; q < 4; ++q) xv[q] += yv[q] * rs * *(const f32x4*)(gpost + lane * 4 + 256 * q);
        }
        if (mode == 3) {
            float* xo;
            if (r >= MP) xo = p.out + O_YS + (size_t)(r - MP) * D;
            else { const int b = r / TP, t = r - b * TP; if (t < NMETA) continue; xo = p.out + O_YP + ((size_t)b * SEQ + (t - NMETA)) * D; }
#pragma unroll
            for (int q = 0; q < 4; ++q) *(f32x4*)(xo + lane * 4 + 256 * q) = xv[q];
        } else {
            float ss = 0.f;
#pragma unroll
            for (int q = 0; q < 4; ++q) ss += xv[q][0] * xv[q][0] + xv[q][1] * xv[q][1] + xv[q][2] * xv[q][2] + xv[q][3] * xv[q][3];
            ss = wave_sum(ss, lane);
            const float ms = ss * (1.0f / D) + EPS; const float rs = rsqrtf(ms);
            if (!dry) {
#pragma unroll
                for (int q = 0; q < 4; ++q) { const f32x4 hv = xv[q] * rs; u32x2 w; w.x = cvt_pk_bf16(hv[0], hv[1]); w.y = cvt_pk_bf16(hv[2], hv[3]);
                    *(u32x2*)(H + (size_t)r * D + lane * 4 + 256 * q) = w; }
                if (lane == 0) SC[r] = ms * rs;
            }
        }
    }
}

constexpr int WL_BYTES = 11264;
__device__ __forceinline__ void scan_item(const Params& p, int b, int j, int h, LAS unsigned char* wl, const LAS unsigned char* wlds, int lane, bool dry) {
    bf16_t* U = (bf16_t*)(p.ws + WS_U);
    const bf16_t* bx = U + 3 * SLOT; bf16_t* bg = U + 1 * SLOT; bf16_t* pp = (bf16_t*)p.out;
    float* summ = (float*)(p.ws + WS_SUMM);
    const int c = h * 64 + lane, fr = lane & 15, fq = lane >> 4;
    const size_t row0 = (size_t)b * TP + (size_t)j * CHUNK;
    const LAS unsigned char* wq = wlds + fr * 144 + fq * 16;
    float brv[4], biv[4], lcv[4];
#pragma unroll
    for (int nt = 0; nt < 4; ++nt) { const int ch = h * 64 + nt * 16 + fr; brv[nt] = p.in[19][ch]; biv[nt] = p.in[21][ch]; lcv[nt] = -8.0f * log1pf(expf(-p.in[22][ch])); }
    const float w0 = p.in[16][c], w1 = p.in[16][D + c], w2 = p.in[16][2 * D + c], w3 = p.in[16][3 * D + c], cbias = p.in[17][c];
    float xm3 = 0.f, xm2 = 0.f, xm1 = 0.f;
    if (j > 0) { xm3 = bf2f(bx[(row0 - 3) * D + c]); xm2 = bf2f(bx[(row0 - 2) * D + c]); xm1 = bf2f(bx[(row0 - 1) * D + c]); }
    float hh = 0.f, ap = 1.f;
    LAS unsigned short* cbT = (LAS unsigned short*)wl;
    LAS float* xu = (LAS float*)(wl + 2304);
    LAS float* aS = (LAS float*)(wl + 2304 + 4352);
    bf16_t xr[16], gr[16], xn[16];
#pragma unroll
    for (int tt = 0; tt < 16; ++tt) xr[tt] = bx[(row0 + tt) * D + c];
#pragma unroll
    for (int g = 0; g < 3; ++g) {
        const size_t r0 = row0 + (size_t)g * 16;
#pragma unroll
        for (int tt = 0; tt < 16; ++tt) gr[tt] = bg[(r0 + tt) * D + c];
        if (g < 2) {
#pragma unroll
            for (int tt = 0; tt < 16; ++tt) xn[tt] = bx[(r0 + 16 + tt) * D + c];
        }
#pragma unroll
        for (int tt = 0; tt < 16; ++tt) { const float x = bf2f(xr[tt]); const float cb = w0 * xm3 + w1 * xm2 + w2 * xm1 + w3 * x + cbias; xm3 = xm2; xm2 = xm1; xm1 = x;
            cbT[tt * 72 + lane] = f2bf(cb); xu[tt * 68 + lane] = cb; }
        __builtin_amdgcn_wave_barrier();
        const bf16x8 a0 = *(const LAS bf16x8*)(cbT + fr * 72 + fq * 8), a1 = *(const LAS bf16x8*)(cbT + fr * 72 + 32 + fq * 8);
        f32x4 accR[4], accI[4];
#pragma unroll
        for (int nt = 0; nt < 4; ++nt) {
            const bf16x8 r0w = *(const LAS bf16x8*)(wq + nt * 2304), r1w = *(const LAS bf16x8*)(wq + nt * 2304 + 64);
            const bf16x8 i0w = *(const LAS bf16x8*)(wq + 9216 + nt * 2304), i1w = *(const LAS bf16x8*)(wq + 9216 + nt * 2304 + 64);
            accR[nt] = __builtin_amdgcn_mfma_f32_16x16x32_bf16(a0, r0w, (f32x4){0.f, 0.f, 0.f, 0.f}, 0, 0, 0);
            accR[nt] = __builtin_amdgcn_mfma_f32_16x16x32_bf16(a1, r1w, accR[nt], 0, 0, 0);
            accI[nt] = __builtin_amdgcn_mfma_f32_16x16x32_bf16(a0, i0w, (f32x4){0.f, 0.f, 0.f, 0.f}, 0, 0, 0);
            accI[nt] = __builtin_amdgcn_mfma_f32_16x16x32_bf16(a1, i1w, accI[nt], 0, 0, 0);
        }
#pragma unroll
        for (int nt = 0; nt < 4; ++nt)
#pragma unroll
            for (int i = 0; i < 4; ++i) { const int idx = (fq * 4 + i) * 68 + nt * 16 + fr; const float x = xu[idx];
                const float r = sigm(accR[nt][i] + brv[nt]), ig = sigm(accI[nt][i] + biv[nt]);
                const float la = lcv[nt] * r; const float a = __expf(la);
                const float z2 = 2.0f * la;
                const float m2s = -z2 * (1.0f + z2 * (0.5f + z2 * (0.16666667f + z2 * (0.041666668f + z2 * (0.0083333338f + z2 * 0.0013888889f)))));
                const float m2 = z2 > -0.25f ? m2s : 1.0f - a * a;
                xu[idx] = __builtin_amdgcn_sqrtf(m2) * ig * x; aS[idx] = a; }
        __builtin_amdgcn_wave_barrier();
#pragma unroll
        for (int tt = 0; tt < 16; ++tt) { const float a = aS[tt * 68 + lane], uu = xu[tt * 68 + lane]; hh = a * hh + uu; ap *= a;
            const float gl = gelu_tanh(bf2f(gr[tt]));
            if (!dry) bg[(r0 + tt) * D + c] = f2bf(gl * hh);
            pp[(r0 + tt) * D + c] = f2bf(gl * ap); }
        __builtin_amdgcn_wave_barrier();
        if (g < 2) {
#pragma unroll
            for (int tt = 0; tt < 16; ++tt) xr[tt] = xn[tt];
        }
    }
    *(float2*)(summ + (((size_t)b * NCH + j) * D + c) * 2) = make_float2(ap, hh);
    if (j == NCH - 1) { p.out[O_CBP + ((size_t)b * 3 + 0) * D + c] = xm3; p.out[O_CBP + ((size_t)b * 3 + 1) * D + c] = xm2; p.out[O_CBP + ((size_t)b * 3 + 2) * D + c] = xm1; }
}
__device__ __forceinline__ void scan_phase(const Params& p, LAS unsigned char* lds, int tid, bool dry) {
    const int wid = tid >> 6, lane = tid & 63;
    LAS unsigned char* wl = lds + wid * WL_BYTES;
    LAS unsigned char* wlds = lds + 8 * WL_BYTES;
    const int h = blockIdx.x & 15;
    {
        const bf16_t* wt = (const bf16_t*)(p.ws + WS_WRG);
#pragma unroll
        for (int q = 0; q < 2; ++q) { const int e = tid + q * 512, g = e >> 9, jrow = (e >> 3) & 63, pc = e & 7;
            *(LAS u32x4*)(wlds + g * 9216 + jrow * 144 + pc * 16) = *(const u32x4*)(wt + (size_t)g * 65536 + (size_t)(h * 64 + jrow) * 64 + pc * 8); }
    }
    __syncthreads();
    const int nbh = gridDim.x >> 4;
    for (int it = (blockIdx.x >> 4) * 8 + wid; it < NB * NCH; it += nbh * 8) scan_item(p, it / NCH, it % NCH, h, wl, wlds, lane, dry);
    __syncthreads();
}
__device__ __forceinline__ void fix_phase(const Params& p, LAS unsigned char* lds, int tid, bool dry) {
    bf16_t* zb = (bf16_t*)(p.ws + WS_U) + 1 * SLOT; const bf16_t* pp = (const bf16_t*)p.out;
    const float* summ = (const float*)(p.ws + WS_SUMM);
    LAS float* cs = (LAS float*)lds;
    for (int it = blockIdx.x; it < NB * (NCH - 1); it += gridDim.x) {
        const int b = it / (NCH - 1), j = it % (NCH - 1) + 1;
#pragma unroll
        for (int cq = 0; cq < 2; ++cq) {
            const int c = tid + cq * 512; const float* sp = summ + ((size_t)b * NCH * D + c) * 2; float hh = 0.f;
            for (int i0 = 0; i0 < j; i0 += 16) {
                float va[16], vh[16];
#pragma unroll
                for (int k = 0; k < 16; ++k) { if (i0 + k < j) { const float2 v = *(const float2*)(sp + (size_t)(i0 + k) * D * 2); va[k] = v.x; vh[k] = v.y; } else { va[k] = 1.f; vh[k] = 0.f; } }
#pragma unroll
                for (int k = 0; k < 16; ++k) hh = va[k] * hh + vh[k];
            }
            cs[c] = hh;
            if (j == NCH - 1) { const float2 v = *(const float2*)(sp + (size_t)j * D * 2); p.out[O_RGP + (size_t)b * D + c] = v.x * hh + v.y; }
        }
        __syncthreads();
        const size_t row0 = (size_t)b * TP + (size_t)j * CHUNK;
#pragma unroll 4
        for (int q = 0; q < CHUNK * 128 / 512; ++q) {
            const int e = tid + q * 512, tt = e >> 7, vc = e & 127; const size_t o = (row0 + tt) * D + vc * 8;
            const u32x4 zq = *(const u32x4*)(zb + o), pq = *(const u32x4*)(pp + o);
            const f32x4 c0 = *(const LAS f32x4*)(cs + vc * 8), c1 = *(const LAS f32x4*)(cs + vc * 8 + 4);
            u32x4 w;
            w.x = cvt_pk_bf16(bflo(zq.x) + bflo(pq.x) * c0[0], bfhi(zq.x) + bfhi(pq.x) * c0[1]); w.y = cvt_pk_bf16(bflo(zq.y) + bflo(pq.y) * c0[2], bfhi(zq.y) + bfhi(pq.y) * c0[3]);
            w.z = cvt_pk_bf16(bflo(zq.z) + bflo(pq.z) * c1[0], bfhi(zq.z) + bfhi(pq.z) * c1[1]); w.w = cvt_pk_bf16(bflo(zq.w) + bflo(pq.w) * c1[2], bfhi(zq.w) + bfhi(pq.w) * c1[3]);
            if (!dry) *(u32x4*)(zb + o) = w;
        }
        __syncthreads();
    }
}
__device__ __forceinline__ void za_phase(const Params& p, int tid, bool dry) {
    bf16_t* U = (bf16_t*)(p.ws + WS_U); bf16_t* ab = U; const bf16_t* ca = U + 2 * SLOT;
    const float* cw = p.in[14];
    for (int idx = blockIdx.x * 512 + tid; idx < NB * 129 * 128; idx += gridDim.x * 512) {
        const int vc = idx & 127, tb = (idx >> 7) % 129, b = idx / (128 * 129); const int c0 = vc * 8;
        float w[3][8];
#pragma unroll
        for (int k = 0; k < 3; ++k) { const f32x4 a = *(const f32x4*)(cw + k * D + c0), bq = *(const f32x4*)(cw + k * D + c0 + 4);
#pragma unroll
            for (int e = 0; e < 4; ++e) { w[k][e] = a[e]; w[k][4 + e] = bq[e]; } }
        const size_t r0 = (size_t)b * TP + (size_t)tb * 16;
        float p2[8], p1[8];
        if (tb > 0) { const u32x4 q2 = *(const u32x4*)(ca + (r0 - 2) * D + c0), q1 = *(const u32x4*)(ca + (r0 - 1) * D + c0);
#pragma unroll
            for (int e = 0; e < 4; ++e) { p2[2 * e] = bflo(q2[e]); p2[2 * e + 1] = bfhi(q2[e]); p1[2 * e] = bflo(q1[e]); p1[2 * e + 1] = bfhi(q1[e]); } }
        else {
#pragma unroll
            for (int e = 0; e < 8; ++e) { p2[e] = 0.f; p1[e] = 0.f; } }
#pragma unroll 4
        for (int tt = 0; tt < 16; ++tt) {
            const u32x4 qc = *(const u32x4*)(ca + (r0 + tt) * D + c0), qa = *(const u32x4*)(ab + (r0 + tt) * D + c0);
            float cv[8], av[8], zv[8];
#pragma unroll
            for (int e = 0; e < 4; ++e) { cv[2 * e] = bflo(qc[e]); cv[2 * e + 1] = bfhi(qc[e]); av[2 * e] = bflo(qa[e]); av[2 * e + 1] = bfhi(qa[e]); }
#pragma unroll
            for (int e = 0; e < 8; ++e) { zv[e] = av[e] * (w[0][e] * p2[e] + w[1][e] * p1[e] + w[2][e] * cv[e]); p2[e] = p1[e]; p1[e] = cv[e]; }
            u32x4 o; o.x = cvt_pk_bf16(zv[0], zv[1]); o.y = cvt_pk_bf16(zv[2], zv[3]); o.z = cvt_pk_bf16(zv[4], zv[5]); o.w = cvt_pk_bf16(zv[6], zv[7]);
            if (!dry) *(u32x4*)(ab + (r0 + tt) * D + c0) = o;
        }
        if (tb == 128) {
            float* o2 = p.out + O_CAP + ((size_t)b * 2 + 0) * D + c0; float* o1 = p.out + O_CAP + ((size_t)b * 2 + 1) * D + c0;
            *(f32x4*)o2 = (f32x4){p2[0], p2[1], p2[2], p2[3]}; *(f32x4*)(o2 + 4) = (f32x4){p2[4], p2[5], p2[6], p2[7]};
            *(f32x4*)o1 = (f32x4){p1[0], p1[1], p1[2], p1[3]}; *(f32x4*)(o1 + 4) = (f32x4){p1[4], p1[5], p1[6], p1[7]};
        }
    }
}
__device__ __forceinline__ void sample_phase(const Params& p, LAS unsigned char* lds, int tid) {
    bf16_t* U = (bf16_t*)(p.ws + WS_U);
    LAS float* cbs = (LAS float*)lds;
    for (int s = (int)blockIdx.x - 128; s >= 0 && s < NS; s += 128) {
#pragma unroll
        for (int cq = 0; cq < 2; ++cq) {
            const int c = tid + cq * 512; const size_t ro = (size_t)(MP + s) * D + c;
            const float cav = bf2f(U[2 * SLOT + ro]), abv = bf2f(U[ro]);
            const float s0 = p.in[2][((size_t)s * 2 + 0) * D + c], s1 = p.in[2][((size_t)s * 2 + 1) * D + c];
            const float cva = p.in[14][c] * s0 + p.in[14][D + c] * s1 + p.in[14][2 * D + c] * cav;
            U[ro] = f2bf(abv * cva);
            p.out[O_CAS + ((size_t)s * 2 + 0) * D + c] = s1; p.out[O_CAS + ((size_t)s * 2 + 1) * D + c] = cav;
            const float bxv = bf2f(U[3 * SLOT + ro]);
            const float t0 = p.in[3][((size_t)s * 3 + 0) * D + c], t1 = p.in[3][((size_t)s * 3 + 1) * D + c], t2 = p.in[3][((size_t)s * 3 + 2) * D + c];
            const float cb = p.in[16][c] * t0 + p.in[16][D + c] * t1 + p.in[16][2 * D + c] * t2 + p.in[16][3 * D + c] * bxv + p.in[17][c];
            p.out[O_CBS + ((size_t)s * 3 + 0) * D + c] = t1; p.out[O_CBS + ((size_t)s * 3 + 1) * D + c] = t2; p.out[O_CBS + ((size_t)s * 3 + 2) * D + c] = bxv;
            cbs[c] = cb;
        }
        __syncthreads();
        {
            const int h = tid >> 6, jj = tid & 63;
            float ar0 = 0.f, ai0 = 0.f, ar1 = 0.f, ai1 = 0.f;
            const float* wr_ = p.in[18] + (size_t)h * 4096 + jj; const float* wi_ = p.in[20] + (size_t)h * 4096 + jj;
#pragma unroll 16
            for (int i = 0; i < 64; ++i) { const float x0 = cbs[h * 64 + i], x1 = cbs[512 + h * 64 + i];
                ar0 += x0 * wr_[i * 64]; ai0 += x0 * wi_[i * 64]; ar1 += x1 * wr_[8 * 4096 + i * 64]; ai1 += x1 * wi_[8 * 4096 + i * 64]; }
#pragma unroll
            for (int cq = 0; cq < 2; ++cq) {
                const int c = tid + cq * 512; const size_t ro = (size_t)(MP + s) * D + c;
                const float lc = -8.0f * log1pf(expf(-p.in[22][c]));
                const float r = sigm((cq ? ar1 : ar0) + p.in[19][c]), ig = sigm((cq ? ai1 : ai0) + p.in[21][c]); const float la = lc * r; const float a = expf(la); const float mult = sqrtf(-expm1f(2.0f * la));
                const float hn = a * p.in[4][(size_t)s * D + c] + mult * ig * cbs[c];
                p.out[O_RGS + (size_t)s * D + c] = hn;
                U[1 * SLOT + ro] = f2bf(gelu_tanh(bf2f(U[1 * SLOT + ro])) * hn);
            }
        }
        __syncthreads();
    }
}

__device__ __forceinline__ void merge_phase(const Params& p, int tid) {
    const bf16_t* U = (const bf16_t*)(p.ws + WS_U); bf16_t* H = (bf16_t*)p.out; const float* PO = (const float*)(p.ws + WS_POAB);
    for (size_t i = (size_t)blockIdx.x * 512 + tid; i < SLOT / 8; i += (size_t)gridDim.x * 512) {
        const u32x4 ga = *(const u32x4*)(U + 4 * SLOT + i * 8), gb = *(const u32x4*)(U + 5 * SLOT + i * 8);
        float ya[8], yb[8];
        const int row = (int)(i >> 7);
        if (row < MAINR) {
            const u32x4 a = *(const u32x4*)(U + 2 * SLOT + i * 8), b = *(const u32x4*)(U + 3 * SLOT + i * 8);
#pragma unroll
            for (int e = 0; e < 4; ++e) { ya[2 * e] = bflo(a[e]); ya[2 * e + 1] = bfhi(a[e]); yb[2 * e] = bflo(b[e]); yb[2 * e + 1] = bfhi(b[e]); }
        } else {
            const size_t o = (size_t)(row - MAINR) * D + (size_t)(i & 127) * 8;
#pragma unroll
            for (int e = 0; e < 8; ++e) { ya[e] = 0.f; yb[e] = 0.f; }
#pragma unroll
            for (int ks = 0; ks < 4; ++ks) {
                const f32x4 a0 = *(const f32x4*)(PO + (size_t)(ks * 2 + 0) * (256 * D) + o), a1 = *(const f32x4*)(PO + (size_t)(ks * 2 + 0) * (256 * D) + o + 4);
                const f32x4 b0 = *(const f32x4*)(PO + (size_t)(ks * 2 + 1) * (256 * D) + o), b1 = *(const f32x4*)(PO + (size_t)(ks * 2 + 1) * (256 * D) + o + 4);
#pragma unroll
                for (int e = 0; e < 4; ++e) { ya[e] += a0[e]; ya[4 + e] += a1[e]; yb[e] += b0[e]; yb[4 + e] += b1[e]; }
            }
        }
        u32x4 o4;
#pragma unroll
        for (int e = 0; e < 4; ++e) { const float lo = sigm(bflo(ga[e])) * ya[2 * e] + sigm(bflo(gb[e])) * yb[2 * e], hi = sigm(bfhi(ga[e])) * ya[2 * e + 1] + sigm(bfhi(gb[e])) * yb[2 * e + 1]; o4[e] = cvt_pk_bf16(lo, hi); }
        *(u32x4*)(H + i * 8) = o4;
    }
}

#define XB_TMO      128
#define XB_XCNT(j)  (256  + 64 * (j))
#define XB_XSUB(j)  (1280 + 64 * (j))
#define XB_XGEN(j)  (2304 + 64 * (j))
#define XB_TOP      3328
#define XB_TOPGEN   3392
#define XCD_BAR_WORDS 3456
#define XB_SPIN_CAP (1u << 18)
__device__ __forceinline__ unsigned xb_ld(unsigned* p)              { return __hip_atomic_load(p, __ATOMIC_RELAXED, __HIP_MEMORY_SCOPE_AGENT); }
__device__ __forceinline__ unsigned xb_add(unsigned* p, unsigned v) { return __hip_atomic_fetch_add(p, v, __ATOMIC_RELAXED, __HIP_MEMORY_SCOPE_AGENT); }
__device__ __forceinline__ unsigned xb_xcc_id() { return (unsigned)__builtin_amdgcn_s_getreg((3 << 11) | 20) & 0xFu; }
#define XB_SPIN(cond, bar) do { unsigned _sp = 0; while (cond) { __builtin_amdgcn_s_sleep(1); \
    if ((++_sp & 255u) == 0u) { if (xb_ld(&(bar)[XB_TMO])) break; if (_sp > XB_SPIN_CAP) { atomicAdd(&(bar)[XB_TMO], 1u); break; } } } } while (0)
struct XcdBarrier { unsigned* bar; unsigned x; volatile LAS unsigned* st; };
__device__ __forceinline__ XcdBarrier xcd_barrier_post(unsigned* bar, volatile LAS unsigned* st) {
    XcdBarrier b; b.bar = bar; b.x = xb_xcc_id(); b.st = st;
    if (threadIdx.x == 0) (void)xb_add(&bar[XB_XCNT(b.x)], 1u);
    return b;
}
__device__ __forceinline__ void xcd_barrier_complete(unsigned* bar, unsigned x, unsigned& nloc, unsigned& nx) {
    const unsigned G = gridDim.x * gridDim.y * gridDim.z;
    unsigned sum, cnt, mine, sp = 0u;
    for (;;) {
        sum = 0u; cnt = 0u; mine = 0u;
#pragma unroll
        for (unsigned j = 0; j < 16; ++j) { const unsigned c = xb_ld(&bar[XB_XCNT(j)]); sum += c; cnt += (c > 0u) ? 1u : 0u; mine = (j == x) ? c : mine; }
        if (sum == G) break;
        __builtin_amdgcn_s_sleep(1);
        if ((++sp & 255u) == 0u) { if (xb_ld(&bar[XB_TMO])) break; if (sp > XB_SPIN_CAP) { atomicAdd(&bar[XB_TMO], 1u); break; } }
    }
    nloc = mine > 0u ? mine : 1u; nx = cnt > 0u ? cnt : 1u;
}
__device__ __forceinline__ void xcd_barrier(const XcdBarrier& b) {
    asm volatile("s_waitcnt vmcnt(0)" ::: "memory");
    __syncthreads();
    if (threadIdx.x == 0) {
        unsigned* bar = b.bar;
        __builtin_amdgcn_s_waitcnt(0);
        unsigned nloc = b.st[0], nx = b.st[1];
        if (nloc == 0u) { xcd_barrier_complete(bar, b.x, nloc, nx); b.st[0] = nloc; b.st[1] = nx; }
        const unsigned old = xb_add(&bar[XB_XSUB(b.x)], 1u);
        const unsigned gen = old / nloc;
        if (old + 1u == (gen + 1u) * nloc) {
            __builtin_amdgcn_fence(__ATOMIC_RELEASE, "agent");
            asm volatile("s_waitcnt vmcnt(0)" ::: "memory");
            const unsigned og = xb_add(&bar[XB_TOP], 1u);
            const unsigned tg = og / nx;
            if (og + 1u == (tg + 1u) * nx) xb_add(&bar[XB_TOPGEN], 1u);
            else XB_SPIN(xb_ld(&bar[XB_TOPGEN]) == tg, bar);
            __builtin_amdgcn_fence(__ATOMIC_ACQUIRE, "agent");
            xb_add(&bar[XB_XGEN(b.x)], 1u);
            asm volatile("s_waitcnt vmcnt(0)" ::: "memory");
        } else {
            XB_SPIN(xb_ld(&bar[XB_XGEN(b.x)]) == gen, bar);
            __builtin_amdgcn_fence(__ATOMIC_ACQUIRE, "agent");
            asm volatile("s_waitcnt vmcnt(0)" ::: "memory");
        }
    }
    __syncthreads();
}

constexpr int NPHASE = 14;
constexpr int LDS_BYTES = 131072 + 16;
__global__ void __launch_bounds__(512, 2) mk_fwd(Params p, int ph_lo, int ph_hi) {
    extern __shared__ __attribute__((aligned(16))) unsigned char shm[];
    LAS unsigned char* lds = (LAS unsigned char*)shm;
    cg::grid_group grid = cg::this_grid();
    if (threadIdx.x == 0) { *(LAS u32x4*)(lds + 131072) = (u32x4){0u, 0u, 0u, 0u}; }
    __syncthreads();
    const XcdBarrier xb = xcd_barrier_post((unsigned*)(p.ws + WS_BAR), (volatile LAS unsigned*)(lds + 131072));
    for (int ph2 = ph_lo * 2; ph2 < ph_hi * 2; ++ph2) {
        const int ph = ph2 >> 1; const bool dry = !(ph2 & 1);
        if (dry && !((REP_MASK >> ph) & 1)) continue;
        int tid = threadIdx.x; asm volatile("" : "+v"(tid));
        if (ph == 0) {
            convert_set(p, 0, lds, tid);
            bf16_t* wt = (bf16_t*)(p.ws + WS_WRG);
            for (int o = blockIdx.x * 512 + tid; o < 2 * 65536; o += gridDim.x * 512) { const int g = o >> 16, h = (o >> 12) & 15, j = (o >> 6) & 63, i = o & 63;
                wt[o] = f2bf((g ? p.in[20] : p.in[18])[(size_t)(h * 64 + i) * 64 + j]); }
            norm_phase(p, 0, tid, dry, 0);
        } else if (ph == 1 || ph == 11) {
            pg8::Gemm g{(const bf16_t*)(p.ws + WS_H), (const bf16_t*)(p.ws + WS_WGU), M, 2 * DFF, D, 0, 0};
            pg8::StaticOrder S; S.init(M, 2 * DFF, D, gridDim.x, blockIdx.x);
            pg8::EpiGU E{(bf16_t*)(p.ws + WS_ACT), dry};
            pg8::gemm_phase(lds, g, S, E);
        } else if (ph == 2 || ph == 12 || ph == 9 || ph == 7) {
            const bool dn = (ph == 2 || ph == 12), oab = (ph == 7);
            pg8::Gemm g{dn ? (const bf16_t*)(p.ws + WS_ACT) : (oab ? (const bf16_t*)(p.ws + WS_U) : (const bf16_t*)p.out), (const bf16_t*)(p.ws + (dn ? WS_WD : (oab ? WS_WOAB : WS_WO))), M, D, dn ? DFF : D, SB, (size_t)1024 * 1024 * 2};
            pg8::SplitOrder S; S.init(oab ? 2 * D : D, dn ? DFF : D, gridDim.x, blockIdx.x, dn ? 11 : 4, 4);
            pg8::EpiBF E{(bf16_t*)(p.ws + (oab ? WS_U + 2 * SB : WS_Y)), SLOT, (float*)(p.ws + (oab ? WS_POAB : WS_PY)), oab ? 2 : 1};
            pg8::gemm_phase(lds, g, S, E);
            if (!dry && ph == 2) convert_set(p, 2, lds, tid);
            if (!dry && ph == 9) convert_set(p, 1, lds, tid);
        } else if (ph == 3) {
            norm_phase(p, 1, tid, dry, 11);
        } else if (ph == 4) {
            pg8::Gemm g{(const bf16_t*)(p.ws + WS_H), (const bf16_t*)(p.ws + WS_WIN), M, DIN, D, 0, 0};
            pg8::StaticOrder S; S.init(M, DIN, D, gridDim.x, blockIdx.x);
            pg8::EpiIN E{(bf16_t*)(p.ws + WS_U)};
            pg8::gemm_phase(lds, g, S, E);
        } else if (ph == 5) {
            scan_phase(p, lds, tid, dry);
        } else if (ph == 6) {
            if (!dry) sample_phase(p, lds, tid);
            fix_phase(p, lds, tid, dry);
            za_phase(p, tid, dry);
        } else if (ph == 8) {
            merge_phase(p, tid);
        } else if (ph == 10) {
            norm_phase(p, 2, tid, dry, 4);
        } else if (ph == 13) {
            norm_phase(p, 3, tid, dry, 11);
        }
        if (ph2 + 1 < ph_hi * 2) { if (ph_hi > NPHASE) grid.sync(); else xcd_barrier(xb); }
    }
}

extern "C" void kernel_launch(void* const* d_in, const int* in_sizes, int n_in, void* d_out, int out_size, void* d_ws, size_t ws_size, hipStream_t stream) {
    if (n_in != 30 || ws_size < WS_END) { fprintf(stderr, "kernel_launch: unexpected n_in %d / ws_size %zu (need %zu)\n", n_in, ws_size, (size_t)WS_END); return; }
    Params p{};
    for (int i = 0; i < 30; ++i) p.in[i] = (const float*)d_in[i];
    p.out = (float*)d_out; p.ws = (unsigned char*)d_ws;
    (void)hipFuncSetAttribute((const void*)mk_fwd, hipFuncAttributeMaxDynamicSharedMemorySize, LDS_BYTES);
    static int grid_blocks = 0;
    if (!grid_blocks) {
        int dev = 0, cus = 0, per_cu = 0;
        (void)hipGetDevice(&dev);
        (void)hipDeviceGetAttribute(&cus, hipDeviceAttributeMultiprocessorCount, dev);
        (void)hipOccupancyMaxActiveBlocksPerMultiprocessor(&per_cu, (const void*)mk_fwd, 512, LDS_BYTES);
        if (per_cu < 1) { fprintf(stderr, "kernel_launch: occupancy query says %d blocks/CU\n", per_cu); per_cu = 1; }
        grid_blocks = cus;
    }
    (void)hipMemsetAsync((unsigned char*)d_ws + WS_BAR, 0, 16384, stream);
#if SINGLE_LAUNCH
    int lo = 0, hi = NPHASE;
    void* args[] = {&p, &lo, &hi};
    hipError_t e = hipLaunchCooperativeKernel((const void*)mk_fwd, dim3(grid_blocks), dim3(512), args, LDS_BYTES, stream);
    if (e != hipSuccess) fprintf(stderr, "cooperative launch failed: %s (grid %d)\n", hipGetErrorString(e), grid_blocks);
#else
    for (int ph = 0; ph < NPHASE; ++ph) hipLaunchKernelGGL(mk_fwd, dim3(grid_blocks), dim3(512), LDS_BYTES, stream, p, ph, ph + 1);
#endif
}
```

```cpp
#include <hip/hip_runtime.h>
#include <hip/hip_cooperative_groups.h>
#include <cstdio>
namespace cg = cooperative_groups;

#ifndef REP_MASK
#define REP_MASK 0
#endif
#ifndef SINGLE_LAUNCH
#define SINGLE_LAUNCH 1
#endif

#define LAS __attribute__((address_space(3)))
typedef unsigned short bf16_t;
typedef short bf16x8 __attribute__((ext_vector_type(8)));
typedef float f32x4 __attribute__((ext_vector_type(4)));
typedef unsigned u32x4 __attribute__((ext_vector_type(4)));
typedef unsigned u32x2 __attribute__((ext_vector_type(2)));

constexpr int D = 1024, DFF = 2816, DIN = 7168;
constexpr int NB = 8, SEQ = 2048, NMETA = 16, TP = SEQ + NMETA;
constexpr int MP = NB * TP;
constexpr int NS = 128;
constexpr int M = MP + NS;
constexpr int CHUNK = 48, NCH = TP / CHUNK;
constexpr float EPS = 1e-6f;

constexpr size_t O_YP = 0, O_YS = 16777216, O_CAP = O_YS + 131072, O_CBP = O_CAP + 16384, O_RGP = O_CBP + 24576,
                 O_CAS = O_RGP + 8192, O_CBS = O_CAS + 262144, O_RGS = O_CBS + 393216;

constexpr size_t SLOT = (size_t)M * D;
constexpr size_t SB = SLOT * 2;
constexpr size_t WS_U = 0;
constexpr size_t WS_ACT = 0;
constexpr size_t WS_Y = 3 * SB;
constexpr size_t WS_PY = 4 * SB;
constexpr int MAINR = 64 * 256;
constexpr size_t WS_WGU = 5 * SB;
constexpr size_t WS_WD = WS_WGU + (size_t)5632 * 1024 * 2;
constexpr size_t WS_H = 6 * SB;
constexpr size_t WS_WIN = 7 * SB;
constexpr size_t WS_POAB = WS_WIN;
constexpr size_t WS_WOAB = WS_WIN + (size_t)7168 * 1024 * 2;
constexpr size_t WS_WO = WS_WOAB + (size_t)2 * 1024 * 1024 * 2;
constexpr size_t WS_WRG = WS_WO + (size_t)1024 * 1024 * 2;
constexpr size_t WS_SUMM = WS_WRG + (size_t)2 * 16 * 64 * 64 * 2;
constexpr size_t WS_SC = WS_SUMM + (size_t)NB * NCH * D * 2 * 4;
constexpr size_t WS_BAR = WS_SC + 131072;
constexpr size_t WS_END = WS_BAR + 16384;
static_assert(WS_END <= (size_t)256 * 1024 * 1024, "workspace");

struct Params { const float* in[30]; float* out; unsigned char* ws; };

__device__ __forceinline__ unsigned cvt_pk_bf16(float lo, float hi) { unsigned r; asm volatile("v_cvt_pk_bf16_f32 %0, %1, %2" : "=v"(r) : "v"(lo), "v"(hi)); return r; }
__device__ __forceinline__ bf16_t f2bf(float f) { return (bf16_t)(cvt_pk_bf16(f, 0.f) & 0xffffu); }
__device__ __forceinline__ float bf2f(bf16_t b) { return __uint_as_float(((unsigned)b) << 16); }
__device__ __forceinline__ float bflo(unsigned w) { return __uint_as_float(w << 16); }
__device__ __forceinline__ float bfhi(unsigned w) { return __uint_as_float(w & 0xffff0000u); }
__device__ __forceinline__ float sigm(float x) { return __builtin_amdgcn_rcpf(1.0f + __expf(-x)); }
__device__ __forceinline__ float gelu_tanh(float x) { const float t = 1.5957691216057308f * (x + 0.044715f * x * x * x); return x * sigm(t); }
__device__ __forceinline__ float wave_sum(float v, int lane) {
#pragma unroll
    for (int o = 32; o >= 1; o >>= 1) v += __int_as_float(__builtin_amdgcn_ds_bpermute((lane ^ o) << 2, __float_as_int(v)));
    return v;
}
__device__ __forceinline__ const float* x0row(const Params& p, int r) {
    if (r >= MP) return p.in[1] + (size_t)(r - MP) * D;
    const int b = r / TP, t = r - b * TP;
    if (t < NMETA) return p.in[5] + (size_t)t * D;
    return p.in[0] + ((size_t)b * SEQ + (t - NMETA)) * D;
}

namespace pg8 {
constexpr int BM = 256, BK = 64, HALF = 128, HTB = HALF * BK * 2, STAGE_BYTES = 8 * HTB, NXCD = 8, WGM = 8;
__host__ __device__ __forceinline__ int lds_byte(int r, int c) { const int st = (r >> 4) * 2 + (c >> 5), rr = r & 15, cc = c & 31, ob = rr * 64 + cc * 2; return st * 1024 + (ob ^ (((ob >> 9) & 1) << 5)); }
__host__ __device__ __forceinline__ void stage_rc(int b, int& R, int& C) { const int st = b / 1024, sb = b % 1024, swz = sb ^ (((sb >> 9) & 1) << 5); R = (st >> 1) * 16 + swz / 64; C = (st & 1) * 32 + (swz % 64) / 2; }
__host__ __device__ __forceinline__ int perm32(int rho) { const int n = rho >> 4, i = rho & 15; return 8 * (i >> 2) + 4 * n + (i & 3); }

struct Unit { int pm, pn, z, k0, nk, part; };
struct Gemm { const bf16_t* A; const bf16_t* Bt; int M, N, K; size_t zA, zB; };

struct StaticOrder {
    int nM, nN, nwg, G, c, ntf;
    __device__ void init(int M_, int N_, int K_, int G_, int c_) { nM = M_ / BM; nN = N_ / BM; nwg = nM * nN; G = G_; c = c_; ntf = K_ / BK; }
    __device__ bool map(long L, Unit& u) const {
        if (L >= nwg) return false;
        int wgid = (int)L; { const int q = nwg / NXCD, r = nwg % NXCD, xcd = wgid % NXCD, off = wgid / NXCD; wgid = (xcd < r ? xcd * (q + 1) : r * (q + 1) + (xcd - r) * q) + off; }
        const int nig = WGM * nN, gid = wgid / nig, fm = gid * WGM, gsz = (nM - fm) < WGM ? (nM - fm) : WGM;
        u.pm = fm + ((wgid % nig) % gsz); u.pn = (wgid % nig) / gsz; u.z = 0; u.k0 = 0; u.nk = ntf; u.part = -1; return true;
    }
    __device__ bool next(int i, Unit& u) const { return map((long)i * G + c, u); }
};
struct SplitOrder : StaticOrder {
    int nsplit, nkm;
    __device__ void init(int N_, int K_, int G_, int c_, int nsplit_, int nkm_) { StaticOrder::init(64 * BM, N_, K_, G_, c_); nsplit = nsplit_; nkm = nkm_; }
    __device__ bool next(int i, Unit& u) const {
        const long L = (long)i * G + c; bool ok;
        if (L < nwg) ok = map(L, u);
        else { const int L2 = (int)(L - nwg); ok = L2 < nN * nsplit; const int ks = L2 / nN; u.pm = 64; u.pn = L2 - ks * nN; u.k0 = ks * nkm; u.nk = nkm; u.part = ks; }
        u.z = u.pn >> 2; u.pn &= 3; return ok;
    }
};

template <class Epi, class Sched>
__device__ __forceinline__ void gemm_phase(LAS unsigned char* lds, const Gemm g, const Sched& S, const Epi& E) {
    int tid_ = threadIdx.x; asm volatile("" : "+v"(tid_));
    const int tid = tid_, wid = __builtin_amdgcn_readfirstlane(tid >> 6), lane = tid & 63, wr = wid >> 2, wc = wid & 3, fr = lane & 15, fq = lane >> 4;
    const int K = g.K;
    unsigned voffA[2], voffB[2];
#pragma unroll
    for (int i = 0; i < 2; ++i) { int R, C; stage_rc(tid * 16 + i * 8192, R, C); const int Rb = Epi::PERM ? ((R & ~31) + perm32(R & 31)) : R;
        voffA[i] = (unsigned)(R * K + C) * 2u; voffB[i] = (unsigned)(Rb * K + C) * 2u; }
    const size_t kstep = (size_t)(BK * 2);
    const size_t hstep = (size_t)HALF * K * 2;
    const size_t tstep = 2 * hstep;
    const unsigned ldsw = (unsigned)wid * 1024u;
    const int aoff = lds_byte(wr * 64 + fr, fq * 8), boff = lds_byte(wc * 32 + fr, fq * 8);
#define PG8_SA(b, h) (((b) * 2 + (h)) * HTB)
#define PG8_SB(b, h) ((4 + (b) * 2 + (h)) * HTB)
#define PG8_STAGE(bufoff, gbase, voff) do { _Pragma("unroll") for (int _i = 0; _i < 2; ++_i) \
        __builtin_amdgcn_global_load_lds((const unsigned*)((const char*)(gbase) + (voff)[_i]), (LAS unsigned*)(lds + (bufoff) + ldsw + _i * 8192), 16, 0, 0); } while (0)
#define PG8_LDA(dst, b, h) do { _Pragma("unroll") for (int m = 0; m < 4; ++m) _Pragma("unroll") for (int k = 0; k < 2; ++k) dst[m][k] = *(const LAS bf16x8*)(lds + PG8_SA(b, h) + aoff + m * 2048 + k * 1024); } while (0)
#define PG8_LDB(dst, b, h) do { _Pragma("unroll") for (int n = 0; n < 2; ++n) _Pragma("unroll") for (int k = 0; k < 2; ++k) dst[n][k] = *(const LAS bf16x8*)(lds + PG8_SB(b, h) + boff + n * 2048 + k * 1024); } while (0)
#define PG8_MMA(ai, bj, At, Bt) do { __builtin_amdgcn_s_setprio(1); _Pragma("unroll") for (int m = 0; m < 4; ++m) _Pragma("unroll") for (int n = 0; n < 2; ++n) _Pragma("unroll") for (int k = 0; k < 2; ++k) \
        acc[ai][bj][m][n] = __builtin_amdgcn_mfma_f32_16x16x32_bf16(Bt[n][k], At[m][k], acc[ai][bj][m][n], 0, 0, 0); __builtin_amdgcn_s_setprio(0); } while (0)
#define PG8_WAIT_V(n) asm volatile("s_waitcnt vmcnt(" #n ")" ::: "memory")
#define PG8_WAIT_L(n) asm volatile("s_waitcnt lgkmcnt(" #n ")" ::: "memory")
#define PG8_BAR __builtin_amdgcn_s_barrier()
#define PG8_SCHED __builtin_amdgcn_sched_barrier(0)
    Unit cur, nxt; int ui = 0;
    if (!S.next(0, cur)) return;
    f32x4 acc[2][2][4][2];
#pragma unroll
    for (int a = 0; a < 2; ++a)
#pragma unroll
        for (int b = 0; b < 2; ++b)
#pragma unroll
            for (int m = 0; m < 4; ++m)
#pragma unroll
                for (int n = 0; n < 2; ++n) acc[a][b][m][n] = (f32x4){0.f, 0.f, 0.f, 0.f};
    bf16x8 At[4][2], B0[2][2], B1[2][2];
    const char* cA = (const char*)g.A + (size_t)cur.z * g.zA + (size_t)cur.pm * tstep + (size_t)cur.k0 * kstep; const char* cB = (const char*)g.Bt + (size_t)cur.z * g.zB + (size_t)cur.pn * tstep + (size_t)cur.k0 * kstep;
    int nt = cur.nk;
    PG8_STAGE(PG8_SB(0, 0), cB, voffB); PG8_STAGE(PG8_SA(0, 0), cA, voffA); PG8_STAGE(PG8_SB(0, 1), cB + hstep, voffB); PG8_STAGE(PG8_SA(0, 1), cA + hstep, voffA);
    if (wr == 1) PG8_BAR;
    PG8_WAIT_V(4); PG8_BAR;
    PG8_STAGE(PG8_SB(1, 0), cB + kstep, voffB); PG8_STAGE(PG8_SA(1, 0), cA + kstep, voffA); PG8_STAGE(PG8_SB(1, 1), cB + hstep + kstep, voffB);
    PG8_WAIT_V(6); PG8_BAR;
    for (;;) {
        const bool has_next = S.next(ui + 1, nxt);
        const char* nA = has_next ? (const char*)g.A + (size_t)nxt.z * g.zA + (size_t)nxt.pm * tstep + (size_t)nxt.k0 * kstep : cA; const char* nB = has_next ? (const char*)g.Bt + (size_t)nxt.z * g.zB + (size_t)nxt.pn * tstep + (size_t)nxt.k0 * kstep : cB;
        for (int t = 0; t < nt; t += 2) {
            const bool last = (t == nt - 2);
            const char* a1 = cA + (size_t)(t + 1) * kstep;
            const char* a2 = last ? nA : cA + (size_t)(t + 2) * kstep; const char* b2 = last ? nB : cB + (size_t)(t + 2) * kstep;
            const char* a3 = a2 + kstep; const char* b3 = b2 + kstep;
            PG8_LDB(B0, 0, 0); PG8_SCHED; PG8_LDA(At, 0, 0); PG8_STAGE(PG8_SA(1, 1), a1 + hstep, voffA);
            PG8_WAIT_L(8); PG8_BAR; PG8_WAIT_L(0); PG8_MMA(0, 0, At, B0); PG8_BAR; PG8_SCHED;
            PG8_LDB(B1, 0, 1); PG8_STAGE(PG8_SB(0, 0), b2, voffB);
            PG8_BAR; PG8_WAIT_L(0); PG8_MMA(0, 1, At, B1); PG8_BAR;
            PG8_LDA(At, 0, 1); PG8_STAGE(PG8_SA(0, 0), a2, voffA);
            PG8_BAR; PG8_WAIT_L(0); PG8_MMA(1, 0, At, B0); PG8_BAR; PG8_SCHED;
            PG8_STAGE(PG8_SB(0, 1), b2 + hstep, voffB);
            PG8_WAIT_V(6); PG8_BAR; PG8_MMA(1, 1, At, B1); PG8_BAR;
            PG8_LDB(B0, 1, 0); PG8_SCHED; PG8_LDA(At, 1, 0); PG8_STAGE(PG8_SA(0, 1), a2 + hstep, voffA);
            PG8_WAIT_L(8); PG8_BAR; PG8_WAIT_L(0); PG8_MMA(0, 0, At, B0); PG8_BAR; PG8_SCHED;
            PG8_LDB(B1, 1, 1); PG8_STAGE(PG8_SB(1, 0), b3, voffB);
            PG8_BAR; PG8_WAIT_L(0); PG8_MMA(0, 1, At, B1); PG8_BAR;
            PG8_LDA(At, 1, 1); PG8_STAGE(PG8_SA(1, 0), a3, voffA);
            PG8_BAR; PG8_WAIT_L(0); PG8_MMA(1, 0, At, B0); PG8_BAR; PG8_SCHED;
            PG8_STAGE(PG8_SB(1, 1), b3 + hstep, voffB);
            PG8_WAIT_V(6); PG8_BAR; PG8_MMA(1, 1, At, B1); PG8_BAR;
        }
        E(acc, cur, wr, wc, fr, fq);
        if (!has_next) break;
#pragma unroll
        for (int a = 0; a < 2; ++a)
#pragma unroll
            for (int b = 0; b < 2; ++b)
#pragma unroll
                for (int m = 0; m < 4; ++m)
#pragma unroll
                    for (int n = 0; n < 2; ++n) acc[a][b][m][n] = (f32x4){0.f, 0.f, 0.f, 0.f};
        cur = nxt; cA = nA; cB = nB; nt = cur.nk; ++ui;
    }
    PG8_WAIT_V(0);
    if (wr == 0) PG8_BAR;
    PG8_BAR;
#undef PG8_SA
#undef PG8_SB
#undef PG8_STAGE
#undef PG8_LDA
#undef PG8_LDB
#undef PG8_MMA
#undef PG8_WAIT_V
#undef PG8_WAIT_L
#undef PG8_BAR
#undef PG8_SCHED
}

struct EpiBF {
    static constexpr bool PERM = true;
    bf16_t* O; size_t zO; float* P; int nz;
    __device__ __forceinline__ void operator()(const f32x4 (&acc)[2][2][4][2], const Unit& u, int wr, int wc, int fr, int fq) const {
        const int col0 = u.pn * BM + wc * 32 + 8 * fq;
        if (u.part < 0) {
            const int row0 = u.pm * BM + wr * 64 + fr; bf16_t* base = O + (size_t)u.z * zO;
#pragma unroll
            for (int ai = 0; ai < 2; ++ai)
#pragma unroll
                for (int m = 0; m < 4; ++m) { bf16_t* rowp = base + (size_t)(row0 + ai * HALF + m * 16) * D + col0;
#pragma unroll
                    for (int bj = 0; bj < 2; ++bj) { const f32x4 v0 = acc[ai][bj][m][0], v1 = acc[ai][bj][m][1];
                        u32x4 w; w.x = cvt_pk_bf16(v0[0], v0[1]); w.y = cvt_pk_bf16(v0[2], v0[3]); w.z = cvt_pk_bf16(v1[0], v1[1]); w.w = cvt_pk_bf16(v1[2], v1[3]);
                        *(u32x4*)(rowp + bj * HALF) = w; } }
        } else {
            const int row0 = wr * 64 + fr; float* base = P + (size_t)(u.part * nz + u.z) * (BM * D);
#pragma unroll
            for (int ai = 0; ai < 2; ++ai)
#pragma unroll
                for (int m = 0; m < 4; ++m) { float* rowp = base + (size_t)(row0 + ai * HALF + m * 16) * D + col0;
#pragma unroll
                    for (int bj = 0; bj < 2; ++bj) { *(f32x4*)(rowp + bj * HALF) = acc[ai][bj][m][0]; *(f32x4*)(rowp + bj * HALF + 4) = acc[ai][bj][m][1]; } }
        }
    }
};
struct EpiGU {
    static constexpr bool PERM = true;
    bf16_t* O; bool dry;
    __device__ __forceinline__ void operator()(const f32x4 (&acc)[2][2][4][2], const Unit& u, int wr, int wc, int fr, int fq) const {
        if (dry) return;
        const int row0 = u.pm * BM + wr * 64 + fr, col0 = u.pn * HALF + wc * 32 + 8 * fq;
#pragma unroll
        for (int ai = 0; ai < 2; ++ai)
#pragma unroll
            for (int m = 0; m < 4; ++m) { bf16_t* rowp = O + (size_t)(row0 + ai * HALF + m * 16) * DFF + col0;
                float v[8];
#pragma unroll
                for (int n = 0; n < 2; ++n)
#pragma unroll
                    for (int j = 0; j < 4; ++j) { const float gt = acc[ai][0][m][n][j], up = acc[ai][1][m][n][j]; v[n * 4 + j] = gt * sigm(gt) * up; }
                u32x4 w; w.x = cvt_pk_bf16(v[0], v[1]); w.y = cvt_pk_bf16(v[2], v[3]); w.z = cvt_pk_bf16(v[4], v[5]); w.w = cvt_pk_bf16(v[6], v[7]);
                *(u32x4*)rowp = w; }
    }
};
struct EpiIN {
    static constexpr bool PERM = true;
    bf16_t* U;
    __device__ __forceinline__ void operator()(const f32x4 (&acc)[2][2][4][2], const Unit& u, int wr, int wc, int fr, int fq) const {
        const int row0 = u.pm * BM + wr * 64 + fr;
        if (u.pn >= 4 && u.pn < 12) {
            const int col0 = (u.pn - 4) * HALF + wc * 32 + 8 * fq; bf16_t* base = U + 2 * SLOT;
#pragma unroll
            for (int ai = 0; ai < 2; ++ai)
#pragma unroll
                for (int m = 0; m < 4; ++m) { bf16_t* rowp = base + (size_t)(row0 + ai * HALF + m * 16) * D + col0;
                    const f32x4 v0 = acc[ai][0][m][0] * acc[ai][1][m][0], v1 = acc[ai][0][m][1] * acc[ai][1][m][1];
                    u32x4 w; w.x = cvt_pk_bf16(v0[0], v0[1]); w.y = cvt_pk_bf16(v0[2], v0[3]); w.z = cvt_pk_bf16(v1[0], v1[1]); w.w = cvt_pk_bf16(v1[2], v1[3]);
                    *(u32x4*)rowp = w; }
        } else {
            int slot, ct; if (u.pn < 4) { slot = 0; ct = u.pn; } else { const int sg = (u.pn - 12) >> 2; slot = sg == 0 ? 3 : (sg == 1 ? 1 : sg + 2); ct = (u.pn - 12) & 3; }
            const int col0 = ct * BM + wc * 32 + 8 * fq; bf16_t* base = U + (size_t)slot * SLOT;
#pragma unroll
            for (int ai = 0; ai < 2; ++ai)
#pragma unroll
                for (int m = 0; m < 4; ++m) { bf16_t* rowp = base + (size_t)(row0 + ai * HALF + m * 16) * D + col0;
#pragma unroll
                    for (int bj = 0; bj < 2; ++bj) { const f32x4 v0 = acc[ai][bj][m][0], v1 = acc[ai][bj][m][1];
                        u32x4 w; w.x = cvt_pk_bf16(v0[0], v0[1]); w.y = cvt_pk_bf16(v0[2], v0[3]); w.z = cvt_pk_bf16(v1[0], v1[1]); w.w = cvt_pk_bf16(v1[2], v1[3]);
                        *(u32x4*)(rowp + bj * HALF) = w; } }
        }
    }
};
}

__device__ __forceinline__ int conv_map(int mode, int n) {
    if (mode == 0) return n;
    if (mode == 1) return 256 * (n >> 7) + (n & 127);
    if (mode == 2) return 256 * (n >> 7) + 128 + (n & 127);
    const int seg = n >> 10, j = n & 1023;
    if (seg == 0) return j;
    if (seg == 1) return 1024 + 256 * (j >> 7) + (j & 127);
    if (seg == 2) return 1024 + 256 * (j >> 7) + 128 + (j & 127);
    return 3072 + (seg - 3) * 1024 + j;
}
struct ConvE { const float* src; bf16_t* dst; const float* gk; int K, N, mode, t; };
__device__ __forceinline__ bool conv_decode(const Params& p, int set, int T, ConvE& e) {
    if (set < 2) {
        const int a = set ? 27 : 8; const float* gk = p.in[set ? 25 : 6];
        if (T < 704)       { e.src = p.in[a];     e.dst = (bf16_t*)(p.ws + WS_WGU); e.gk = gk;      e.K = 1024; e.N = 2816; e.mode = 1; e.t = T; }
        else if (T < 1408) { e.src = p.in[a + 1]; e.dst = (bf16_t*)(p.ws + WS_WGU); e.gk = gk;      e.K = 1024; e.N = 2816; e.mode = 2; e.t = T - 704; }
        else if (T < 2112) { e.src = p.in[a + 2]; e.dst = (bf16_t*)(p.ws + WS_WD);  e.gk = nullptr; e.K = 2816; e.N = 1024; e.mode = 0; e.t = T - 1408; }
        else return false;
    } else {
        if (T < 1792)      { e.src = p.in[13]; e.dst = (bf16_t*)(p.ws + WS_WIN); e.gk = p.in[11]; e.K = 1024; e.N = 7168; e.mode = 3; e.t = T; }
        else if (T < 2048) { e.src = p.in[15]; e.dst = (bf16_t*)(p.ws + WS_WOAB); e.gk = nullptr; e.K = 1024; e.N = 1024; e.mode = 0; e.t = T - 1792; }
        else if (T < 2304) { e.src = p.in[23]; e.dst = (bf16_t*)(p.ws + WS_WOAB + (size_t)1024 * 1024 * 2); e.gk = nullptr; e.K = 1024; e.N = 1024; e.mode = 0; e.t = T - 2048; }
        else if (T < 2560) { e.src = p.in[24]; e.dst = (bf16_t*)(p.ws + WS_WO);  e.gk = nullptr;  e.K = 1024; e.N = 1024; e.mode = 0; e.t = T - 2304; }
        else return false;
    }
    return true;
}
__device__ __forceinline__ void conv_load(const ConvE& e, int tid, f32x4& v0, f32x4& v1) {
    const int ntn = e.N >> 6; const int tk = e.t / ntn, tn = e.t - tk * ntn;
    const float* s0 = e.src + (size_t)(tk * 64 + (tid >> 4)) * e.N + tn * 64 + (tid & 15) * 4;
    v0 = *(const f32x4*)s0; v1 = *(const f32x4*)(s0 + (size_t)32 * e.N);
}
__device__ __forceinline__ void conv_emit(const ConvE& e, int tid, const f32x4& v0, const f32x4& v1, LAS float* sl) {
    const int ntn = e.N >> 6; const int tk = e.t / ntn, tn = e.t - tk * ntn; const int k0 = tk * 64, n0 = tn * 64;
    { LAS float* d = sl + (tid >> 4) * 65 + (tid & 15) * 4; d[0] = v0[0]; d[1] = v0[1]; d[2] = v0[2]; d[3] = v0[3]; d += 32 * 65; d[0] = v1[0]; d[1] = v1[1]; d[2] = v1[2]; d[3] = v1[3]; }
    __syncthreads();
    const int n = tid >> 3, ko = (tid & 7) * 8;
    float f[8];
#pragma unroll
    for (int i = 0; i < 8; ++i) f[i] = sl[(ko + i) * 65 + n];
    if (e.gk) {
        const f32x4 g0 = *(const f32x4*)(e.gk + k0 + ko), g1 = *(const f32x4*)(e.gk + k0 + ko + 4);
#pragma unroll
        for (int i = 0; i < 4; ++i) { f[i] *= g0[i]; f[4 + i] *= g1[i]; }
    }
    u32x4 w; w.x = cvt_pk_bf16(f[0], f[1]); w.y = cvt_pk_bf16(f[2], f[3]); w.z = cvt_pk_bf16(f[4], f[5]); w.w = cvt_pk_bf16(f[6], f[7]);
    *(u32x4*)(e.dst + (size_t)conv_map(e.mode, n0 + n) * e.K + k0 + ko) = w;
    __syncthreads();
}
__device__ __forceinline__ void convert_set(const Params& p, int set, LAS unsigned char* lds, int tid) {
    ConvE e, en; f32x4 v0, v1, n0 = {0.f, 0.f, 0.f, 0.f}, n1 = {0.f, 0.f, 0.f, 0.f};
    int T = blockIdx.x;
    bool have = conv_decode(p, set, T, e);
    if (have) conv_load(e, tid, v0, v1);
    while (have) {
        T += gridDim.x;
        const bool hn = conv_decode(p, set, T, en);
        if (hn) conv_load(en, tid, n0, n1);
        conv_emit(e, tid, v0, v1, (LAS float*)lds);
        e = en; v0 = n0; v1 = n1; have = hn;
    }
}

__device__ __forceinline__ void norm_phase(const Params& p, int mode, int tid, bool dry, int nsplit) {
    const int lane = tid & 63, gw = blockIdx.x * 8 + (tid >> 6), nw = gridDim.x * 8;
    const float* gpost = mode == 1 ? p.in[7] : (mode == 2 ? p.in[12] : p.in[26]);
    const float cc = mode == 2 ? 1.0f : 0.5f;
    const bf16_t* Yb = (const bf16_t*)(p.ws + WS_Y); const float* PY = (const float*)(p.ws + WS_PY); bf16_t* H = (bf16_t*)(p.ws + WS_H); float* SC = (float*)(p.ws + WS_SC);
    for (int r = gw; r < M; r += nw) {
        f32x4 xv[4];
        if (mode == 0) {
            const float* xin = x0row(p, r);
#pragma unroll
            for (int q = 0; q < 4; ++q) xv[q] = *(const f32x4*)(xin + lane * 4 + 256 * q);
        } else {
            const float sc = SC[r];
#pragma unroll
            for (int q = 0; q < 4; ++q) { const u32x2 w = *(const u32x2*)(H + (size_t)r * D + lane * 4 + 256 * q); xv[q] = (f32x4){bflo(w.x), bfhi(w.x), bflo(w.y), bfhi(w.y)} * sc; }
            f32x4 yv[4]; float ss = 0.f;
            if (r < MAINR) {
#pragma unroll
                for (int q = 0; q < 4; ++q) { const u32x2 w = *(const u32x2*)(Yb + (size_t)r * D + lane * 4 + 256 * q); yv[q] = (f32x4){bflo(w.x), bfhi(w.x), bflo(w.y), bfhi(w.y)}; }
            } else {
#pragma unroll
                for (int q = 0; q < 4; ++q) yv[q] = (f32x4){0.f, 0.f, 0.f, 0.f};
                for (int ks = 0; ks < nsplit; ++ks) {
#pragma unroll
                    for (int q = 0; q < 4; ++q) yv[q] += *(const f32x4*)(PY + ((size_t)ks * 256 + (r - MAINR)) * D + lane * 4 + 256 * q);
                }
            }
#pragma unroll
            for (int q = 0; q < 4; ++q) ss += yv[q][0] * yv[q][0] + yv[q][1] * yv[q][1] + yv[q][2] * yv[q][2] + yv[q][3] * yv[q][3];
            ss = wave_sum(ss, lane);
            const float rs = cc * rsqrtf(ss * (1.0f / D) + EPS);
#pragma unroll
            for (int q = 0; q < 4; ++q) xv[q] += yv[q] * rs * *(const f32x4*)(gpost + lane * 4 + 256 * q);
        }
        if (mode == 3) {
            float* xo;
            if (r >= MP) xo = p.out + O_YS + (size_t)(r - MP) * D;
            else { const int b = r / TP, t = r - b * TP; if (t < NMETA) continue; xo = p.out + O_YP + ((size_t)b * SEQ + (t - NMETA)) * D; }
#pragma unroll
            for (int q = 0; q < 4; ++q) *(f32x4*)(xo + lane * 4 + 256 * q) = xv[q];
        } else {
            float ss = 0.f;
#pragma unroll
            for (int q = 0; q < 4; ++q) ss += xv[q][0] * xv[q][0] + xv[q][1] * xv[q][1] + xv[q][2] * xv[q][2] + xv[q][3] * xv[q][3];
            ss = wave_sum(ss, lane);
            const float ms = ss * (1.0f / D) + EPS; const float rs = rsqrtf(ms);
            if (!dry) {
#pragma unroll
                for (int q = 0; q < 4; ++q) { const f32x4 hv = xv[q] * rs; u32x2 w; w.x = cvt_pk_bf16(hv[0], hv[1]); w.y = cvt_pk_bf16(hv[2], hv[3]);
                    *(u32x2*)(H + (size_t)r * D + lane * 4 + 256 * q) = w; }
                if (lane == 0) SC[r] = ms * rs;
            }
        }
    }
}

constexpr int WL_BYTES = 11264;
__device__ __forceinline__ void scan_item(const Params& p, int b, int j, int h, LAS unsigned char* wl, const LAS unsigned char* wlds, int lane, bool dry) {
    bf16_t* U = (bf16_t*)(p.ws + WS_U);
    const bf16_t* bx = U + 3 * SLOT; bf16_t* bg = U + 1 * SLOT; bf16_t* pp = (bf16_t*)p.out;
    float* summ = (float*)(p.ws + WS_SUMM);
    const int c = h * 64 + lane, fr = lane & 15, fq = lane >> 4;
    const size_t row0 = (size_t)b * TP + (size_t)j * CHUNK;
    const bf16_t* bx0 = bx + row0 * D; bf16_t* bg0 = bg + row0 * D; bf16_t* pp0 = pp + row0 * D;
    const LAS unsigned char* wq = wlds + fr * 144 + fq * 16;
    float brv[4], biv[4], lcv[4];
#pragma unroll
    for (int nt = 0; nt < 4; ++nt) { const int ch = h * 64 + nt * 16 + fr; brv[nt] = p.in[19][ch]; biv[nt] = p.in[21][ch]; lcv[nt] = -8.0f * log1pf(expf(-p.in[22][ch])); }
    const float w0 = p.in[16][c], w1 = p.in[16][D + c], w2 = p.in[16][2 * D + c], w3 = p.in[16][3 * D + c], cbias = p.in[17][c];
    float xm3 = 0.f, xm2 = 0.f, xm1 = 0.f;
    if (j > 0) { xm3 = bf2f(bx0[-3 * D + c]); xm2 = bf2f(bx0[-2 * D + c]); xm1 = bf2f(bx0[-1 * D + c]); }
    float hh = 0.f, ap = 1.f;
    LAS unsigned short* cbT = (LAS unsigned short*)wl;
    LAS float* xu = (LAS float*)(wl + 2304);
    LAS float* aS = (LAS float*)(wl + 2304 + 4352);
    bf16_t xr[16], gr[16], xn[16];
#pragma unroll
    for (int tt = 0; tt < 16; ++tt) xr[tt] = bx0[tt * D + c];
#pragma unroll
    for (int g = 0; g < 3; ++g) {
        const int r0 = g * 16;
#pragma unroll
        for (int tt = 0; tt < 16; ++tt) gr[tt] = bg0[(r0 + tt) * D + c];
        if (g < 2) {
#pragma unroll
            for (int tt = 0; tt < 16; ++tt) xn[tt] = bx0[(r0 + 16 + tt) * D + c];
        }
#pragma unroll
        for (int tt = 0; tt < 16; ++tt) { const float x = bf2f(xr[tt]); const float cb = w0 * xm3 + w1 * xm2 + w2 * xm1 + w3 * x + cbias; xm3 = xm2; xm2 = xm1; xm1 = x;
            cbT[tt * 72 + lane] = f2bf(cb); xu[tt * 68 + lane] = cb; }
        __builtin_amdgcn_wave_barrier();
        const bf16x8 a0 = *(const LAS bf16x8*)(cbT + fr * 72 + fq * 8), a1 = *(const LAS bf16x8*)(cbT + fr * 72 + 32 + fq * 8);
        f32x4 accR[4], accI[4];
#pragma unroll
        for (int nt = 0; nt < 4; ++nt) {
            const bf16x8 r0w = *(const LAS bf16x8*)(wq + nt * 2304), r1w = *(const LAS bf16x8*)(wq + nt * 2304 + 64);
            const bf16x8 i0w = *(const LAS bf16x8*)(wq + 9216 + nt * 2304), i1w = *(const LAS bf16x8*)(wq + 9216 + nt * 2304 + 64);
            accR[nt] = __builtin_amdgcn_mfma_f32_16x16x32_bf16(a0, r0w, (f32x4){0.f, 0.f, 0.f, 0.f}, 0, 0, 0);
            accR[nt] = __builtin_amdgcn_mfma_f32_16x16x32_bf16(a1, r1w, accR[nt], 0, 0, 0);
            accI[nt] = __builtin_amdgcn_mfma_f32_16x16x32_bf16(a0, i0w, (f32x4){0.f, 0.f, 0.f, 0.f}, 0, 0, 0);
            accI[nt] = __builtin_amdgcn_mfma_f32_16x16x32_bf16(a1, i1w, accI[nt], 0, 0, 0);
        }
#pragma unroll
        for (int nt = 0; nt < 4; ++nt)
#pragma unroll
            for (int i = 0; i < 4; ++i) { const int idx = (fq * 4 + i) * 68 + nt * 16 + fr; const float x = xu[idx];
                const float r = sigm(accR[nt][i] + brv[nt]), ig = sigm(accI[nt][i] + biv[nt]);
                const float la = lcv[nt] * r; const float a = __expf(la);
                const float z2 = 2.0f * la;
                const float m2s = -z2 * (1.0f + z2 * (0.5f + z2 * (0.16666667f + z2 * (0.041666668f + z2 * (0.0083333338f + z2 * 0.0013888889f)))));
                const float m2 = z2 > -0.25f ? m2s : 1.0f - a * a;
                xu[idx] = __builtin_amdgcn_sqrtf(m2) * ig * x; aS[idx] = a; }
        __builtin_amdgcn_wave_barrier();
#pragma unroll
        for (int tt = 0; tt < 16; ++tt) { const float a = aS[tt * 68 + lane], uu = xu[tt * 68 + lane]; hh = a * hh + uu; ap *= a;
            const float gl = gelu_tanh(bf2f(gr[tt]));
            if (!dry) bg0[(r0 + tt) * D + c] = f2bf(gl * hh);
            pp0[(r0 + tt) * D + c] = f2bf(gl * ap); }
        __builtin_amdgcn_wave_barrier();
        if (g < 2) {
#pragma unroll
            for (int tt = 0; tt < 16; ++tt) xr[tt] = xn[tt];
        }
    }
    *(float2*)(summ + (((size_t)b * NCH + j) * D + c) * 2) = make_float2(ap, hh);
    if (j == NCH - 1) { p.out[O_CBP + ((size_t)b * 3 + 0) * D + c] = xm3; p.out[O_CBP + ((size_t)b * 3 + 1) * D + c] = xm2; p.out[O_CBP + ((size_t)b * 3 + 2) * D + c] = xm1; }
}
__device__ __forceinline__ void scan_phase(const Params& p, LAS unsigned char* lds, int tid, bool dry) {
    const int wid = __builtin_amdgcn_readfirstlane(tid >> 6), lane = tid & 63;
    LAS unsigned char* wl = lds + wid * WL_BYTES;
    LAS unsigned char* wlds = lds + 8 * WL_BYTES;
    const int h = blockIdx.x & 15;
    {
        const bf16_t* wt = (const bf16_t*)(p.ws + WS_WRG);
#pragma unroll
        for (int q = 0; q < 2; ++q) { const int e = tid + q * 512, g = e >> 9, jrow = (e >> 3) & 63, pc = e & 7;
            *(LAS u32x4*)(wlds + g * 9216 + jrow * 144 + pc * 16) = *(const u32x4*)(wt + (size_t)g * 65536 + (size_t)(h * 64 + jrow) * 64 + pc * 8); }
    }
    __syncthreads();
    const int nbh = gridDim.x >> 4;
    for (int it = (blockIdx.x >> 4) * 8 + wid; it < NB * NCH; it += nbh * 8) scan_item(p, it / NCH, it % NCH, h, wl, wlds, lane, dry);
    __syncthreads();
}
__device__ __forceinline__ void fix_phase(const Params& p, LAS unsigned char* lds, int tid, bool dry) {
    bf16_t* zb = (bf16_t*)(p.ws + WS_U) + 1 * SLOT; const bf16_t* pp = (const bf16_t*)p.out;
    const float* summ = (const float*)(p.ws + WS_SUMM);
    LAS float* cs = (LAS float*)lds;
    for (int it = blockIdx.x; it < NB * (NCH - 1); it += gridDim.x) {
        const int b = it / (NCH - 1), j = it % (NCH - 1) + 1;
#pragma unroll
        for (int cq = 0; cq < 2; ++cq) {
            const int c = tid + cq * 512; const float* sp = summ + ((size_t)b * NCH * D + c) * 2; float hh = 0.f;
            for (int i0 = 0; i0 < j; i0 += 16) {
                float va[16], vh[16];
#pragma unroll
                for (int k = 0; k < 16; ++k) { if (i0 + k < j) { const float2 v = *(const float2*)(sp + (size_t)(i0 + k) * D * 2); va[k] = v.x; vh[k] = v.y; } else { va[k] = 1.f; vh[k] = 0.f; } }
#pragma unroll
                for (int k = 0; k < 16; ++k) hh = va[k] * hh + vh[k];
            }
            cs[c] = hh;
            if (j == NCH - 1) { const float2 v = *(const float2*)(sp + (size_t)j * D * 2); p.out[O_RGP + (size_t)b * D + c] = v.x * hh + v.y; }
        }
        __syncthreads();
        const size_t row0 = (size_t)b * TP + (size_t)j * CHUNK;
#pragma unroll 4
        for (int q = 0; q < CHUNK * 128 / 512; ++q) {
            const int e = tid + q * 512, tt = e >> 7, vc = e & 127; const size_t o = (row0 + tt) * D + vc * 8;
            const u32x4 zq = *(const u32x4*)(zb + o), pq = *(const u32x4*)(pp + o);
            const f32x4 c0 = *(const LAS f32x4*)(cs + vc * 8), c1 = *(const LAS f32x4*)(cs + vc * 8 + 4);
            u32x4 w;
            w.x = cvt_pk_bf16(bflo(zq.x) + bflo(pq.x) * c0[0], bfhi(zq.x) + bfhi(pq.x) * c0[1]); w.y = cvt_pk_bf16(bflo(zq.y) + bflo(pq.y) * c0[2], bfhi(zq.y) + bfhi(pq.y) * c0[3]);
            w.z = cvt_pk_bf16(bflo(zq.z) + bflo(pq.z) * c1[0], bfhi(zq.z) + bfhi(pq.z) * c1[1]); w.w = cvt_pk_bf16(bflo(zq.w) + bflo(pq.w) * c1[2], bfhi(zq.w) + bfhi(pq.w) * c1[3]);
            if (!dry) *(u32x4*)(zb + o) = w;
        }
        __syncthreads();
    }
}
__device__ __forceinline__ void za_phase(const Params& p, int tid, bool dry) {
    bf16_t* U = (bf16_t*)(p.ws + WS_U); bf16_t* ab = U; const bf16_t* ca = U + 2 * SLOT;
    const float* cw = p.in[14];
    for (int idx = blockIdx.x * 512 + tid; idx < NB * 129 * 128; idx += gridDim.x * 512) {
        const int vc = idx & 127, tb = (idx >> 7) % 129, b = idx / (128 * 129); const int c0 = vc * 8;
        float w[3][8];
#pragma unroll
        for (int k = 0; k < 3; ++k) { const f32x4 a = *(const f32x4*)(cw + k * D + c0), bq = *(const f32x4*)(cw + k * D + c0 + 4);
#pragma unroll
            for (int e = 0; e < 4; ++e) { w[k][e] = a[e]; w[k][4 + e] = bq[e]; } }
        const size_t r0 = (size_t)b * TP + (size_t)tb * 16;
        float p2[8], p1[8];
        if (tb > 0) { const u32x4 q2 = *(const u32x4*)(ca + (r0 - 2) * D + c0), q1 = *(const u32x4*)(ca + (r0 - 1) * D + c0);
#pragma unroll
            for (int e = 0; e < 4; ++e) { p2[2 * e] = bflo(q2[e]); p2[2 * e + 1] = bfhi(q2[e]); p1[2 * e] = bflo(q1[e]); p1[2 * e + 1] = bfhi(q1[e]); } }
        else {
#pragma unroll
            for (int e = 0; e < 8; ++e) { p2[e] = 0.f; p1[e] = 0.f; } }
#pragma unroll 4
        for (int tt = 0; tt < 16; ++tt) {
            const u32x4 qc = *(const u32x4*)(ca + (r0 + tt) * D + c0), qa = *(const u32x4*)(ab + (r0 + tt) * D + c0);
            float cv[8], av[8], zv[8];
#pragma unroll
            for (int e = 0; e < 4; ++e) { cv[2 * e] = bflo(qc[e]); cv[2 * e + 1] = bfhi(qc[e]); av[2 * e] = bflo(qa[e]); av[2 * e + 1] = bfhi(qa[e]); }
#pragma unroll
            for (int e = 0; e < 8; ++e) { zv[e] = av[e] * (w[0][e] * p2[e] + w[1][e] * p1[e] + w[2][e] * cv[e]); p2[e] = p1[e]; p1[e] = cv[e]; }
            u32x4 o; o.x = cvt_pk_bf16(zv[0], zv[1]); o.y = cvt_pk_bf16(zv[2], zv[3]); o.z = cvt_pk_bf16(zv[4], zv[5]); o.w = cvt_pk_bf16(zv[6], zv[7]);
            if (!dry) *(u32x4*)(ab + (r0 + tt) * D + c0) = o;
        }
        if (tb == 128) {
            float* o2 = p.out + O_CAP + ((size_t)b * 2 + 0) * D + c0; float* o1 = p.out + O_CAP + ((size_t)b * 2 + 1) * D + c0;
            *(f32x4*)o2 = (f32x4){p2[0], p2[1], p2[2], p2[3]}; *(f32x4*)(o2 + 4) = (f32x4){p2[4], p2[5], p2[6], p2[7]};
            *(f32x4*)o1 = (f32x4){p1[0], p1[1], p1[2], p1[3]}; *(f32x4*)(o1 + 4) = (f32x4){p1[4], p1[5], p1[6], p1[7]};
        }
    }
}
__device__ __forceinline__ void sample_phase(const Params& p, LAS unsigned char* lds, int tid) {
    bf16_t* U = (bf16_t*)(p.ws + WS_U);
    LAS float* cbs = (LAS float*)lds;
    for (int s = (int)blockIdx.x - 128; s >= 0 && s < NS; s += 128) {
#pragma unroll
        for (int cq = 0; cq < 2; ++cq) {
            const int c = tid + cq * 512; const size_t ro = (size_t)(MP + s) * D + c;
            const float cav = bf2f(U[2 * SLOT + ro]), abv = bf2f(U[ro]);
            const float s0 = p.in[2][((size_t)s * 2 + 0) * D + c], s1 = p.in[2][((size_t)s * 2 + 1) * D + c];
            const float cva = p.in[14][c] * s0 + p.in[14][D + c] * s1 + p.in[14][2 * D + c] * cav;
            U[ro] = f2bf(abv * cva);
            p.out[O_CAS + ((size_t)s * 2 + 0) * D + c] = s1; p.out[O_CAS + ((size_t)s * 2 + 1) * D + c] = cav;
            const float bxv = bf2f(U[3 * SLOT + ro]);
            const float t0 = p.in[3][((size_t)s * 3 + 0) * D + c], t1 = p.in[3][((size_t)s * 3 + 1) * D + c], t2 = p.in[3][((size_t)s * 3 + 2) * D + c];
            const float cb = p.in[16][c] * t0 + p.in[16][D + c] * t1 + p.in[16][2 * D + c] * t2 + p.in[16][3 * D + c] * bxv + p.in[17][c];
            p.out[O_CBS + ((size_t)s * 3 + 0) * D + c] = t1; p.out[O_CBS + ((size_t)s * 3 + 1) * D + c] = t2; p.out[O_CBS + ((size_t)s * 3 + 2) * D + c] = bxv;
            cbs[c] = cb;
        }
        __syncthreads();
        {
            const int h = tid >> 6, jj = tid & 63;
            float ar0 = 0.f, ai0 = 0.f, ar1 = 0.f, ai1 = 0.f;
            const float* wr_ = p.in[18] + (size_t)h * 4096 + jj; const float* wi_ = p.in[20] + (size_t)h * 4096 + jj;
#pragma unroll 16
            for (int i = 0; i < 64; ++i) { const float x0 = cbs[h * 64 + i], x1 = cbs[512 + h * 64 + i];
                ar0 += x0 * wr_[i * 64]; ai0 += x0 * wi_[i * 64]; ar1 += x1 * wr_[8 * 4096 + i * 64]; ai1 += x1 * wi_[8 * 4096 + i * 64]; }
#pragma unroll
            for (int cq = 0; cq < 2; ++cq) {
                const int c = tid + cq * 512; const size_t ro = (size_t)(MP + s) * D + c;
                const float lc = -8.0f * log1pf(expf(-p.in[22][c]));
                const float r = sigm((cq ? ar1 : ar0) + p.in[19][c]), ig = sigm((cq ? ai1 : ai0) + p.in[21][c]); const float la = lc * r; const float a = expf(la); const float mult = sqrtf(-expm1f(2.0f * la));
                const float hn = a * p.in[4][(size_t)s * D + c] + mult * ig * cbs[c];
                p.out[O_RGS + (size_t)s * D + c] = hn;
                U[1 * SLOT + ro] = f2bf(gelu_tanh(bf2f(U[1 * SLOT + ro])) * hn);
            }
        }
        __syncthreads();
    }
}

__device__ __forceinline__ void merge_phase(const Params& p, int tid) {
    const bf16_t* U = (const bf16_t*)(p.ws + WS_U); bf16_t* H = (bf16_t*)p.out; const float* PO = (const float*)(p.ws + WS_POAB);
    for (size_t i = (size_t)blockIdx.x * 512 + tid; i < SLOT / 8; i += (size_t)gridDim.x * 512) {
        const u32x4 ga = *(const u32x4*)(U + 4 * SLOT + i * 8), gb = *(const u32x4*)(U + 5 * SLOT + i * 8);
        float ya[8], yb[8];
        const int row = (int)(i >> 7);
        if (row < MAINR) {
            const u32x4 a = *(const u32x4*)(U + 2 * SLOT + i * 8), b = *(const u32x4*)(U + 3 * SLOT + i * 8);
#pragma unroll
            for (int e = 0; e < 4; ++e) { ya[2 * e] = bflo(a[e]); ya[2 * e + 1] = bfhi(a[e]); yb[2 * e] = bflo(b[e]); yb[2 * e + 1] = bfhi(b[e]); }
        } else {
            const size_t o = (size_t)(row - MAINR) * D + (size_t)(i & 127) * 8;
#pragma unroll
            for (int e = 0; e < 8; ++e) { ya[e] = 0.f; yb[e] = 0.f; }
#pragma unroll
            for (int ks = 0; ks < 4; ++ks) {
                const f32x4 a0 = *(const f32x4*)(PO + (size_t)(ks * 2 + 0) * (256 * D) + o), a1 = *(const f32x4*)(PO + (size_t)(ks * 2 + 0) * (256 * D) + o + 4);
                const f32x4 b0 = *(const f32x4*)(PO + (size_t)(ks * 2 + 1) * (256 * D) + o), b1 = *(const f32x4*)(PO + (size_t)(ks * 2 + 1) * (256 * D) + o + 4);
#pragma unroll
                for (int e = 0; e < 4; ++e) { ya[e] += a0[e]; ya[4 + e] += a1[e]; yb[e] += b0[e]; yb[4 + e] += b1[e]; }
            }
        }
        u32x4 o4;
#pragma unroll
        for (int e = 0; e < 4; ++e) { const float lo = sigm(bflo(ga[e])) * ya[2 * e] + sigm(bflo(gb[e])) * yb[2 * e], hi = sigm(bfhi(ga[e])) * ya[2 * e + 1] + sigm(bfhi(gb[e])) * yb[2 * e + 1]; o4[e] = cvt_pk_bf16(lo, hi); }
        *(u32x4*)(H + i * 8) = o4;
    }
}

#define XB_TMO      128
#define XB_XCNT(j)  (256  + 64 * (j))
#define XB_XSUB(j)  (1280 + 64 * (j))
#define XB_XGEN(j)  (2304 + 64 * (j))
#define XB_TOP      3328
#define XB_TOPGEN   3392
#define XCD_BAR_WORDS 3456
#define XB_SPIN_CAP (1u << 18)
__device__ __forceinline__ unsigned xb_ld(unsigned* p)              { return __hip_atomic_load(p, __ATOMIC_RELAXED, __HIP_MEMORY_SCOPE_AGENT); }
__device__ __forceinline__ unsigned xb_add(unsigned* p, unsigned v) { return __hip_atomic_fetch_add(p, v, __ATOMIC_RELAXED, __HIP_MEMORY_SCOPE_AGENT); }
__device__ __forceinline__ unsigned xb_xcc_id() { return (unsigned)__builtin_amdgcn_s_getreg((3 << 11) | 20) & 0xFu; }
#define XB_SPIN(cond, bar) do { unsigned _sp = 0; while (cond) { __builtin_amdgcn_s_sleep(1); \
    if ((++_sp & 255u) == 0u) { if (xb_ld(&(bar)[XB_TMO])) break; if (_sp > XB_SPIN_CAP) { atomicAdd(&(bar)[XB_TMO], 1u); break; } } } } while (0)
struct XcdBarrier { unsigned* bar; unsigned x; volatile LAS unsigned* st; };
__device__ __forceinline__ XcdBarrier xcd_barrier_post(unsigned* bar, volatile LAS unsigned* st) {
    XcdBarrier b; b.bar = bar; b.x = xb_xcc_id(); b.st = st;
    if (threadIdx.x == 0) (void)xb_add(&bar[XB_XCNT(b.x)], 1u);
    return b;
}
__device__ __forceinline__ void xcd_barrier_complete(unsigned* bar, unsigned x, unsigned& nloc, unsigned& nx) {
    const unsigned G = gridDim.x * gridDim.y * gridDim.z;
    unsigned sum, cnt, mine, sp = 0u;
    for (;;) {
        sum = 0u; cnt = 0u; mine = 0u;
#pragma unroll
        for (unsigned j = 0; j < 16; ++j) { const unsigned c = xb_ld(&bar[XB_XCNT(j)]); sum += c; cnt += (c > 0u) ? 1u : 0u; mine = (j == x) ? c : mine; }
        if (sum == G) break;
        __builtin_amdgcn_s_sleep(1);
        if ((++sp & 255u) == 0u) { if (xb_ld(&bar[XB_TMO])) break; if (sp > XB_SPIN_CAP) { atomicAdd(&bar[XB_TMO], 1u); break; } }
    }
    nloc = mine > 0u ? mine : 1u; nx = cnt > 0u ? cnt : 1u;
}
__device__ __forceinline__ void xcd_barrier(const XcdBarrier& b) {
    asm volatile("s_waitcnt vmcnt(0)" ::: "memory");
    __syncthreads();
    if (threadIdx.x == 0) {
        unsigned* bar = b.bar;
        __builtin_amdgcn_s_waitcnt(0);
        unsigned nloc = b.st[0], nx = b.st[1];
        if (nloc == 0u) { xcd_barrier_complete(bar, b.x, nloc, nx); b.st[0] = nloc; b.st[1] = nx; }
        const unsigned old = xb_add(&bar[XB_XSUB(b.x)], 1u);
        const unsigned gen = old / nloc;
        if (old + 1u == (gen + 1u) * nloc) {
            __builtin_amdgcn_fence(__ATOMIC_RELEASE, "agent");
            asm volatile("s_waitcnt vmcnt(0)" ::: "memory");
            const unsigned og = xb_add(&bar[XB_TOP], 1u);
            const unsigned tg = og / nx;
            if (og + 1u == (tg + 1u) * nx) xb_add(&bar[XB_TOPGEN], 1u);
            else XB_SPIN(xb_ld(&bar[XB_TOPGEN]) == tg, bar);
            __builtin_amdgcn_fence(__ATOMIC_ACQUIRE, "agent");
            xb_add(&bar[XB_XGEN(b.x)], 1u);
            asm volatile("s_waitcnt vmcnt(0)" ::: "memory");
        } else {
            XB_SPIN(xb_ld(&bar[XB_XGEN(b.x)]) == gen, bar);
            __builtin_amdgcn_fence(__ATOMIC_ACQUIRE, "agent");
            asm volatile("s_waitcnt vmcnt(0)" ::: "memory");
        }
    }
    __syncthreads();
}

constexpr int NPHASE = 14;
constexpr int LDS_BYTES = 131072 + 16;
__global__ void __launch_bounds__(512, 2) mk_fwd(Params p, int ph_lo, int ph_hi) {
    extern __shared__ __attribute__((aligned(16))) unsigned char shm[];
    LAS unsigned char* lds = (LAS unsigned char*)shm;
    cg::grid_group grid = cg::this_grid();
    if (threadIdx.x == 0) { *(LAS u32x4*)(lds + 131072) = (u32x4){0u, 0u, 0u, 0u}; }
    __syncthreads();
    const XcdBarrier xb = xcd_barrier_post((unsigned*)(p.ws + WS_BAR), (volatile LAS unsigned*)(lds + 131072));
    for (int ph2 = ph_lo * 2; ph2 < ph_hi * 2; ++ph2) {
        const int ph = ph2 >> 1; const bool dry = !(ph2 & 1);
        if (dry && !((REP_MASK >> ph) & 1)) continue;
        int tid = threadIdx.x; asm volatile("" : "+v"(tid));
        if (ph == 0) {
            convert_set(p, 0, lds, tid);
            bf16_t* wt = (bf16_t*)(p.ws + WS_WRG);
            for (int o = blockIdx.x * 512 + tid; o < 2 * 65536; o += gridDim.x * 512) { const int g = o >> 16, h = (o >> 12) & 15, j = (o >> 6) & 63, i = o & 63;
                wt[o] = f2bf((g ? p.in[20] : p.in[18])[(size_t)(h * 64 + i) * 64 + j]); }
            norm_phase(p, 0, tid, dry, 0);
        } else if (ph == 1 || ph == 11) {
            pg8::Gemm g{(const bf16_t*)(p.ws + WS_H), (const bf16_t*)(p.ws + WS_WGU), M, 2 * DFF, D, 0, 0};
            pg8::StaticOrder S; S.init(M, 2 * DFF, D, gridDim.x, blockIdx.x);
            pg8::EpiGU E{(bf16_t*)(p.ws + WS_ACT), dry};
            pg8::gemm_phase(lds, g, S, E);
        } else if (ph == 2 || ph == 12 || ph == 9 || ph == 7) {
            const bool dn = (ph == 2 || ph == 12), oab = (ph == 7);
            pg8::Gemm g{dn ? (const bf16_t*)(p.ws + WS_ACT) : (oab ? (const bf16_t*)(p.ws + WS_U) : (const bf16_t*)p.out), (const bf16_t*)(p.ws + (dn ? WS_WD : (oab ? WS_WOAB : WS_WO))), M, D, dn ? DFF : D, SB, (size_t)1024 * 1024 * 2};
            pg8::SplitOrder S; S.init(oab ? 2 * D : D, dn ? DFF : D, gridDim.x, blockIdx.x, dn ? 11 : 4, 4);
            pg8::EpiBF E{(bf16_t*)(p.ws + (oab ? WS_U + 2 * SB : WS_Y)), SLOT, (float*)(p.ws + (oab ? WS_POAB : WS_PY)), oab ? 2 : 1};
            pg8::gemm_phase(lds, g, S, E);
            if (!dry && ph == 2) convert_set(p, 2, lds, tid);
            if (!dry && ph == 9) convert_set(p, 1, lds, tid);
        } else if (ph == 3) {
            norm_phase(p, 1, tid, dry, 11);
        } else if (ph == 4) {
            pg8::Gemm g{(const bf16_t*)(p.ws + WS_H), (const bf16_t*)(p.ws + WS_WIN), M, DIN, D, 0, 0};
            pg8::StaticOrder S; S.init(M, DIN, D, gridDim.x, blockIdx.x);
            pg8::EpiIN E{(bf16_t*)(p.ws + WS_U)};
            pg8::gemm_phase(lds, g, S, E);
        } else if (ph == 5) {
            scan_phase(p, lds, tid, dry);
        } else if (ph == 6) {
            if (!dry) sample_phase(p, lds, tid);
            fix_phase(p, lds, tid, dry);
            za_phase(p, tid, dry);
        } else if (ph == 8) {
            merge_phase(p, tid);
        } else if (ph == 10) {
            norm_phase(p, 2, tid, dry, 4);
        } else if (ph == 13) {
            norm_phase(p, 3, tid, dry, 11);
        }
        if (ph2 + 1 < ph_hi * 2) { if (ph_hi > NPHASE) grid.sync(); else xcd_barrier(xb); }
    }
}

extern "C" void kernel_launch(void* const* d_in, const int* in_sizes, int n_in, void* d_out, int out_size, void* d_ws, size_t ws_size, hipStream_t stream) {
    if (n_in != 30 || ws_size < WS_END) { fprintf(stderr, "kernel_launch: unexpected n_in %d / ws_size %zu (need %zu)\n", n_in, ws_size, (size_t)WS_END); return; }
    Params p{};
    for (int i = 0; i < 30; ++i) p.in[i] = (const float*)d_in[i];
    p.out = (float*)d_out; p.ws = (unsigned char*)d_ws;
    (void)hipFuncSetAttribute((const void*)mk_fwd, hipFuncAttributeMaxDynamicSharedMemorySize, LDS_BYTES);
    static int grid_blocks = 0;
    if (!grid_blocks) {
        int dev = 0, cus = 0, per_cu = 0;
        (void)hipGetDevice(&dev);
        (void)hipDeviceGetAttribute(&cus, hipDeviceAttributeMultiprocessorCount, dev);
        (void)hipOccupancyMaxActiveBlocksPerMultiprocessor(&per_cu, (const void*)mk_fwd, 512, LDS_BYTES);
        if (per_cu < 1) { fprintf(stderr, "kernel_launch: occupancy query says %d blocks/CU\n", per_cu); per_cu = 1; }
        grid_blocks = cus;
    }
    (void)hipMemsetAsync((unsigned char*)d_ws + WS_BAR, 0, 16384, stream);
#if SINGLE_LAUNCH
    int lo = 0, hi = NPHASE;
    void* args[] = {&p, &lo, &hi};
    hipError_t e = hipLaunchCooperativeKernel((const void*)mk_fwd, dim3(grid_blocks), dim3(512), args, LDS_BYTES, stream);
    if (e != hipSuccess) fprintf(stderr, "cooperative launch failed: %s (grid %d)\n", hipGetErrorString(e), grid_blocks);
#else
    for (int ph = 0; ph < NPHASE; ++ph) hipLaunchKernelGGL(mk_fwd, dim3(grid_blocks), dim3(512), LDS_BYTES, stream, p, ph, ph + 1);
#endif
}
```

```cpp
#include <hip/hip_runtime.h>
#include <hip/hip_cooperative_groups.h>
#include <cstdio>
namespace cg = cooperative_groups;

#ifndef REP_MASK
#define REP_MASK 0
#endif
#ifndef SINGLE_LAUNCH
#define SINGLE_LAUNCH 1
#endif

#define LAS __attribute__((address_space(3)))
typedef unsigned short bf16_t;
typedef short bf16x8 __attribute__((ext_vector_type(8)));
typedef float f32x4 __attribute__((ext_vector_type(4)));
typedef unsigned u32x4 __attribute__((ext_vector_type(4)));
typedef unsigned u32x2 __attribute__((ext_vector_type(2)));

constexpr int D = 1024, DFF = 2816, DIN = 7168;
constexpr int NB = 8, SEQ = 2048, NMETA = 16, TP = SEQ + NMETA;
constexpr int MP = NB * TP;
constexpr int NS = 128;
constexpr int M = MP + NS;
constexpr int CHUNK = 48, NCH = TP / CHUNK;
constexpr float EPS = 1e-6f;

constexpr size_t O_YP = 0, O_YS = 16777216, O_CAP = O_YS + 131072, O_CBP = O_CAP + 16384, O_RGP = O_CBP + 24576,
                 O_CAS = O_RGP + 8192, O_CBS = O_CAS + 262144, O_RGS = O_CBS + 393216;

constexpr size_t SLOT = (size_t)M * D;
constexpr size_t SB = SLOT * 2;
constexpr size_t WS_U = 0;
constexpr size_t WS_ACT = 0;
constexpr size_t WS_Y = 3 * SB;
constexpr size_t WS_PY = 4 * SB;
constexpr int MAINR = 64 * 256;
constexpr size_t WS_WGU = 5 * SB;
constexpr size_t WS_WD = WS_WGU + (size_t)5632 * 1024 * 2;
constexpr size_t WS_H = 6 * SB;
constexpr size_t WS_WIN = 7 * SB;
constexpr size_t WS_POAB = WS_WIN;
constexpr size_t WS_WOAB = WS_WIN + (size_t)7168 * 1024 * 2;
constexpr size_t WS_WO = WS_WOAB + (size_t)2 * 1024 * 1024 * 2;
constexpr size_t WS_WRG = WS_WO + (size_t)1024 * 1024 * 2;
constexpr size_t WS_SUMM = WS_WRG + (size_t)2 * 16 * 64 * 64 * 2;
constexpr size_t WS_SC = WS_SUMM + (size_t)NB * NCH * D * 2 * 4;
constexpr size_t WS_BAR = WS_SC + 131072;
constexpr size_t WS_END = WS_BAR + 16384;
static_assert(WS_END <= (size_t)256 * 1024 * 1024, "workspace");

struct Params { const float* in[30]; float* out; unsigned char* ws; };

__device__ __forceinline__ unsigned cvt_pk_bf16(float lo, float hi) { unsigned r; asm volatile("v_cvt_pk_bf16_f32 %0, %1, %2" : "=v"(r) : "v"(lo), "v"(hi)); return r; }
__device__ __forceinline__ bf16_t f2bf(float f) { return (bf16_t)(cvt_pk_bf16(f, 0.f) & 0xffffu); }
__device__ __forceinline__ float bf2f(bf16_t b) { return __uint_as_float(((unsigned)b) << 16); }
__device__ __forceinline__ float bflo(unsigned w) { return __uint_as_float(w << 16); }
__device__ __forceinline__ float bfhi(unsigned w) { return __uint_as_float(w & 0xffff0000u); }
__device__ __forceinline__ float sigm(float x) { return __builtin_amdgcn_rcpf(1.0f + __expf(-x)); }
__device__ __forceinline__ float gelu_tanh(float x) { const float t = 1.5957691216057308f * (x + 0.044715f * x * x * x); return x * sigm(t); }
__device__ __forceinline__ float wave_sum(float v, int lane) {
#pragma unroll
    for (int o = 32; o >= 1; o >>= 1) v += __int_as_float(__builtin_amdgcn_ds_bpermute((lane ^ o) << 2, __float_as_int(v)));
    return v;
}
__device__ __forceinline__ const float* x0row(const Params& p, int r) {
    if (r >= MP) return p.in[1] + (size_t)(r - MP) * D;
    const int b = r / TP, t = r - b * TP;
    if (t < NMETA) return p.in[5] + (size_t)t * D;
    return p.in[0] + ((size_t)b * SEQ + (t - NMETA)) * D;
}

namespace pg8 {
constexpr int BM = 256, BK = 64, HALF = 128, HTB = HALF * BK * 2, STAGE_BYTES = 8 * HTB, NXCD = 8, WGM = 8;
__host__ __device__ __forceinline__ int lds_byte(int r, int c) { const int st = (r >> 4) * 2 + (c >> 5), rr = r & 15, cc = c & 31, ob = rr * 64 + cc * 2; return st * 1024 + (ob ^ (((ob >> 9) & 1) << 5)); }
__host__ __device__ __forceinline__ void stage_rc(int b, int& R, int& C) { const int st = b / 1024, sb = b % 1024, swz = sb ^ (((sb >> 9) & 1) << 5); R = (st >> 1) * 16 + swz / 64; C = (st & 1) * 32 + (swz % 64) / 2; }
__host__ __device__ __forceinline__ int perm32(int rho) { const int n = rho >> 4, i = rho & 15; return 8 * (i >> 2) + 4 * n + (i & 3); }

struct Unit { int pm, pn, z, k0, nk, part; };
struct Gemm { const bf16_t* A; const bf16_t* Bt; int M, N, K; size_t zA, zB; };

struct StaticOrder {
    int nM, nN, nwg, G, c, ntf;
    __device__ void init(int M_, int N_, int K_, int G_, int c_) { nM = M_ / BM; nN = N_ / BM; nwg = nM * nN; G = G_; c = c_; ntf = K_ / BK; }
    __device__ bool map(long L, Unit& u) const {
        if (L >= nwg) return false;
        int wgid = (int)L; { const int q = nwg / NXCD, r = nwg % NXCD, xcd = wgid % NXCD, off = wgid / NXCD; wgid = (xcd < r ? xcd * (q + 1) : r * (q + 1) + (xcd - r) * q) + off; }
        const int nig = WGM * nN, gid = wgid / nig, fm = gid * WGM, gsz = (nM - fm) < WGM ? (nM - fm) : WGM;
        u.pm = fm + ((wgid % nig) % gsz); u.pn = (wgid % nig) / gsz; u.z = 0; u.k0 = 0; u.nk = ntf; u.part = -1; return true;
    }
    __device__ bool next(int i, Unit& u) const { return map((long)i * G + c, u); }
};
struct SplitOrder : StaticOrder {
    int nsplit, nkm;
    __device__ void init(int N_, int K_, int G_, int c_, int nsplit_, int nkm_) { StaticOrder::init(64 * BM, N_, K_, G_, c_); nsplit = nsplit_; nkm = nkm_; }
    __device__ bool next(int i, Unit& u) const {
        const long L = (long)i * G + c; bool ok;
        if (L < nwg) ok = map(L, u);
        else { const int L2 = (int)(L - nwg); ok = L2 < nN * nsplit; const int ks = L2 / nN; u.pm = 64; u.pn = L2 - ks * nN; u.k0 = ks * nkm; u.nk = nkm; u.part = ks; }
        u.z = u.pn >> 2; u.pn &= 3; return ok;
    }
};

template <class Epi, class Sched>
__device__ __forceinline__ void gemm_phase(LAS unsigned char* lds, const Gemm g, const Sched& S, const Epi& E) {
    int tid_ = threadIdx.x; asm volatile("" : "+v"(tid_));
    const int tid = tid_, wid = __builtin_amdgcn_readfirstlane(tid >> 6), lane = tid & 63, wr = wid >> 2, wc = wid & 3, fr = lane & 15, fq = lane >> 4;
    const int K = g.K;
    unsigned voffA[2], voffB[2];
#pragma unroll
    for (int i = 0; i < 2; ++i) { int R, C; stage_rc(tid * 16 + i * 8192, R, C); const int Rb = Epi::PERM ? ((R & ~31) + perm32(R & 31)) : R;
        voffA[i] = (unsigned)(R * K + C) * 2u; voffB[i] = (unsigned)(Rb * K + C) * 2u; }
    const size_t kstep = (size_t)(BK * 2);
    const size_t hstep = (size_t)HALF * K * 2;
    const size_t tstep = 2 * hstep;
    const unsigned ldsw = (unsigned)wid * 1024u;
    const int aoff = lds_byte(wr * 64 + fr, fq * 8), boff = lds_byte(wc * 32 + fr, fq * 8);
#define PG8_SA(b, h) (((b) * 2 + (h)) * HTB)
#define PG8_SB(b, h) ((4 + (b) * 2 + (h)) * HTB)
#define PG8_STAGE(bufoff, gbase, voff) do { _Pragma("unroll") for (int _i = 0; _i < 2; ++_i) \
        __builtin_amdgcn_global_load_lds((const unsigned*)((const char*)(gbase) + (voff)[_i]), (LAS unsigned*)(lds + (bufoff) + ldsw + _i * 8192), 16, 0, 0); } while (0)
#define PG8_LDA(dst, b, h) do { _Pragma("unroll") for (int m = 0; m < 4; ++m) _Pragma("unroll") for (int k = 0; k < 2; ++k) dst[m][k] = *(const LAS bf16x8*)(lds + PG8_SA(b, h) + aoff + m * 2048 + k * 1024); } while (0)
#define PG8_LDB(dst, b, h) do { _Pragma("unroll") for (int n = 0; n < 2; ++n) _Pragma("unroll") for (int k = 0; k < 2; ++k) dst[n][k] = *(const LAS bf16x8*)(lds + PG8_SB(b, h) + boff + n * 2048 + k * 1024); } while (0)
#define PG8_MMA(ai, bj, At, Bt) do { __builtin_amdgcn_s_setprio(1); _Pragma("unroll") for (int m = 0; m < 4; ++m) _Pragma("unroll") for (int n = 0; n < 2; ++n) _Pragma("unroll") for (int k = 0; k < 2; ++k) \
        acc[ai][bj][m][n] = __builtin_amdgcn_mfma_f32_16x16x32_bf16(Bt[n][k], At[m][k], acc[ai][bj][m][n], 0, 0, 0); __builtin_amdgcn_s_setprio(0); } while (0)
#define PG8_WAIT_V(n) asm volatile("s_waitcnt vmcnt(" #n ")" ::: "memory")
#define PG8_WAIT_L(n) asm volatile("s_waitcnt lgkmcnt(" #n ")" ::: "memory")
#define PG8_BAR __builtin_amdgcn_s_barrier()
#define PG8_SCHED __builtin_amdgcn_sched_barrier(0)
    Unit cur, nxt; int ui = 0;
    if (!S.next(0, cur)) return;
    f32x4 acc[2][2][4][2];
#pragma unroll
    for (int a = 0; a < 2; ++a)
#pragma unroll
        for (int b = 0; b < 2; ++b)
#pragma unroll
            for (int m = 0; m < 4; ++m)
#pragma unroll
                for (int n = 0; n < 2; ++n) acc[a][b][m][n] = (f32x4){0.f, 0.f, 0.f, 0.f};
    bf16x8 At[4][2], B0[2][2], B1[2][2];
    const char* cA = (const char*)g.A + (size_t)cur.z * g.zA + (size_t)cur.pm * tstep + (size_t)cur.k0 * kstep; const char* cB = (const char*)g.Bt + (size_t)cur.z * g.zB + (size_t)cur.pn * tstep + (size_t)cur.k0 * kstep;
    int nt = cur.nk;
    PG8_STAGE(PG8_SB(0, 0), cB, voffB); PG8_STAGE(PG8_SA(0, 0), cA, voffA); PG8_STAGE(PG8_SB(0, 1), cB + hstep, voffB); PG8_STAGE(PG8_SA(0, 1), cA + hstep, voffA);
    if (wr == 1) PG8_BAR;
    PG8_WAIT_V(4); PG8_BAR;
    PG8_STAGE(PG8_SB(1, 0), cB + kstep, voffB); PG8_STAGE(PG8_SA(1, 0), cA + kstep, voffA); PG8_STAGE(PG8_SB(1, 1), cB + hstep + kstep, voffB);
    PG8_WAIT_V(6); PG8_BAR;
    for (;;) {
        const bool has_next = S.next(ui + 1, nxt);
        const char* nA = has_next ? (const char*)g.A + (size_t)nxt.z * g.zA + (size_t)nxt.pm * tstep + (size_t)nxt.k0 * kstep : cA; const char* nB = has_next ? (const char*)g.Bt + (size_t)nxt.z * g.zB + (size_t)nxt.pn * tstep + (size_t)nxt.k0 * kstep : cB;
        for (int t = 0; t < nt; t += 2) {
            const bool last = (t == nt - 2);
            const char* a1 = cA + (size_t)(t + 1) * kstep;
            const char* a2 = last ? nA : cA + (size_t)(t + 2) * kstep; const char* b2 = last ? nB : cB + (size_t)(t + 2) * kstep;
            const char* a3 = a2 + kstep; const char* b3 = b2 + kstep;
            PG8_LDB(B0, 0, 0); PG8_SCHED; PG8_LDA(At, 0, 0); PG8_STAGE(PG8_SA(1, 1), a1 + hstep, voffA);
            PG8_WAIT_L(8); PG8_BAR; PG8_WAIT_L(0); PG8_MMA(0, 0, At, B0); PG8_BAR; PG8_SCHED;
            PG8_LDB(B1, 0, 1); PG8_STAGE(PG8_SB(0, 0), b2, voffB);
            PG8_BAR; PG8_WAIT_L(0); PG8_MMA(0, 1, At, B1); PG8_BAR;
            PG8_LDA(At, 0, 1); PG8_STAGE(PG8_SA(0, 0), a2, voffA);
            PG8_BAR; PG8_WAIT_L(0); PG8_MMA(1, 0, At, B0); PG8_BAR; PG8_SCHED;
            PG8_STAGE(PG8_SB(0, 1), b2 + hstep, voffB);
            PG8_WAIT_V(6); PG8_BAR; PG8_MMA(1, 1, At, B1); PG8_BAR;
            PG8_LDB(B0, 1, 0); PG8_SCHED; PG8_LDA(At, 1, 0); PG8_STAGE(PG8_SA(0, 1), a2 + hstep, voffA);
            PG8_WAIT_L(8); PG8_BAR; PG8_WAIT_L(0); PG8_MMA(0, 0, At, B0); PG8_BAR; PG8_SCHED;
            PG8_LDB(B1, 1, 1); PG8_STAGE(PG8_SB(1, 0), b3, voffB);
            PG8_BAR; PG8_WAIT_L(0); PG8_MMA(0, 1, At, B1); PG8_BAR;
            PG8_LDA(At, 1, 1); PG8_STAGE(PG8_SA(1, 0), a3, voffA);
            PG8_BAR; PG8_WAIT_L(0); PG8_MMA(1, 0, At, B0); PG8_BAR; PG8_SCHED;
            PG8_STAGE(PG8_SB(1, 1), b3 + hstep, voffB);
            PG8_WAIT_V(6); PG8_BAR; PG8_MMA(1, 1, At, B1); PG8_BAR;
        }
        E(acc, cur, wr, wc, fr, fq);
        if (!has_next) break;
#pragma unroll
        for (int a = 0; a < 2; ++a)
#pragma unroll
            for (int b = 0; b < 2; ++b)
#pragma unroll
                for (int m = 0; m < 4; ++m)
#pragma unroll
                    for (int n = 0; n < 2; ++n) acc[a][b][m][n] = (f32x4){0.f, 0.f, 0.f, 0.f};
        cur = nxt; cA = nA; cB = nB; nt = cur.nk; ++ui;
    }
    PG8_WAIT_V(0);
    if (wr == 0) PG8_BAR;
    PG8_BAR;
#undef PG8_SA
#undef PG8_SB
#undef PG8_STAGE
#undef PG8_LDA
#undef PG8_LDB
#undef PG8_MMA
#undef PG8_WAIT_V
#undef PG8_WAIT_L
#undef PG8_BAR
#undef PG8_SCHED
}

struct EpiBF {
    static constexpr bool PERM = true;
    bf16_t* O; size_t zO; float* P; int nz;
    __device__ __forceinline__ void operator()(const f32x4 (&acc)[2][2][4][2], const Unit& u, int wr, int wc, int fr, int fq) const {
        const int col0 = u.pn * BM + wc * 32 + 8 * fq;
        if (u.part < 0) {
            const int row0 = u.pm * BM + wr * 64 + fr; bf16_t* base = O + (size_t)u.z * zO;
#pragma unroll
            for (int ai = 0; ai < 2; ++ai)
#pragma unroll
                for (int m = 0; m < 4; ++m) { bf16_t* rowp = base + (size_t)(row0 + ai * HALF + m * 16) * D + col0;
#pragma unroll
                    for (int bj = 0; bj < 2; ++bj) { const f32x4 v0 = acc[ai][bj][m][0], v1 = acc[ai][bj][m][1];
                        u32x4 w; w.x = cvt_pk_bf16(v0[0], v0[1]); w.y = cvt_pk_bf16(v0[2], v0[3]); w.z = cvt_pk_bf16(v1[0], v1[1]); w.w = cvt_pk_bf16(v1[2], v1[3]);
                        *(u32x4*)(rowp + bj * HALF) = w; } }
        } else {
            const int row0 = wr * 64 + fr; float* base = P + (size_t)(u.part * nz + u.z) * (BM * D);
#pragma unroll
            for (int ai = 0; ai < 2; ++ai)
#pragma unroll
                for (int m = 0; m < 4; ++m) { float* rowp = base + (size_t)(row0 + ai * HALF + m * 16) * D + col0;
#pragma unroll
                    for (int bj = 0; bj < 2; ++bj) { *(f32x4*)(rowp + bj * HALF) = acc[ai][bj][m][0]; *(f32x4*)(rowp + bj * HALF + 4) = acc[ai][bj][m][1]; } }
        }
    }
};
struct EpiGU {
    static constexpr bool PERM = true;
    bf16_t* O; bool dry;
    __device__ __forceinline__ void operator()(const f32x4 (&acc)[2][2][4][2], const Unit& u, int wr, int wc, int fr, int fq) const {
        if (dry) return;
        const int row0 = u.pm * BM + wr * 64 + fr, col0 = u.pn * HALF + wc * 32 + 8 * fq;
#pragma unroll
        for (int ai = 0; ai < 2; ++ai)
#pragma unroll
            for (int m = 0; m < 4; ++m) { bf16_t* rowp = O + (size_t)(row0 + ai * HALF + m * 16) * DFF + col0;
                float v[8];
#pragma unroll
                for (int n = 0; n < 2; ++n)
#pragma unroll
                    for (int j = 0; j < 4; ++j) { const float gt = acc[ai][0][m][n][j], up = acc[ai][1][m][n][j]; v[n * 4 + j] = gt * sigm(gt) * up; }
                u32x4 w; w.x = cvt_pk_bf16(v[0], v[1]); w.y = cvt_pk_bf16(v[2], v[3]); w.z = cvt_pk_bf16(v[4], v[5]); w.w = cvt_pk_bf16(v[6], v[7]);
                *(u32x4*)rowp = w; }
    }
};
struct EpiIN {
    static constexpr bool PERM = true;
    bf16_t* U;
    __device__ __forceinline__ void operator()(const f32x4 (&acc)[2][2][4][2], const Unit& u, int wr, int wc, int fr, int fq) const {
        const int row0 = u.pm * BM + wr * 64 + fr;
        if (u.pn >= 4 && u.pn < 12) {
            const int col0 = (u.pn - 4) * HALF + wc * 32 + 8 * fq; bf16_t* base = U + 2 * SLOT;
#pragma unroll
            for (int ai = 0; ai < 2; ++ai)
#pragma unroll
                for (int m = 0; m < 4; ++m) { bf16_t* rowp = base + (size_t)(row0 + ai * HALF + m * 16) * D + col0;
                    const f32x4 v0 = acc[ai][0][m][0] * acc[ai][1][m][0], v1 = acc[ai][0][m][1] * acc[ai][1][m][1];
                    u32x4 w; w.x = cvt_pk_bf16(v0[0], v0[1]); w.y = cvt_pk_bf16(v0[2], v0[3]); w.z = cvt_pk_bf16(v1[0], v1[1]); w.w = cvt_pk_bf16(v1[2], v1[3]);
                    *(u32x4*)rowp = w; }
        } else {
            int slot, ct; if (u.pn < 4) { slot = 0; ct = u.pn; } else { const int sg = (u.pn - 12) >> 2; slot = sg == 0 ? 3 : (sg == 1 ? 1 : sg + 2); ct = (u.pn - 12) & 3; }
            const int col0 = ct * BM + wc * 32 + 8 * fq; bf16_t* base = U + (size_t)slot * SLOT;
#pragma unroll
            for (int ai = 0; ai < 2; ++ai)
#pragma unroll
                for (int m = 0; m < 4; ++m) { bf16_t* rowp = base + (size_t)(row0 + ai * HALF + m * 16) * D + col0;
#pragma unroll
                    for (int bj = 0; bj < 2; ++bj) { const f32x4 v0 = acc[ai][bj][m][0], v1 = acc[ai][bj][m][1];
                        u32x4 w; w.x = cvt_pk_bf16(v0[0], v0[1]); w.y = cvt_pk_bf16(v0[2], v0[3]); w.z = cvt_pk_bf16(v1[0], v1[1]); w.w = cvt_pk_bf16(v1[2], v1[3]);
                        *(u32x4*)(rowp + bj * HALF) = w; } }
        }
    }
};
}

__device__ __forceinline__ int conv_map(int mode, int n) {
    if (mode == 0) return n;
    if (mode == 1) return 256 * (n >> 7) + (n & 127);
    if (mode == 2) return 256 * (n >> 7) + 128 + (n & 127);
    const int seg = n >> 10, j = n & 1023;
    if (seg == 0) return j;
    if (seg == 1) return 1024 + 256 * (j >> 7) + (j & 127);
    if (seg == 2) return 1024 + 256 * (j >> 7) + 128 + (j & 127);
    return 3072 + (seg - 3) * 1024 + j;
}
struct ConvE { const float* src; bf16_t* dst; const float* gk; int K, N, mode, t; };
__device__ __forceinline__ bool conv_decode(const Params& p, int set, int T, ConvE& e) {
    if (set < 2) {
        const int a = set ? 27 : 8; const float* gk = p.in[set ? 25 : 6];
        if (T < 704)       { e.src = p.in[a];     e.dst = (bf16_t*)(p.ws + WS_WGU); e.gk = gk;      e.K = 1024; e.N = 2816; e.mode = 1; e.t = T; }
        else if (T < 1408) { e.src = p.in[a + 1]; e.dst = (bf16_t*)(p.ws + WS_WGU); e.gk = gk;      e.K = 1024; e.N = 2816; e.mode = 2; e.t = T - 704; }
        else if (T < 2112) { e.src = p.in[a + 2]; e.dst = (bf16_t*)(p.ws + WS_WD);  e.gk = nullptr; e.K = 2816; e.N = 1024; e.mode = 0; e.t = T - 1408; }
        else return false;
    } else {
        if (T < 1792)      { e.src = p.in[13]; e.dst = (bf16_t*)(p.ws + WS_WIN); e.gk = p.in[11]; e.K = 1024; e.N = 7168; e.mode = 3; e.t = T; }
        else if (T < 2048) { e.src = p.in[15]; e.dst = (bf16_t*)(p.ws + WS_WOAB); e.gk = nullptr; e.K = 1024; e.N = 1024; e.mode = 0; e.t = T - 1792; }
        else if (T < 2304) { e.src = p.in[23]; e.dst = (bf16_t*)(p.ws + WS_WOAB + (size_t)1024 * 1024 * 2); e.gk = nullptr; e.K = 1024; e.N = 1024; e.mode = 0; e.t = T - 2048; }
        else if (T < 2560) { e.src = p.in[24]; e.dst = (bf16_t*)(p.ws + WS_WO);  e.gk = nullptr;  e.K = 1024; e.N = 1024; e.mode = 0; e.t = T - 2304; }
        else return false;
    }
    return true;
}
__device__ __forceinline__ void conv_load(const ConvE& e, int tid, f32x4& v0, f32x4& v1) {
    const int ntn = e.N >> 6; const int tk = e.t / ntn, tn = e.t - tk * ntn;
    const float* s0 = e.src + (size_t)(tk * 64 + (tid >> 4)) * e.N + tn * 64 + (tid & 15) * 4;
    v0 = *(const f32x4*)s0; v1 = *(const f32x4*)(s0 + (size_t)32 * e.N);
}
__device__ __forceinline__ void conv_emit(const ConvE& e, int tid, const f32x4& v0, const f32x4& v1, LAS float* sl) {
    const int ntn = e.N >> 6; const int tk = e.t / ntn, tn = e.t - tk * ntn; const int k0 = tk * 64, n0 = tn * 64;
    { LAS float* d = sl + (tid >> 4) * 65 + (tid & 15) * 4; d[0] = v0[0]; d[1] = v0[1]; d[2] = v0[2]; d[3] = v0[3]; d += 32 * 65; d[0] = v1[0]; d[1] = v1[1]; d[2] = v1[2]; d[3] = v1[3]; }
    __syncthreads();
    const int n = tid >> 3, ko = (tid & 7) * 8;
    float f[8];
#pragma unroll
    for (int i = 0; i < 8; ++i) f[i] = sl[(ko + i) * 65 + n];
    if (e.gk) {
        const f32x4 g0 = *(const f32x4*)(e.gk + k0 + ko), g1 = *(const f32x4*)(e.gk + k0 + ko + 4);
#pragma unroll
        for (int i = 0; i < 4; ++i) { f[i] *= g0[i]; f[4 + i] *= g1[i]; }
    }
    u32x4 w; w.x = cvt_pk_bf16(f[0], f[1]); w.y = cvt_pk_bf16(f[2], f[3]); w.z = cvt_pk_bf16(f[4], f[5]); w.w = cvt_pk_bf16(f[6], f[7]);
    *(u32x4*)(e.dst + (size_t)conv_map(e.mode, n0 + n) * e.K + k0 + ko) = w;
    __syncthreads();
}
__device__ __forceinline__ void convert_set(const Params& p, int set, LAS unsigned char* lds, int tid) {
    ConvE e, en; f32x4 v0, v1, n0 = {0.f, 0.f, 0.f, 0.f}, n1 = {0.f, 0.f, 0.f, 0.f};
    int T = blockIdx.x;
    bool have = conv_decode(p, set, T, e);
    if (have) conv_load(e, tid, v0, v1);
    while (have) {
        T += gridDim.x;
        const bool hn = conv_decode(p, set, T, en);
        if (hn) conv_load(en, tid, n0, n1);
        conv_emit(e, tid, v0, v1, (LAS float*)lds);
        e = en; v0 = n0; v1 = n1; have = hn;
    }
}

__device__ __forceinline__ void norm_phase(const Params& p, int mode, int tid, bool dry, int nsplit) {
    const int lane = tid & 63, gw = blockIdx.x * 8 + (tid >> 6), nw = gridDim.x * 8;
    const float* gpost = mode == 1 ? p.in[7] : (mode == 2 ? p.in[12] : p.in[26]);
    const float cc = mode == 2 ? 1.0f : 0.5f;
    const bf16_t* Yb = (const bf16_t*)(p.ws + WS_Y); const float* PY = (const float*)(p.ws + WS_PY); bf16_t* H = (bf16_t*)(p.ws + WS_H); float* SC = (float*)(p.ws + WS_SC);
    for (int r = gw; r < M; r += nw) {
        f32x4 xv[4];
        if (mode == 0) {
            const float* xin = x0row(p, r);
#pragma unroll
            for (int q = 0; q < 4; ++q) xv[q] = *(const f32x4*)(xin + lane * 4 + 256 * q);
        } else {
            const float sc = SC[r];
#pragma unroll
            for (int q = 0; q < 4; ++q) { const u32x2 w = *(const u32x2*)(H + (size_t)r * D + lane * 4 + 256 * q); xv[q] = (f32x4){bflo(w.x), bfhi(w.x), bflo(w.y), bfhi(w.y)} * sc; }
            f32x4 yv[4]; float ss = 0.f;
            if (r < MAINR) {
#pragma unroll
                for (int q = 0; q < 4; ++q) { const u32x2 w = *(const u32x2*)(Yb + (size_t)r * D + lane * 4 + 256 * q); yv[q] = (f32x4){bflo(w.x), bfhi(w.x), bflo(w.y), bfhi(w.y)}; }
            } else {
#pragma unroll
                for (int q = 0; q < 4; ++q) yv[q] = (f32x4){0.f, 0.f, 0.f, 0.f};
                for (int ks = 0; ks < nsplit; ++ks) {
#pragma unroll
                    for (int q = 0; q < 4; ++q) yv[q] += *(const f32x4*)(PY + ((size_t)ks * 256 + (r - MAINR)) * D + lane * 4 + 256 * q);
                }
            }
#pragma unroll
            for (int q = 0; q < 4; ++q) ss += yv[q][0] * yv[q][0] + yv[q][1] * yv[q][1] + yv[q][2] * yv[q][2] + yv[q][3] * yv[q][3];
            ss = wave_sum(ss, lane);
            const float rs = cc * rsqrtf(ss * (1.0f / D) + EPS);
#pragma unroll
            for (int q = 0; q < 4; ++q) xv[q] += yv[q] * rs * *(const f32x4*)(gpost + lane * 4 + 256 * q);
        }
        if (mode == 3) {
            float* xo;
            if (r >= MP) xo = p.out + O_YS + (size_t)(r - MP) * D;
            else { const int b = r / TP, t = r - b * TP; if (t < NMETA) continue; xo = p.out + O_YP + ((size_t)b * SEQ + (t - NMETA)) * D; }
#pragma unroll
            for (int q = 0; q < 4; ++q) *(f32x4*)(xo + lane * 4 + 256 * q) = xv[q];
        } else {
            float ss = 0.f;
#pragma unroll
            for (int q = 0; q < 4; ++q) ss += xv[q][0] * xv[q][0] + xv[q][1] * xv[q][1] + xv[q][2] * xv[q][2] + xv[q][3] * xv[q][3];
            ss = wave_sum(ss, lane);
            const float ms = ss * (1.0f / D) + EPS; const float rs = rsqrtf(ms);
            if (!dry) {
#pragma unroll
                for (int q = 0; q < 4; ++q) { const f32x4 hv = xv[q] * rs; u32x2 w; w.x = cvt_pk_bf16(hv[0], hv[1]); w.y = cvt_pk_bf16(hv[2], hv[3]);
                    *(u32x2*)(H + (size_t)r * D + lane * 4 + 256 * q) = w; }
                if (lane == 0) SC[r] = ms * rs;
            }
        }
    }
}

constexpr int WL_BYTES = 11264;
__device__ __forceinline__ void scan_item(const Params& p, int b, int j, int h, LAS unsigned char* wl, const LAS unsigned char* wlds, int lane, bool dry) {
    bf16_t* U = (bf16_t*)(p.ws + WS_U);
    const bf16_t* bx = U + 3 * SLOT; bf16_t* bg = U + 1 * SLOT; bf16_t* pp = (bf16_t*)p.out;
    float* summ = (float*)(p.ws + WS_SUMM);
    const int c = h * 64 + lane, fr = lane & 15, fq = lane >> 4;
    const size_t row0 = (size_t)b * TP + (size_t)j * CHUNK;
    const bf16_t* bx0 = bx + row0 * D; bf16_t* bg0 = bg + row0 * D; bf16_t* pp0 = pp + row0 * D;
    const LAS unsigned char* wq = wlds + fr * 144 + fq * 16;
    float brv[4], biv[4], lcv[4];
#pragma unroll
    for (int nt = 0; nt < 4; ++nt) { const int ch = h * 64 + nt * 16 + fr; brv[nt] = p.in[19][ch]; biv[nt] = p.in[21][ch]; lcv[nt] = -8.0f * log1pf(expf(-p.in[22][ch])); }
    const float w0 = p.in[16][c], w1 = p.in[16][D + c], w2 = p.in[16][2 * D + c], w3 = p.in[16][3 * D + c], cbias = p.in[17][c];
    float xm3 = 0.f, xm2 = 0.f, xm1 = 0.f;
    if (j > 0) { xm3 = bf2f(bx0[-3 * D + c]); xm2 = bf2f(bx0[-2 * D + c]); xm1 = bf2f(bx0[-1 * D + c]); }
    float hh = 0.f, ap = 1.f;
    LAS unsigned short* cbT = (LAS unsigned short*)wl;
    LAS float* xu = (LAS float*)(wl + 2304);
    LAS float* aS = (LAS float*)(wl + 2304 + 4352);
    bf16_t xr[16], gr[16], xn[16];
#pragma unroll
    for (int tt = 0; tt < 16; ++tt) xr[tt] = bx0[tt * D + c];
#pragma unroll
    for (int g = 0; g < 3; ++g) {
        const int r0 = g * 16;
#pragma unroll
        for (int tt = 0; tt < 16; ++tt) gr[tt] = bg0[(r0 + tt) * D + c];
        if (g < 2) {
#pragma unroll
            for (int tt = 0; tt < 16; ++tt) xn[tt] = bx0[(r0 + 16 + tt) * D + c];
        }
#pragma unroll
        for (int tt = 0; tt < 16; ++tt) { const float x = bf2f(xr[tt]); const float cb = w0 * xm3 + w1 * xm2 + w2 * xm1 + w3 * x + cbias; xm3 = xm2; xm2 = xm1; xm1 = x;
            cbT[tt * 72 + lane] = f2bf(cb); xu[tt * 68 + lane] = cb; }
        __builtin_amdgcn_wave_barrier();
        const bf16x8 a0 = *(const LAS bf16x8*)(cbT + fr * 72 + fq * 8), a1 = *(const LAS bf16x8*)(cbT + fr * 72 + 32 + fq * 8);
        f32x4 accR[4], accI[4];
#pragma unroll
        for (int nt = 0; nt < 4; ++nt) {
            const bf16x8 r0w = *(const LAS bf16x8*)(wq + nt * 2304), r1w = *(const LAS bf16x8*)(wq + nt * 2304 + 64);
            const bf16x8 i0w = *(const LAS bf16x8*)(wq + 9216 + nt * 2304), i1w = *(const LAS bf16x8*)(wq + 9216 + nt * 2304 + 64);
            accR[nt] = __builtin_amdgcn_mfma_f32_16x16x32_bf16(a0, r0w, (f32x4){0.f, 0.f, 0.f, 0.f}, 0, 0, 0);
            accR[nt] = __builtin_amdgcn_mfma_f32_16x16x32_bf16(a1, r1w, accR[nt], 0, 0, 0);
            accI[nt] = __builtin_amdgcn_mfma_f32_16x16x32_bf16(a0, i0w, (f32x4){0.f, 0.f, 0.f, 0.f}, 0, 0, 0);
            accI[nt] = __builtin_amdgcn_mfma_f32_16x16x32_bf16(a1, i1w, accI[nt], 0, 0, 0);
        }
#pragma unroll
        for (int nt = 0; nt < 4; ++nt)
#pragma unroll
            for (int i = 0; i < 4; ++i) { const int idx = (fq * 4 + i) * 68 + nt * 16 + fr; const float x = xu[idx];
                const float r = sigm(accR[nt][i] + brv[nt]), ig = sigm(accI[nt][i] + biv[nt]);
                const float la = lcv[nt] * r; const float a = __expf(la);
                const float z2 = 2.0f * la;
                const float m2s = -z2 * (1.0f + z2 * (0.5f + z2 * (0.16666667f + z2 * (0.041666668f + z2 * (0.0083333338f + z2 * 0.0013888889f)))));
                const float m2 = z2 > -0.25f ? m2s : 1.0f - a * a;
                xu[idx] = __builtin_amdgcn_sqrtf(m2) * ig * x; aS[idx] = a; }
        __builtin_amdgcn_wave_barrier();
#pragma unroll
        for (int tt = 0; tt < 16; ++tt) { const float a = aS[tt * 68 + lane], uu = xu[tt * 68 + lane]; hh = a * hh + uu; ap *= a;
            const float gl = gelu_tanh(bf2f(gr[tt]));
            if (!dry) bg0[(r0 + tt) * D + c] = f2bf(gl * hh);
            pp0[(r0 + tt) * D + c] = f2bf(gl * ap); }
        __builtin_amdgcn_wave_barrier();
        if (g < 2) {
#pragma unroll
            for (int tt = 0; tt < 16; ++tt) xr[tt] = xn[tt];
        }
    }
    *(float2*)(summ + (((size_t)b * NCH + j) * D + c) * 2) = make_float2(ap, hh);
    if (j == NCH - 1) { p.out[O_CBP + ((size_t)b * 3 + 0) * D + c] = xm3; p.out[O_CBP + ((size_t)b * 3 + 1) * D + c] = xm2; p.out[O_CBP + ((size_t)b * 3 + 2) * D + c] = xm1; }
}
__device__ __forceinline__ void sample_item(const Params& p, int k, int h, LAS unsigned char* wl, const LAS unsigned char* wlds, int lane) {
    bf16_t* U = (bf16_t*)(p.ws + WS_U);
    const int c = h * 64 + lane, fr = lane & 15, fq = lane >> 4;
    const size_t row0 = (size_t)MP + (size_t)k * 16; const int s0 = k * 16;
    const bf16_t* bx0 = U + 3 * SLOT + row0 * D; bf16_t* bg0 = U + 1 * SLOT + row0 * D;
    const LAS unsigned char* wq = wlds + fr * 144 + fq * 16;
    float brv[4], biv[4], lcv[4];
#pragma unroll
    for (int nt = 0; nt < 4; ++nt) { const int ch = h * 64 + nt * 16 + fr; brv[nt] = p.in[19][ch]; biv[nt] = p.in[21][ch]; lcv[nt] = -8.0f * log1pf(expf(-p.in[22][ch])); }
    const float w0 = p.in[16][c], w1 = p.in[16][D + c], w2 = p.in[16][2 * D + c], w3 = p.in[16][3 * D + c], cbias = p.in[17][c];
    LAS unsigned short* cbT = (LAS unsigned short*)wl;
    LAS float* xu = (LAS float*)(wl + 2304);
    LAS float* aS = (LAS float*)(wl + 2304 + 4352);
    const float* sb = p.in[3] + (size_t)s0 * 3 * D + c;
#pragma unroll
    for (int tt = 0; tt < 16; ++tt) {
        const float x = bf2f(bx0[tt * D + c]); const float t0 = sb[(tt * 3 + 0) * D], t1 = sb[(tt * 3 + 1) * D], t2 = sb[(tt * 3 + 2) * D];
        const float cb = w0 * t0 + w1 * t1 + w2 * t2 + w3 * x + cbias;
        float* ob = p.out + O_CBS + ((size_t)(s0 + tt) * 3) * D + c; ob[0] = t1; ob[D] = t2; ob[2 * D] = x;
        cbT[tt * 72 + lane] = f2bf(cb); xu[tt * 68 + lane] = cb;
    }
    __builtin_amdgcn_wave_barrier();
    const bf16x8 a0 = *(const LAS bf16x8*)(cbT + fr * 72 + fq * 8), a1 = *(const LAS bf16x8*)(cbT + fr * 72 + 32 + fq * 8);
    f32x4 accR[4], accI[4];
#pragma unroll
    for (int nt = 0; nt < 4; ++nt) {
        const bf16x8 r0w = *(const LAS bf16x8*)(wq + nt * 2304), r1w = *(const LAS bf16x8*)(wq + nt * 2304 + 64);
        const bf16x8 i0w = *(const LAS bf16x8*)(wq + 9216 + nt * 2304), i1w = *(const LAS bf16x8*)(wq + 9216 + nt * 2304 + 64);
        accR[nt] = __builtin_amdgcn_mfma_f32_16x16x32_bf16(a0, r0w, (f32x4){0.f, 0.f, 0.f, 0.f}, 0, 0, 0);
        accR[nt] = __builtin_amdgcn_mfma_f32_16x16x32_bf16(a1, r1w, accR[nt], 0, 0, 0);
        accI[nt] = __builtin_amdgcn_mfma_f32_16x16x32_bf16(a0, i0w, (f32x4){0.f, 0.f, 0.f, 0.f}, 0, 0, 0);
        accI[nt] = __builtin_amdgcn_mfma_f32_16x16x32_bf16(a1, i1w, accI[nt], 0, 0, 0);
    }
#pragma unroll
    for (int nt = 0; nt < 4; ++nt)
#pragma unroll
        for (int i = 0; i < 4; ++i) { const int idx = (fq * 4 + i) * 68 + nt * 16 + fr; const float x = xu[idx];
            const float r = sigm(accR[nt][i] + brv[nt]), ig = sigm(accI[nt][i] + biv[nt]);
            const float la = lcv[nt] * r; const float a = __expf(la);
            const float z2 = 2.0f * la;
            const float m2s = -z2 * (1.0f + z2 * (0.5f + z2 * (0.16666667f + z2 * (0.041666668f + z2 * (0.0083333338f + z2 * 0.0013888889f)))));
            const float m2 = z2 > -0.25f ? m2s : 1.0f - a * a;
            xu[idx] = __builtin_amdgcn_sqrtf(m2) * ig * x; aS[idx] = a; }
    __builtin_amdgcn_wave_barrier();
#pragma unroll
    for (int tt = 0; tt < 16; ++tt) {
        const float hn = aS[tt * 68 + lane] * p.in[4][(size_t)(s0 + tt) * D + c] + xu[tt * 68 + lane];
        p.out[O_RGS + (size_t)(s0 + tt) * D + c] = hn;
        bg0[tt * D + c] = f2bf(gelu_tanh(bf2f(bg0[tt * D + c])) * hn);
    }
    __builtin_amdgcn_wave_barrier();
}
__device__ __forceinline__ void scan_phase(const Params& p, LAS unsigned char* lds, int tid, bool dry) {
    const int wid = __builtin_amdgcn_readfirstlane(tid >> 6), lane = tid & 63;
    LAS unsigned char* wl = lds + wid * WL_BYTES;
    LAS unsigned char* wlds = lds + 8 * WL_BYTES;
    const int h = blockIdx.x & 15;
    {
        const bf16_t* wt = (const bf16_t*)(p.ws + WS_WRG);
#pragma unroll
        for (int q = 0; q < 2; ++q) { const int e = tid + q * 512, g = e >> 9, jrow = (e >> 3) & 63, pc = e & 7;
            *(LAS u32x4*)(wlds + g * 9216 + jrow * 144 + pc * 16) = *(const u32x4*)(wt + (size_t)g * 65536 + (size_t)(h * 64 + jrow) * 64 + pc * 8); }
    }
    __syncthreads();
    const int nbh = gridDim.x >> 4;
    for (int it = (blockIdx.x >> 4) * 8 + wid; it < NB * NCH; it += nbh * 8) scan_item(p, it / NCH, it % NCH, h, wl, wlds, lane, dry);
    if (!dry && (int)(blockIdx.x >> 4) == nbh - 1) {
        for (int k = wid; k < NS / 16; k += 8) sample_item(p, k, h, wl, wlds, lane);
    }
    __syncthreads();
}
__device__ __forceinline__ void fix_phase(const Params& p, LAS unsigned char* lds, int tid, bool dry) {
    bf16_t* zb = (bf16_t*)(p.ws + WS_U) + 1 * SLOT; const bf16_t* pp = (const bf16_t*)p.out;
    const float* summ = (const float*)(p.ws + WS_SUMM);
    LAS float* cs = (LAS float*)lds;
    for (int it = blockIdx.x; it < NB * (NCH - 1); it += gridDim.x) {
        const int b = it / (NCH - 1), j = it % (NCH - 1) + 1;
#pragma unroll
        for (int cq = 0; cq < 2; ++cq) {
            const int c = tid + cq * 512; const float* sp = summ + ((size_t)b * NCH * D + c) * 2; float hh = 0.f;
            for (int i0 = 0; i0 < j; i0 += 16) {
                float va[16], vh[16];
#pragma unroll
                for (int k = 0; k < 16; ++k) { if (i0 + k < j) { const float2 v = *(const float2*)(sp + (size_t)(i0 + k) * D * 2); va[k] = v.x; vh[k] = v.y; } else { va[k] = 1.f; vh[k] = 0.f; } }
#pragma unroll
                for (int k = 0; k < 16; ++k) hh = va[k] * hh + vh[k];
            }
            cs[c] = hh;
            if (j == NCH - 1) { const float2 v = *(const float2*)(sp + (size_t)j * D * 2); p.out[O_RGP + (size_t)b * D + c] = v.x * hh + v.y; }
        }
        __syncthreads();
        const size_t row0 = (size_t)b * TP + (size_t)j * CHUNK;
#pragma unroll 4
        for (int q = 0; q < CHUNK * 128 / 512; ++q) {
            const int e = tid + q * 512, tt = e >> 7, vc = e & 127; const size_t o = (row0 + tt) * D + vc * 8;
            const u32x4 zq = *(const u32x4*)(zb + o), pq = *(const u32x4*)(pp + o);
            const f32x4 c0 = *(const LAS f32x4*)(cs + vc * 8), c1 = *(const LAS f32x4*)(cs + vc * 8 + 4);
            u32x4 w;
            w.x = cvt_pk_bf16(bflo(zq.x) + bflo(pq.x) * c0[0], bfhi(zq.x) + bfhi(pq.x) * c0[1]); w.y = cvt_pk_bf16(bflo(zq.y) + bflo(pq.y) * c0[2], bfhi(zq.y) + bfhi(pq.y) * c0[3]);
            w.z = cvt_pk_bf16(bflo(zq.z) + bflo(pq.z) * c1[0], bfhi(zq.z) + bfhi(pq.z) * c1[1]); w.w = cvt_pk_bf16(bflo(zq.w) + bflo(pq.w) * c1[2], bfhi(zq.w) + bfhi(pq.w) * c1[3]);
            if (!dry) *(u32x4*)(zb + o) = w;
        }
        __syncthreads();
    }
}
__device__ __forceinline__ void za_phase(const Params& p, int tid, bool dry) {
    bf16_t* U = (bf16_t*)(p.ws + WS_U); bf16_t* ab = U; const bf16_t* ca = U + 2 * SLOT;
    const float* cw = p.in[14];
    for (int idx = blockIdx.x * 512 + tid; idx < NB * 129 * 128; idx += gridDim.x * 512) {
        const int vc = idx & 127, tb = (idx >> 7) % 129, b = idx / (128 * 129); const int c0 = vc * 8;
        float w[3][8];
#pragma unroll
        for (int k = 0; k < 3; ++k) { const f32x4 a = *(const f32x4*)(cw + k * D + c0), bq = *(const f32x4*)(cw + k * D + c0 + 4);
#pragma unroll
            for (int e = 0; e < 4; ++e) { w[k][e] = a[e]; w[k][4 + e] = bq[e]; } }
        const size_t r0 = (size_t)b * TP + (size_t)tb * 16;
        float p2[8], p1[8];
        if (tb > 0) { const u32x4 q2 = *(const u32x4*)(ca + (r0 - 2) * D + c0), q1 = *(const u32x4*)(ca + (r0 - 1) * D + c0);
#pragma unroll
            for (int e = 0; e < 4; ++e) { p2[2 * e] = bflo(q2[e]); p2[2 * e + 1] = bfhi(q2[e]); p1[2 * e] = bflo(q1[e]); p1[2 * e + 1] = bfhi(q1[e]); } }
        else {
#pragma unroll
            for (int e = 0; e < 8; ++e) { p2[e] = 0.f; p1[e] = 0.f; } }
#pragma unroll 4
        for (int tt = 0; tt < 16; ++tt) {
            const u32x4 qc = *(const u32x4*)(ca + (r0 + tt) * D + c0), qa = *(const u32x4*)(ab + (r0 + tt) * D + c0);
            float cv[8], av[8], zv[8];
#pragma unroll
            for (int e = 0; e < 4; ++e) { cv[2 * e] = bflo(qc[e]); cv[2 * e + 1] = bfhi(qc[e]); av[2 * e] = bflo(qa[e]); av[2 * e + 1] = bfhi(qa[e]); }
#pragma unroll
            for (int e = 0; e < 8; ++e) { zv[e] = av[e] * (w[0][e] * p2[e] + w[1][e] * p1[e] + w[2][e] * cv[e]); p2[e] = p1[e]; p1[e] = cv[e]; }
            u32x4 o; o.x = cvt_pk_bf16(zv[0], zv[1]); o.y = cvt_pk_bf16(zv[2], zv[3]); o.z = cvt_pk_bf16(zv[4], zv[5]); o.w = cvt_pk_bf16(zv[6], zv[7]);
            if (!dry) *(u32x4*)(ab + (r0 + tt) * D + c0) = o;
        }
        if (tb == 128) {
            float* o2 = p.out + O_CAP + ((size_t)b * 2 + 0) * D + c0; float* o1 = p.out + O_CAP + ((size_t)b * 2 + 1) * D + c0;
            *(f32x4*)o2 = (f32x4){p2[0], p2[1], p2[2], p2[3]}; *(f32x4*)(o2 + 4) = (f32x4){p2[4], p2[5], p2[6], p2[7]};
            *(f32x4*)o1 = (f32x4){p1[0], p1[1], p1[2], p1[3]}; *(f32x4*)(o1 + 4) = (f32x4){p1[4], p1[5], p1[6], p1[7]};
        }
    }
    if (!dry) {
        for (int idx = blockIdx.x * 512 + tid; idx < NS * 128; idx += gridDim.x * 512) {
            const int vc = idx & 127, sm = idx >> 7, c0 = vc * 8; const size_t ro = (size_t)(MP + sm) * D + c0;
            const u32x4 qc = *(const u32x4*)(ca + ro), qa = *(const u32x4*)(ab + ro);
            const float* sa = p.in[2] + (size_t)sm * 2 * D + c0;
            float h0[8], h1[8], cv[8], zv[8];
            { const f32x4 a0 = *(const f32x4*)sa, a1 = *(const f32x4*)(sa + 4), b0 = *(const f32x4*)(sa + D), b1 = *(const f32x4*)(sa + D + 4);
#pragma unroll
              for (int e = 0; e < 4; ++e) { h0[e] = a0[e]; h0[4 + e] = a1[e]; h1[e] = b0[e]; h1[4 + e] = b1[e]; } }
#pragma unroll
            for (int e = 0; e < 4; ++e) { cv[2 * e] = bflo(qc[e]); cv[2 * e + 1] = bfhi(qc[e]); }
#pragma unroll
            for (int e = 0; e < 8; ++e) { const float wa0 = cw[c0 + e], wa1 = cw[D + c0 + e], wa2 = cw[2 * D + c0 + e];
                const float av = (e & 1) ? bfhi(qa[e >> 1]) : bflo(qa[e >> 1]); zv[e] = av * (wa0 * h0[e] + wa1 * h1[e] + wa2 * cv[e]); }
            u32x4 o; o.x = cvt_pk_bf16(zv[0], zv[1]); o.y = cvt_pk_bf16(zv[2], zv[3]); o.z = cvt_pk_bf16(zv[4], zv[5]); o.w = cvt_pk_bf16(zv[6], zv[7]);
            *(u32x4*)(ab + ro) = o;
            float* o0 = p.out + O_CAS + ((size_t)sm * 2 + 0) * D + c0; float* o1 = o0 + D;
            *(f32x4*)o0 = (f32x4){h1[0], h1[1], h1[2], h1[3]}; *(f32x4*)(o0 + 4) = (f32x4){h1[4], h1[5], h1[6], h1[7]};
            *(f32x4*)o1 = (f32x4){cv[0], cv[1], cv[2], cv[3]}; *(f32x4*)(o1 + 4) = (f32x4){cv[4], cv[5], cv[6], cv[7]};
        }
    }
}

__device__ __forceinline__ void merge_phase(const Params& p, int tid) {
    const bf16_t* U = (const bf16_t*)(p.ws + WS_U); bf16_t* H = (bf16_t*)p.out; const float* PO = (const float*)(p.ws + WS_POAB);
    for (size_t i = (size_t)blockIdx.x * 512 + tid; i < SLOT / 8; i += (size_t)gridDim.x * 512) {
        const u32x4 ga = *(const u32x4*)(U + 4 * SLOT + i * 8), gb = *(const u32x4*)(U + 5 * SLOT + i * 8);
        float ya[8], yb[8];
        const int row = (int)(i >> 7);
        if (row < MAINR) {
            const u32x4 a = *(const u32x4*)(U + 2 * SLOT + i * 8), b = *(const u32x4*)(U + 3 * SLOT + i * 8);
#pragma unroll
            for (int e = 0; e < 4; ++e) { ya[2 * e] = bflo(a[e]); ya[2 * e + 1] = bfhi(a[e]); yb[2 * e] = bflo(b[e]); yb[2 * e + 1] = bfhi(b[e]); }
        } else {
            const size_t o = (size_t)(row - MAINR) * D + (size_t)(i & 127) * 8;
#pragma unroll
            for (int e = 0; e < 8; ++e) { ya[e] = 0.f; yb[e] = 0.f; }
#pragma unroll
            for (int ks = 0; ks < 4; ++ks) {
                const f32x4 a0 = *(const f32x4*)(PO + (size_t)(ks * 2 + 0) * (256 * D) + o), a1 = *(const f32x4*)(PO + (size_t)(ks * 2 + 0) * (256 * D) + o + 4);
                const f32x4 b0 = *(const f32x4*)(PO + (size_t)(ks * 2 + 1) * (256 * D) + o), b1 = *(const f32x4*)(PO + (size_t)(ks * 2 + 1) * (256 * D) + o + 4);
#pragma unroll
                for (int e = 0; e < 4; ++e) { ya[e] += a0[e]; ya[4 + e] += a1[e]; yb[e] += b0[e]; yb[4 + e] += b1[e]; }
            }
        }
        u32x4 o4;
#pragma unroll
        for (int e = 0; e < 4; ++e) { const float lo = sigm(bflo(ga[e])) * ya[2 * e] + sigm(bflo(gb[e])) * yb[2 * e], hi = sigm(bfhi(ga[e])) * ya[2 * e + 1] + sigm(bfhi(gb[e])) * yb[2 * e + 1]; o4[e] = cvt_pk_bf16(lo, hi); }
        *(u32x4*)(H + i * 8) = o4;
    }
}

#define XB_TMO      128
#define XB_XCNT(j)  (256  + 64 * (j))
#define XB_XSUB(j)  (1280 + 64 * (j))
#define XB_XGEN(j)  (2304 + 64 * (j))
#define XB_TOP      3328
#define XB_TOPGEN   3392
#define XCD_BAR_WORDS 3456
#define XB_SPIN_CAP (1u << 18)
__device__ __forceinline__ unsigned xb_ld(unsigned* p)              { return __hip_atomic_load(p, __ATOMIC_RELAXED, __HIP_MEMORY_SCOPE_AGENT); }
__device__ __forceinline__ unsigned xb_add(unsigned* p, unsigned v) { return __hip_atomic_fetch_add(p, v, __ATOMIC_RELAXED, __HIP_MEMORY_SCOPE_AGENT); }
__device__ __forceinline__ unsigned xb_xcc_id() { return (unsigned)__builtin_amdgcn_s_getreg((3 << 11) | 20) & 0xFu; }
#define XB_SPIN(cond, bar) do { unsigned _sp = 0; while (cond) { __builtin_amdgcn_s_sleep(1); \
    if ((++_sp & 255u) == 0u) { if (xb_ld(&(bar)[XB_TMO])) break; if (_sp > XB_SPIN_CAP) { atomicAdd(&(bar)[XB_TMO], 1u); break; } } } } while (0)
struct XcdBarrier { unsigned* bar; unsigned x; volatile LAS unsigned* st; };
__device__ __forceinline__ XcdBarrier xcd_barrier_post(unsigned* bar, volatile LAS unsigned* st) {
    XcdBarrier b; b.bar = bar; b.x = xb_xcc_id(); b.st = st;
    if (threadIdx.x == 0) (void)xb_add(&bar[XB_XCNT(b.x)], 1u);
    return b;
}
__device__ __forceinline__ void xcd_barrier_complete(unsigned* bar, unsigned x, unsigned& nloc, unsigned& nx) {
    const unsigned G = gridDim.x * gridDim.y * gridDim.z;
    unsigned sum, cnt, mine, sp = 0u;
    for (;;) {
        sum = 0u; cnt = 0u; mine = 0u;
#pragma unroll
        for (unsigned j = 0; j < 16; ++j) { const unsigned c = xb_ld(&bar[XB_XCNT(j)]); sum += c; cnt += (c > 0u) ? 1u : 0u; mine = (j == x) ? c : mine; }
        if (sum == G) break;
        __builtin_amdgcn_s_sleep(1);
        if ((++sp & 255u) == 0u) { if (xb_ld(&bar[XB_TMO])) break; if (sp > XB_SPIN_CAP) { atomicAdd(&bar[XB_TMO], 1u); break; } }
    }
    nloc = mine > 0u ? mine : 1u; nx = cnt > 0u ? cnt : 1u;
}
__device__ __forceinline__ void xcd_barrier(const XcdBarrier& b) {
    asm volatile("s_waitcnt vmcnt(0)" ::: "memory");
    __syncthreads();
    if (threadIdx.x == 0) {
        unsigned* bar = b.bar;
        __builtin_amdgcn_s_waitcnt(0);
        unsigned nloc = b.st[0], nx = b.st[1];
        if (nloc == 0u) { xcd_barrier_complete(bar, b.x, nloc, nx); b.st[0] = nloc; b.st[1] = nx; }
        const unsigned old = xb_add(&bar[XB_XSUB(b.x)], 1u);
        const unsigned gen = old / nloc;
        if (old + 1u == (gen + 1u) * nloc) {
            __builtin_amdgcn_fence(__ATOMIC_RELEASE, "agent");
            asm volatile("s_waitcnt vmcnt(0)" ::: "memory");
            const unsigned og = xb_add(&bar[XB_TOP], 1u);
            const unsigned tg = og / nx;
            if (og + 1u == (tg + 1u) * nx) xb_add(&bar[XB_TOPGEN], 1u);
            else XB_SPIN(xb_ld(&bar[XB_TOPGEN]) == tg, bar);
            __builtin_amdgcn_fence(__ATOMIC_ACQUIRE, "agent");
            xb_add(&bar[XB_XGEN(b.x)], 1u);
            asm volatile("s_waitcnt vmcnt(0)" ::: "memory");
        } else {
            XB_SPIN(xb_ld(&bar[XB_XGEN(b.x)]) == gen, bar);
            __builtin_amdgcn_fence(__ATOMIC_ACQUIRE, "agent");
            asm volatile("s_waitcnt vmcnt(0)" ::: "memory");
        }
    }
    __syncthreads();
}

constexpr int NPHASE = 14;
constexpr int LDS_BYTES = 131072 + 16;
__global__ void __launch_bounds__(512, 2) mk_fwd(Params p, int ph_lo, int ph_hi) {
    extern __shared__ __attribute__((aligned(16))) unsigned char shm[];
    LAS unsigned char* lds = (LAS unsigned char*)shm;
    cg::grid_group grid = cg::this_grid();
    if (threadIdx.x == 0) { *(LAS u32x4*)(lds + 131072) = (u32x4){0u, 0u, 0u, 0u}; }
    __syncthreads();
    const XcdBarrier xb = xcd_barrier_post((unsigned*)(p.ws + WS_BAR), (volatile LAS unsigned*)(lds + 131072));
    for (int ph2 = ph_lo * 2; ph2 < ph_hi * 2; ++ph2) {
        const int ph = ph2 >> 1; const bool dry = !(ph2 & 1);
        if (dry && !((REP_MASK >> ph) & 1)) continue;
        int tid = threadIdx.x; asm volatile("" : "+v"(tid));
        if (ph == 0) {
            convert_set(p, 0, lds, tid);
            bf16_t* wt = (bf16_t*)(p.ws + WS_WRG);
            for (int o = blockIdx.x * 512 + tid; o < 2 * 65536; o += gridDim.x * 512) { const int g = o >> 16, h = (o >> 12) & 15, j = (o >> 6) & 63, i = o & 63;
                wt[o] = f2bf((g ? p.in[20] : p.in[18])[(size_t)(h * 64 + i) * 64 + j]); }
            norm_phase(p, 0, tid, dry, 0);
        } else if (ph == 1 || ph == 11) {
            pg8::Gemm g{(const bf16_t*)(p.ws + WS_H), (const bf16_t*)(p.ws + WS_WGU), M, 2 * DFF, D, 0, 0};
            pg8::StaticOrder S; S.init(M, 2 * DFF, D, gridDim.x, blockIdx.x);
            pg8::EpiGU E{(bf16_t*)(p.ws + WS_ACT), dry};
            pg8::gemm_phase(lds, g, S, E);
        } else if (ph == 2 || ph == 12 || ph == 9 || ph == 7) {
            const bool dn = (ph == 2 || ph == 12), oab = (ph == 7);
            pg8::Gemm g{dn ? (const bf16_t*)(p.ws + WS_ACT) : (oab ? (const bf16_t*)(p.ws + WS_U) : (const bf16_t*)p.out), (const bf16_t*)(p.ws + (dn ? WS_WD : (oab ? WS_WOAB : WS_WO))), M, D, dn ? DFF : D, SB, (size_t)1024 * 1024 * 2};
            pg8::SplitOrder S; S.init(oab ? 2 * D : D, dn ? DFF : D, gridDim.x, blockIdx.x, dn ? 11 : 4, 4);
            pg8::EpiBF E{(bf16_t*)(p.ws + (oab ? WS_U + 2 * SB : WS_Y)), SLOT, (float*)(p.ws + (oab ? WS_POAB : WS_PY)), oab ? 2 : 1};
            pg8::gemm_phase(lds, g, S, E);
            if (!dry && ph == 2) convert_set(p, 2, lds, tid);
            if (!dry && ph == 9) convert_set(p, 1, lds, tid);
        } else if (ph == 3) {
            norm_phase(p, 1, tid, dry, 11);
        } else if (ph == 4) {
            pg8::Gemm g{(const bf16_t*)(p.ws + WS_H), (const bf16_t*)(p.ws + WS_WIN), M, DIN, D, 0, 0};
            pg8::StaticOrder S; S.init(M, DIN, D, gridDim.x, blockIdx.x);
            pg8::EpiIN E{(bf16_t*)(p.ws + WS_U)};
            pg8::gemm_phase(lds, g, S, E);
        } else if (ph == 5) {
            scan_phase(p, lds, tid, dry);
        } else if (ph == 6) {
            fix_phase(p, lds, tid, dry);
            za_phase(p, tid, dry);
        } else if (ph == 8) {
            merge_phase(p, tid);
        } else if (ph == 10) {
            norm_phase(p, 2, tid, dry, 4);
        } else if (ph == 13) {
            norm_phase(p, 3, tid, dry, 11);
        }
        if (ph2 + 1 < ph_hi * 2) { if (ph_hi > NPHASE) grid.sync(); else xcd_barrier(xb); }
    }
}

extern "C" void kernel_launch(void* const* d_in, const int* in_sizes, int n_in, void* d_out, int out_size, void* d_ws, size_t ws_size, hipStream_t stream) {
    if (n_in != 30 || ws_size < WS_END) { fprintf(stderr, "kernel_launch: unexpected n_in %d / ws_size %zu (need %zu)\n", n_in, ws_size, (size_t)WS_END); return; }
    Params p{};
    for (int i = 0; i < 30; ++i) p.in[i] = (const float*)d_in[i];
    p.out = (float*)d_out; p.ws = (unsigned char*)d_ws;
    (void)hipFuncSetAttribute((const void*)mk_fwd, hipFuncAttributeMaxDynamicSharedMemorySize, LDS_BYTES);
    static int grid_blocks = 0;
    if (!grid_blocks) {
        int dev = 0, cus = 0, per_cu = 0;
        (void)hipGetDevice(&dev);
        (void)hipDeviceGetAttribute(&cus, hipDeviceAttributeMultiprocessorCount, dev);
        (void)hipOccupancyMaxActiveBlocksPerMultiprocessor(&per_cu, (const void*)mk_fwd, 512, LDS_BYTES);
        if (per_cu < 1) { fprintf(stderr, "kernel_launch: occupancy query says %d blocks/CU\n", per_cu); per_cu = 1; }
        grid_blocks = cus;
    }
    (void)hipMemsetAsync((unsigned char*)d_ws + WS_BAR, 0, 16384, stream);
#if SINGLE_LAUNCH
    int lo = 0, hi = NPHASE;
    void* args[] = {&p, &lo, &hi};
    hipError_t e = hipLaunchCooperativeKernel((const void*)mk_fwd, dim3(grid_blocks), dim3(512), args, LDS_BYTES, stream);
    if (e != hipSuccess) fprintf(stderr, "cooperative launch failed: %s (grid %d)\n", hipGetErrorString(e), grid_blocks);
#else
    for (int ph = 0; ph < NPHASE; ++ph) hipLaunchKernelGGL(mk_fwd, dim3(grid_blocks), dim3(512), LDS_BYTES, stream, p, ph, ph + 1);
#endif
}
```

```cpp
#include <hip/hip_runtime.h>
#include <hip/hip_cooperative_groups.h>
#include <cstdio>
namespace cg = cooperative_groups;

#ifndef REP_MASK
#define REP_MASK 0
#endif
#ifndef SINGLE_LAUNCH
#define SINGLE_LAUNCH 1
#endif

#define LAS __attribute__((address_space(3)))
typedef unsigned short bf16_t;
typedef short bf16x8 __attribute__((ext_vector_type(8)));
typedef float f32x4 __attribute__((ext_vector_type(4)));
typedef unsigned u32x4 __attribute__((ext_vector_type(4)));
typedef unsigned u32x2 __attribute__((ext_vector_type(2)));

constexpr int D = 1024, DFF = 2816, DIN = 7168;
constexpr int NB = 8, SEQ = 2048, NMETA = 16, TP = SEQ + NMETA;
constexpr int MP = NB * TP;
constexpr int NS = 128;
constexpr int M = MP + NS;
constexpr int CHUNK = 48, NCH = TP / CHUNK;
constexpr float EPS = 1e-6f;

constexpr size_t O_YP = 0, O_YS = 16777216, O_CAP = O_YS + 131072, O_CBP = O_CAP + 16384, O_RGP = O_CBP + 24576,
                 O_CAS = O_RGP + 8192, O_CBS = O_CAS + 262144, O_RGS = O_CBS + 393216;

constexpr size_t SLOT = (size_t)M * D;
constexpr size_t SB = SLOT * 2;
constexpr size_t WS_U = 0;
constexpr size_t WS_ACT = 0;
constexpr size_t WS_Y = 3 * SB;
constexpr size_t WS_PY = 4 * SB;
constexpr int MAINR = 64 * 256;
constexpr size_t WS_WGU = 5 * SB;
constexpr size_t WS_WD = WS_WGU + (size_t)5632 * 1024 * 2;
constexpr size_t WS_H = 6 * SB;
constexpr size_t WS_WIN = 7 * SB;
constexpr size_t WS_POAB = WS_WIN;
constexpr size_t WS_WOAB = WS_WIN + (size_t)7168 * 1024 * 2;
constexpr size_t WS_WO = WS_WOAB + (size_t)2 * 1024 * 1024 * 2;
constexpr size_t WS_WRG = WS_WO + (size_t)1024 * 1024 * 2;
constexpr size_t WS_SUMM = WS_WRG + (size_t)2 * 16 * 64 * 64 * 2;
constexpr size_t WS_SC = WS_SUMM + (size_t)NB * NCH * D * 2 * 4;
constexpr size_t WS_LC = WS_SC + 98304;
constexpr size_t WS_BAR = WS_SC + 131072;
constexpr size_t WS_END = WS_BAR + 16384;
static_assert(WS_END <= (size_t)256 * 1024 * 1024, "workspace");

struct Params { const float* in[30]; float* out; unsigned char* ws; };

__device__ __forceinline__ unsigned cvt_pk_bf16(float lo, float hi) { unsigned r; asm volatile("v_cvt_pk_bf16_f32 %0, %1, %2" : "=v"(r) : "v"(lo), "v"(hi)); return r; }
__device__ __forceinline__ bf16_t f2bf(float f) { return (bf16_t)(cvt_pk_bf16(f, 0.f) & 0xffffu); }
__device__ __forceinline__ float bf2f(bf16_t b) { return __uint_as_float(((unsigned)b) << 16); }
__device__ __forceinline__ float bflo(unsigned w) { return __uint_as_float(w << 16); }
__device__ __forceinline__ float bfhi(unsigned w) { return __uint_as_float(w & 0xffff0000u); }
__device__ __forceinline__ float sigm(float x) { return __builtin_amdgcn_rcpf(1.0f + __expf(-x)); }
__device__ __forceinline__ float gelu_tanh(float x) { const float t = 1.5957691216057308f * (x + 0.044715f * x * x * x); return x * sigm(t); }
__device__ __forceinline__ float wave_sum(float v, int lane) {
#pragma unroll
    for (int o = 32; o >= 1; o >>= 1) v += __int_as_float(__builtin_amdgcn_ds_bpermute((lane ^ o) << 2, __float_as_int(v)));
    return v;
}
__device__ __forceinline__ const float* x0row(const Params& p, int r) {
    if (r >= MP) return p.in[1] + (size_t)(r - MP) * D;
    const int b = r / TP, t = r - b * TP;
    if (t < NMETA) return p.in[5] + (size_t)t * D;
    return p.in[0] + ((size_t)b * SEQ + (t - NMETA)) * D;
}

namespace pg8 {
constexpr int BM = 256, BK = 64, HALF = 128, HTB = HALF * BK * 2, STAGE_BYTES = 8 * HTB, NXCD = 8, WGM = 8;
__host__ __device__ __forceinline__ int lds_byte(int r, int c) { const int st = (r >> 4) * 2 + (c >> 5), rr = r & 15, cc = c & 31, ob = rr * 64 + cc * 2; return st * 1024 + (ob ^ (((ob >> 9) & 1) << 5)); }
__host__ __device__ __forceinline__ void stage_rc(int b, int& R, int& C) { const int st = b / 1024, sb = b % 1024, swz = sb ^ (((sb >> 9) & 1) << 5); R = (st >> 1) * 16 + swz / 64; C = (st & 1) * 32 + (swz % 64) / 2; }
__host__ __device__ __forceinline__ int perm32(int rho) { const int n = rho >> 4, i = rho & 15; return 8 * (i >> 2) + 4 * n + (i & 3); }

struct Unit { int pm, pn, z, k0, nk, part; };
struct Gemm { const bf16_t* A; const bf16_t* Bt; int M, N, K; size_t zA, zB; };

struct StaticOrder {
    int nM, nN, nwg, G, c, ntf;
    __device__ void init(int M_, int N_, int K_, int G_, int c_) { nM = M_ / BM; nN = N_ / BM; nwg = nM * nN; G = G_; c = c_; ntf = K_ / BK; }
    __device__ bool map(long L, Unit& u) const {
        if (L >= nwg) return false;
        int wgid = (int)L; { const int q = nwg / NXCD, r = nwg % NXCD, xcd = wgid % NXCD, off = wgid / NXCD; wgid = (xcd < r ? xcd * (q + 1) : r * (q + 1) + (xcd - r) * q) + off; }
        const int nig = WGM * nN, gid = wgid / nig, fm = gid * WGM, gsz = (nM - fm) < WGM ? (nM - fm) : WGM;
        u.pm = fm + ((wgid % nig) % gsz); u.pn = (wgid % nig) / gsz; u.z = 0; u.k0 = 0; u.nk = ntf; u.part = -1; return true;
    }
    __device__ bool next(int i, Unit& u) const { return map((long)i * G + c, u); }
};
struct SplitOrder : StaticOrder {
    int nsplit, nkm;
    __device__ void init(int N_, int K_, int G_, int c_, int nsplit_, int nkm_) { StaticOrder::init(64 * BM, N_, K_, G_, c_); nsplit = nsplit_; nkm = nkm_; }
    __device__ bool next(int i, Unit& u) const {
        const long L = (long)i * G + c; bool ok;
        if (L < nwg) ok = map(L, u);
        else { const int L2 = (int)(L - nwg); ok = L2 < nN * nsplit; const int ks = L2 / nN; u.pm = 64; u.pn = L2 - ks * nN; u.k0 = ks * nkm; u.nk = nkm; u.part = ks; }
        u.z = u.pn >> 2; u.pn &= 3; return ok;
    }
};

template <class Epi, class Sched>
__device__ __forceinline__ void gemm_phase(LAS unsigned char* lds, const Gemm g, const Sched& S, const Epi& E) {
    int tid_ = threadIdx.x; asm volatile("" : "+v"(tid_));
    const int tid = tid_, wid = __builtin_amdgcn_readfirstlane(tid >> 6), lane = tid & 63, wr = wid >> 2, wc = wid & 3, fr = lane & 15, fq = lane >> 4;
    const int K = g.K;
    unsigned voffA[2], voffB[2];
#pragma unroll
    for (int i = 0; i < 2; ++i) { int R, C; stage_rc(tid * 16 + i * 8192, R, C); const int Rb = Epi::PERM ? ((R & ~31) + perm32(R & 31)) : R;
        voffA[i] = (unsigned)(R * K + C) * 2u; voffB[i] = (unsigned)(Rb * K + C) * 2u; }
    const size_t kstep = (size_t)(BK * 2);
    const size_t hstep = (size_t)HALF * K * 2;
    const size_t tstep = 2 * hstep;
    const unsigned ldsw = (unsigned)wid * 1024u;
    const int aoff = lds_byte(wr * 64 + fr, fq * 8), boff = lds_byte(wc * 32 + fr, fq * 8);
#define PG8_SA(b, h) (((b) * 2 + (h)) * HTB)
#define PG8_SB(b, h) ((4 + (b) * 2 + (h)) * HTB)
#define PG8_STAGE(bufoff, gbase, voff) do { _Pragma("unroll") for (int _i = 0; _i < 2; ++_i) \
        __builtin_amdgcn_global_load_lds((const unsigned*)((const char*)(gbase) + (voff)[_i]), (LAS unsigned*)(lds + (bufoff) + ldsw + _i * 8192), 16, 0, 0); } while (0)
#define PG8_LDA(dst, b, h) do { _Pragma("unroll") for (int m = 0; m < 4; ++m) _Pragma("unroll") for (int k = 0; k < 2; ++k) dst[m][k] = *(const LAS bf16x8*)(lds + PG8_SA(b, h) + aoff + m * 2048 + k * 1024); } while (0)
#define PG8_LDB(dst, b, h) do { _Pragma("unroll") for (int n = 0; n < 2; ++n) _Pragma("unroll") for (int k = 0; k < 2; ++k) dst[n][k] = *(const LAS bf16x8*)(lds + PG8_SB(b, h) + boff + n * 2048 + k * 1024); } while (0)
#define PG8_MMA(ai, bj, At, Bt) do { __builtin_amdgcn_s_setprio(1); _Pragma("unroll") for (int m = 0; m < 4; ++m) _Pragma("unroll") for (int n = 0; n < 2; ++n) _Pragma("unroll") for (int k = 0; k < 2; ++k) \
        acc[ai][bj][m][n] = __builtin_amdgcn_mfma_f32_16x16x32_bf16(Bt[n][k], At[m][k], acc[ai][bj][m][n], 0, 0, 0); __builtin_amdgcn_s_setprio(0); } while (0)
#define PG8_WAIT_V(n) asm volatile("s_waitcnt vmcnt(" #n ")" ::: "memory")
#define PG8_WAIT_L(n) asm volatile("s_waitcnt lgkmcnt(" #n ")" ::: "memory")
#define PG8_BAR __builtin_amdgcn_s_barrier()
#define PG8_SCHED __builtin_amdgcn_sched_barrier(0)
    Unit cur, nxt; int ui = 0;
    if (!S.next(0, cur)) return;
    f32x4 acc[2][2][4][2];
#pragma unroll
    for (int a = 0; a < 2; ++a)
#pragma unroll
        for (int b = 0; b < 2; ++b)
#pragma unroll
            for (int m = 0; m < 4; ++m)
#pragma unroll
                for (int n = 0; n < 2; ++n) acc[a][b][m][n] = (f32x4){0.f, 0.f, 0.f, 0.f};
    bf16x8 At[4][2], B0[2][2], B1[2][2];
    const char* cA = (const char*)g.A + (size_t)cur.z * g.zA + (size_t)cur.pm * tstep + (size_t)cur.k0 * kstep; const char* cB = (const char*)g.Bt + (size_t)cur.z * g.zB + (size_t)cur.pn * tstep + (size_t)cur.k0 * kstep;
    int nt = cur.nk;
    PG8_STAGE(PG8_SB(0, 0), cB, voffB); PG8_STAGE(PG8_SA(0, 0), cA, voffA); PG8_STAGE(PG8_SB(0, 1), cB + hstep, voffB); PG8_STAGE(PG8_SA(0, 1), cA + hstep, voffA);
    if (wr == 1) PG8_BAR;
    PG8_WAIT_V(4); PG8_BAR;
    PG8_STAGE(PG8_SB(1, 0), cB + kstep, voffB); PG8_STAGE(PG8_SA(1, 0), cA + kstep, voffA); PG8_STAGE(PG8_SB(1, 1), cB + hstep + kstep, voffB);
    PG8_WAIT_V(6); PG8_BAR;
    for (;;) {
        const bool has_next = S.next(ui + 1, nxt);
        const char* nA = has_next ? (const char*)g.A + (size_t)nxt.z * g.zA + (size_t)nxt.pm * tstep + (size_t)nxt.k0 * kstep : cA; const char* nB = has_next ? (const char*)g.Bt + (size_t)nxt.z * g.zB + (size_t)nxt.pn * tstep + (size_t)nxt.k0 * kstep : cB;
        for (int t = 0; t < nt; t += 2) {
            const bool last = (t == nt - 2);
            const char* a1 = cA + (size_t)(t + 1) * kstep;
            const char* a2 = last ? nA : cA + (size_t)(t + 2) * kstep; const char* b2 = last ? nB : cB + (size_t)(t + 2) * kstep;
            const char* a3 = a2 + kstep; const char* b3 = b2 + kstep;
            PG8_LDB(B0, 0, 0); PG8_SCHED; PG8_LDA(At, 0, 0); PG8_STAGE(PG8_SA(1, 1), a1 + hstep, voffA);
            PG8_WAIT_L(8); PG8_BAR; PG8_WAIT_L(0); PG8_MMA(0, 0, At, B0); PG8_BAR; PG8_SCHED;
            PG8_LDB(B1, 0, 1); PG8_STAGE(PG8_SB(0, 0), b2, voffB);
            PG8_BAR; PG8_WAIT_L(0); PG8_MMA(0, 1, At, B1); PG8_BAR;
            PG8_LDA(At, 0, 1); PG8_STAGE(PG8_SA(0, 0), a2, voffA);
            PG8_BAR; PG8_WAIT_L(0); PG8_MMA(1, 0, At, B0); PG8_BAR; PG8_SCHED;
            PG8_STAGE(PG8_SB(0, 1), b2 + hstep, voffB);
            PG8_WAIT_V(6); PG8_BAR; PG8_MMA(1, 1, At, B1); PG8_BAR;
            PG8_LDB(B0, 1, 0); PG8_SCHED; PG8_LDA(At, 1, 0); PG8_STAGE(PG8_SA(0, 1), a2 + hstep, voffA);
            PG8_WAIT_L(8); PG8_BAR; PG8_WAIT_L(0); PG8_MMA(0, 0, At, B0); PG8_BAR; PG8_SCHED;
            PG8_LDB(B1, 1, 1); PG8_STAGE(PG8_SB(1, 0), b3, voffB);
            PG8_BAR; PG8_WAIT_L(0); PG8_MMA(0, 1, At, B1); PG8_BAR;
            PG8_LDA(At, 1, 1); PG8_STAGE(PG8_SA(1, 0), a3, voffA);
            PG8_BAR; PG8_WAIT_L(0); PG8_MMA(1, 0, At, B0); PG8_BAR; PG8_SCHED;
            PG8_STAGE(PG8_SB(1, 1), b3 + hstep, voffB);
            PG8_WAIT_V(6); PG8_BAR; PG8_MMA(1, 1, At, B1); PG8_BAR;
        }
        E(acc, cur, wr, wc, fr, fq);
        if (!has_next) break;
#pragma unroll
        for (int a = 0; a < 2; ++a)
#pragma unroll
            for (int b = 0; b < 2; ++b)
#pragma unroll
                for (int m = 0; m < 4; ++m)
#pragma unroll
                    for (int n = 0; n < 2; ++n) acc[a][b][m][n] = (f32x4){0.f, 0.f, 0.f, 0.f};
        cur = nxt; cA = nA; cB = nB; nt = cur.nk; ++ui;
    }
    PG8_WAIT_V(0);
    if (wr == 0) PG8_BAR;
    PG8_BAR;
#undef PG8_SA
#undef PG8_SB
#undef PG8_STAGE
#undef PG8_LDA
#undef PG8_LDB
#undef PG8_MMA
#undef PG8_WAIT_V
#undef PG8_WAIT_L
#undef PG8_BAR
#undef PG8_SCHED
}

struct EpiBF {
    static constexpr bool PERM = true;
    bf16_t* O; size_t zO; float* P; int nz;
    __device__ __forceinline__ void operator()(const f32x4 (&acc)[2][2][4][2], const Unit& u, int wr, int wc, int fr, int fq) const {
        const int col0 = u.pn * BM + wc * 32 + 8 * fq;
        if (u.part < 0) {
            const int row0 = u.pm * BM + wr * 64 + fr; bf16_t* base = O + (size_t)u.z * zO;
#pragma unroll
            for (int ai = 0; ai < 2; ++ai)
#pragma unroll
                for (int m = 0; m < 4; ++m) { bf16_t* rowp = base + (size_t)(row0 + ai * HALF + m * 16) * D + col0;
#pragma unroll
                    for (int bj = 0; bj < 2; ++bj) { const f32x4 v0 = acc[ai][bj][m][0], v1 = acc[ai][bj][m][1];
                        u32x4 w; w.x = cvt_pk_bf16(v0[0], v0[1]); w.y = cvt_pk_bf16(v0[2], v0[3]); w.z = cvt_pk_bf16(v1[0], v1[1]); w.w = cvt_pk_bf16(v1[2], v1[3]);
                        *(u32x4*)(rowp + bj * HALF) = w; } }
        } else {
            const int row0 = wr * 64 + fr; float* base = P + (size_t)(u.part * nz + u.z) * (BM * D);
#pragma unroll
            for (int ai = 0; ai < 2; ++ai)
#pragma unroll
                for (int m = 0; m < 4; ++m) { float* rowp = base + (size_t)(row0 + ai * HALF + m * 16) * D + col0;
#pragma unroll
                    for (int bj = 0; bj < 2; ++bj) { *(f32x4*)(rowp + bj * HALF) = acc[ai][bj][m][0]; *(f32x4*)(rowp + bj * HALF + 4) = acc[ai][bj][m][1]; } }
        }
    }
};
struct EpiGU {
    static constexpr bool PERM = true;
    bf16_t* O; bool dry;
    __device__ __forceinline__ void operator()(const f32x4 (&acc)[2][2][4][2], const Unit& u, int wr, int wc, int fr, int fq) const {
        if (dry) return;
        const int row0 = u.pm * BM + wr * 64 + fr, col0 = u.pn * HALF + wc * 32 + 8 * fq;
#pragma unroll
        for (int ai = 0; ai < 2; ++ai)
#pragma unroll
            for (int m = 0; m < 4; ++m) { bf16_t* rowp = O + (size_t)(row0 + ai * HALF + m * 16) * DFF + col0;
                float v[8];
#pragma unroll
                for (int n = 0; n < 2; ++n)
#pragma unroll
                    for (int j = 0; j < 4; ++j) { const float gt = acc[ai][0][m][n][j], up = acc[ai][1][m][n][j]; v[n * 4 + j] = gt * sigm(gt) * up; }
                u32x4 w; w.x = cvt_pk_bf16(v[0], v[1]); w.y = cvt_pk_bf16(v[2], v[3]); w.z = cvt_pk_bf16(v[4], v[5]); w.w = cvt_pk_bf16(v[6], v[7]);
                *(u32x4*)rowp = w; }
    }
};
struct EpiIN {
    static constexpr bool PERM = true;
    bf16_t* U;
    __device__ __forceinline__ void operator()(const f32x4 (&acc)[2][2][4][2], const Unit& u, int wr, int wc, int fr, int fq) const {
        const int row0 = u.pm * BM + wr * 64 + fr;
        if (u.pn >= 4 && u.pn < 12) {
            const int col0 = (u.pn - 4) * HALF + wc * 32 + 8 * fq; bf16_t* base = U + 2 * SLOT;
#pragma unroll
            for (int ai = 0; ai < 2; ++ai)
#pragma unroll
                for (int m = 0; m < 4; ++m) { bf16_t* rowp = base + (size_t)(row0 + ai * HALF + m * 16) * D + col0;
                    const f32x4 v0 = acc[ai][0][m][0] * acc[ai][1][m][0], v1 = acc[ai][0][m][1] * acc[ai][1][m][1];
                    u32x4 w; w.x = cvt_pk_bf16(v0[0], v0[1]); w.y = cvt_pk_bf16(v0[2], v0[3]); w.z = cvt_pk_bf16(v1[0], v1[1]); w.w = cvt_pk_bf16(v1[2], v1[3]);
                    *(u32x4*)rowp = w; }
        } else {
            int slot, ct; if (u.pn < 4) { slot = 0; ct = u.pn; } else { const int sg = (u.pn - 12) >> 2; slot = sg == 0 ? 3 : (sg == 1 ? 1 : sg + 2); ct = (u.pn - 12) & 3; }
            const int col0 = ct * BM + wc * 32 + 8 * fq; bf16_t* base = U + (size_t)slot * SLOT;
#pragma unroll
            for (int ai = 0; ai < 2; ++ai)
#pragma unroll
                for (int m = 0; m < 4; ++m) { bf16_t* rowp = base + (size_t)(row0 + ai * HALF + m * 16) * D + col0;
#pragma unroll
                    for (int bj = 0; bj < 2; ++bj) { const f32x4 v0 = acc[ai][bj][m][0], v1 = acc[ai][bj][m][1];
                        u32x4 w; w.x = cvt_pk_bf16(v0[0], v0[1]); w.y = cvt_pk_bf16(v0[2], v0[3]); w.z = cvt_pk_bf16(v1[0], v1[1]); w.w = cvt_pk_bf16(v1[2], v1[3]);
                        *(u32x4*)(rowp + bj * HALF) = w; } }
        }
    }
};
}

__device__ __forceinline__ int conv_map(int mode, int n) {
    if (mode == 0) return n;
    if (mode == 1) return 256 * (n >> 7) + (n & 127);
    if (mode == 2) return 256 * (n >> 7) + 128 + (n & 127);
    const int seg = n >> 10, j = n & 1023;
    if (seg == 0) return j;
    if (seg == 1) return 1024 + 256 * (j >> 7) + (j & 127);
    if (seg == 2) return 1024 + 256 * (j >> 7) + 128 + (j & 127);
    return 3072 + (seg - 3) * 1024 + j;
}
struct ConvE { const float* src; bf16_t* dst; const float* gk; int K, N, mode, t; };
__device__ __forceinline__ bool conv_decode(const Params& p, int set, int T, ConvE& e) {
    if (set < 2) {
        const int a = set ? 27 : 8; const float* gk = p.in[set ? 25 : 6];
        if (T < 704)       { e.src = p.in[a];     e.dst = (bf16_t*)(p.ws + WS_WGU); e.gk = gk;      e.K = 1024; e.N = 2816; e.mode = 1; e.t = T; }
        else if (T < 1408) { e.src = p.in[a + 1]; e.dst = (bf16_t*)(p.ws + WS_WGU); e.gk = gk;      e.K = 1024; e.N = 2816; e.mode = 2; e.t = T - 704; }
        else if (T < 2112) { e.src = p.in[a + 2]; e.dst = (bf16_t*)(p.ws + WS_WD);  e.gk = nullptr; e.K = 2816; e.N = 1024; e.mode = 0; e.t = T - 1408; }
        else return false;
    } else {
        if (T < 1792)      { e.src = p.in[13]; e.dst = (bf16_t*)(p.ws + WS_WIN); e.gk = p.in[11]; e.K = 1024; e.N = 7168; e.mode = 3; e.t = T; }
        else if (T < 2048) { e.src = p.in[15]; e.dst = (bf16_t*)(p.ws + WS_WOAB); e.gk = nullptr; e.K = 1024; e.N = 1024; e.mode = 0; e.t = T - 1792; }
        else if (T < 2304) { e.src = p.in[23]; e.dst = (bf16_t*)(p.ws + WS_WOAB + (size_t)1024 * 1024 * 2); e.gk = nullptr; e.K = 1024; e.N = 1024; e.mode = 0; e.t = T - 2048; }
        else if (T < 2560) { e.src = p.in[24]; e.dst = (bf16_t*)(p.ws + WS_WO);  e.gk = nullptr;  e.K = 1024; e.N = 1024; e.mode = 0; e.t = T - 2304; }
        else return false;
    }
    return true;
}
__device__ __forceinline__ void conv_load(const ConvE& e, int tid, f32x4& v0, f32x4& v1) {
    const int ntn = e.N >> 6; const int tk = e.t / ntn, tn = e.t - tk * ntn;
    const float* s0 = e.src + (size_t)(tk * 64 + (tid >> 4)) * e.N + tn * 64 + (tid & 15) * 4;
    v0 = *(const f32x4*)s0; v1 = *(const f32x4*)(s0 + (size_t)32 * e.N);
}
__device__ __forceinline__ void conv_emit(const ConvE& e, int tid, const f32x4& v0, const f32x4& v1, LAS float* sl) {
    const int ntn = e.N >> 6; const int tk = e.t / ntn, tn = e.t - tk * ntn; const int k0 = tk * 64, n0 = tn * 64;
    { LAS float* d = sl + (tid >> 4) * 65 + (tid & 15) * 4; d[0] = v0[0]; d[1] = v0[1]; d[2] = v0[2]; d[3] = v0[3]; d += 32 * 65; d[0] = v1[0]; d[1] = v1[1]; d[2] = v1[2]; d[3] = v1[3]; }
    __syncthreads();
    const int n = tid >> 3, ko = (tid & 7) * 8;
    float f[8];
#pragma unroll
    for (int i = 0; i < 8; ++i) f[i] = sl[(ko + i) * 65 + n];
    if (e.gk) {
        const f32x4 g0 = *(const f32x4*)(e.gk + k0 + ko), g1 = *(const f32x4*)(e.gk + k0 + ko + 4);
#pragma unroll
        for (int i = 0; i < 4; ++i) { f[i] *= g0[i]; f[4 + i] *= g1[i]; }
    }
    u32x4 w; w.x = cvt_pk_bf16(f[0], f[1]); w.y = cvt_pk_bf16(f[2], f[3]); w.z = cvt_pk_bf16(f[4], f[5]); w.w = cvt_pk_bf16(f[6], f[7]);
    *(u32x4*)(e.dst + (size_t)conv_map(e.mode, n0 + n) * e.K + k0 + ko) = w;
    __syncthreads();
}
__device__ __forceinline__ void convert_set(const Params& p, int set, LAS unsigned char* lds, int tid) {
    ConvE e, en; f32x4 v0, v1, n0 = {0.f, 0.f, 0.f, 0.f}, n1 = {0.f, 0.f, 0.f, 0.f};
    int T = blockIdx.x;
    bool have = conv_decode(p, set, T, e);
    if (have) conv_load(e, tid, v0, v1);
    while (have) {
        T += gridDim.x;
        const bool hn = conv_decode(p, set, T, en);
        if (hn) conv_load(en, tid, n0, n1);
        conv_emit(e, tid, v0, v1, (LAS float*)lds);
        e = en; v0 = n0; v1 = n1; have = hn;
    }
}

__device__ __forceinline__ void norm_phase(const Params& p, int mode, int tid, bool dry, int nsplit) {
    const int lane = tid & 63, gw = blockIdx.x * 8 + (tid >> 6), nw = gridDim.x * 8;
    const float* gpost = mode == 1 ? p.in[7] : (mode == 2 ? p.in[12] : p.in[26]);
    const float cc = mode == 2 ? 1.0f : 0.5f;
    const bf16_t* Yb = (const bf16_t*)(p.ws + WS_Y); const float* PY = (const float*)(p.ws + WS_PY); bf16_t* H = (bf16_t*)(p.ws + WS_H); float* SC = (float*)(p.ws + WS_SC);
    for (int r = gw; r < M; r += nw) {
        f32x4 xv[4];
        if (mode == 0) {
            const float* xin = x0row(p, r);
#pragma unroll
            for (int q = 0; q < 4; ++q) xv[q] = *(const f32x4*)(xin + lane * 4 + 256 * q);
        } else {
            const float sc = SC[r];
#pragma unroll
            for (int q = 0; q < 4; ++q) { const u32x2 w = *(const u32x2*)(H + (size_t)r * D + lane * 4 + 256 * q); xv[q] = (f32x4){bflo(w.x), bfhi(w.x), bflo(w.y), bfhi(w.y)} * sc; }
            f32x4 yv[4]; float ss = 0.f;
            if (r < MAINR) {
#pragma unroll
                for (int q = 0; q < 4; ++q) { const u32x2 w = *(const u32x2*)(Yb + (size_t)r * D + lane * 4 + 256 * q); yv[q] = (f32x4){bflo(w.x), bfhi(w.x), bflo(w.y), bfhi(w.y)}; }
            } else {
#pragma unroll
                for (int q = 0; q < 4; ++q) yv[q] = (f32x4){0.f, 0.f, 0.f, 0.f};
                for (int ks = 0; ks < nsplit; ++ks) {
#pragma unroll
                    for (int q = 0; q < 4; ++q) yv[q] += *(const f32x4*)(PY + ((size_t)ks * 256 + (r - MAINR)) * D + lane * 4 + 256 * q);
                }
            }
#pragma unroll
            for (int q = 0; q < 4; ++q) ss += yv[q][0] * yv[q][0] + yv[q][1] * yv[q][1] + yv[q][2] * yv[q][2] + yv[q][3] * yv[q][3];
            ss = wave_sum(ss, lane);
            const float rs = cc * rsqrtf(ss * (1.0f / D) + EPS);
#pragma unroll
            for (int q = 0; q < 4; ++q) xv[q] += yv[q] * rs * *(const f32x4*)(gpost + lane * 4 + 256 * q);
        }
        if (mode == 3) {
            float* xo;
            if (r >= MP) xo = p.out + O_YS + (size_t)(r - MP) * D;
            else { const int b = r / TP, t = r - b * TP; if (t < NMETA) continue; xo = p.out + O_YP + ((size_t)b * SEQ + (t - NMETA)) * D; }
#pragma unroll
            for (int q = 0; q < 4; ++q) *(f32x4*)(xo + lane * 4 + 256 * q) = xv[q];
        } else {
            float ss = 0.f;
#pragma unroll
            for (int q = 0; q < 4; ++q) ss += xv[q][0] * xv[q][0] + xv[q][1] * xv[q][1] + xv[q][2] * xv[q][2] + xv[q][3] * xv[q][3];
            ss = wave_sum(ss, lane);
            const float ms = ss * (1.0f / D) + EPS; const float rs = rsqrtf(ms);
            if (!dry) {
#pragma unroll
                for (int q = 0; q < 4; ++q) { const f32x4 hv = xv[q] * rs; u32x2 w; w.x = cvt_pk_bf16(hv[0], hv[1]); w.y = cvt_pk_bf16(hv[2], hv[3]);
                    *(u32x2*)(H + (size_t)r * D + lane * 4 + 256 * q) = w; }
                if (lane == 0) SC[r] = ms * rs;
            }
        }
    }
}

constexpr int WL_BYTES = 11264;
__device__ __forceinline__ void scan_item(const Params& p, int b, int j, int h, LAS unsigned char* wl, const LAS unsigned char* wlds, int lane, bool dry) {
    bf16_t* U = (bf16_t*)(p.ws + WS_U);
    const bf16_t* bx = U + 3 * SLOT; bf16_t* bg = U + 1 * SLOT; bf16_t* pp = (bf16_t*)p.out;
    float* summ = (float*)(p.ws + WS_SUMM);
    const int c = h * 64 + lane, fr = lane & 15, fq = lane >> 4;
    const size_t row0 = (size_t)b * TP + (size_t)j * CHUNK;
    const bf16_t* bx0 = bx + row0 * D; bf16_t* bg0 = bg + row0 * D; bf16_t* pp0 = pp + row0 * D;
    const LAS unsigned char* wq = wlds + fr * 144 + fq * 16;
    float brv[4], biv[4], lcv[4];
#pragma unroll
    for (int nt = 0; nt < 4; ++nt) { const int ch = h * 64 + nt * 16 + fr; brv[nt] = p.in[19][ch]; biv[nt] = p.in[21][ch]; lcv[nt] = ((const float*)(p.ws + WS_LC))[ch]; }
    const float w0 = p.in[16][c], w1 = p.in[16][D + c], w2 = p.in[16][2 * D + c], w3 = p.in[16][3 * D + c], cbias = p.in[17][c];
    float xm3 = 0.f, xm2 = 0.f, xm1 = 0.f;
    if (j > 0) { xm3 = bf2f(bx0[-3 * D + c]); xm2 = bf2f(bx0[-2 * D + c]); xm1 = bf2f(bx0[-1 * D + c]); }
    float hh = 0.f, ap = 1.f;
    LAS unsigned short* cbT = (LAS unsigned short*)wl;
    LAS float* xu = (LAS float*)(wl + 2304);
    LAS float* aS = (LAS float*)(wl + 2304 + 4352);
    bf16_t xr[16], gr[16], xn[16];
#pragma unroll
    for (int tt = 0; tt < 16; ++tt) xr[tt] = bx0[tt * D + c];
#pragma unroll
    for (int g = 0; g < 3; ++g) {
        const int r0 = g * 16;
#pragma unroll
        for (int tt = 0; tt < 16; ++tt) gr[tt] = bg0[(r0 + tt) * D + c];
        if (g < 2) {
#pragma unroll
            for (int tt = 0; tt < 16; ++tt) xn[tt] = bx0[(r0 + 16 + tt) * D + c];
        }
#pragma unroll
        for (int tt = 0; tt < 16; ++tt) { const float x = bf2f(xr[tt]); const float cb = w0 * xm3 + w1 * xm2 + w2 * xm1 + w3 * x + cbias; xm3 = xm2; xm2 = xm1; xm1 = x;
            cbT[tt * 72 + lane] = f2bf(cb); xu[tt * 68 + lane] = cb; }
        __builtin_amdgcn_wave_barrier();
        const bf16x8 a0 = *(const LAS bf16x8*)(cbT + fr * 72 + fq * 8), a1 = *(const LAS bf16x8*)(cbT + fr * 72 + 32 + fq * 8);
        f32x4 accR[4], accI[4];
#pragma unroll
        for (int nt = 0; nt < 4; ++nt) {
            const bf16x8 r0w = *(const LAS bf16x8*)(wq + nt * 2304), r1w = *(const LAS bf16x8*)(wq + nt * 2304 + 64);
            const bf16x8 i0w = *(const LAS bf16x8*)(wq + 9216 + nt * 2304), i1w = *(const LAS bf16x8*)(wq + 9216 + nt * 2304 + 64);
            accR[nt] = __builtin_amdgcn_mfma_f32_16x16x32_bf16(a0, r0w, (f32x4){0.f, 0.f, 0.f, 0.f}, 0, 0, 0);
            accR[nt] = __builtin_amdgcn_mfma_f32_16x16x32_bf16(a1, r1w, accR[nt], 0, 0, 0);
            accI[nt] = __builtin_amdgcn_mfma_f32_16x16x32_bf16(a0, i0w, (f32x4){0.f, 0.f, 0.f, 0.f}, 0, 0, 0);
            accI[nt] = __builtin_amdgcn_mfma_f32_16x16x32_bf16(a1, i1w, accI[nt], 0, 0, 0);
        }
#pragma unroll
        for (int nt = 0; nt < 4; ++nt)
#pragma unroll
            for (int i = 0; i < 4; ++i) { const int idx = (fq * 4 + i) * 68 + nt * 16 + fr; const float x = xu[idx];
                const float r = sigm(accR[nt][i] + brv[nt]), ig = sigm(accI[nt][i] + biv[nt]);
                const float la = lcv[nt] * r; const float a = __expf(la);
                const float z2 = 2.0f * la;
                const float m2s = -z2 * (1.0f + z2 * (0.5f + z2 * (0.16666667f + z2 * (0.041666668f + z2 * (0.0083333338f + z2 * 0.0013888889f)))));
                const float m2 = z2 > -0.25f ? m2s : 1.0f - a * a;
                xu[idx] = __builtin_amdgcn_sqrtf(m2) * ig * x; aS[idx] = a; }
        __builtin_amdgcn_wave_barrier();
#pragma unroll
        for (int tt = 0; tt < 16; ++tt) { const float a = aS[tt * 68 + lane], uu = xu[tt * 68 + lane]; hh = a * hh + uu; ap *= a;
            const float gl = gelu_tanh(bf2f(gr[tt]));
            if (!dry) bg0[(r0 + tt) * D + c] = f2bf(gl * hh);
            pp0[(r0 + tt) * D + c] = f2bf(gl * ap); }
        __builtin_amdgcn_wave_barrier();
        if (g < 2) {
#pragma unroll
            for (int tt = 0; tt < 16; ++tt) xr[tt] = xn[tt];
        }
    }
    *(float2*)(summ + (((size_t)b * NCH + j) * D + c) * 2) = make_float2(ap, hh);
    if (j == NCH - 1) { p.out[O_CBP + ((size_t)b * 3 + 0) * D + c] = xm3; p.out[O_CBP + ((size_t)b * 3 + 1) * D + c] = xm2; p.out[O_CBP + ((size_t)b * 3 + 2) * D + c] = xm1; }
}
__device__ __forceinline__ void sample_item(const Params& p, int k, int h, LAS unsigned char* wl, const LAS unsigned char* wlds, int lane) {
    bf16_t* U = (bf16_t*)(p.ws + WS_U);
    const int c = h * 64 + lane, fr = lane & 15, fq = lane >> 4;
    const size_t row0 = (size_t)MP + (size_t)k * 16; const int s0 = k * 16;
    const bf16_t* bx0 = U + 3 * SLOT + row0 * D; bf16_t* bg0 = U + 1 * SLOT + row0 * D;
    const LAS unsigned char* wq = wlds + fr * 144 + fq * 16;
    float brv[4], biv[4], lcv[4];
#pragma unroll
    for (int nt = 0; nt < 4; ++nt) { const int ch = h * 64 + nt * 16 + fr; brv[nt] = p.in[19][ch]; biv[nt] = p.in[21][ch]; lcv[nt] = ((const float*)(p.ws + WS_LC))[ch]; }
    const float w0 = p.in[16][c], w1 = p.in[16][D + c], w2 = p.in[16][2 * D + c], w3 = p.in[16][3 * D + c], cbias = p.in[17][c];
    LAS unsigned short* cbT = (LAS unsigned short*)wl;
    LAS float* xu = (LAS float*)(wl + 2304);
    LAS float* aS = (LAS float*)(wl + 2304 + 4352);
    const float* sb = p.in[3] + (size_t)s0 * 3 * D + c;
#pragma unroll
    for (int tt = 0; tt < 16; ++tt) {
        const float x = bf2f(bx0[tt * D + c]); const float t0 = sb[(tt * 3 + 0) * D], t1 = sb[(tt * 3 + 1) * D], t2 = sb[(tt * 3 + 2) * D];
        const float cb = w0 * t0 + w1 * t1 + w2 * t2 + w3 * x + cbias;
        float* ob = p.out + O_CBS + ((size_t)(s0 + tt) * 3) * D + c; ob[0] = t1; ob[D] = t2; ob[2 * D] = x;
        cbT[tt * 72 + lane] = f2bf(cb); xu[tt * 68 + lane] = cb;
    }
    __builtin_amdgcn_wave_barrier();
    const bf16x8 a0 = *(const LAS bf16x8*)(cbT + fr * 72 + fq * 8), a1 = *(const LAS bf16x8*)(cbT + fr * 72 + 32 + fq * 8);
    f32x4 accR[4], accI[4];
#pragma unroll
    for (int nt = 0; nt < 4; ++nt) {
        const bf16x8 r0w = *(const LAS bf16x8*)(wq + nt * 2304), r1w = *(const LAS bf16x8*)(wq + nt * 2304 + 64);
        const bf16x8 i0w = *(const LAS bf16x8*)(wq + 9216 + nt * 2304), i1w = *(const LAS bf16x8*)(wq + 9216 + nt * 2304 + 64);
        accR[nt] = __builtin_amdgcn_mfma_f32_16x16x32_bf16(a0, r0w, (f32x4){0.f, 0.f, 0.f, 0.f}, 0, 0, 0);
        accR[nt] = __builtin_amdgcn_mfma_f32_16x16x32_bf16(a1, r1w, accR[nt], 0, 0, 0);
        accI[nt] = __builtin_amdgcn_mfma_f32_16x16x32_bf16(a0, i0w, (f32x4){0.f, 0.f, 0.f, 0.f}, 0, 0, 0);
        accI[nt] = __builtin_amdgcn_mfma_f32_16x16x32_bf16(a1, i1w, accI[nt], 0, 0, 0);
    }
#pragma unroll
    for (int nt = 0; nt < 4; ++nt)
#pragma unroll
        for (int i = 0; i < 4; ++i) { const int idx = (fq * 4 + i) * 68 + nt * 16 + fr; const float x = xu[idx];
            const float r = sigm(accR[nt][i] + brv[nt]), ig = sigm(accI[nt][i] + biv[nt]);
            const float la = lcv[nt] * r; const float a = __expf(la);
            const float z2 = 2.0f * la;
            const float m2s = -z2 * (1.0f + z2 * (0.5f + z2 * (0.16666667f + z2 * (0.041666668f + z2 * (0.0083333338f + z2 * 0.0013888889f)))));
            const float m2 = z2 > -0.25f ? m2s : 1.0f - a * a;
            xu[idx] = __builtin_amdgcn_sqrtf(m2) * ig * x; aS[idx] = a; }
    __builtin_amdgcn_wave_barrier();
#pragma unroll
    for (int tt = 0; tt < 16; ++tt) {
        const float hn = aS[tt * 68 + lane] * p.in[4][(size_t)(s0 + tt) * D + c] + xu[tt * 68 + lane];
        p.out[O_RGS + (size_t)(s0 + tt) * D + c] = hn;
        bg0[tt * D + c] = f2bf(gelu_tanh(bf2f(bg0[tt * D + c])) * hn);
    }
    __builtin_amdgcn_wave_barrier();
}
__device__ __forceinline__ void scan_phase(const Params& p, LAS unsigned char* lds, int tid, bool dry) {
    const int wid = __builtin_amdgcn_readfirstlane(tid >> 6), lane = tid & 63;
    LAS unsigned char* wl = lds + wid * WL_BYTES;
    LAS unsigned char* wlds = lds + 8 * WL_BYTES;
    const int h = blockIdx.x & 15;
    {
        const bf16_t* wt = (const bf16_t*)(p.ws + WS_WRG);
#pragma unroll
        for (int q = 0; q < 2; ++q) { const int e = tid + q * 512, g = e >> 9, jrow = (e >> 3) & 63, pc = e & 7;
            *(LAS u32x4*)(wlds + g * 9216 + jrow * 144 + pc * 16) = *(const u32x4*)(wt + (size_t)g * 65536 + (size_t)(h * 64 + jrow) * 64 + pc * 8); }
    }
    __syncthreads();
    const int nbh = gridDim.x >> 4;
    for (int it = (blockIdx.x >> 4) * 8 + wid; it < NB * NCH; it += nbh * 8) scan_item(p, it / NCH, it % NCH, h, wl, wlds, lane, dry);
    if (!dry && wid < 2 && (int)(blockIdx.x >> 4) >= nbh - 4) {
        const int k = ((int)(blockIdx.x >> 4) - (nbh - 4)) * 2 + wid;
        if (k < NS / 16) sample_item(p, k, h, wl, wlds, lane);
    }
    __syncthreads();
}
__device__ __forceinline__ void fix_phase(const Params& p, LAS unsigned char* lds, int tid, bool dry) {
    bf16_t* zb = (bf16_t*)(p.ws + WS_U) + 1 * SLOT; const bf16_t* pp = (const bf16_t*)p.out;
    const float* summ = (const float*)(p.ws + WS_SUMM);
    LAS float* cs = (LAS float*)lds;
    for (int it = blockIdx.x; it < NB * (NCH - 1); it += gridDim.x) {
        const int b = it / (NCH - 1), j = it % (NCH - 1) + 1;
#pragma unroll
        for (int cq = 0; cq < 2; ++cq) {
            const int c = tid + cq * 512; const float* sp = summ + ((size_t)b * NCH * D + c) * 2; float hh = 0.f;
            for (int i0 = 0; i0 < j; i0 += 16) {
                float va[16], vh[16];
#pragma unroll
                for (int k = 0; k < 16; ++k) { if (i0 + k < j) { const float2 v = *(const float2*)(sp + (size_t)(i0 + k) * D * 2); va[k] = v.x; vh[k] = v.y; } else { va[k] = 1.f; vh[k] = 0.f; } }
#pragma unroll
                for (int k = 0; k < 16; ++k) hh = va[k] * hh + vh[k];
            }
            cs[c] = hh;
            if (j == NCH - 1) { const float2 v = *(const float2*)(sp + (size_t)j * D * 2); p.out[O_RGP + (size_t)b * D + c] = v.x * hh + v.y; }
        }
        __syncthreads();
        const size_t row0 = (size_t)b * TP + (size_t)j * CHUNK;
#pragma unroll 4
        for (int q = 0; q < CHUNK * 128 / 512; ++q) {
            const int e = tid + q * 512, tt = e >> 7, vc = e & 127; const size_t o = (row0 + tt) * D + vc * 8;
            const u32x4 zq = *(const u32x4*)(zb + o), pq = *(const u32x4*)(pp + o);
            const f32x4 c0 = *(const LAS f32x4*)(cs + vc * 8), c1 = *(const LAS f32x4*)(cs + vc * 8 + 4);
            u32x4 w;
            w.x = cvt_pk_bf16(bflo(zq.x) + bflo(pq.x) * c0[0], bfhi(zq.x) + bfhi(pq.x) * c0[1]); w.y = cvt_pk_bf16(bflo(zq.y) + bflo(pq.y) * c0[2], bfhi(zq.y) + bfhi(pq.y) * c0[3]);
            w.z = cvt_pk_bf16(bflo(zq.z) + bflo(pq.z) * c1[0], bfhi(zq.z) + bfhi(pq.z) * c1[1]); w.w = cvt_pk_bf16(bflo(zq.w) + bflo(pq.w) * c1[2], bfhi(zq.w) + bfhi(pq.w) * c1[3]);
            if (!dry) *(u32x4*)(zb + o) = w;
        }
        __syncthreads();
    }
}
__device__ __forceinline__ void za_phase(const Params& p, int tid, bool dry) {
    bf16_t* U = (bf16_t*)(p.ws + WS_U); bf16_t* ab = U; const bf16_t* ca = U + 2 * SLOT;
    const float* cw = p.in[14];
    for (int idx = blockIdx.x * 512 + tid; idx < NB * 129 * 128; idx += gridDim.x * 512) {
        const int vc = idx & 127, tb = (idx >> 7) % 129, b = idx / (128 * 129); const int c0 = vc * 8;
        float w[3][8];
#pragma unroll
        for (int k = 0; k < 3; ++k) { const f32x4 a = *(const f32x4*)(cw + k * D + c0), bq = *(const f32x4*)(cw + k * D + c0 + 4);
#pragma unroll
            for (int e = 0; e < 4; ++e) { w[k][e] = a[e]; w[k][4 + e] = bq[e]; } }
        const size_t r0 = (size_t)b * TP + (size_t)tb * 16;
        float p2[8], p1[8];
        if (tb > 0) { const u32x4 q2 = *(const u32x4*)(ca + (r0 - 2) * D + c0), q1 = *(const u32x4*)(ca + (r0 - 1) * D + c0);
#pragma unroll
            for (int e = 0; e < 4; ++e) { p2[2 * e] = bflo(q2[e]); p2[2 * e + 1] = bfhi(q2[e]); p1[2 * e] = bflo(q1[e]); p1[2 * e + 1] = bfhi(q1[e]); } }
        else {
#pragma unroll
            for (int e = 0; e < 8; ++e) { p2[e] = 0.f; p1[e] = 0.f; } }
#pragma unroll 4
        for (int tt = 0; tt < 16; ++tt) {
            const u32x4 qc = *(const u32x4*)(ca + (r0 + tt) * D + c0), qa = *(const u32x4*)(ab + (r0 + tt) * D + c0);
            float cv[8], av[8], zv[8];
#pragma unroll
            for (int e = 0; e < 4; ++e) { cv[2 * e] = bflo(qc[e]); cv[2 * e + 1] = bfhi(qc[e]); av[2 * e] = bflo(qa[e]); av[2 * e + 1] = bfhi(qa[e]); }
#pragma unroll
            for (int e = 0; e < 8; ++e) { zv[e] = av[e] * (w[0][e] * p2[e] + w[1][e] * p1[e] + w[2][e] * cv[e]); p2[e] = p1[e]; p1[e] = cv[e]; }
            u32x4 o; o.x = cvt_pk_bf16(zv[0], zv[1]); o.y = cvt_pk_bf16(zv[2], zv[3]); o.z = cvt_pk_bf16(zv[4], zv[5]); o.w = cvt_pk_bf16(zv[6], zv[7]);
            if (!dry) *(u32x4*)(ab + (r0 + tt) * D + c0) = o;
        }
        if (tb == 128) {
            float* o2 = p.out + O_CAP + ((size_t)b * 2 + 0) * D + c0; float* o1 = p.out + O_CAP + ((size_t)b * 2 + 1) * D + c0;
            *(f32x4*)o2 = (f32x4){p2[0], p2[1], p2[2], p2[3]}; *(f32x4*)(o2 + 4) = (f32x4){p2[4], p2[5], p2[6], p2[7]};
            *(f32x4*)o1 = (f32x4){p1[0], p1[1], p1[2], p1[3]}; *(f32x4*)(o1 + 4) = (f32x4){p1[4], p1[5], p1[6], p1[7]};
        }
    }
    if (!dry) {
        for (int idx = blockIdx.x * 512 + tid; idx < NS * 128; idx += gridDim.x * 512) {
            const int vc = idx & 127, sm = idx >> 7, c0 = vc * 8; const size_t ro = (size_t)(MP + sm) * D + c0;
            const u32x4 qc = *(const u32x4*)(ca + ro), qa = *(const u32x4*)(ab + ro);
            const float* sa = p.in[2] + (size_t)sm * 2 * D + c0;
            float h0[8], h1[8], cv[8], zv[8];
            { const f32x4 a0 = *(const f32x4*)sa, a1 = *(const f32x4*)(sa + 4), b0 = *(const f32x4*)(sa + D), b1 = *(const f32x4*)(sa + D + 4);
#pragma unroll
              for (int e = 0; e < 4; ++e) { h0[e] = a0[e]; h0[4 + e] = a1[e]; h1[e] = b0[e]; h1[4 + e] = b1[e]; } }
#pragma unroll
            for (int e = 0; e < 4; ++e) { cv[2 * e] = bflo(qc[e]); cv[2 * e + 1] = bfhi(qc[e]); }
#pragma unroll
            for (int e = 0; e < 8; ++e) { const float wa0 = cw[c0 + e], wa1 = cw[D + c0 + e], wa2 = cw[2 * D + c0 + e];
                const float av = (e & 1) ? bfhi(qa[e >> 1]) : bflo(qa[e >> 1]); zv[e] = av * (wa0 * h0[e] + wa1 * h1[e] + wa2 * cv[e]); }
            u32x4 o; o.x = cvt_pk_bf16(zv[0], zv[1]); o.y = cvt_pk_bf16(zv[2], zv[3]); o.z = cvt_pk_bf16(zv[4], zv[5]); o.w = cvt_pk_bf16(zv[6], zv[7]);
            *(u32x4*)(ab + ro) = o;
            float* o0 = p.out + O_CAS + ((size_t)sm * 2 + 0) * D + c0; float* o1 = o0 + D;
            *(f32x4*)o0 = (f32x4){h1[0], h1[1], h1[2], h1[3]}; *(f32x4*)(o0 + 4) = (f32x4){h1[4], h1[5], h1[6], h1[7]};
            *(f32x4*)o1 = (f32x4){cv[0], cv[1], cv[2], cv[3]}; *(f32x4*)(o1 + 4) = (f32x4){cv[4], cv[5], cv[6], cv[7]};
        }
    }
}

__device__ __forceinline__ void merge_phase(const Params& p, int tid) {
    const bf16_t* U = (const bf16_t*)(p.ws + WS_U); bf16_t* H = (bf16_t*)p.out; const float* PO = (const float*)(p.ws + WS_POAB);
    for (size_t i = (size_t)blockIdx.x * 512 + tid; i < SLOT / 8; i += (size_t)gridDim.x * 512) {
        const u32x4 ga = *(const u32x4*)(U + 4 * SLOT + i * 8), gb = *(const u32x4*)(U + 5 * SLOT + i * 8);
        float ya[8], yb[8];
        const int row = (int)(i >> 7);
        if (row < MAINR) {
            const u32x4 a = *(const u32x4*)(U + 2 * SLOT + i * 8), b = *(const u32x4*)(U + 3 * SLOT + i * 8);
#pragma unroll
            for (int e = 0; e < 4; ++e) { ya[2 * e] = bflo(a[e]); ya[2 * e + 1] = bfhi(a[e]); yb[2 * e] = bflo(b[e]); yb[2 * e + 1] = bfhi(b[e]); }
        } else {
            const size_t o = (size_t)(row - MAINR) * D + (size_t)(i & 127) * 8;
#pragma unroll
            for (int e = 0; e < 8; ++e) { ya[e] = 0.f; yb[e] = 0.f; }
#pragma unroll
            for (int ks = 0; ks < 4; ++ks) {
                const f32x4 a0 = *(const f32x4*)(PO + (size_t)(ks * 2 + 0) * (256 * D) + o), a1 = *(const f32x4*)(PO + (size_t)(ks * 2 + 0) * (256 * D) + o + 4);
                const f32x4 b0 = *(const f32x4*)(PO + (size_t)(ks * 2 + 1) * (256 * D) + o), b1 = *(const f32x4*)(PO + (size_t)(ks * 2 + 1) * (256 * D) + o + 4);
#pragma unroll
                for (int e = 0; e < 4; ++e) { ya[e] += a0[e]; ya[4 + e] += a1[e]; yb[e] += b0[e]; yb[4 + e] += b1[e]; }
            }
        }
        u32x4 o4;
#pragma unroll
        for (int e = 0; e < 4; ++e) { const float lo = sigm(bflo(ga[e])) * ya[2 * e] + sigm(bflo(gb[e])) * yb[2 * e], hi = sigm(bfhi(ga[e])) * ya[2 * e + 1] + sigm(bfhi(gb[e])) * yb[2 * e + 1]; o4[e] = cvt_pk_bf16(lo, hi); }
        *(u32x4*)(H + i * 8) = o4;
    }
}

#define XB_TMO      128
#define XB_XCNT(j)  (256  + 64 * (j))
#define XB_XSUB(j)  (1280 + 64 * (j))
#define XB_XGEN(j)  (2304 + 64 * (j))
#define XB_TOP      3328
#define XB_TOPGEN   3392
#define XCD_BAR_WORDS 3456
#define XB_SPIN_CAP (1u << 18)
__device__ __forceinline__ unsigned xb_ld(unsigned* p)              { return __hip_atomic_load(p, __ATOMIC_RELAXED, __HIP_MEMORY_SCOPE_AGENT); }
__device__ __forceinline__ unsigned xb_add(unsigned* p, unsigned v) { return __hip_atomic_fetch_add(p, v, __ATOMIC_RELAXED, __HIP_MEMORY_SCOPE_AGENT); }
__device__ __forceinline__ unsigned xb_xcc_id() { return (unsigned)__builtin_amdgcn_s_getreg((3 << 11) | 20) & 0xFu; }
#define XB_SPIN(cond, bar) do { unsigned _sp = 0; while (cond) { __builtin_amdgcn_s_sleep(1); \
    if ((++_sp & 255u) == 0u) { if (xb_ld(&(bar)[XB_TMO])) break; if (_sp > XB_SPIN_CAP) { atomicAdd(&(bar)[XB_TMO], 1u); break; } } } } while (0)
struct XcdBarrier { unsigned* bar; unsigned x; volatile LAS unsigned* st; };
__device__ __forceinline__ XcdBarrier xcd_barrier_post(unsigned* bar, volatile LAS unsigned* st) {
    XcdBarrier b; b.bar = bar; b.x = xb_xcc_id(); b.st = st;
    if (threadIdx.x == 0) (void)xb_add(&bar[XB_XCNT(b.x)], 1u);
    return b;
}
__device__ __forceinline__ void xcd_barrier_complete(unsigned* bar, unsigned x, unsigned& nloc, unsigned& nx) {
    const unsigned G = gridDim.x * gridDim.y * gridDim.z;
    unsigned sum, cnt, mine, sp = 0u;
    for (;;) {
        sum = 0u; cnt = 0u; mine = 0u;
#pragma unroll
        for (unsigned j = 0; j < 16; ++j) { const unsigned c = xb_ld(&bar[XB_XCNT(j)]); sum += c; cnt += (c > 0u) ? 1u : 0u; mine = (j == x) ? c : mine; }
        if (sum == G) break;
        __builtin_amdgcn_s_sleep(1);
        if ((++sp & 255u) == 0u) { if (xb_ld(&bar[XB_TMO])) break; if (sp > XB_SPIN_CAP) { atomicAdd(&bar[XB_TMO], 1u); break; } }
    }
    nloc = mine > 0u ? mine : 1u; nx = cnt > 0u ? cnt : 1u;
}
__device__ __forceinline__ void xcd_barrier(const XcdBarrier& b) {
    asm volatile("s_waitcnt vmcnt(0)" ::: "memory");
    __syncthreads();
    if (threadIdx.x == 0) {
        unsigned* bar = b.bar;
        __builtin_amdgcn_s_waitcnt(0);
        unsigned nloc = b.st[0], nx = b.st[1];
        if (nloc == 0u) { xcd_barrier_complete(bar, b.x, nloc, nx); b.st[0] = nloc; b.st[1] = nx; }
        const unsigned old = xb_add(&bar[XB_XSUB(b.x)], 1u);
        const unsigned gen = old / nloc;
        if (old + 1u == (gen + 1u) * nloc) {
            __builtin_amdgcn_fence(__ATOMIC_RELEASE, "agent");
            asm volatile("s_waitcnt vmcnt(0)" ::: "memory");
            const unsigned og = xb_add(&bar[XB_TOP], 1u);
            const unsigned tg = og / nx;
            if (og + 1u == (tg + 1u) * nx) xb_add(&bar[XB_TOPGEN], 1u);
            else XB_SPIN(xb_ld(&bar[XB_TOPGEN]) == tg, bar);
            __builtin_amdgcn_fence(__ATOMIC_ACQUIRE, "agent");
            xb_add(&bar[XB_XGEN(b.x)], 1u);
            asm volatile("s_waitcnt vmcnt(0)" ::: "memory");
        } else {
            XB_SPIN(xb_ld(&bar[XB_XGEN(b.x)]) == gen, bar);
            __builtin_amdgcn_fence(__ATOMIC_ACQUIRE, "agent");
            asm volatile("s_waitcnt vmcnt(0)" ::: "memory");
        }
    }
    __syncthreads();
}

constexpr int NPHASE = 14;
constexpr int LDS_BYTES = 131072 + 16;
__global__ void __launch_bounds__(512, 2) mk_fwd(Params p, int ph_lo, int ph_hi) {
    extern __shared__ __attribute__((aligned(16))) unsigned char shm[];
    LAS unsigned char* lds = (LAS unsigned char*)shm;
    cg::grid_group grid = cg::this_grid();
    if (threadIdx.x == 0) { *(LAS u32x4*)(lds + 131072) = (u32x4){0u, 0u, 0u, 0u}; }
    __syncthreads();
    const XcdBarrier xb = xcd_barrier_post((unsigned*)(p.ws + WS_BAR), (volatile LAS unsigned*)(lds + 131072));
    for (int ph2 = ph_lo * 2; ph2 < ph_hi * 2; ++ph2) {
        const int ph = ph2 >> 1; const bool dry = !(ph2 & 1);
        if (dry && !((REP_MASK >> ph) & 1)) continue;
        int tid = threadIdx.x; asm volatile("" : "+v"(tid));
        if (ph == 0) {
            convert_set(p, 0, lds, tid);
            bf16_t* wt = (bf16_t*)(p.ws + WS_WRG);
            for (int o = blockIdx.x * 512 + tid; o < 2 * 65536; o += gridDim.x * 512) { const int g = o >> 16, h = (o >> 12) & 15, j = (o >> 6) & 63, i = o & 63;
                wt[o] = f2bf((g ? p.in[20] : p.in[18])[(size_t)(h * 64 + i) * 64 + j]); }
            if (blockIdx.x * 512 + tid < D) { const int ch = blockIdx.x * 512 + tid; ((float*)(p.ws + WS_LC))[ch] = -8.0f * log1pf(expf(-p.in[22][ch])); }
            norm_phase(p, 0, tid, dry, 0);
        } else if (ph == 1 || ph == 11) {
            pg8::Gemm g{(const bf16_t*)(p.ws + WS_H), (const bf16_t*)(p.ws + WS_WGU), M, 2 * DFF, D, 0, 0};
            pg8::StaticOrder S; S.init(M, 2 * DFF, D, gridDim.x, blockIdx.x);
            pg8::EpiGU E{(bf16_t*)(p.ws + WS_ACT), dry};
            pg8::gemm_phase(lds, g, S, E);
        } else if (ph == 2 || ph == 12 || ph == 9 || ph == 7) {
            const bool dn = (ph == 2 || ph == 12), oab = (ph == 7);
            pg8::Gemm g{dn ? (const bf16_t*)(p.ws + WS_ACT) : (oab ? (const bf16_t*)(p.ws + WS_U) : (const bf16_t*)p.out), (const bf16_t*)(p.ws + (dn ? WS_WD : (oab ? WS_WOAB : WS_WO))), M, D, dn ? DFF : D, SB, (size_t)1024 * 1024 * 2};
            pg8::SplitOrder S; S.init(oab ? 2 * D : D, dn ? DFF : D, gridDim.x, blockIdx.x, dn ? 11 : 4, 4);
            pg8::EpiBF E{(bf16_t*)(p.ws + (oab ? WS_U + 2 * SB : WS_Y)), SLOT, (float*)(p.ws + (oab ? WS_POAB : WS_PY)), oab ? 2 : 1};
            pg8::gemm_phase(lds, g, S, E);
            if (!dry && ph == 2) convert_set(p, 2, lds, tid);
            if (!dry && ph == 9) convert_set(p, 1, lds, tid);
        } else if (ph == 3) {
            norm_phase(p, 1, tid, dry, 11);
        } else if (ph == 4) {
            pg8::Gemm g{(const bf16_t*)(p.ws + WS_H), (const bf16_t*)(p.ws + WS_WIN), M, DIN, D, 0, 0};
            pg8::StaticOrder S; S.init(M, DIN, D, gridDim.x, blockIdx.x);
            pg8::EpiIN E{(bf16_t*)(p.ws + WS_U)};
            pg8::gemm_phase(lds, g, S, E);
        } else if (ph == 5) {
            scan_phase(p, lds, tid, dry);
        } else if (ph == 6) {
            fix_phase(p, lds, tid, dry);
            za_phase(p, tid, dry);
        } else if (ph == 8) {
            merge_phase(p, tid);
        } else if (ph == 10) {
            norm_phase(p, 2, tid, dry, 4);
        } else if (ph == 13) {
            norm_phase(p, 3, tid, dry, 11);
        }
        if (ph2 + 1 < ph_hi * 2) { if (ph_hi > NPHASE) grid.sync(); else xcd_barrier(xb); }
    }
}

extern "C" void kernel_launch(void* const* d_in, const int* in_sizes, int n_in, void* d_out, int out_size, void* d_ws, size_t ws_size, hipStream_t stream) {
    if (n_in != 30 || ws_size < WS_END) { fprintf(stderr, "kernel_launch: unexpected n_in %d / ws_size %zu (need %zu)\n", n_in, ws_size, (size_t)WS_END); return; }
    Params p{};
    for (int i = 0; i < 30; ++i) p.in[i] = (const float*)d_in[i];
    p.out = (float*)d_out; p.ws = (unsigned char*)d_ws;
    (void)hipFuncSetAttribute((const void*)mk_fwd, hipFuncAttributeMaxDynamicSharedMemorySize, LDS_BYTES);
    static int grid_blocks = 0;
    if (!grid_blocks) {
        int dev = 0, cus = 0, per_cu = 0;
        (void)hipGetDevice(&dev);
        (void)hipDeviceGetAttribute(&cus, hipDeviceAttributeMultiprocessorCount, dev);
        (void)hipOccupancyMaxActiveBlocksPerMultiprocessor(&per_cu, (const void*)mk_fwd, 512, LDS_BYTES);
        if (per_cu < 1) { fprintf(stderr, "kernel_launch: occupancy query says %d blocks/CU\n", per_cu); per_cu = 1; }
        grid_blocks = cus;
    }
    (void)hipMemsetAsync((unsigned char*)d_ws + WS_BAR, 0, 16384, stream);
#if SINGLE_LAUNCH
    int lo = 0, hi = NPHASE;
    void* args[] = {&p, &lo, &hi};
    hipError_t e = hipLaunchCooperativeKernel((const void*)mk_fwd, dim3(grid_blocks), dim3(512), args, LDS_BYTES, stream);
    if (e != hipSuccess) fprintf(stderr, "cooperative launch failed: %s (grid %d)\n", hipGetErrorString(e), grid_blocks);
#else
    for (int ph = 0; ph < NPHASE; ++ph) hipLaunchKernelGGL(mk_fwd, dim3(grid_blocks), dim3(512), LDS_BYTES, stream, p, ph, ph + 1);
#endif
}
```

```cpp
#include <hip/hip_runtime.h>
#include <hip/hip_cooperative_groups.h>
#include <cstdio>
namespace cg = cooperative_groups;

#ifndef REP_MASK
#define REP_MASK 0
#endif
#ifndef SINGLE_LAUNCH
#define SINGLE_LAUNCH 1
#endif

#define LAS __attribute__((address_space(3)))
typedef unsigned short bf16_t;
typedef short bf16x8 __attribute__((ext_vector_type(8)));
typedef float f32x4 __attribute__((ext_vector_type(4)));
typedef unsigned u32x4 __attribute__((ext_vector_type(4)));
typedef unsigned u32x2 __attribute__((ext_vector_type(2)));

constexpr int D = 1024, DFF = 2816, DIN = 7168;
constexpr int NB = 8, SEQ = 2048, NMETA = 16, TP = SEQ + NMETA;
constexpr int MP = NB * TP;
constexpr int NS = 128;
constexpr int M = MP + NS;
constexpr int CHUNK = 48, NCH = TP / CHUNK;
constexpr float EPS = 1e-6f;

constexpr size_t O_YP = 0, O_YS = 16777216, O_CAP = O_YS + 131072, O_CBP = O_CAP + 16384, O_RGP = O_CBP + 24576,
                 O_CAS = O_RGP + 8192, O_CBS = O_CAS + 262144, O_RGS = O_CBS + 393216;

constexpr size_t SLOT = (size_t)M * D;
constexpr size_t SB = SLOT * 2;
constexpr size_t WS_U = 0;
constexpr size_t WS_ACT = 0;
constexpr size_t WS_Y = 3 * SB;
constexpr size_t WS_PY = 4 * SB;
constexpr int MAINR = 64 * 256;
constexpr size_t WS_WGU = 5 * SB;
constexpr size_t WS_WD = WS_WGU + (size_t)5632 * 1024 * 2;
constexpr size_t WS_H = 6 * SB;
constexpr size_t WS_WIN = 7 * SB;
constexpr size_t WS_POAB = WS_WIN;
constexpr size_t WS_WOAB = WS_WIN + (size_t)7168 * 1024 * 2;
constexpr size_t WS_WO = WS_WOAB + (size_t)2 * 1024 * 1024 * 2;
constexpr size_t WS_WRG = WS_WO + (size_t)1024 * 1024 * 2;
constexpr size_t WS_SUMM = WS_WRG + (size_t)2 * 16 * 64 * 64 * 2;
constexpr size_t WS_SC = WS_SUMM + (size_t)NB * NCH * D * 2 * 4;
constexpr size_t WS_LC = WS_SC + 98304;
constexpr size_t WS_BAR = WS_SC + 131072;
constexpr size_t WS_PCB = WS_BAR + 16384;
constexpr size_t WS_PCA = WS_PCB + (size_t)NS * D * 4;
constexpr size_t WS_END = WS_PCA + (size_t)NS * D * 4;
static_assert(WS_END <= (size_t)256 * 1024 * 1024, "workspace");

struct Params { const float* in[30]; float* out; unsigned char* ws; };

__device__ __forceinline__ unsigned cvt_pk_bf16(float lo, float hi) { unsigned r; asm volatile("v_cvt_pk_bf16_f32 %0, %1, %2" : "=v"(r) : "v"(lo), "v"(hi)); return r; }
__device__ __forceinline__ bf16_t f2bf(float f) { return (bf16_t)(cvt_pk_bf16(f, 0.f) & 0xffffu); }
__device__ __forceinline__ float bf2f(bf16_t b) { return __uint_as_float(((unsigned)b) << 16); }
__device__ __forceinline__ float bflo(unsigned w) { return __uint_as_float(w << 16); }
__device__ __forceinline__ float bfhi(unsigned w) { return __uint_as_float(w & 0xffff0000u); }
__device__ __forceinline__ float sigm(float x) { return __builtin_amdgcn_rcpf(1.0f + __expf(-x)); }
__device__ __forceinline__ float gelu_tanh(float x) { const float t = 1.5957691216057308f * (x + 0.044715f * x * x * x); return x * sigm(t); }
__device__ __forceinline__ float wave_sum(float v, int lane) {
#pragma unroll
    for (int o = 32; o >= 1; o >>= 1) v += __int_as_float(__builtin_amdgcn_ds_bpermute((lane ^ o) << 2, __float_as_int(v)));
    return v;
}
__device__ __forceinline__ const float* x0row(const Params& p, int r) {
    if (r >= MP) return p.in[1] + (size_t)(r - MP) * D;
    const int b = r / TP, t = r - b * TP;
    if (t < NMETA) return p.in[5] + (size_t)t * D;
    return p.in[0] + ((size_t)b * SEQ + (t - NMETA)) * D;
}

namespace pg8 {
constexpr int BM = 256, BK = 64, HALF = 128, HTB = HALF * BK * 2, STAGE_BYTES = 8 * HTB, NXCD = 8, WGM = 8;
__host__ __device__ __forceinline__ int lds_byte(int r, int c) { const int st = (r >> 4) * 2 + (c >> 5), rr = r & 15, cc = c & 31, ob = rr * 64 + cc * 2; return st * 1024 + (ob ^ (((ob >> 9) & 1) << 5)); }
__host__ __device__ __forceinline__ void stage_rc(int b, int& R, int& C) { const int st = b / 1024, sb = b % 1024, swz = sb ^ (((sb >> 9) & 1) << 5); R = (st >> 1) * 16 + swz / 64; C = (st & 1) * 32 + (swz % 64) / 2; }
__host__ __device__ __forceinline__ int perm32(int rho) { const int n = rho >> 4, i = rho & 15; return 8 * (i >> 2) + 4 * n + (i & 3); }

struct Unit { int pm, pn, z, k0, nk, part; };
struct Gemm { const bf16_t* A; const bf16_t* Bt; int M, N, K; size_t zA, zB; };

struct StaticOrder {
    int nM, nN, nwg, G, c, ntf;
    __device__ void init(int M_, int N_, int K_, int G_, int c_) { nM = M_ / BM; nN = N_ / BM; nwg = nM * nN; G = G_; c = c_; ntf = K_ / BK; }
    __device__ bool map(long L, Unit& u) const {
        if (L >= nwg) return false;
        int wgid = (int)L; { const int q = nwg / NXCD, r = nwg % NXCD, xcd = wgid % NXCD, off = wgid / NXCD; wgid = (xcd < r ? xcd * (q + 1) : r * (q + 1) + (xcd - r) * q) + off; }
        const int nig = WGM * nN, gid = wgid / nig, fm = gid * WGM, gsz = (nM - fm) < WGM ? (nM - fm) : WGM;
        u.pm = fm + ((wgid % nig) % gsz); u.pn = (wgid % nig) / gsz; u.z = 0; u.k0 = 0; u.nk = ntf; u.part = -1; return true;
    }
    __device__ bool next(int i, Unit& u) const { return map((long)i * G + c, u); }
};
struct SplitOrder : StaticOrder {
    int nsplit, nkm;
    __device__ void init(int N_, int K_, int G_, int c_, int nsplit_, int nkm_) { StaticOrder::init(64 * BM, N_, K_, G_, c_); nsplit = nsplit_; nkm = nkm_; }
    __device__ bool next(int i, Unit& u) const {
        const long L = (long)i * G + c; bool ok;
        if (L < nwg) ok = map(L, u);
        else { const int L2 = (int)(L - nwg); ok = L2 < nN * nsplit; const int ks = L2 / nN; u.pm = 64; u.pn = L2 - ks * nN; u.k0 = ks * nkm; u.nk = nkm; u.part = ks; }
        u.z = u.pn >> 2; u.pn &= 3; return ok;
    }
};

template <class Epi, class Sched>
__device__ __forceinline__ void gemm_phase(LAS unsigned char* lds, const Gemm g, const Sched& S, const Epi& E) {
    int tid_ = threadIdx.x; asm volatile("" : "+v"(tid_));
    const int tid = tid_, wid = __builtin_amdgcn_readfirstlane(tid >> 6), lane = tid & 63, wr = wid >> 2, wc = wid & 3, fr = lane & 15, fq = lane >> 4;
    const int K = g.K;
    unsigned voffA[2], voffB[2];
#pragma unroll
    for (int i = 0; i < 2; ++i) { int R, C; stage_rc(tid * 16 + i * 8192, R, C); const int Rb = Epi::PERM ? ((R & ~31) + perm32(R & 31)) : R;
        voffA[i] = (unsigned)(R * K + C) * 2u; voffB[i] = (unsigned)(Rb * K + C) * 2u; }
    const size_t kstep = (size_t)(BK * 2);
    const size_t hstep = (size_t)HALF * K * 2;
    const size_t tstep = 2 * hstep;
    const unsigned ldsw = (unsigned)wid * 1024u;
    const int aoff = lds_byte(wr * 64 + fr, fq * 8), boff = lds_byte(wc * 32 + fr, fq * 8);
#define PG8_SA(b, h) (((b) * 2 + (h)) * HTB)
#define PG8_SB(b, h) ((4 + (b) * 2 + (h)) * HTB)
#define PG8_STAGE(bufoff, gbase, voff) do { _Pragma("unroll") for (int _i = 0; _i < 2; ++_i) \
        __builtin_amdgcn_global_load_lds((const unsigned*)((const char*)(gbase) + (voff)[_i]), (LAS unsigned*)(lds + (bufoff) + ldsw + _i * 8192), 16, 0, 0); } while (0)
#define PG8_LDA(dst, b, h) do { _Pragma("unroll") for (int m = 0; m < 4; ++m) _Pragma("unroll") for (int k = 0; k < 2; ++k) dst[m][k] = *(const LAS bf16x8*)(lds + PG8_SA(b, h) + aoff + m * 2048 + k * 1024); } while (0)
#define PG8_LDB(dst, b, h) do { _Pragma("unroll") for (int n = 0; n < 2; ++n) _Pragma("unroll") for (int k = 0; k < 2; ++k) dst[n][k] = *(const LAS bf16x8*)(lds + PG8_SB(b, h) + boff + n * 2048 + k * 1024); } while (0)
#define PG8_MMA(ai, bj, At, Bt) do { __builtin_amdgcn_s_setprio(1); _Pragma("unroll") for (int m = 0; m < 4; ++m) _Pragma("unroll") for (int n = 0; n < 2; ++n) _Pragma("unroll") for (int k = 0; k < 2; ++k) \
        acc[ai][bj][m][n] = __builtin_amdgcn_mfma_f32_16x16x32_bf16(Bt[n][k], At[m][k], acc[ai][bj][m][n], 0, 0, 0); __builtin_amdgcn_s_setprio(0); } while (0)
#define PG8_WAIT_V(n) asm volatile("s_waitcnt vmcnt(" #n ")" ::: "memory")
#define PG8_WAIT_L(n) asm volatile("s_waitcnt lgkmcnt(" #n ")" ::: "memory")
#define PG8_BAR __builtin_amdgcn_s_barrier()
#define PG8_SCHED __builtin_amdgcn_sched_barrier(0)
    Unit cur, nxt; int ui = 0;
    if (!S.next(0, cur)) return;
    f32x4 acc[2][2][4][2];
#pragma unroll
    for (int a = 0; a < 2; ++a)
#pragma unroll
        for (int b = 0; b < 2; ++b)
#pragma unroll
            for (int m = 0; m < 4; ++m)
#pragma unroll
                for (int n = 0; n < 2; ++n) acc[a][b][m][n] = (f32x4){0.f, 0.f, 0.f, 0.f};
    bf16x8 At[4][2], B0[2][2], B1[2][2];
    const char* cA = (const char*)g.A + (size_t)cur.z * g.zA + (size_t)cur.pm * tstep + (size_t)cur.k0 * kstep; const char* cB = (const char*)g.Bt + (size_t)cur.z * g.zB + (size_t)cur.pn * tstep + (size_t)cur.k0 * kstep;
    int nt = cur.nk;
    PG8_STAGE(PG8_SB(0, 0), cB, voffB); PG8_STAGE(PG8_SA(0, 0), cA, voffA); PG8_STAGE(PG8_SB(0, 1), cB + hstep, voffB); PG8_STAGE(PG8_SA(0, 1), cA + hstep, voffA);
    if (wr == 1) PG8_BAR;
    PG8_WAIT_V(4); PG8_BAR;
    PG8_STAGE(PG8_SB(1, 0), cB + kstep, voffB); PG8_STAGE(PG8_SA(1, 0), cA + kstep, voffA); PG8_STAGE(PG8_SB(1, 1), cB + hstep + kstep, voffB);
    PG8_WAIT_V(6); PG8_BAR;
    for (;;) {
        const bool has_next = S.next(ui + 1, nxt);
        const char* nA = has_next ? (const char*)g.A + (size_t)nxt.z * g.zA + (size_t)nxt.pm * tstep + (size_t)nxt.k0 * kstep : cA; const char* nB = has_next ? (const char*)g.Bt + (size_t)nxt.z * g.zB + (size_t)nxt.pn * tstep + (size_t)nxt.k0 * kstep : cB;
        for (int t = 0; t < nt; t += 2) {
            const bool last = (t == nt - 2);
            const char* a1 = cA + (size_t)(t + 1) * kstep;
            const char* a2 = last ? nA : cA + (size_t)(t + 2) * kstep; const char* b2 = last ? nB : cB + (size_t)(t + 2) * kstep;
            const char* a3 = a2 + kstep; const char* b3 = b2 + kstep;
            PG8_LDB(B0, 0, 0); PG8_SCHED; PG8_LDA(At, 0, 0); PG8_STAGE(PG8_SA(1, 1), a1 + hstep, voffA);
            PG8_WAIT_L(8); PG8_BAR; PG8_WAIT_L(0); PG8_MMA(0, 0, At, B0); PG8_BAR; PG8_SCHED;
            PG8_LDB(B1, 0, 1); PG8_STAGE(PG8_SB(0, 0), b2, voffB);
            PG8_BAR; PG8_WAIT_L(0); PG8_MMA(0, 1, At, B1); PG8_BAR;
            PG8_LDA(At, 0, 1); PG8_STAGE(PG8_SA(0, 0), a2, voffA);
            PG8_BAR; PG8_WAIT_L(0); PG8_MMA(1, 0, At, B0); PG8_BAR; PG8_SCHED;
            PG8_STAGE(PG8_SB(0, 1), b2 + hstep, voffB);
            PG8_WAIT_V(6); PG8_BAR; PG8_MMA(1, 1, At, B1); PG8_BAR;
            PG8_LDB(B0, 1, 0); PG8_SCHED; PG8_LDA(At, 1, 0); PG8_STAGE(PG8_SA(0, 1), a2 + hstep, voffA);
            PG8_WAIT_L(8); PG8_BAR; PG8_WAIT_L(0); PG8_MMA(0, 0, At, B0); PG8_BAR; PG8_SCHED;
            PG8_LDB(B1, 1, 1); PG8_STAGE(PG8_SB(1, 0), b3, voffB);
            PG8_BAR; PG8_WAIT_L(0); PG8_MMA(0, 1, At, B1); PG8_BAR;
            PG8_LDA(At, 1, 1); PG8_STAGE(PG8_SA(1, 0), a3, voffA);
            PG8_BAR; PG8_WAIT_L(0); PG8_MMA(1, 0, At, B0); PG8_BAR; PG8_SCHED;
            PG8_STAGE(PG8_SB(1, 1), b3 + hstep, voffB);
            PG8_WAIT_V(6); PG8_BAR; PG8_MMA(1, 1, At, B1); PG8_BAR;
        }
        E(acc, cur, wr, wc, fr, fq);
        if (!has_next) break;
#pragma unroll
        for (int a = 0; a < 2; ++a)
#pragma unroll
            for (int b = 0; b < 2; ++b)
#pragma unroll
                for (int m = 0; m < 4; ++m)
#pragma unroll
                    for (int n = 0; n < 2; ++n) acc[a][b][m][n] = (f32x4){0.f, 0.f, 0.f, 0.f};
        cur = nxt; cA = nA; cB = nB; nt = cur.nk; ++ui;
    }
    PG8_WAIT_V(0);
    if (wr == 0) PG8_BAR;
    PG8_BAR;
#undef PG8_SA
#undef PG8_SB
#undef PG8_STAGE
#undef PG8_LDA
#undef PG8_LDB
#undef PG8_MMA
#undef PG8_WAIT_V
#undef PG8_WAIT_L
#undef PG8_BAR
#undef PG8_SCHED
}

struct EpiBF {
    static constexpr bool PERM = true;
    bf16_t* O; size_t zO; float* P; int nz;
    __device__ __forceinline__ void operator()(const f32x4 (&acc)[2][2][4][2], const Unit& u, int wr, int wc, int fr, int fq) const {
        const int col0 = u.pn * BM + wc * 32 + 8 * fq;
        if (u.part < 0) {
            const int row0 = u.pm * BM + wr * 64 + fr; bf16_t* base = O + (size_t)u.z * zO;
#pragma unroll
            for (int ai = 0; ai < 2; ++ai)
#pragma unroll
                for (int m = 0; m < 4; ++m) { bf16_t* rowp = base + (size_t)(row0 + ai * HALF + m * 16) * D + col0;
#pragma unroll
                    for (int bj = 0; bj < 2; ++bj) { const f32x4 v0 = acc[ai][bj][m][0], v1 = acc[ai][bj][m][1];
                        u32x4 w; w.x = cvt_pk_bf16(v0[0], v0[1]); w.y = cvt_pk_bf16(v0[2], v0[3]); w.z = cvt_pk_bf16(v1[0], v1[1]); w.w = cvt_pk_bf16(v1[2], v1[3]);
                        *(u32x4*)(rowp + bj * HALF) = w; } }
        } else {
            const int row0 = wr * 64 + fr; float* base = P + (size_t)(u.part * nz + u.z) * (BM * D);
#pragma unroll
            for (int ai = 0; ai < 2; ++ai)
#pragma unroll
                for (int m = 0; m < 4; ++m) { float* rowp = base + (size_t)(row0 + ai * HALF + m * 16) * D + col0;
#pragma unroll
                    for (int bj = 0; bj < 2; ++bj) { *(f32x4*)(rowp + bj * HALF) = acc[ai][bj][m][0]; *(f32x4*)(rowp + bj * HALF + 4) = acc[ai][bj][m][1]; } }
        }
    }
};
struct EpiGU {
    static constexpr bool PERM = true;
    bf16_t* O; bool dry;
    __device__ __forceinline__ void operator()(const f32x4 (&acc)[2][2][4][2], const Unit& u, int wr, int wc, int fr, int fq) const {
        if (dry) return;
        const int row0 = u.pm * BM + wr * 64 + fr, col0 = u.pn * HALF + wc * 32 + 8 * fq;
#pragma unroll
        for (int ai = 0; ai < 2; ++ai)
#pragma unroll
            for (int m = 0; m < 4; ++m) { bf16_t* rowp = O + (size_t)(row0 + ai * HALF + m * 16) * DFF + col0;
                float v[8];
#pragma unroll
                for (int n = 0; n < 2; ++n)
#pragma unroll
                    for (int j = 0; j < 4; ++j) { const float gt = acc[ai][0][m][n][j], up = acc[ai][1][m][n][j]; v[n * 4 + j] = gt * sigm(gt) * up; }
                u32x4 w; w.x = cvt_pk_bf16(v[0], v[1]); w.y = cvt_pk_bf16(v[2], v[3]); w.z = cvt_pk_bf16(v[4], v[5]); w.w = cvt_pk_bf16(v[6], v[7]);
                *(u32x4*)rowp = w; }
    }
};
struct EpiIN {
    static constexpr bool PERM = true;
    bf16_t* U;
    __device__ __forceinline__ void operator()(const f32x4 (&acc)[2][2][4][2], const Unit& u, int wr, int wc, int fr, int fq) const {
        const int row0 = u.pm * BM + wr * 64 + fr;
        if (u.pn >= 4 && u.pn < 12) {
            const int col0 = (u.pn - 4) * HALF + wc * 32 + 8 * fq; bf16_t* base = U + 2 * SLOT;
#pragma unroll
            for (int ai = 0; ai < 2; ++ai)
#pragma unroll
                for (int m = 0; m < 4; ++m) { bf16_t* rowp = base + (size_t)(row0 + ai * HALF + m * 16) * D + col0;
                    const f32x4 v0 = acc[ai][0][m][0] * acc[ai][1][m][0], v1 = acc[ai][0][m][1] * acc[ai][1][m][1];
                    u32x4 w; w.x = cvt_pk_bf16(v0[0], v0[1]); w.y = cvt_pk_bf16(v0[2], v0[3]); w.z = cvt_pk_bf16(v1[0], v1[1]); w.w = cvt_pk_bf16(v1[2], v1[3]);
                    *(u32x4*)rowp = w; }
        } else {
            int slot, ct; if (u.pn < 4) { slot = 0; ct = u.pn; } else { const int sg = (u.pn - 12) >> 2; slot = sg == 0 ? 3 : (sg == 1 ? 1 : sg + 2); ct = (u.pn - 12) & 3; }
            const int col0 = ct * BM + wc * 32 + 8 * fq; bf16_t* base = U + (size_t)slot * SLOT;
#pragma unroll
            for (int ai = 0; ai < 2; ++ai)
#pragma unroll
                for (int m = 0; m < 4; ++m) { bf16_t* rowp = base + (size_t)(row0 + ai * HALF + m * 16) * D + col0;
#pragma unroll
                    for (int bj = 0; bj < 2; ++bj) { const f32x4 v0 = acc[ai][bj][m][0], v1 = acc[ai][bj][m][1];
                        u32x4 w; w.x = cvt_pk_bf16(v0[0], v0[1]); w.y = cvt_pk_bf16(v0[2], v0[3]); w.z = cvt_pk_bf16(v1[0], v1[1]); w.w = cvt_pk_bf16(v1[2], v1[3]);
                        *(u32x4*)(rowp + bj * HALF) = w; } }
        }
    }
};
}

__device__ __forceinline__ int conv_map(int mode, int n) {
    if (mode == 0) return n;
    if (mode == 1) return 256 * (n >> 7) + (n & 127);
    if (mode == 2) return 256 * (n >> 7) + 128 + (n & 127);
    const int seg = n >> 10, j = n & 1023;
    if (seg == 0) return j;
    if (seg == 1) return 1024 + 256 * (j >> 7) + (j & 127);
    if (seg == 2) return 1024 + 256 * (j >> 7) + 128 + (j & 127);
    return 3072 + (seg - 3) * 1024 + j;
}
struct ConvE { const float* src; bf16_t* dst; const float* gk; int K, N, mode, t; };
__device__ __forceinline__ bool conv_decode(const Params& p, int set, int T, ConvE& e) {
    if (set < 2) {
        const int a = set ? 27 : 8; const float* gk = p.in[set ? 25 : 6];
        if (T < 704)       { e.src = p.in[a];     e.dst = (bf16_t*)(p.ws + WS_WGU); e.gk = gk;      e.K = 1024; e.N = 2816; e.mode = 1; e.t = T; }
        else if (T < 1408) { e.src = p.in[a + 1]; e.dst = (bf16_t*)(p.ws + WS_WGU); e.gk = gk;      e.K = 1024; e.N = 2816; e.mode = 2; e.t = T - 704; }
        else if (T < 2112) { e.src = p.in[a + 2]; e.dst = (bf16_t*)(p.ws + WS_WD);  e.gk = nullptr; e.K = 2816; e.N = 1024; e.mode = 0; e.t = T - 1408; }
        else return false;
    } else {
        if (T < 1792)      { e.src = p.in[13]; e.dst = (bf16_t*)(p.ws + WS_WIN); e.gk = p.in[11]; e.K = 1024; e.N = 7168; e.mode = 3; e.t = T; }
        else if (T < 2048) { e.src = p.in[15]; e.dst = (bf16_t*)(p.ws + WS_WOAB); e.gk = nullptr; e.K = 1024; e.N = 1024; e.mode = 0; e.t = T - 1792; }
        else if (T < 2304) { e.src = p.in[23]; e.dst = (bf16_t*)(p.ws + WS_WOAB + (size_t)1024 * 1024 * 2); e.gk = nullptr; e.K = 1024; e.N = 1024; e.mode = 0; e.t = T - 2048; }
        else if (T < 2560) { e.src = p.in[24]; e.dst = (bf16_t*)(p.ws + WS_WO);  e.gk = nullptr;  e.K = 1024; e.N = 1024; e.mode = 0; e.t = T - 2304; }
        else return false;
    }
    return true;
}
__device__ __forceinline__ void conv_load(const ConvE& e, int tid, f32x4& v0, f32x4& v1) {
    const int ntn = e.N >> 6; const int tk = e.t / ntn, tn = e.t - tk * ntn;
    const float* s0 = e.src + (size_t)(tk * 64 + (tid >> 4)) * e.N + tn * 64 + (tid & 15) * 4;
    v0 = *(const f32x4*)s0; v1 = *(const f32x4*)(s0 + (size_t)32 * e.N);
}
__device__ __forceinline__ void conv_emit(const ConvE& e, int tid, const f32x4& v0, const f32x4& v1, LAS float* sl) {
    const int ntn = e.N >> 6; const int tk = e.t / ntn, tn = e.t - tk * ntn; const int k0 = tk * 64, n0 = tn * 64;
    { LAS float* d = sl + (tid >> 4) * 65 + (tid & 15) * 4; d[0] = v0[0]; d[1] = v0[1]; d[2] = v0[2]; d[3] = v0[3]; d += 32 * 65; d[0] = v1[0]; d[1] = v1[1]; d[2] = v1[2]; d[3] = v1[3]; }
    __syncthreads();
    const int n = tid >> 3, ko = (tid & 7) * 8;
    float f[8];
#pragma unroll
    for (int i = 0; i < 8; ++i) f[i] = sl[(ko + i) * 65 + n];
    if (e.gk) {
        const f32x4 g0 = *(const f32x4*)(e.gk + k0 + ko), g1 = *(const f32x4*)(e.gk + k0 + ko + 4);
#pragma unroll
        for (int i = 0; i < 4; ++i) { f[i] *= g0[i]; f[4 + i] *= g1[i]; }
    }
    u32x4 w; w.x = cvt_pk_bf16(f[0], f[1]); w.y = cvt_pk_bf16(f[2], f[3]); w.z = cvt_pk_bf16(f[4], f[5]); w.w = cvt_pk_bf16(f[6], f[7]);
    *(u32x4*)(e.dst + (size_t)conv_map(e.mode, n0 + n) * e.K + k0 + ko) = w;
    __syncthreads();
}
__device__ __forceinline__ void convert_set(const Params& p, int set, LAS unsigned char* lds, int tid) {
    ConvE e, en; f32x4 v0, v1, n0 = {0.f, 0.f, 0.f, 0.f}, n1 = {0.f, 0.f, 0.f, 0.f};
    int T = blockIdx.x;
    bool have = conv_decode(p, set, T, e);
    if (have) conv_load(e, tid, v0, v1);
    while (have) {
        T += gridDim.x;
        const bool hn = conv_decode(p, set, T, en);
        if (hn) conv_load(en, tid, n0, n1);
        conv_emit(e, tid, v0, v1, (LAS float*)lds);
        e = en; v0 = n0; v1 = n1; have = hn;
    }
}

__device__ __forceinline__ void norm_phase(const Params& p, int mode, int tid, bool dry, int nsplit) {
    const int lane = tid & 63, gw = blockIdx.x * 8 + (tid >> 6), nw = gridDim.x * 8;
    const float* gpost = mode == 1 ? p.in[7] : (mode == 2 ? p.in[12] : p.in[26]);
    const float cc = mode == 2 ? 1.0f : 0.5f;
    const bf16_t* Yb = (const bf16_t*)(p.ws + WS_Y); const float* PY = (const float*)(p.ws + WS_PY); bf16_t* H = (bf16_t*)(p.ws + WS_H); float* SC = (float*)(p.ws + WS_SC);
    for (int r = gw; r < M; r += nw) {
        f32x4 xv[4];
        if (mode == 0) {
            const float* xin = x0row(p, r);
#pragma unroll
            for (int q = 0; q < 4; ++q) xv[q] = *(const f32x4*)(xin + lane * 4 + 256 * q);
        } else {
            const float sc = SC[r];
#pragma unroll
            for (int q = 0; q < 4; ++q) { const u32x2 w = *(const u32x2*)(H + (size_t)r * D + lane * 4 + 256 * q); xv[q] = (f32x4){bflo(w.x), bfhi(w.x), bflo(w.y), bfhi(w.y)} * sc; }
            f32x4 yv[4]; float ss = 0.f;
            if (r < MAINR) {
#pragma unroll
                for (int q = 0; q < 4; ++q) { const u32x2 w = *(const u32x2*)(Yb + (size_t)r * D + lane * 4 + 256 * q); yv[q] = (f32x4){bflo(w.x), bfhi(w.x), bflo(w.y), bfhi(w.y)}; }
            } else {
#pragma unroll
                for (int q = 0; q < 4; ++q) yv[q] = (f32x4){0.f, 0.f, 0.f, 0.f};
                for (int ks = 0; ks < nsplit; ++ks) {
#pragma unroll
                    for (int q = 0; q < 4; ++q) yv[q] += *(const f32x4*)(PY + ((size_t)ks * 256 + (r - MAINR)) * D + lane * 4 + 256 * q);
                }
            }
#pragma unroll
            for (int q = 0; q < 4; ++q) ss += yv[q][0] * yv[q][0] + yv[q][1] * yv[q][1] + yv[q][2] * yv[q][2] + yv[q][3] * yv[q][3];
            ss = wave_sum(ss, lane);
            const float rs = cc * rsqrtf(ss * (1.0f / D) + EPS);
#pragma unroll
            for (int q = 0; q < 4; ++q) xv[q] += yv[q] * rs * *(const f32x4*)(gpost + lane * 4 + 256 * q);
        }
        if (mode == 3) {
            float* xo;
            if (r >= MP) xo = p.out + O_YS + (size_t)(r - MP) * D;
            else { const int b = r / TP, t = r - b * TP; if (t < NMETA) continue; xo = p.out + O_YP + ((size_t)b * SEQ + (t - NMETA)) * D; }
#pragma unroll
            for (int q = 0; q < 4; ++q) *(f32x4*)(xo + lane * 4 + 256 * q) = xv[q];
        } else {
            float ss = 0.f;
#pragma unroll
            for (int q = 0; q < 4; ++q) ss += xv[q][0] * xv[q][0] + xv[q][1] * xv[q][1] + xv[q][2] * xv[q][2] + xv[q][3] * xv[q][3];
            ss = wave_sum(ss, lane);
            const float ms = ss * (1.0f / D) + EPS; const float rs = rsqrtf(ms);
            if (!dry) {
#pragma unroll
                for (int q = 0; q < 4; ++q) { const f32x4 hv = xv[q] * rs; u32x2 w; w.x = cvt_pk_bf16(hv[0], hv[1]); w.y = cvt_pk_bf16(hv[2], hv[3]);
                    *(u32x2*)(H + (size_t)r * D + lane * 4 + 256 * q) = w; }
                if (lane == 0) SC[r] = ms * rs;
            }
        }
    }
}

constexpr int WL_BYTES = 11264;
__device__ __forceinline__ void scan_item(const Params& p, int b, int j, int h, LAS unsigned char* wl, const LAS unsigned char* wlds, int lane, bool dry) {
    bf16_t* U = (bf16_t*)(p.ws + WS_U);
    const bf16_t* bx = U + 3 * SLOT; bf16_t* bg = U + 1 * SLOT; bf16_t* pp = (bf16_t*)p.out;
    float* summ = (float*)(p.ws + WS_SUMM);
    const int c = h * 64 + lane, fr = lane & 15, fq = lane >> 4;
    const size_t row0 = (size_t)b * TP + (size_t)j * CHUNK;
    const bf16_t* bx0 = bx + row0 * D; bf16_t* bg0 = bg + row0 * D; bf16_t* pp0 = pp + row0 * D;
    const LAS unsigned char* wq = wlds + fr * 144 + fq * 16;
    float brv[4], biv[4], lcv[4];
#pragma unroll
    for (int nt = 0; nt < 4; ++nt) { const int ch = h * 64 + nt * 16 + fr; brv[nt] = p.in[19][ch]; biv[nt] = p.in[21][ch]; lcv[nt] = ((const float*)(p.ws + WS_LC))[ch]; }
    const float w0 = p.in[16][c], w1 = p.in[16][D + c], w2 = p.in[16][2 * D + c], w3 = p.in[16][3 * D + c], cbias = p.in[17][c];
    float xm3 = 0.f, xm2 = 0.f, xm1 = 0.f;
    if (j > 0) { xm3 = bf2f(bx0[-3 * D + c]); xm2 = bf2f(bx0[-2 * D + c]); xm1 = bf2f(bx0[-1 * D + c]); }
    float hh = 0.f, ap = 1.f;
    LAS unsigned short* cbT = (LAS unsigned short*)wl;
    LAS float* xu = (LAS float*)(wl + 2304);
    LAS float* aS = (LAS float*)(wl + 2304 + 4352);
    bf16_t xr[16], gr[16], xn[16];
#pragma unroll
    for (int tt = 0; tt < 16; ++tt) xr[tt] = bx0[tt * D + c];
#pragma unroll
    for (int g = 0; g < 3; ++g) {
        const int r0 = g * 16;
#pragma unroll
        for (int tt = 0; tt < 16; ++tt) gr[tt] = bg0[(r0 + tt) * D + c];
        if (g < 2) {
#pragma unroll
            for (int tt = 0; tt < 16; ++tt) xn[tt] = bx0[(r0 + 16 + tt) * D + c];
        }
#pragma unroll
        for (int tt = 0; tt < 16; ++tt) { const float x = bf2f(xr[tt]); const float cb = w0 * xm3 + w1 * xm2 + w2 * xm1 + w3 * x + cbias; xm3 = xm2; xm2 = xm1; xm1 = x;
            cbT[tt * 72 + lane] = f2bf(cb); xu[tt * 68 + lane] = cb; }
        __builtin_amdgcn_wave_barrier();
        const bf16x8 a0 = *(const LAS bf16x8*)(cbT + fr * 72 + fq * 8), a1 = *(const LAS bf16x8*)(cbT + fr * 72 + 32 + fq * 8);
        f32x4 accR[4], accI[4];
#pragma unroll
        for (int nt = 0; nt < 4; ++nt) {
            const bf16x8 r0w = *(const LAS bf16x8*)(wq + nt * 2304), r1w = *(const LAS bf16x8*)(wq + nt * 2304 + 64);
            const bf16x8 i0w = *(const LAS bf16x8*)(wq + 9216 + nt * 2304), i1w = *(const LAS bf16x8*)(wq + 9216 + nt * 2304 + 64);
            accR[nt] = __builtin_amdgcn_mfma_f32_16x16x32_bf16(a0, r0w, (f32x4){0.f, 0.f, 0.f, 0.f}, 0, 0, 0);
            accR[nt] = __builtin_amdgcn_mfma_f32_16x16x32_bf16(a1, r1w, accR[nt], 0, 0, 0);
            accI[nt] = __builtin_amdgcn_mfma_f32_16x16x32_bf16(a0, i0w, (f32x4){0.f, 0.f, 0.f, 0.f}, 0, 0, 0);
            accI[nt] = __builtin_amdgcn_mfma_f32_16x16x32_bf16(a1, i1w, accI[nt], 0, 0, 0);
        }
#pragma unroll
        for (int nt = 0; nt < 4; ++nt)
#pragma unroll
            for (int i = 0; i < 4; ++i) { const int idx = (fq * 4 + i) * 68 + nt * 16 + fr; const float x = xu[idx];
                const float r = sigm(accR[nt][i] + brv[nt]), ig = sigm(accI[nt][i] + biv[nt]);
                const float la = lcv[nt] * r; const float a = __expf(la);
                const float z2 = 2.0f * la;
                const float m2s = -z2 * (1.0f + z2 * (0.5f + z2 * (0.16666667f + z2 * (0.041666668f + z2 * (0.0083333338f + z2 * 0.0013888889f)))));
                const float m2 = z2 > -0.25f ? m2s : 1.0f - a * a;
                xu[idx] = __builtin_amdgcn_sqrtf(m2) * ig * x; aS[idx] = a; }
        __builtin_amdgcn_wave_barrier();
#pragma unroll
        for (int tt = 0; tt < 16; ++tt) { const float a = aS[tt * 68 + lane], uu = xu[tt * 68 + lane]; hh = a * hh + uu; ap *= a;
            const float gl = gelu_tanh(bf2f(gr[tt]));
            if (!dry) bg0[(r0 + tt) * D + c] = f2bf(gl * hh);
            pp0[(r0 + tt) * D + c] = f2bf(gl * ap); }
        __builtin_amdgcn_wave_barrier();
        if (g < 2) {
#pragma unroll
            for (int tt = 0; tt < 16; ++tt) xr[tt] = xn[tt];
        }
    }
    *(float2*)(summ + (((size_t)b * NCH + j) * D + c) * 2) = make_float2(ap, hh);
    if (j == NCH - 1) { p.out[O_CBP + ((size_t)b * 3 + 0) * D + c] = xm3; p.out[O_CBP + ((size_t)b * 3 + 1) * D + c] = xm2; p.out[O_CBP + ((size_t)b * 3 + 2) * D + c] = xm1; }
}
__device__ __forceinline__ void sample_item(const Params& p, int k, int h, LAS unsigned char* wl, const LAS unsigned char* wlds, int lane) {
    bf16_t* U = (bf16_t*)(p.ws + WS_U);
    const int c = h * 64 + lane, fr = lane & 15, fq = lane >> 4;
    const size_t row0 = (size_t)MP + (size_t)k * 16; const int s0 = k * 16;
    const bf16_t* bx0 = U + 3 * SLOT + row0 * D; bf16_t* bg0 = U + 1 * SLOT + row0 * D;
    const LAS unsigned char* wq = wlds + fr * 144 + fq * 16;
    float brv[4], biv[4], lcv[4];
#pragma unroll
    for (int nt = 0; nt < 4; ++nt) { const int ch = h * 64 + nt * 16 + fr; brv[nt] = p.in[19][ch]; biv[nt] = p.in[21][ch]; lcv[nt] = ((const float*)(p.ws + WS_LC))[ch]; }
    const float w3 = p.in[16][3 * D + c];
    LAS unsigned short* cbT = (LAS unsigned short*)wl;
    LAS float* xu = (LAS float*)(wl + 2304);
    LAS float* aS = (LAS float*)(wl + 2304 + 4352);
    const float* pcb = (const float*)(p.ws + WS_PCB) + (size_t)s0 * D + c;
    {
        bf16_t xr[16]; float pc[16];
#pragma unroll
        for (int tt = 0; tt < 16; ++tt) { xr[tt] = bx0[tt * D + c]; pc[tt] = pcb[tt * D]; }
#pragma unroll
        for (int tt = 0; tt < 16; ++tt) { const float x = bf2f(xr[tt]); const float cb = pc[tt] + w3 * x;
            p.out[O_CBS + ((size_t)(s0 + tt) * 3 + 2) * D + c] = x;
            cbT[tt * 72 + lane] = f2bf(cb); xu[tt * 68 + lane] = cb; }
    }
    __builtin_amdgcn_wave_barrier();
    const bf16x8 a0 = *(const LAS bf16x8*)(cbT + fr * 72 + fq * 8), a1 = *(const LAS bf16x8*)(cbT + fr * 72 + 32 + fq * 8);
    f32x4 accR[4], accI[4];
#pragma unroll
    for (int nt = 0; nt < 4; ++nt) {
        const bf16x8 r0w = *(const LAS bf16x8*)(wq + nt * 2304), r1w = *(const LAS bf16x8*)(wq + nt * 2304 + 64);
        const bf16x8 i0w = *(const LAS bf16x8*)(wq + 9216 + nt * 2304), i1w = *(const LAS bf16x8*)(wq + 9216 + nt * 2304 + 64);
        accR[nt] = __builtin_amdgcn_mfma_f32_16x16x32_bf16(a0, r0w, (f32x4){0.f, 0.f, 0.f, 0.f}, 0, 0, 0);
        accR[nt] = __builtin_amdgcn_mfma_f32_16x16x32_bf16(a1, r1w, accR[nt], 0, 0, 0);
        accI[nt] = __builtin_amdgcn_mfma_f32_16x16x32_bf16(a0, i0w, (f32x4){0.f, 0.f, 0.f, 0.f}, 0, 0, 0);
        accI[nt] = __builtin_amdgcn_mfma_f32_16x16x32_bf16(a1, i1w, accI[nt], 0, 0, 0);
    }
#pragma unroll
    for (int nt = 0; nt < 4; ++nt)
#pragma unroll
        for (int i = 0; i < 4; ++i) { const int idx = (fq * 4 + i) * 68 + nt * 16 + fr; const float x = xu[idx];
            const float r = sigm(accR[nt][i] + brv[nt]), ig = sigm(accI[nt][i] + biv[nt]);
            const float la = lcv[nt] * r; const float a = __expf(la);
            const float z2 = 2.0f * la;
            const float m2s = -z2 * (1.0f + z2 * (0.5f + z2 * (0.16666667f + z2 * (0.041666668f + z2 * (0.0083333338f + z2 * 0.0013888889f)))));
            const float m2 = z2 > -0.25f ? m2s : 1.0f - a * a;
            xu[idx] = __builtin_amdgcn_sqrtf(m2) * ig * x; aS[idx] = a; }
    __builtin_amdgcn_wave_barrier();
    {
        float h0[16]; bf16_t gq[16];
#pragma unroll
        for (int tt = 0; tt < 16; ++tt) { h0[tt] = p.in[4][(size_t)(s0 + tt) * D + c]; gq[tt] = bg0[tt * D + c]; }
#pragma unroll
        for (int tt = 0; tt < 16; ++tt) {
            const float hn = aS[tt * 68 + lane] * h0[tt] + xu[tt * 68 + lane];
            p.out[O_RGS + (size_t)(s0 + tt) * D + c] = hn;
            bg0[tt * D + c] = f2bf(gelu_tanh(bf2f(gq[tt])) * hn);
        }
    }
    __builtin_amdgcn_wave_barrier();
}
__device__ __forceinline__ void scan_phase(const Params& p, LAS unsigned char* lds, int tid, bool dry) {
    const int wid = __builtin_amdgcn_readfirstlane(tid >> 6), lane = tid & 63;
    LAS unsigned char* wl = lds + wid * WL_BYTES;
    LAS unsigned char* wlds = lds + 8 * WL_BYTES;
    const int h = blockIdx.x & 15;
    {
        const bf16_t* wt = (const bf16_t*)(p.ws + WS_WRG);
#pragma unroll
        for (int q = 0; q < 2; ++q) { const int e = tid + q * 512, g = e >> 9, jrow = (e >> 3) & 63, pc = e & 7;
            *(LAS u32x4*)(wlds + g * 9216 + jrow * 144 + pc * 16) = *(const u32x4*)(wt + (size_t)g * 65536 + (size_t)(h * 64 + jrow) * 64 + pc * 8); }
    }
    __syncthreads();
    const int nbh = gridDim.x >> 4;
    for (int it = (blockIdx.x >> 4) * 8 + wid; it < NB * NCH; it += nbh * 8) scan_item(p, it / NCH, it % NCH, h, wl, wlds, lane, dry);
    if (!dry && wid < 2 && (int)(blockIdx.x >> 4) >= nbh - 4) {
        const int k = ((int)(blockIdx.x >> 4) - (nbh - 4)) * 2 + wid;
        if (k < NS / 16) sample_item(p, k, h, wl, wlds, lane);
    }
    __syncthreads();
}
__device__ __forceinline__ void fix_phase(const Params& p, LAS unsigned char* lds, int tid, bool dry) {
    bf16_t* zb = (bf16_t*)(p.ws + WS_U) + 1 * SLOT; const bf16_t* pp = (const bf16_t*)p.out;
    const float* summ = (const float*)(p.ws + WS_SUMM);
    LAS float* cs = (LAS float*)lds;
    for (int it = blockIdx.x; it < NB * (NCH - 1); it += gridDim.x) {
        const int b = it / (NCH - 1), j = it % (NCH - 1) + 1;
#pragma unroll
        for (int cq = 0; cq < 2; ++cq) {
            const int c = tid + cq * 512; const float* sp = summ + ((size_t)b * NCH * D + c) * 2; float hh = 0.f;
            for (int i0 = 0; i0 < j; i0 += 16) {
                float va[16], vh[16];
#pragma unroll
                for (int k = 0; k < 16; ++k) { if (i0 + k < j) { const float2 v = *(const float2*)(sp + (size_t)(i0 + k) * D * 2); va[k] = v.x; vh[k] = v.y; } else { va[k] = 1.f; vh[k] = 0.f; } }
#pragma unroll
                for (int k = 0; k < 16; ++k) hh = va[k] * hh + vh[k];
            }
            cs[c] = hh;
            if (j == NCH - 1) { const float2 v = *(const float2*)(sp + (size_t)j * D * 2); p.out[O_RGP + (size_t)b * D + c] = v.x * hh + v.y; }
        }
        __syncthreads();
        const size_t row0 = (size_t)b * TP + (size_t)j * CHUNK;
        for (int q0 = 0; q0 < CHUNK * 128 / 512; q0 += 4) {
            u32x4 zq[4], pq[4];
#pragma unroll
            for (int k = 0; k < 4; ++k) { const int e = tid + (q0 + k) * 512, tt = e >> 7, vc = e & 127; const size_t o = (row0 + tt) * D + vc * 8; zq[k] = *(const u32x4*)(zb + o); pq[k] = *(const u32x4*)(pp + o); }
#pragma unroll
            for (int k = 0; k < 4; ++k) { const int e = tid + (q0 + k) * 512, tt = e >> 7, vc = e & 127; const size_t o = (row0 + tt) * D + vc * 8;
                const f32x4 c0 = *(const LAS f32x4*)(cs + vc * 8), c1 = *(const LAS f32x4*)(cs + vc * 8 + 4);
                u32x4 w;
                w.x = cvt_pk_bf16(bflo(zq[k].x) + bflo(pq[k].x) * c0[0], bfhi(zq[k].x) + bfhi(pq[k].x) * c0[1]); w.y = cvt_pk_bf16(bflo(zq[k].y) + bflo(pq[k].y) * c0[2], bfhi(zq[k].y) + bfhi(pq[k].y) * c0[3]);
                w.z = cvt_pk_bf16(bflo(zq[k].z) + bflo(pq[k].z) * c1[0], bfhi(zq[k].z) + bfhi(pq[k].z) * c1[1]); w.w = cvt_pk_bf16(bflo(zq[k].w) + bflo(pq[k].w) * c1[2], bfhi(zq[k].w) + bfhi(pq[k].w) * c1[3]);
                if (!dry) *(u32x4*)(zb + o) = w; }
        }
        __syncthreads();
    }
}
__device__ __forceinline__ void za_phase(const Params& p, int tid, bool dry) {
    bf16_t* U = (bf16_t*)(p.ws + WS_U); bf16_t* ab = U; const bf16_t* ca = U + 2 * SLOT;
    const float* cw = p.in[14];
    for (int idx = blockIdx.x * 512 + tid; idx < NB * 129 * 128; idx += gridDim.x * 512) {
        const int vc = idx & 127, tb = (idx >> 7) % 129, b = idx / (128 * 129); const int c0 = vc * 8;
        float w[3][8];
#pragma unroll
        for (int k = 0; k < 3; ++k) { const f32x4 a = *(const f32x4*)(cw + k * D + c0), bq = *(const f32x4*)(cw + k * D + c0 + 4);
#pragma unroll
            for (int e = 0; e < 4; ++e) { w[k][e] = a[e]; w[k][4 + e] = bq[e]; } }
        const size_t r0 = (size_t)b * TP + (size_t)tb * 16;
        float p2[8], p1[8];
        if (tb > 0) { const u32x4 q2 = *(const u32x4*)(ca + (r0 - 2) * D + c0), q1 = *(const u32x4*)(ca + (r0 - 1) * D + c0);
#pragma unroll
            for (int e = 0; e < 4; ++e) { p2[2 * e] = bflo(q2[e]); p2[2 * e + 1] = bfhi(q2[e]); p1[2 * e] = bflo(q1[e]); p1[2 * e + 1] = bfhi(q1[e]); } }
        else {
#pragma unroll
            for (int e = 0; e < 8; ++e) { p2[e] = 0.f; p1[e] = 0.f; } }
        for (int t4 = 0; t4 < 16; t4 += 4) {
            u32x4 qcs[4], qas[4];
#pragma unroll
            for (int k = 0; k < 4; ++k) { qcs[k] = *(const u32x4*)(ca + (r0 + t4 + k) * D + c0); qas[k] = *(const u32x4*)(ab + (r0 + t4 + k) * D + c0); }
#pragma unroll
            for (int k = 0; k < 4; ++k) {
                const u32x4 qc = qcs[k], qa = qas[k];
                float cv[8], av[8], zv[8];
#pragma unroll
                for (int e = 0; e < 4; ++e) { cv[2 * e] = bflo(qc[e]); cv[2 * e + 1] = bfhi(qc[e]); av[2 * e] = bflo(qa[e]); av[2 * e + 1] = bfhi(qa[e]); }
#pragma unroll
                for (int e = 0; e < 8; ++e) { zv[e] = av[e] * (w[0][e] * p2[e] + w[1][e] * p1[e] + w[2][e] * cv[e]); p2[e] = p1[e]; p1[e] = cv[e]; }
                u32x4 o; o.x = cvt_pk_bf16(zv[0], zv[1]); o.y = cvt_pk_bf16(zv[2], zv[3]); o.z = cvt_pk_bf16(zv[4], zv[5]); o.w = cvt_pk_bf16(zv[6], zv[7]);
                if (!dry) *(u32x4*)(ab + (r0 + t4 + k) * D + c0) = o;
            }
        }
        if (tb == 128) {
            float* o2 = p.out + O_CAP + ((size_t)b * 2 + 0) * D + c0; float* o1 = p.out + O_CAP + ((size_t)b * 2 + 1) * D + c0;
            *(f32x4*)o2 = (f32x4){p2[0], p2[1], p2[2], p2[3]}; *(f32x4*)(o2 + 4) = (f32x4){p2[4], p2[5], p2[6], p2[7]};
            *(f32x4*)o1 = (f32x4){p1[0], p1[1], p1[2], p1[3]}; *(f32x4*)(o1 + 4) = (f32x4){p1[4], p1[5], p1[6], p1[7]};
        }
    }
    if (!dry) {
        for (int idx = blockIdx.x * 512 + tid; idx < NS * 128; idx += gridDim.x * 512) {
            const int vc = idx & 127, sm = idx >> 7, c0 = vc * 8; const size_t ro = (size_t)(MP + sm) * D + c0;
            const u32x4 qc = *(const u32x4*)(ca + ro), qa = *(const u32x4*)(ab + ro);
            const float* pca = (const float*)(p.ws + WS_PCA) + (size_t)sm * D + c0;
            float hp[8], cv[8], zv[8];
            { const f32x4 a0 = *(const f32x4*)pca, a1 = *(const f32x4*)(pca + 4);
#pragma unroll
              for (int e = 0; e < 4; ++e) { hp[e] = a0[e]; hp[4 + e] = a1[e]; } }
#pragma unroll
            for (int e = 0; e < 4; ++e) { cv[2 * e] = bflo(qc[e]); cv[2 * e + 1] = bfhi(qc[e]); }
#pragma unroll
            for (int e = 0; e < 8; ++e) { const float av = (e & 1) ? bfhi(qa[e >> 1]) : bflo(qa[e >> 1]); zv[e] = av * (hp[e] + cw[2 * D + c0 + e] * cv[e]); }
            u32x4 o; o.x = cvt_pk_bf16(zv[0], zv[1]); o.y = cvt_pk_bf16(zv[2], zv[3]); o.z = cvt_pk_bf16(zv[4], zv[5]); o.w = cvt_pk_bf16(zv[6], zv[7]);
            *(u32x4*)(ab + ro) = o;
            float* o1 = p.out + O_CAS + ((size_t)sm * 2 + 1) * D + c0;
            *(f32x4*)o1 = (f32x4){cv[0], cv[1], cv[2], cv[3]}; *(f32x4*)(o1 + 4) = (f32x4){cv[4], cv[5], cv[6], cv[7]};
        }
    }
}

__device__ __forceinline__ u32x4 merge_math(const u32x4& ga, const u32x4& gb, const float (&ya)[8], const float (&yb)[8]) {
    u32x4 o4;
#pragma unroll
    for (int e = 0; e < 4; ++e) { const float lo = sigm(bflo(ga[e])) * ya[2 * e] + sigm(bflo(gb[e])) * yb[2 * e], hi = sigm(bfhi(ga[e])) * ya[2 * e + 1] + sigm(bfhi(gb[e])) * yb[2 * e + 1]; o4[e] = cvt_pk_bf16(lo, hi); }
    return o4;
}
__device__ __forceinline__ void merge_phase(const Params& p, int tid) {
    const bf16_t* U = (const bf16_t*)(p.ws + WS_U); bf16_t* H = (bf16_t*)p.out; const float* PO = (const float*)(p.ws + WS_POAB);
    const size_t G = (size_t)gridDim.x * 512, NMAIN = (size_t)MAINR * 128;
    for (size_t i0 = (size_t)blockIdx.x * 512 + tid; i0 < NMAIN; i0 += 4 * G) {
        u32x4 ga[4], gb[4], a[4], b[4];
#pragma unroll
        for (int k = 0; k < 4; ++k) { const size_t i = i0 + k * G; if (i < NMAIN) { ga[k] = *(const u32x4*)(U + 4 * SLOT + i * 8); gb[k] = *(const u32x4*)(U + 5 * SLOT + i * 8); a[k] = *(const u32x4*)(U + 2 * SLOT + i * 8); b[k] = *(const u32x4*)(U + 3 * SLOT + i * 8); } }
#pragma unroll
        for (int k = 0; k < 4; ++k) { const size_t i = i0 + k * G; if (i < NMAIN) {
            float ya[8], yb[8];
#pragma unroll
            for (int e = 0; e < 4; ++e) { ya[2 * e] = bflo(a[k][e]); ya[2 * e + 1] = bfhi(a[k][e]); yb[2 * e] = bflo(b[k][e]); yb[2 * e + 1] = bfhi(b[k][e]); }
            *(u32x4*)(H + i * 8) = merge_math(ga[k], gb[k], ya, yb); } }
    }
    for (size_t i = NMAIN + (size_t)blockIdx.x * 512 + tid; i < SLOT / 8; i += G) {
        const u32x4 ga = *(const u32x4*)(U + 4 * SLOT + i * 8), gb = *(const u32x4*)(U + 5 * SLOT + i * 8);
        float ya[8], yb[8];
        const int row = (int)(i >> 7);
        const size_t o = (size_t)(row - MAINR) * D + (size_t)(i & 127) * 8;
#pragma unroll
        for (int e = 0; e < 8; ++e) { ya[e] = 0.f; yb[e] = 0.f; }
#pragma unroll
        for (int ks = 0; ks < 4; ++ks) {
            const f32x4 a0 = *(const f32x4*)(PO + (size_t)(ks * 2 + 0) * (256 * D) + o), a1 = *(const f32x4*)(PO + (size_t)(ks * 2 + 0) * (256 * D) + o + 4);
            const f32x4 b0 = *(const f32x4*)(PO + (size_t)(ks * 2 + 1) * (256 * D) + o), b1 = *(const f32x4*)(PO + (size_t)(ks * 2 + 1) * (256 * D) + o + 4);
#pragma unroll
            for (int e = 0; e < 4; ++e) { ya[e] += a0[e]; ya[4 + e] += a1[e]; yb[e] += b0[e]; yb[4 + e] += b1[e]; }
        }
        *(u32x4*)(H + i * 8) = merge_math(ga, gb, ya, yb);
    }
}

#define XB_TMO      128
#define XB_XCNT(j)  (256  + 64 * (j))
#define XB_XSUB(j)  (1280 + 64 * (j))
#define XB_XGEN(j)  (2304 + 64 * (j))
#define XB_TOP      3328
#define XB_TOPGEN   3392
#define XCD_BAR_WORDS 3456
#define XB_SPIN_CAP (1u << 18)
__device__ __forceinline__ unsigned xb_ld(unsigned* p)              { return __hip_atomic_load(p, __ATOMIC_RELAXED, __HIP_MEMORY_SCOPE_AGENT); }
__device__ __forceinline__ unsigned xb_add(unsigned* p, unsigned v) { return __hip_atomic_fetch_add(p, v, __ATOMIC_RELAXED, __HIP_MEMORY_SCOPE_AGENT); }
__device__ __forceinline__ unsigned xb_xcc_id() { return (unsigned)__builtin_amdgcn_s_getreg((3 << 11) | 20) & 0xFu; }
#define XB_SPIN(cond, bar) do { unsigned _sp = 0; while (cond) { __builtin_amdgcn_s_sleep(1); \
    if ((++_sp & 255u) == 0u) { if (xb_ld(&(bar)[XB_TMO])) break; if (_sp > XB_SPIN_CAP) { atomicAdd(&(bar)[XB_TMO], 1u); break; } } } } while (0)
struct XcdBarrier { unsigned* bar; unsigned x; volatile LAS unsigned* st; };
__device__ __forceinline__ XcdBarrier xcd_barrier_post(unsigned* bar, volatile LAS unsigned* st) {
    XcdBarrier b; b.bar = bar; b.x = xb_xcc_id(); b.st = st;
    if (threadIdx.x == 0) (void)xb_add(&bar[XB_XCNT(b.x)], 1u);
    return b;
}
__device__ __forceinline__ void xcd_barrier_complete(unsigned* bar, unsigned x, unsigned& nloc, unsigned& nx) {
    const unsigned G = gridDim.x * gridDim.y * gridDim.z;
    unsigned sum, cnt, mine, sp = 0u;
    for (;;) {
        sum = 0u; cnt = 0u; mine = 0u;
#pragma unroll
        for (unsigned j = 0; j < 16; ++j) { const unsigned c = xb_ld(&bar[XB_XCNT(j)]); sum += c; cnt += (c > 0u) ? 1u : 0u; mine = (j == x) ? c : mine; }
        if (sum == G) break;
        __builtin_amdgcn_s_sleep(1);
        if ((++sp & 255u) == 0u) { if (xb_ld(&bar[XB_TMO])) break; if (sp > XB_SPIN_CAP) { atomicAdd(&bar[XB_TMO], 1u); break; } }
    }
    nloc = mine > 0u ? mine : 1u; nx = cnt > 0u ? cnt : 1u;
}
__device__ __forceinline__ void xcd_barrier(const XcdBarrier& b) {
    asm volatile("s_waitcnt vmcnt(0)" ::: "memory");
    __syncthreads();
    if (threadIdx.x == 0) {
        unsigned* bar = b.bar;
        __builtin_amdgcn_s_waitcnt(0);
        unsigned nloc = b.st[0], nx = b.st[1];
        if (nloc == 0u) { xcd_barrier_complete(bar, b.x, nloc, nx); b.st[0] = nloc; b.st[1] = nx; }
        const unsigned old = xb_add(&bar[XB_XSUB(b.x)], 1u);
        const unsigned gen = old / nloc;
        if (old + 1u == (gen + 1u) * nloc) {
            __builtin_amdgcn_fence(__ATOMIC_RELEASE, "agent");
            asm volatile("s_waitcnt vmcnt(0)" ::: "memory");
            const unsigned og = xb_add(&bar[XB_TOP], 1u);
            const unsigned tg = og / nx;
            if (og + 1u == (tg + 1u) * nx) xb_add(&bar[XB_TOPGEN], 1u);
            else XB_SPIN(xb_ld(&bar[XB_TOPGEN]) == tg, bar);
            __builtin_amdgcn_fence(__ATOMIC_ACQUIRE, "agent");
            xb_add(&bar[XB_XGEN(b.x)], 1u);
            asm volatile("s_waitcnt vmcnt(0)" ::: "memory");
        } else {
            XB_SPIN(xb_ld(&bar[XB_XGEN(b.x)]) == gen, bar);
            __builtin_amdgcn_fence(__ATOMIC_ACQUIRE, "agent");
            asm volatile("s_waitcnt vmcnt(0)" ::: "memory");
        }
    }
    __syncthreads();
}

constexpr int NPHASE = 14;
constexpr int LDS_BYTES = 131072 + 16;
__global__ void __launch_bounds__(512, 2) mk_fwd(Params p, int ph_lo, int ph_hi) {
    extern __shared__ __attribute__((aligned(16))) unsigned char shm[];
    LAS unsigned char* lds = (LAS unsigned char*)shm;
    cg::grid_group grid = cg::this_grid();
    if (threadIdx.x == 0) { *(LAS u32x4*)(lds + 131072) = (u32x4){0u, 0u, 0u, 0u}; }
    __syncthreads();
    const XcdBarrier xb = xcd_barrier_post((unsigned*)(p.ws + WS_BAR), (volatile LAS unsigned*)(lds + 131072));
    for (int ph2 = ph_lo * 2; ph2 < ph_hi * 2; ++ph2) {
        const int ph = ph2 >> 1; const bool dry = !(ph2 & 1);
        if (dry && !((REP_MASK >> ph) & 1)) continue;
        int tid = threadIdx.x; asm volatile("" : "+v"(tid));
        if (ph == 0) {
            convert_set(p, 0, lds, tid);
            bf16_t* wt = (bf16_t*)(p.ws + WS_WRG);
            for (int o = blockIdx.x * 512 + tid; o < 2 * 65536; o += gridDim.x * 512) { const int g = o >> 16, h = (o >> 12) & 15, j = (o >> 6) & 63, i = o & 63;
                wt[o] = f2bf((g ? p.in[20] : p.in[18])[(size_t)(h * 64 + i) * 64 + j]); }
            if (blockIdx.x * 512 + tid < D) { const int ch = blockIdx.x * 512 + tid; ((float*)(p.ws + WS_LC))[ch] = -8.0f * log1pf(expf(-p.in[22][ch])); }
            for (int e = blockIdx.x * 512 + tid; e < NS * D; e += gridDim.x * 512) {
                const int sm = e >> 10, c = e & 1023;
                const float t0 = p.in[3][((size_t)sm * 3 + 0) * D + c], t1 = p.in[3][((size_t)sm * 3 + 1) * D + c], t2 = p.in[3][((size_t)sm * 3 + 2) * D + c];
                const float a0 = p.in[2][((size_t)sm * 2 + 0) * D + c], a1 = p.in[2][((size_t)sm * 2 + 1) * D + c];
                ((float*)(p.ws + WS_PCB))[e] = p.in[16][c] * t0 + p.in[16][D + c] * t1 + p.in[16][2 * D + c] * t2 + p.in[17][c];
                ((float*)(p.ws + WS_PCA))[e] = p.in[14][c] * a0 + p.in[14][D + c] * a1;
                p.out[O_CBS + ((size_t)sm * 3 + 0) * D + c] = t1; p.out[O_CBS + ((size_t)sm * 3 + 1) * D + c] = t2;
                p.out[O_CAS + ((size_t)sm * 2 + 0) * D + c] = a1;
            }
            norm_phase(p, 0, tid, dry, 0);
        } else if (ph == 1 || ph == 11) {
            pg8::Gemm g{(const bf16_t*)(p.ws + WS_H), (const bf16_t*)(p.ws + WS_WGU), M, 2 * DFF, D, 0, 0};
            pg8::StaticOrder S; S.init(M, 2 * DFF, D, gridDim.x, blockIdx.x);
            pg8::EpiGU E{(bf16_t*)(p.ws + WS_ACT), dry};
            pg8::gemm_phase(lds, g, S, E);
        } else if (ph == 2 || ph == 12 || ph == 9 || ph == 7) {
            const bool dn = (ph == 2 || ph == 12), oab = (ph == 7);
            pg8::Gemm g{dn ? (const bf16_t*)(p.ws + WS_ACT) : (oab ? (const bf16_t*)(p.ws + WS_U) : (const bf16_t*)p.out), (const bf16_t*)(p.ws + (dn ? WS_WD : (oab ? WS_WOAB : WS_WO))), M, D, dn ? DFF : D, SB, (size_t)1024 * 1024 * 2};
            pg8::SplitOrder S; S.init(oab ? 2 * D : D, dn ? DFF : D, gridDim.x, blockIdx.x, dn ? 11 : 4, 4);
            pg8::EpiBF E{(bf16_t*)(p.ws + (oab ? WS_U + 2 * SB : WS_Y)), SLOT, (float*)(p.ws + (oab ? WS_POAB : WS_PY)), oab ? 2 : 1};
            pg8::gemm_phase(lds, g, S, E);
            if (!dry && ph == 2) convert_set(p, 2, lds, tid);
            if (!dry && ph == 9) convert_set(p, 1, lds, tid);
        } else if (ph == 3) {
            norm_phase(p, 1, tid, dry, 11);
        } else if (ph == 4) {
            pg8::Gemm g{(const bf16_t*)(p.ws + WS_H), (const bf16_t*)(p.ws + WS_WIN), M, DIN, D, 0, 0};
            pg8::StaticOrder S; S.init(M, DIN, D, gridDim.x, blockIdx.x);
            pg8::EpiIN E{(bf16_t*)(p.ws + WS_U)};
            pg8::gemm_phase(lds, g, S, E);
        } else if (ph == 5) {
            scan_phase(p, lds, tid, dry);
        } else if (ph == 6) {
            fix_phase(p, lds, tid, dry);
            za_phase(p, tid, dry);
        } else if (ph == 8) {
            merge_phase(p, tid);
        } else if (ph == 10) {
            norm_phase(p, 2, tid, dry, 4);
        } else if (ph == 13) {
            norm_phase(p, 3, tid, dry, 11);
        }
        if (ph2 + 1 < ph_hi * 2) { if (ph_hi > NPHASE) grid.sync(); else xcd_barrier(xb); }
    }
}

extern "C" void kernel_launch(void* const* d_in, const int* in_sizes, int n_in, void* d_out, int out_size, void* d_ws, size_t ws_size, hipStream_t stream) {
    if (n_in != 30 || ws_size < WS_END) { fprintf(stderr, "kernel_launch: unexpected n_in %d / ws_size %zu (need %zu)\n", n_in, ws_size, (size_t)WS_END); return; }
    Params p{};
    for (int i = 0; i < 30; ++i) p.in[i] = (const float*)d_in[i];
    p.out = (float*)d_out; p.ws = (unsigned char*)d_ws;
    (void)hipFuncSetAttribute((const void*)mk_fwd, hipFuncAttributeMaxDynamicSharedMemorySize, LDS_BYTES);
    static int grid_blocks = 0;
    if (!grid_blocks) {
        int dev = 0, cus = 0, per_cu = 0;
        (void)hipGetDevice(&dev);
        (void)hipDeviceGetAttribute(&cus, hipDeviceAttributeMultiprocessorCount, dev);
        (void)hipOccupancyMaxActiveBlocksPerMultiprocessor(&per_cu, (const void*)mk_fwd, 512, LDS_BYTES);
        if (per_cu < 1) { fprintf(stderr, "kernel_launch: occupancy query says %d blocks/CU\n", per_cu); per_cu = 1; }
        grid_blocks = cus;
    }
    (void)hipMemsetAsync((unsigned char*)d_ws + WS_BAR, 0, 16384, stream);
#if SINGLE_LAUNCH
    int lo = 0, hi = NPHASE;
    void* args[] = {&p, &lo, &hi};
    hipError_t e = hipLaunchCooperativeKernel((const void*)mk_fwd, dim3(grid_blocks), dim3(512), args, LDS_BYTES, stream);
    if (e != hipSuccess) fprintf(stderr, "cooperative launch failed: %s (grid %d)\n", hipGetErrorString(e), grid_blocks);
#else
    for (int ph = 0; ph < NPHASE; ++ph) hipLaunchKernelGGL(mk_fwd, dim3(grid_blocks), dim3(512), LDS_BYTES, stream, p, ph, ph + 1);
#endif
}
```

```cpp
#include <hip/hip_runtime.h>
#include <hip/hip_cooperative_groups.h>
#include <cstdio>
namespace cg = cooperative_groups;

#ifndef REP_MASK
#define REP_MASK 0
#endif
#ifndef SINGLE_LAUNCH
#define SINGLE_LAUNCH 1
#endif

#define LAS __attribute__((address_space(3)))
typedef unsigned short bf16_t;
typedef short bf16x8 __attribute__((ext_vector_type(8)));
typedef float f32x4 __attribute__((ext_vector_type(4)));
typedef unsigned u32x4 __attribute__((ext_vector_type(4)));
typedef unsigned u32x2 __attribute__((ext_vector_type(2)));

constexpr int D = 1024, DFF = 2816, DIN = 7168;
constexpr int NB = 8, SEQ = 2048, NMETA = 16, TP = SEQ + NMETA;
constexpr int MP = NB * TP;
constexpr int NS = 128;
constexpr int M = MP + NS;
constexpr int CHUNK = 48, NCH = TP / CHUNK;
constexpr float EPS = 1e-6f;

constexpr size_t O_YP = 0, O_YS = 16777216, O_CAP = O_YS + 131072, O_CBP = O_CAP + 16384, O_RGP = O_CBP + 24576,
                 O_CAS = O_RGP + 8192, O_CBS = O_CAS + 262144, O_RGS = O_CBS + 393216;

constexpr size_t SLOT = (size_t)M * D;
constexpr size_t SB = SLOT * 2;
constexpr size_t WS_U = 0;
constexpr size_t WS_ACT = 0;
constexpr size_t WS_Y = 3 * SB;
constexpr size_t WS_PY = 4 * SB;
constexpr int MAINR = 64 * 256;
constexpr size_t WS_WGU = 5 * SB;
constexpr size_t WS_WD = WS_WGU + (size_t)5632 * 1024 * 2;
constexpr size_t WS_H = 6 * SB;
constexpr size_t WS_WIN = 7 * SB;
constexpr size_t WS_POAB = WS_WIN;
constexpr size_t WS_WOAB = WS_WIN + (size_t)7168 * 1024 * 2;
constexpr size_t WS_WO = WS_WOAB + (size_t)2 * 1024 * 1024 * 2;
constexpr size_t WS_WRG = WS_WO + (size_t)1024 * 1024 * 2;
constexpr size_t WS_SUMM = WS_WRG + (size_t)2 * 16 * 64 * 64 * 2;
constexpr size_t WS_SC = WS_SUMM + (size_t)NB * NCH * D * 2 * 4;
constexpr size_t WS_LC = WS_SC + 98304;
constexpr size_t WS_BAR = WS_SC + 131072;
constexpr size_t WS_PCB = WS_BAR + 16384;
constexpr size_t WS_PCA = WS_PCB + (size_t)NS * D * 4;
constexpr size_t WS_END = WS_PCA + (size_t)NS * D * 4;
static_assert(WS_END <= (size_t)256 * 1024 * 1024, "workspace");

struct Params { const float* in[30]; float* out; unsigned char* ws; };

__device__ __forceinline__ unsigned cvt_pk_bf16(float lo, float hi) { unsigned r; asm volatile("v_cvt_pk_bf16_f32 %0, %1, %2" : "=v"(r) : "v"(lo), "v"(hi)); return r; }
__device__ __forceinline__ bf16_t f2bf(float f) { return (bf16_t)(cvt_pk_bf16(f, 0.f) & 0xffffu); }
__device__ __forceinline__ float bf2f(bf16_t b) { return __uint_as_float(((unsigned)b) << 16); }
__device__ __forceinline__ float bflo(unsigned w) { return __uint_as_float(w << 16); }
__device__ __forceinline__ float bfhi(unsigned w) { return __uint_as_float(w & 0xffff0000u); }
__device__ __forceinline__ float sigm(float x) { return __builtin_amdgcn_rcpf(1.0f + __expf(-x)); }
__device__ __forceinline__ float gelu_tanh(float x) { const float t = 1.5957691216057308f * (x + 0.044715f * x * x * x); return x * sigm(t); }
__device__ __forceinline__ float wave_sum(float v, int lane) {
#pragma unroll
    for (int o = 32; o >= 1; o >>= 1) v += __int_as_float(__builtin_amdgcn_ds_bpermute((lane ^ o) << 2, __float_as_int(v)));
    return v;
}
__device__ __forceinline__ const float* x0row(const Params& p, int r) {
    if (r >= MP) return p.in[1] + (size_t)(r - MP) * D;
    const int b = r / TP, t = r - b * TP;
    if (t < NMETA) return p.in[5] + (size_t)t * D;
    return p.in[0] + ((size_t)b * SEQ + (t - NMETA)) * D;
}

namespace pg8 {
constexpr int BM = 256, BK = 64, HALF = 128, HTB = HALF * BK * 2, STAGE_BYTES = 8 * HTB, NXCD = 8, WGM = 8;
__host__ __device__ __forceinline__ int lds_byte(int r, int c) { const int st = (r >> 4) * 2 + (c >> 5), rr = r & 15, cc = c & 31, ob = rr * 64 + cc * 2; return st * 1024 + (ob ^ (((ob >> 9) & 1) << 5)); }
__host__ __device__ __forceinline__ void stage_rc(int b, int& R, int& C) { const int st = b / 1024, sb = b % 1024, swz = sb ^ (((sb >> 9) & 1) << 5); R = (st >> 1) * 16 + swz / 64; C = (st & 1) * 32 + (swz % 64) / 2; }
__host__ __device__ __forceinline__ int perm32(int rho) { const int n = rho >> 4, i = rho & 15; return 8 * (i >> 2) + 4 * n + (i & 3); }

struct Unit { int pm, pn, z, k0, nk, part; };
struct Gemm { const bf16_t* A; const bf16_t* Bt; int M, N, K; size_t zA, zB; };

struct StaticOrder {
    int nM, nN, nwg, G, c, ntf;
    __device__ void init(int M_, int N_, int K_, int G_, int c_) { nM = M_ / BM; nN = N_ / BM; nwg = nM * nN; G = G_; c = c_; ntf = K_ / BK; }
    __device__ bool map(long L, Unit& u) const {
        if (L >= nwg) return false;
        int wgid = (int)L; { const int q = nwg / NXCD, r = nwg % NXCD, xcd = wgid % NXCD, off = wgid / NXCD; wgid = (xcd < r ? xcd * (q + 1) : r * (q + 1) + (xcd - r) * q) + off; }
        const int nig = WGM * nN, gid = wgid / nig, fm = gid * WGM, gsz = (nM - fm) < WGM ? (nM - fm) : WGM;
        u.pm = fm + ((wgid % nig) % gsz); u.pn = (wgid % nig) / gsz; u.z = 0; u.k0 = 0; u.nk = ntf; u.part = -1; return true;
    }
    __device__ bool next(int i, Unit& u) const { return map((long)i * G + c, u); }
};
struct SplitOrder : StaticOrder {
    int nsplit, nkm;
    __device__ void init(int N_, int K_, int G_, int c_, int nsplit_, int nkm_) { StaticOrder::init(64 * BM, N_, K_, G_, c_); nsplit = nsplit_; nkm = nkm_; }
    __device__ bool next(int i, Unit& u) const {
        const long L = (long)i * G + c; bool ok;
        if (L < nwg) ok = map(L, u);
        else { const int L2 = (int)(L - nwg); ok = L2 < nN * nsplit; const int ks = L2 / nN; u.pm = 64; u.pn = L2 - ks * nN; u.k0 = ks * nkm; u.nk = nkm; u.part = ks; }
        u.z = u.pn >> 2; u.pn &= 3; return ok;
    }
};

template <class Epi, class Sched>
__device__ __forceinline__ void gemm_phase(LAS unsigned char* lds, const Gemm g, const Sched& S, const Epi& E) {
    int tid_ = threadIdx.x; asm volatile("" : "+v"(tid_));
    const int tid = tid_, wid = __builtin_amdgcn_readfirstlane(tid >> 6), lane = tid & 63, wr = wid >> 2, wc = wid & 3, fr = lane & 15, fq = lane >> 4;
    const int K = g.K;
    unsigned voffA[2], voffB[2];
#pragma unroll
    for (int i = 0; i < 2; ++i) { int R, C; stage_rc(tid * 16 + i * 8192, R, C); const int Rb = Epi::PERM ? ((R & ~31) + perm32(R & 31)) : R;
        voffA[i] = (unsigned)(R * K + C) * 2u; voffB[i] = (unsigned)(Rb * K + C) * 2u; }
    const size_t kstep = (size_t)(BK * 2);
    const size_t hstep = (size_t)HALF * K * 2;
    const size_t tstep = 2 * hstep;
    const unsigned ldsw = (unsigned)wid * 1024u;
    const int aoff = lds_byte(wr * 64 + fr, fq * 8), boff = lds_byte(wc * 32 + fr, fq * 8);
#define PG8_SA(b, h) (((b) * 2 + (h)) * HTB)
#define PG8_SB(b, h) ((4 + (b) * 2 + (h)) * HTB)
#define PG8_STAGE(bufoff, gbase, voff) do { _Pragma("unroll") for (int _i = 0; _i < 2; ++_i) \
        __builtin_amdgcn_global_load_lds((const unsigned*)((const char*)(gbase) + (voff)[_i]), (LAS unsigned*)(lds + (bufoff) + ldsw + _i * 8192), 16, 0, 0); } while (0)
#define PG8_LDA(dst, b, h) do { _Pragma("unroll") for (int m = 0; m < 4; ++m) _Pragma("unroll") for (int k = 0; k < 2; ++k) dst[m][k] = *(const LAS bf16x8*)(lds + PG8_SA(b, h) + aoff + m * 2048 + k * 1024); } while (0)
#define PG8_LDB(dst, b, h) do { _Pragma("unroll") for (int n = 0; n < 2; ++n) _Pragma("unroll") for (int k = 0; k < 2; ++k) dst[n][k] = *(const LAS bf16x8*)(lds + PG8_SB(b, h) + boff + n * 2048 + k * 1024); } while (0)
#define PG8_MMA(ai, bj, At, Bt) do { __builtin_amdgcn_s_setprio(1); _Pragma("unroll") for (int m = 0; m < 4; ++m) _Pragma("unroll") for (int n = 0; n < 2; ++n) _Pragma("unroll") for (int k = 0; k < 2; ++k) \
        acc[ai][bj][m][n] = __builtin_amdgcn_mfma_f32_16x16x32_bf16(Bt[n][k], At[m][k], acc[ai][bj][m][n], 0, 0, 0); __builtin_amdgcn_s_setprio(0); } while (0)
#define PG8_WAIT_V(n) asm volatile("s_waitcnt vmcnt(" #n ")" ::: "memory")
#define PG8_WAIT_L(n) asm volatile("s_waitcnt lgkmcnt(" #n ")" ::: "memory")
#define PG8_BAR __builtin_amdgcn_s_barrier()
#define PG8_SCHED __builtin_amdgcn_sched_barrier(0)
    Unit cur, nxt; int ui = 0;
    if (!S.next(0, cur)) return;
    f32x4 acc[2][2][4][2];
#pragma unroll
    for (int a = 0; a < 2; ++a)
#pragma unroll
        for (int b = 0; b < 2; ++b)
#pragma unroll
            for (int m = 0; m < 4; ++m)
#pragma unroll
                for (int n = 0; n < 2; ++n) acc[a][b][m][n] = (f32x4){0.f, 0.f, 0.f, 0.f};
    bf16x8 At[4][2], B0[2][2], B1[2][2];
    const char* cA = (const char*)g.A + (size_t)cur.z * g.zA + (size_t)cur.pm * tstep + (size_t)cur.k0 * kstep; const char* cB = (const char*)g.Bt + (size_t)cur.z * g.zB + (size_t)cur.pn * tstep + (size_t)cur.k0 * kstep;
    int nt = cur.nk;
    PG8_STAGE(PG8_SB(0, 0), cB, voffB); PG8_STAGE(PG8_SA(0, 0), cA, voffA); PG8_STAGE(PG8_SB(0, 1), cB + hstep, voffB); PG8_STAGE(PG8_SA(0, 1), cA + hstep, voffA);
    if (wr == 1) PG8_BAR;
    PG8_WAIT_V(4); PG8_BAR;
    PG8_STAGE(PG8_SB(1, 0), cB + kstep, voffB); PG8_STAGE(PG8_SA(1, 0), cA + kstep, voffA); PG8_STAGE(PG8_SB(1, 1), cB + hstep + kstep, voffB);
    PG8_WAIT_V(6); PG8_BAR;
    for (;;) {
        const bool has_next = S.next(ui + 1, nxt);
        const char* nA = has_next ? (const char*)g.A + (size_t)nxt.z * g.zA + (size_t)nxt.pm * tstep + (size_t)nxt.k0 * kstep : cA; const char* nB = has_next ? (const char*)g.Bt + (size_t)nxt.z * g.zB + (size_t)nxt.pn * tstep + (size_t)nxt.k0 * kstep : cB;
        for (int t = 0; t < nt; t += 2) {
            const bool last = (t == nt - 2);
            const char* a1 = cA + (size_t)(t + 1) * kstep;
            const char* a2 = last ? nA : cA + (size_t)(t + 2) * kstep; const char* b2 = last ? nB : cB + (size_t)(t + 2) * kstep;
            const char* a3 = a2 + kstep; const char* b3 = b2 + kstep;
            PG8_LDB(B0, 0, 0); PG8_SCHED; PG8_LDA(At, 0, 0); PG8_STAGE(PG8_SA(1, 1), a1 + hstep, voffA);
            PG8_WAIT_L(8); PG8_BAR; PG8_WAIT_L(0); PG8_MMA(0, 0, At, B0); PG8_BAR; PG8_SCHED;
            PG8_LDB(B1, 0, 1); PG8_STAGE(PG8_SB(0, 0), b2, voffB);
            PG8_BAR; PG8_WAIT_L(0); PG8_MMA(0, 1, At, B1); PG8_BAR;
            PG8_LDA(At, 0, 1); PG8_STAGE(PG8_SA(0, 0), a2, voffA);
            PG8_BAR; PG8_WAIT_L(0); PG8_MMA(1, 0, At, B0); PG8_BAR; PG8_SCHED;
            PG8_STAGE(PG8_SB(0, 1), b2 + hstep, voffB);
            PG8_WAIT_V(6); PG8_BAR; PG8_MMA(1, 1, At, B1); PG8_BAR;
            PG8_LDB(B0, 1, 0); PG8_SCHED; PG8_LDA(At, 1, 0); PG8_STAGE(PG8_SA(0, 1), a2 + hstep, voffA);
            PG8_WAIT_L(8); PG8_BAR; PG8_WAIT_L(0); PG8_MMA(0, 0, At, B0); PG8_BAR; PG8_SCHED;
            PG8_LDB(B1, 1, 1); PG8_STAGE(PG8_SB(1, 0), b3, voffB);
            PG8_BAR; PG8_WAIT_L(0); PG8_MMA(0, 1, At, B1); PG8_BAR;
            PG8_LDA(At, 1, 1); PG8_STAGE(PG8_SA(1, 0), a3, voffA);
            PG8_BAR; PG8_WAIT_L(0); PG8_MMA(1, 0, At, B0); PG8_BAR; PG8_SCHED;
            PG8_STAGE(PG8_SB(1, 1), b3 + hstep, voffB);
            PG8_WAIT_V(6); PG8_BAR; PG8_MMA(1, 1, At, B1); PG8_BAR;
        }
        E(acc, cur, wr, wc, fr, fq);
        if (!has_next) break;
#pragma unroll
        for (int a = 0; a < 2; ++a)
#pragma unroll
            for (int b = 0; b < 2; ++b)
#pragma unroll
                for (int m = 0; m < 4; ++m)
#pragma unroll
                    for (int n = 0; n < 2; ++n) acc[a][b][m][n] = (f32x4){0.f, 0.f, 0.f, 0.f};
        cur = nxt; cA = nA; cB = nB; nt = cur.nk; ++ui;
    }
    PG8_WAIT_V(0);
    if (wr == 0) PG8_BAR;
    PG8_BAR;
#undef PG8_SA
#undef PG8_SB
#undef PG8_STAGE
#undef PG8_LDA
#undef PG8_LDB
#undef PG8_MMA
#undef PG8_WAIT_V
#undef PG8_WAIT_L
#undef PG8_BAR
#undef PG8_SCHED
}

struct EpiBF {
    static constexpr bool PERM = true;
    bf16_t* O; size_t zO; float* P; int nz;
    __device__ __forceinline__ void operator()(const f32x4 (&acc)[2][2][4][2], const Unit& u, int wr, int wc, int fr, int fq) const {
        const int col0 = u.pn * BM + wc * 32 + 8 * fq;
        if (u.part < 0) {
            const int row0 = u.pm * BM + wr * 64 + fr; bf16_t* base = O + (size_t)u.z * zO;
#pragma unroll
            for (int ai = 0; ai < 2; ++ai)
#pragma unroll
                for (int m = 0; m < 4; ++m) { bf16_t* rowp = base + (size_t)(row0 + ai * HALF + m * 16) * D + col0;
#pragma unroll
                    for (int bj = 0; bj < 2; ++bj) { const f32x4 v0 = acc[ai][bj][m][0], v1 = acc[ai][bj][m][1];
                        u32x4 w; w.x = cvt_pk_bf16(v0[0], v0[1]); w.y = cvt_pk_bf16(v0[2], v0[3]); w.z = cvt_pk_bf16(v1[0], v1[1]); w.w = cvt_pk_bf16(v1[2], v1[3]);
                        *(u32x4*)(rowp + bj * HALF) = w; } }
        } else {
            const int row0 = wr * 64 + fr; float* base = P + (size_t)(u.part * nz + u.z) * (BM * D);
#pragma unroll
            for (int ai = 0; ai < 2; ++ai)
#pragma unroll
                for (int m = 0; m < 4; ++m) { float* rowp = base + (size_t)(row0 + ai * HALF + m * 16) * D + col0;
#pragma unroll
                    for (int bj = 0; bj < 2; ++bj) { *(f32x4*)(rowp + bj * HALF) = acc[ai][bj][m][0]; *(f32x4*)(rowp + bj * HALF + 4) = acc[ai][bj][m][1]; } }
        }
    }
};
struct EpiGU {
    static constexpr bool PERM = true;
    bf16_t* O; bool dry;
    __device__ __forceinline__ void operator()(const f32x4 (&acc)[2][2][4][2], const Unit& u, int wr, int wc, int fr, int fq) const {
        if (dry) return;
        const int row0 = u.pm * BM + wr * 64 + fr, col0 = u.pn * HALF + wc * 32 + 8 * fq;
#pragma unroll
        for (int ai = 0; ai < 2; ++ai)
#pragma unroll
            for (int m = 0; m < 4; ++m) { bf16_t* rowp = O + (size_t)(row0 + ai * HALF + m * 16) * DFF + col0;
                float v[8];
#pragma unroll
                for (int n = 0; n < 2; ++n)
#pragma unroll
                    for (int j = 0; j < 4; ++j) { const float gt = acc[ai][0][m][n][j], up = acc[ai][1][m][n][j]; v[n * 4 + j] = gt * sigm(gt) * up; }
                u32x4 w; w.x = cvt_pk_bf16(v[0], v[1]); w.y = cvt_pk_bf16(v[2], v[3]); w.z = cvt_pk_bf16(v[4], v[5]); w.w = cvt_pk_bf16(v[6], v[7]);
                *(u32x4*)rowp = w; }
    }
};
struct EpiIN {
    static constexpr bool PERM = true;
    bf16_t* U;
    __device__ __forceinline__ void operator()(const f32x4 (&acc)[2][2][4][2], const Unit& u, int wr, int wc, int fr, int fq) const {
        const int row0 = u.pm * BM + wr * 64 + fr;
        if (u.pn >= 4 && u.pn < 12) {
            const int col0 = (u.pn - 4) * HALF + wc * 32 + 8 * fq; bf16_t* base = U + 2 * SLOT;
#pragma unroll
            for (int ai = 0; ai < 2; ++ai)
#pragma unroll
                for (int m = 0; m < 4; ++m) { bf16_t* rowp = base + (size_t)(row0 + ai * HALF + m * 16) * D + col0;
                    const f32x4 v0 = acc[ai][0][m][0] * acc[ai][1][m][0], v1 = acc[ai][0][m][1] * acc[ai][1][m][1];
                    u32x4 w; w.x = cvt_pk_bf16(v0[0], v0[1]); w.y = cvt_pk_bf16(v0[2], v0[3]); w.z = cvt_pk_bf16(v1[0], v1[1]); w.w = cvt_pk_bf16(v1[2], v1[3]);
                    *(u32x4*)rowp = w; }
        } else {
            int slot, ct; if (u.pn < 4) { slot = 0; ct = u.pn; } else { const int sg = (u.pn - 12) >> 2; slot = sg == 0 ? 3 : (sg == 1 ? 1 : sg + 2); ct = (u.pn - 12) & 3; }
            const int col0 = ct * BM + wc * 32 + 8 * fq; bf16_t* base = U + (size_t)slot * SLOT;
#pragma unroll
            for (int ai = 0; ai < 2; ++ai)
#pragma unroll
                for (int m = 0; m < 4; ++m) { bf16_t* rowp = base + (size_t)(row0 + ai * HALF + m * 16) * D + col0;
#pragma unroll
                    for (int bj = 0; bj < 2; ++bj) { const f32x4 v0 = acc[ai][bj][m][0], v1 = acc[ai][bj][m][1];
                        u32x4 w; w.x = cvt_pk_bf16(v0[0], v0[1]); w.y = cvt_pk_bf16(v0[2], v0[3]); w.z = cvt_pk_bf16(v1[0], v1[1]); w.w = cvt_pk_bf16(v1[2], v1[3]);
                        *(u32x4*)(rowp + bj * HALF) = w; } }
        }
    }
};
}

__device__ __forceinline__ int conv_map(int mode, int n) {
    if (mode == 0) return n;
    if (mode == 1) return 256 * (n >> 7) + (n & 127);
    if (mode == 2) return 256 * (n >> 7) + 128 + (n & 127);
    const int seg = n >> 10, j = n & 1023;
    if (seg == 0) return j;
    if (seg == 1) return 1024 + 256 * (j >> 7) + (j & 127);
    if (seg == 2) return 1024 + 256 * (j >> 7) + 128 + (j & 127);
    return 3072 + (seg - 3) * 1024 + j;
}
struct ConvE { const float* src; bf16_t* dst; const float* gk; int K, N, mode, t; };
__device__ __forceinline__ bool conv_decode(const Params& p, int set, int T, ConvE& e) {
    if (set < 2) {
        const int a = set ? 27 : 8; const float* gk = p.in[set ? 25 : 6];
        if (T < 704)       { e.src = p.in[a];     e.dst = (bf16_t*)(p.ws + WS_WGU); e.gk = gk;      e.K = 1024; e.N = 2816; e.mode = 1; e.t = T; }
        else if (T < 1408) { e.src = p.in[a + 1]; e.dst = (bf16_t*)(p.ws + WS_WGU); e.gk = gk;      e.K = 1024; e.N = 2816; e.mode = 2; e.t = T - 704; }
        else if (T < 2112) { e.src = p.in[a + 2]; e.dst = (bf16_t*)(p.ws + WS_WD);  e.gk = nullptr; e.K = 2816; e.N = 1024; e.mode = 0; e.t = T - 1408; }
        else return false;
    } else {
        if (T < 1792)      { e.src = p.in[13]; e.dst = (bf16_t*)(p.ws + WS_WIN); e.gk = p.in[11]; e.K = 1024; e.N = 7168; e.mode = 3; e.t = T; }
        else if (T < 2048) { e.src = p.in[15]; e.dst = (bf16_t*)(p.ws + WS_WOAB); e.gk = nullptr; e.K = 1024; e.N = 1024; e.mode = 0; e.t = T - 1792; }
        else if (T < 2304) { e.src = p.in[23]; e.dst = (bf16_t*)(p.ws + WS_WOAB + (size_t)1024 * 1024 * 2); e.gk = nullptr; e.K = 1024; e.N = 1024; e.mode = 0; e.t = T - 2048; }
        else if (T < 2560) { e.src = p.in[24]; e.dst = (bf16_t*)(p.ws + WS_WO);  e.gk = nullptr;  e.K = 1024; e.N = 1024; e.mode = 0; e.t = T - 2304; }
        else return false;
    }
    return true;
}
__device__ __forceinline__ void conv_load(const ConvE& e, int tid, f32x4& v0, f32x4& v1) {
    const int ntn = e.N >> 6; const int tk = e.t / ntn, tn = e.t - tk * ntn;
    const float* s0 = e.src + (size_t)(tk * 64 + (tid >> 4)) * e.N + tn * 64 + (tid & 15) * 4;
    v0 = *(const f32x4*)s0; v1 = *(const f32x4*)(s0 + (size_t)32 * e.N);
}
__device__ __forceinline__ void conv_emit(const ConvE& e, int tid, const f32x4& v0, const f32x4& v1, LAS float* sl) {
    const int ntn = e.N >> 6; const int tk = e.t / ntn, tn = e.t - tk * ntn; const int k0 = tk * 64, n0 = tn * 64;
    { LAS float* d = sl + (tid >> 4) * 65 + (tid & 15) * 4; d[0] = v0[0]; d[1] = v0[1]; d[2] = v0[2]; d[3] = v0[3]; d += 32 * 65; d[0] = v1[0]; d[1] = v1[1]; d[2] = v1[2]; d[3] = v1[3]; }
    __syncthreads();
    const int n = tid >> 3, ko = (tid & 7) * 8;
    float f[8];
#pragma unroll
    for (int i = 0; i < 8; ++i) f[i] = sl[(ko + i) * 65 + n];
    if (e.gk) {
        const f32x4 g0 = *(const f32x4*)(e.gk + k0 + ko), g1 = *(const f32x4*)(e.gk + k0 + ko + 4);
#pragma unroll
        for (int i = 0; i < 4; ++i) { f[i] *= g0[i]; f[4 + i] *= g1[i]; }
    }
    u32x4 w; w.x = cvt_pk_bf16(f[0], f[1]); w.y = cvt_pk_bf16(f[2], f[3]); w.z = cvt_pk_bf16(f[4], f[5]); w.w = cvt_pk_bf16(f[6], f[7]);
    *(u32x4*)(e.dst + (size_t)conv_map(e.mode, n0 + n) * e.K + k0 + ko) = w;
    __syncthreads();
}
__device__ __forceinline__ void convert_set(const Params& p, int set, LAS unsigned char* lds, int tid, int skip) {
    ConvE e, en; f32x4 v0, v1, n0 = {0.f, 0.f, 0.f, 0.f}, n1 = {0.f, 0.f, 0.f, 0.f};
    if ((int)blockIdx.x < skip) return;
    int T = blockIdx.x - skip; const int stride = gridDim.x - skip;
    bool have = conv_decode(p, set, T, e);
    if (have) conv_load(e, tid, v0, v1);
    while (have) {
        T += stride;
        const bool hn = conv_decode(p, set, T, en);
        if (hn) conv_load(en, tid, n0, n1);
        conv_emit(e, tid, v0, v1, (LAS float*)lds);
        e = en; v0 = n0; v1 = n1; have = hn;
    }
}

__device__ __forceinline__ void norm_phase(const Params& p, int mode, int tid, bool dry, int nsplit) {
    const int lane = tid & 63, gw = blockIdx.x * 8 + (tid >> 6), nw = gridDim.x * 8;
    const float* gpost = mode == 1 ? p.in[7] : (mode == 2 ? p.in[12] : p.in[26]);
    const float cc = mode == 2 ? 1.0f : 0.5f;
    const bf16_t* Yb = (const bf16_t*)(p.ws + WS_Y); const float* PY = (const float*)(p.ws + WS_PY); bf16_t* H = (bf16_t*)(p.ws + WS_H); float* SC = (float*)(p.ws + WS_SC);
    for (int r = gw; r < M; r += nw) {
        f32x4 xv[4];
        if (mode == 0) {
            const float* xin = x0row(p, r);
#pragma unroll
            for (int q = 0; q < 4; ++q) xv[q] = *(const f32x4*)(xin + lane * 4 + 256 * q);
        } else {
            const float sc = SC[r];
#pragma unroll
            for (int q = 0; q < 4; ++q) { const u32x2 w = *(const u32x2*)(H + (size_t)r * D + lane * 4 + 256 * q); xv[q] = (f32x4){bflo(w.x), bfhi(w.x), bflo(w.y), bfhi(w.y)} * sc; }
            f32x4 yv[4]; float ss = 0.f;
            if (r < MAINR) {
#pragma unroll
                for (int q = 0; q < 4; ++q) { const u32x2 w = *(const u32x2*)(Yb + (size_t)r * D + lane * 4 + 256 * q); yv[q] = (f32x4){bflo(w.x), bfhi(w.x), bflo(w.y), bfhi(w.y)}; }
            } else {
#pragma unroll
                for (int q = 0; q < 4; ++q) yv[q] = (f32x4){0.f, 0.f, 0.f, 0.f};
                for (int ks = 0; ks < nsplit; ++ks) {
#pragma unroll
                    for (int q = 0; q < 4; ++q) yv[q] += *(const f32x4*)(PY + ((size_t)ks * 256 + (r - MAINR)) * D + lane * 4 + 256 * q);
                }
            }
#pragma unroll
            for (int q = 0; q < 4; ++q) ss += yv[q][0] * yv[q][0] + yv[q][1] * yv[q][1] + yv[q][2] * yv[q][2] + yv[q][3] * yv[q][3];
            ss = wave_sum(ss, lane);
            const float rs = cc * rsqrtf(ss * (1.0f / D) + EPS);
#pragma unroll
            for (int q = 0; q < 4; ++q) xv[q] += yv[q] * rs * *(const f32x4*)(gpost + lane * 4 + 256 * q);
        }
        if (mode == 3) {
            float* xo;
            if (r >= MP) xo = p.out + O_YS + (size_t)(r - MP) * D;
            else { const int b = r / TP, t = r - b * TP; if (t < NMETA) continue; xo = p.out + O_YP + ((size_t)b * SEQ + (t - NMETA)) * D; }
#pragma unroll
            for (int q = 0; q < 4; ++q) *(f32x4*)(xo + lane * 4 + 256 * q) = xv[q];
        } else {
            float ss = 0.f;
#pragma unroll
            for (int q = 0; q < 4; ++q) ss += xv[q][0] * xv[q][0] + xv[q][1] * xv[q][1] + xv[q][2] * xv[q][2] + xv[q][3] * xv[q][3];
            ss = wave_sum(ss, lane);
            const float ms = ss * (1.0f / D) + EPS; const float rs = rsqrtf(ms);
            if (!dry) {
#pragma unroll
                for (int q = 0; q < 4; ++q) { const f32x4 hv = xv[q] * rs; u32x2 w; w.x = cvt_pk_bf16(hv[0], hv[1]); w.y = cvt_pk_bf16(hv[2], hv[3]);
                    *(u32x2*)(H + (size_t)r * D + lane * 4 + 256 * q) = w; }
                if (lane == 0) SC[r] = ms * rs;
            }
        }
    }
}

constexpr int WL_BYTES = 11264;
__device__ __forceinline__ void scan_item(const Params& p, int b, int j, int h, LAS unsigned char* wl, const LAS unsigned char* wlds, int lane, bool dry) {
    bf16_t* U = (bf16_t*)(p.ws + WS_U);
    const bf16_t* bx = U + 3 * SLOT; bf16_t* bg = U + 1 * SLOT; bf16_t* pp = (bf16_t*)p.out;
    float* summ = (float*)(p.ws + WS_SUMM);
    const int c = h * 64 + lane, fr = lane & 15, fq = lane >> 4;
    const size_t row0 = (size_t)b * TP + (size_t)j * CHUNK;
    const bf16_t* bx0 = bx + row0 * D; bf16_t* bg0 = bg + row0 * D; bf16_t* pp0 = pp + row0 * D;
    const LAS unsigned char* wq = wlds + fr * 144 + fq * 16;
    float brv[4], biv[4], lcv[4];
#pragma unroll
    for (int nt = 0; nt < 4; ++nt) { const int ch = h * 64 + nt * 16 + fr; brv[nt] = p.in[19][ch]; biv[nt] = p.in[21][ch]; lcv[nt] = ((const float*)(p.ws + WS_LC))[ch]; }
    const float w0 = p.in[16][c], w1 = p.in[16][D + c], w2 = p.in[16][2 * D + c], w3 = p.in[16][3 * D + c], cbias = p.in[17][c];
    float xm3 = 0.f, xm2 = 0.f, xm1 = 0.f;
    if (j > 0) { xm3 = bf2f(bx0[-3 * D + c]); xm2 = bf2f(bx0[-2 * D + c]); xm1 = bf2f(bx0[-1 * D + c]); }
    float hh = 0.f, ap = 1.f;
    LAS unsigned short* cbT = (LAS unsigned short*)wl;
    LAS float* xu = (LAS float*)(wl + 2304);
    LAS float* aS = (LAS float*)(wl + 2304 + 4352);
    bf16_t xr[16], gr[16], xn[16];
#pragma unroll
    for (int tt = 0; tt < 16; ++tt) xr[tt] = bx0[tt * D + c];
#pragma unroll
    for (int g = 0; g < 3; ++g) {
        const int r0 = g * 16;
#pragma unroll
        for (int tt = 0; tt < 16; ++tt) gr[tt] = bg0[(r0 + tt) * D + c];
        if (g < 2) {
#pragma unroll
            for (int tt = 0; tt < 16; ++tt) xn[tt] = bx0[(r0 + 16 + tt) * D + c];
        }
#pragma unroll
        for (int tt = 0; tt < 16; ++tt) { const float x = bf2f(xr[tt]); const float cb = w0 * xm3 + w1 * xm2 + w2 * xm1 + w3 * x + cbias; xm3 = xm2; xm2 = xm1; xm1 = x;
            cbT[tt * 72 + lane] = f2bf(cb); xu[tt * 68 + lane] = cb; }
        __builtin_amdgcn_wave_barrier();
        const bf16x8 a0 = *(const LAS bf16x8*)(cbT + fr * 72 + fq * 8), a1 = *(const LAS bf16x8*)(cbT + fr * 72 + 32 + fq * 8);
        f32x4 accR[4], accI[4];
#pragma unroll
        for (int nt = 0; nt < 4; ++nt) {
            const bf16x8 r0w = *(const LAS bf16x8*)(wq + nt * 2304), r1w = *(const LAS bf16x8*)(wq + nt * 2304 + 64);
            const bf16x8 i0w = *(const LAS bf16x8*)(wq + 9216 + nt * 2304), i1w = *(const LAS bf16x8*)(wq + 9216 + nt * 2304 + 64);
            accR[nt] = __builtin_amdgcn_mfma_f32_16x16x32_bf16(a0, r0w, (f32x4){0.f, 0.f, 0.f, 0.f}, 0, 0, 0);
            accR[nt] = __builtin_amdgcn_mfma_f32_16x16x32_bf16(a1, r1w, accR[nt], 0, 0, 0);
            accI[nt] = __builtin_amdgcn_mfma_f32_16x16x32_bf16(a0, i0w, (f32x4){0.f, 0.f, 0.f, 0.f}, 0, 0, 0);
            accI[nt] = __builtin_amdgcn_mfma_f32_16x16x32_bf16(a1, i1w, accI[nt], 0, 0, 0);
        }
#pragma unroll
        for (int nt = 0; nt < 4; ++nt)
#pragma unroll
            for (int i = 0; i < 4; ++i) { const int idx = (fq * 4 + i) * 68 + nt * 16 + fr; const float x = xu[idx];
                const float r = sigm(accR[nt][i] + brv[nt]), ig = sigm(accI[nt][i] + biv[nt]);
                const float la = lcv[nt] * r; const float a = __expf(la);
                const float z2 = 2.0f * la;
                const float m2s = -z2 * (1.0f + z2 * (0.5f + z2 * (0.16666667f + z2 * (0.041666668f + z2 * (0.0083333338f + z2 * 0.0013888889f)))));
                const float m2 = z2 > -0.25f ? m2s : 1.0f - a * a;
                xu[idx] = __builtin_amdgcn_sqrtf(m2) * ig * x; aS[idx] = a; }
        __builtin_amdgcn_wave_barrier();
#pragma unroll
        for (int tt = 0; tt < 16; ++tt) { const float a = aS[tt * 68 + lane], uu = xu[tt * 68 + lane]; hh = a * hh + uu; ap *= a;
            const float gl = gelu_tanh(bf2f(gr[tt]));
            if (!dry) bg0[(r0 + tt) * D + c] = f2bf(gl * hh);
            pp0[(r0 + tt) * D + c] = f2bf(gl * ap); }
        __builtin_amdgcn_wave_barrier();
        if (g < 2) {
#pragma unroll
            for (int tt = 0; tt < 16; ++tt) xr[tt] = xn[tt];
        }
    }
    *(float2*)(summ + (((size_t)b * NCH + j) * D + c) * 2) = make_float2(ap, hh);
    if (j == NCH - 1) { p.out[O_CBP + ((size_t)b * 3 + 0) * D + c] = xm3; p.out[O_CBP + ((size_t)b * 3 + 1) * D + c] = xm2; p.out[O_CBP + ((size_t)b * 3 + 2) * D + c] = xm1; }
}
__device__ __forceinline__ void sample_item(const Params& p, int k, int h, LAS unsigned char* wl, const LAS unsigned char* wlds, int lane) {
    bf16_t* U = (bf16_t*)(p.ws + WS_U);
    const int c = h * 64 + lane, fr = lane & 15, fq = lane >> 4;
    const size_t row0 = (size_t)MP + (size_t)k * 16; const int s0 = k * 16;
    const bf16_t* bx0 = U + 3 * SLOT + row0 * D; bf16_t* bg0 = U + 1 * SLOT + row0 * D;
    const LAS unsigned char* wq = wlds + fr * 144 + fq * 16;
    float brv[4], biv[4], lcv[4];
#pragma unroll
    for (int nt = 0; nt < 4; ++nt) { const int ch = h * 64 + nt * 16 + fr; brv[nt] = p.in[19][ch]; biv[nt] = p.in[21][ch]; lcv[nt] = ((const float*)(p.ws + WS_LC))[ch]; }
    const float w3 = p.in[16][3 * D + c];
    LAS unsigned short* cbT = (LAS unsigned short*)wl;
    LAS float* xu = (LAS float*)(wl + 2304);
    LAS float* aS = (LAS float*)(wl + 2304 + 4352);
    const float* pcb = (const float*)(p.ws + WS_PCB) + (size_t)s0 * D + c;
    {
        bf16_t xr[16]; float pc[16];
#pragma unroll
        for (int tt = 0; tt < 16; ++tt) { xr[tt] = bx0[tt * D + c]; pc[tt] = pcb[tt * D]; }
#pragma unroll
        for (int tt = 0; tt < 16; ++tt) { const float x = bf2f(xr[tt]); const float cb = pc[tt] + w3 * x;
            p.out[O_CBS + ((size_t)(s0 + tt) * 3 + 2) * D + c] = x;
            cbT[tt * 72 + lane] = f2bf(cb); xu[tt * 68 + lane] = cb; }
    }
    __builtin_amdgcn_wave_barrier();
    const bf16x8 a0 = *(const LAS bf16x8*)(cbT + fr * 72 + fq * 8), a1 = *(const LAS bf16x8*)(cbT + fr * 72 + 32 + fq * 8);
    f32x4 accR[4], accI[4];
#pragma unroll
    for (int nt = 0; nt < 4; ++nt) {
        const bf16x8 r0w = *(const LAS bf16x8*)(wq + nt * 2304), r1w = *(const LAS bf16x8*)(wq + nt * 2304 + 64);
        const bf16x8 i0w = *(const LAS bf16x8*)(wq + 9216 + nt * 2304), i1w = *(const LAS bf16x8*)(wq + 9216 + nt * 2304 + 64);
        accR[nt] = __builtin_amdgcn_mfma_f32_16x16x32_bf16(a0, r0w, (f32x4){0.f, 0.f, 0.f, 0.f}, 0, 0, 0);
        accR[nt] = __builtin_amdgcn_mfma_f32_16x16x32_bf16(a1, r1w, accR[nt], 0, 0, 0);
        accI[nt] = __builtin_amdgcn_mfma_f32_16x16x32_bf16(a0, i0w, (f32x4){0.f, 0.f, 0.f, 0.f}, 0, 0, 0);
        accI[nt] = __builtin_amdgcn_mfma_f32_16x16x32_bf16(a1, i1w, accI[nt], 0, 0, 0);
    }
#pragma unroll
    for (int nt = 0; nt < 4; ++nt)
#pragma unroll
        for (int i = 0; i < 4; ++i) { const int idx = (fq * 4 + i) * 68 + nt * 16 + fr; const float x = xu[idx];
            const float r = sigm(accR[nt][i] + brv[nt]), ig = sigm(accI[nt][i] + biv[nt]);
            const float la = lcv[nt] * r; const float a = __expf(la);
            const float z2 = 2.0f * la;
            const float m2s = -z2 * (1.0f + z2 * (0.5f + z2 * (0.16666667f + z2 * (0.041666668f + z2 * (0.0083333338f + z2 * 0.0013888889f)))));
            const float m2 = z2 > -0.25f ? m2s : 1.0f - a * a;
            xu[idx] = __builtin_amdgcn_sqrtf(m2) * ig * x; aS[idx] = a; }
    __builtin_amdgcn_wave_barrier();
    {
        float h0[16]; bf16_t gq[16];
#pragma unroll
        for (int tt = 0; tt < 16; ++tt) { h0[tt] = p.in[4][(size_t)(s0 + tt) * D + c]; gq[tt] = bg0[tt * D + c]; }
#pragma unroll
        for (int tt = 0; tt < 16; ++tt) {
            const float hn = aS[tt * 68 + lane] * h0[tt] + xu[tt * 68 + lane];
            p.out[O_RGS + (size_t)(s0 + tt) * D + c] = hn;
            bg0[tt * D + c] = f2bf(gelu_tanh(bf2f(gq[tt])) * hn);
        }
    }
    __builtin_amdgcn_wave_barrier();
}
__device__ __forceinline__ void scan_phase(const Params& p, LAS unsigned char* lds, int tid, bool dry) {
    const int wid = __builtin_amdgcn_readfirstlane(tid >> 6), lane = tid & 63;
    LAS unsigned char* wl = lds + wid * WL_BYTES;
    LAS unsigned char* wlds = lds + 8 * WL_BYTES;
    const int h = blockIdx.x & 15;
    {
        const bf16_t* wt = (const bf16_t*)(p.ws + WS_WRG);
#pragma unroll
        for (int q = 0; q < 2; ++q) { const int e = tid + q * 512, g = e >> 9, jrow = (e >> 3) & 63, pc = e & 7;
            *(LAS u32x4*)(wlds + g * 9216 + jrow * 144 + pc * 16) = *(const u32x4*)(wt + (size_t)g * 65536 + (size_t)(h * 64 + jrow) * 64 + pc * 8); }
    }
    __syncthreads();
    const int nbh = gridDim.x >> 4;
    for (int it = (blockIdx.x >> 4) * 8 + wid; it < NB * NCH; it += nbh * 8) scan_item(p, it / NCH, it % NCH, h, wl, wlds, lane, dry);
    if (!dry && wid < 2 && (int)(blockIdx.x >> 4) >= nbh - 4) {
        const int k = ((int)(blockIdx.x >> 4) - (nbh - 4)) * 2 + wid;
        if (k < NS / 16) sample_item(p, k, h, wl, wlds, lane);
    }
    __syncthreads();
}
__device__ __forceinline__ void fix_phase(const Params& p, LAS unsigned char* lds, int tid, bool dry) {
    bf16_t* zb = (bf16_t*)(p.ws + WS_U) + 1 * SLOT; const bf16_t* pp = (const bf16_t*)p.out;
    const float* summ = (const float*)(p.ws + WS_SUMM);
    LAS float* cs = (LAS float*)lds;
    for (int it = blockIdx.x; it < NB * (NCH - 1); it += gridDim.x) {
        const int b = it / (NCH - 1), j = it % (NCH - 1) + 1;
#pragma unroll
        for (int cq = 0; cq < 2; ++cq) {
            const int c = tid + cq * 512; const float* sp = summ + ((size_t)b * NCH * D + c) * 2; float hh = 0.f;
            for (int i0 = 0; i0 < j; i0 += 16) {
                float va[16], vh[16];
#pragma unroll
                for (int k = 0; k < 16; ++k) { if (i0 + k < j) { const float2 v = *(const float2*)(sp + (size_t)(i0 + k) * D * 2); va[k] = v.x; vh[k] = v.y; } else { va[k] = 1.f; vh[k] = 0.f; } }
#pragma unroll
                for (int k = 0; k < 16; ++k) hh = va[k] * hh + vh[k];
            }
            cs[c] = hh;
            if (j == NCH - 1) { const float2 v = *(const float2*)(sp + (size_t)j * D * 2); p.out[O_RGP + (size_t)b * D + c] = v.x * hh + v.y; }
        }
        __syncthreads();
        const size_t row0 = (size_t)b * TP + (size_t)j * CHUNK;
        for (int q0 = 0; q0 < CHUNK * 128 / 512; q0 += 4) {
            u32x4 zq[4], pq[4];
#pragma unroll
            for (int k = 0; k < 4; ++k) { const int e = tid + (q0 + k) * 512, tt = e >> 7, vc = e & 127; const size_t o = (row0 + tt) * D + vc * 8; zq[k] = *(const u32x4*)(zb + o); pq[k] = *(const u32x4*)(pp + o); }
#pragma unroll
            for (int k = 0; k < 4; ++k) { const int e = tid + (q0 + k) * 512, tt = e >> 7, vc = e & 127; const size_t o = (row0 + tt) * D + vc * 8;
                const f32x4 c0 = *(const LAS f32x4*)(cs + vc * 8), c1 = *(const LAS f32x4*)(cs + vc * 8 + 4);
                u32x4 w;
                w.x = cvt_pk_bf16(bflo(zq[k].x) + bflo(pq[k].x) * c0[0], bfhi(zq[k].x) + bfhi(pq[k].x) * c0[1]); w.y = cvt_pk_bf16(bflo(zq[k].y) + bflo(pq[k].y) * c0[2], bfhi(zq[k].y) + bfhi(pq[k].y) * c0[3]);
                w.z = cvt_pk_bf16(bflo(zq[k].z) + bflo(pq[k].z) * c1[0], bfhi(zq[k].z) + bfhi(pq[k].z) * c1[1]); w.w = cvt_pk_bf16(bflo(zq[k].w) + bflo(pq[k].w) * c1[2], bfhi(zq[k].w) + bfhi(pq[k].w) * c1[3]);
                if (!dry) *(u32x4*)(zb + o) = w; }
        }
        __syncthreads();
    }
}
__device__ __forceinline__ void za_phase(const Params& p, int tid, bool dry) {
    bf16_t* U = (bf16_t*)(p.ws + WS_U); bf16_t* ab = U; const bf16_t* ca = U + 2 * SLOT;
    const float* cw = p.in[14];
    for (int idx = blockIdx.x * 512 + tid; idx < NB * 129 * 128; idx += gridDim.x * 512) {
        const int vc = idx & 127, tb = (idx >> 7) % 129, b = idx / (128 * 129); const int c0 = vc * 8;
        float w[3][8];
#pragma unroll
        for (int k = 0; k < 3; ++k) { const f32x4 a = *(const f32x4*)(cw + k * D + c0), bq = *(const f32x4*)(cw + k * D + c0 + 4);
#pragma unroll
            for (int e = 0; e < 4; ++e) { w[k][e] = a[e]; w[k][4 + e] = bq[e]; } }
        const size_t r0 = (size_t)b * TP + (size_t)tb * 16;
        float p2[8], p1[8];
        if (tb > 0) { const u32x4 q2 = *(const u32x4*)(ca + (r0 - 2) * D + c0), q1 = *(const u32x4*)(ca + (r0 - 1) * D + c0);
#pragma unroll
            for (int e = 0; e < 4; ++e) { p2[2 * e] = bflo(q2[e]); p2[2 * e + 1] = bfhi(q2[e]); p1[2 * e] = bflo(q1[e]); p1[2 * e + 1] = bfhi(q1[e]); } }
        else {
#pragma unroll
            for (int e = 0; e < 8; ++e) { p2[e] = 0.f; p1[e] = 0.f; } }
        for (int t4 = 0; t4 < 16; t4 += 4) {
            u32x4 qcs[4], qas[4];
#pragma unroll
            for (int k = 0; k < 4; ++k) { qcs[k] = *(const u32x4*)(ca + (r0 + t4 + k) * D + c0); qas[k] = *(const u32x4*)(ab + (r0 + t4 + k) * D + c0); }
#pragma unroll
            for (int k = 0; k < 4; ++k) {
                const u32x4 qc = qcs[k], qa = qas[k];
                float cv[8], av[8], zv[8];
#pragma unroll
                for (int e = 0; e < 4; ++e) { cv[2 * e] = bflo(qc[e]); cv[2 * e + 1] = bfhi(qc[e]); av[2 * e] = bflo(qa[e]); av[2 * e + 1] = bfhi(qa[e]); }
#pragma unroll
                for (int e = 0; e < 8; ++e) { zv[e] = av[e] * (w[0][e] * p2[e] + w[1][e] * p1[e] + w[2][e] * cv[e]); p2[e] = p1[e]; p1[e] = cv[e]; }
                u32x4 o; o.x = cvt_pk_bf16(zv[0], zv[1]); o.y = cvt_pk_bf16(zv[2], zv[3]); o.z = cvt_pk_bf16(zv[4], zv[5]); o.w = cvt_pk_bf16(zv[6], zv[7]);
                if (!dry) *(u32x4*)(ab + (r0 + t4 + k) * D + c0) = o;
            }
        }
        if (tb == 128) {
            float* o2 = p.out + O_CAP + ((size_t)b * 2 + 0) * D + c0; float* o1 = p.out + O_CAP + ((size_t)b * 2 + 1) * D + c0;
            *(f32x4*)o2 = (f32x4){p2[0], p2[1], p2[2], p2[3]}; *(f32x4*)(o2 + 4) = (f32x4){p2[4], p2[5], p2[6], p2[7]};
            *(f32x4*)o1 = (f32x4){p1[0], p1[1], p1[2], p1[3]}; *(f32x4*)(o1 + 4) = (f32x4){p1[4], p1[5], p1[6], p1[7]};
        }
    }
    if (!dry) {
        for (int idx = blockIdx.x * 512 + tid; idx < NS * 128; idx += gridDim.x * 512) {
            const int vc = idx & 127, sm = idx >> 7, c0 = vc * 8; const size_t ro = (size_t)(MP + sm) * D + c0;
            const u32x4 qc = *(const u32x4*)(ca + ro), qa = *(const u32x4*)(ab + ro);
            const float* pca = (const float*)(p.ws + WS_PCA) + (size_t)sm * D + c0;
            float hp[8], cv[8], zv[8];
            { const f32x4 a0 = *(const f32x4*)pca, a1 = *(const f32x4*)(pca + 4);
#pragma unroll
              for (int e = 0; e < 4; ++e) { hp[e] = a0[e]; hp[4 + e] = a1[e]; } }
#pragma unroll
            for (int e = 0; e < 4; ++e) { cv[2 * e] = bflo(qc[e]); cv[2 * e + 1] = bfhi(qc[e]); }
#pragma unroll
            for (int e = 0; e < 8; ++e) { const float av = (e & 1) ? bfhi(qa[e >> 1]) : bflo(qa[e >> 1]); zv[e] = av * (hp[e] + cw[2 * D + c0 + e] * cv[e]); }
            u32x4 o; o.x = cvt_pk_bf16(zv[0], zv[1]); o.y = cvt_pk_bf16(zv[2], zv[3]); o.z = cvt_pk_bf16(zv[4], zv[5]); o.w = cvt_pk_bf16(zv[6], zv[7]);
            *(u32x4*)(ab + ro) = o;
            float* o1 = p.out + O_CAS + ((size_t)sm * 2 + 1) * D + c0;
            *(f32x4*)o1 = (f32x4){cv[0], cv[1], cv[2], cv[3]}; *(f32x4*)(o1 + 4) = (f32x4){cv[4], cv[5], cv[6], cv[7]};
        }
    }
}

__device__ __forceinline__ u32x4 merge_math(const u32x4& ga, const u32x4& gb, const float (&ya)[8], const float (&yb)[8]) {
    u32x4 o4;
#pragma unroll
    for (int e = 0; e < 4; ++e) { const float lo = sigm(bflo(ga[e])) * ya[2 * e] + sigm(bflo(gb[e])) * yb[2 * e], hi = sigm(bfhi(ga[e])) * ya[2 * e + 1] + sigm(bfhi(gb[e])) * yb[2 * e + 1]; o4[e] = cvt_pk_bf16(lo, hi); }
    return o4;
}
__device__ __forceinline__ void merge_phase(const Params& p, int tid) {
    const bf16_t* U = (const bf16_t*)(p.ws + WS_U); bf16_t* H = (bf16_t*)p.out; const float* PO = (const float*)(p.ws + WS_POAB);
    const size_t G = (size_t)gridDim.x * 512, NMAIN = (size_t)MAINR * 128;
    for (size_t i0 = (size_t)blockIdx.x * 512 + tid; i0 < NMAIN; i0 += 4 * G) {
        u32x4 ga[4], gb[4], a[4], b[4];
#pragma unroll
        for (int k = 0; k < 4; ++k) { const size_t i = i0 + k * G; if (i < NMAIN) { ga[k] = *(const u32x4*)(U + 4 * SLOT + i * 8); gb[k] = *(const u32x4*)(U + 5 * SLOT + i * 8); a[k] = *(const u32x4*)(U + 2 * SLOT + i * 8); b[k] = *(const u32x4*)(U + 3 * SLOT + i * 8); } }
#pragma unroll
        for (int k = 0; k < 4; ++k) { const size_t i = i0 + k * G; if (i < NMAIN) {
            float ya[8], yb[8];
#pragma unroll
            for (int e = 0; e < 4; ++e) { ya[2 * e] = bflo(a[k][e]); ya[2 * e + 1] = bfhi(a[k][e]); yb[2 * e] = bflo(b[k][e]); yb[2 * e + 1] = bfhi(b[k][e]); }
            *(u32x4*)(H + i * 8) = merge_math(ga[k], gb[k], ya, yb); } }
    }
    for (size_t i = NMAIN + (size_t)blockIdx.x * 512 + tid; i < SLOT / 8; i += G) {
        const u32x4 ga = *(const u32x4*)(U + 4 * SLOT + i * 8), gb = *(const u32x4*)(U + 5 * SLOT + i * 8);
        float ya[8], yb[8];
        const int row = (int)(i >> 7);
        const size_t o = (size_t)(row - MAINR) * D + (size_t)(i & 127) * 8;
#pragma unroll
        for (int e = 0; e < 8; ++e) { ya[e] = 0.f; yb[e] = 0.f; }
#pragma unroll
        for (int ks = 0; ks < 4; ++ks) {
            const f32x4 a0 = *(const f32x4*)(PO + (size_t)(ks * 2 + 0) * (256 * D) + o), a1 = *(const f32x4*)(PO + (size_t)(ks * 2 + 0) * (256 * D) + o + 4);
            const f32x4 b0 = *(const f32x4*)(PO + (size_t)(ks * 2 + 1) * (256 * D) + o), b1 = *(const f32x4*)(PO + (size_t)(ks * 2 + 1) * (256 * D) + o + 4);
#pragma unroll
            for (int e = 0; e < 4; ++e) { ya[e] += a0[e]; ya[4 + e] += a1[e]; yb[e] += b0[e]; yb[4 + e] += b1[e]; }
        }
        *(u32x4*)(H + i * 8) = merge_math(ga, gb, ya, yb);
    }
}

#define XB_TMO      128
#define XB_XCNT(j)  (256  + 64 * (j))
#define XB_XSUB(j)  (1280 + 64 * (j))
#define XB_XGEN(j)  (2304 + 64 * (j))
#define XB_TOP      3328
#define XB_TOPGEN   3392
#define XCD_BAR_WORDS 3456
#define XB_SPIN_CAP (1u << 18)
__device__ __forceinline__ unsigned xb_ld(unsigned* p)              { return __hip_atomic_load(p, __ATOMIC_RELAXED, __HIP_MEMORY_SCOPE_AGENT); }
__device__ __forceinline__ unsigned xb_add(unsigned* p, unsigned v) { return __hip_atomic_fetch_add(p, v, __ATOMIC_RELAXED, __HIP_MEMORY_SCOPE_AGENT); }
__device__ __forceinline__ unsigned xb_xcc_id() { return (unsigned)__builtin_amdgcn_s_getreg((3 << 11) | 20) & 0xFu; }
#define XB_SPIN(cond, bar) do { unsigned _sp = 0; while (cond) { __builtin_amdgcn_s_sleep(1); \
    if ((++_sp & 255u) == 0u) { if (xb_ld(&(bar)[XB_TMO])) break; if (_sp > XB_SPIN_CAP) { atomicAdd(&(bar)[XB_TMO], 1u); break; } } } } while (0)
struct XcdBarrier { unsigned* bar; unsigned x; volatile LAS unsigned* st; };
__device__ __forceinline__ XcdBarrier xcd_barrier_post(unsigned* bar, volatile LAS unsigned* st) {
    XcdBarrier b; b.bar = bar; b.x = xb_xcc_id(); b.st = st;
    if (threadIdx.x == 0) (void)xb_add(&bar[XB_XCNT(b.x)], 1u);
    return b;
}
__device__ __forceinline__ void xcd_barrier_complete(unsigned* bar, unsigned x, unsigned& nloc, unsigned& nx) {
    const unsigned G = gridDim.x * gridDim.y * gridDim.z;
    unsigned sum, cnt, mine, sp = 0u;
    for (;;) {
        sum = 0u; cnt = 0u; mine = 0u;
#pragma unroll
        for (unsigned j = 0; j < 16; ++j) { const unsigned c = xb_ld(&bar[XB_XCNT(j)]); sum += c; cnt += (c > 0u) ? 1u : 0u; mine = (j == x) ? c : mine; }
        if (sum == G) break;
        __builtin_amdgcn_s_sleep(1);
        if ((++sp & 255u) == 0u) { if (xb_ld(&bar[XB_TMO])) break; if (sp > XB_SPIN_CAP) { atomicAdd(&bar[XB_TMO], 1u); break; } }
    }
    nloc = mine > 0u ? mine : 1u; nx = cnt > 0u ? cnt : 1u;
}
__device__ __forceinline__ void xcd_barrier(const XcdBarrier& b) {
    asm volatile("s_waitcnt vmcnt(0)" ::: "memory");
    __syncthreads();
    if (threadIdx.x == 0) {
        unsigned* bar = b.bar;
        __builtin_amdgcn_s_waitcnt(0);
        unsigned nloc = b.st[0], nx = b.st[1];
        if (nloc == 0u) { xcd_barrier_complete(bar, b.x, nloc, nx); b.st[0] = nloc; b.st[1] = nx; }
        const unsigned old = xb_add(&bar[XB_XSUB(b.x)], 1u);
        const unsigned gen = old / nloc;
        if (old + 1u == (gen + 1u) * nloc) {
            __builtin_amdgcn_fence(__ATOMIC_RELEASE, "agent");
            asm volatile("s_waitcnt vmcnt(0)" ::: "memory");
            const unsigned og = xb_add(&bar[XB_TOP], 1u);
            const unsigned tg = og / nx;
            if (og + 1u == (tg + 1u) * nx) xb_add(&bar[XB_TOPGEN], 1u);
            else XB_SPIN(xb_ld(&bar[XB_TOPGEN]) == tg, bar);
            __builtin_amdgcn_fence(__ATOMIC_ACQUIRE, "agent");
            xb_add(&bar[XB_XGEN(b.x)], 1u);
            asm volatile("s_waitcnt vmcnt(0)" ::: "memory");
        } else {
            XB_SPIN(xb_ld(&bar[XB_XGEN(b.x)]) == gen, bar);
            __builtin_amdgcn_fence(__ATOMIC_ACQUIRE, "agent");
            asm volatile("s_waitcnt vmcnt(0)" ::: "memory");
        }
    }
    __syncthreads();
}

constexpr int NPHASE = 14;
constexpr int LDS_BYTES = 131072 + 16;
__global__ void __launch_bounds__(512, 2) mk_fwd(Params p, int ph_lo, int ph_hi) {
    extern __shared__ __attribute__((aligned(16))) unsigned char shm[];
    LAS unsigned char* lds = (LAS unsigned char*)shm;
    cg::grid_group grid = cg::this_grid();
    if (threadIdx.x == 0) { *(LAS u32x4*)(lds + 131072) = (u32x4){0u, 0u, 0u, 0u}; }
    __syncthreads();
    const XcdBarrier xb = xcd_barrier_post((unsigned*)(p.ws + WS_BAR), (volatile LAS unsigned*)(lds + 131072));
    for (int ph2 = ph_lo * 2; ph2 < ph_hi * 2; ++ph2) {
        const int ph = ph2 >> 1; const bool dry = !(ph2 & 1);
        if (dry && !((REP_MASK >> ph) & 1)) continue;
        int tid = threadIdx.x; asm volatile("" : "+v"(tid));
        if (ph == 0) {
            convert_set(p, 0, lds, tid, 0);
            bf16_t* wt = (bf16_t*)(p.ws + WS_WRG);
            for (int o = blockIdx.x * 512 + tid; o < 2 * 65536; o += gridDim.x * 512) { const int g = o >> 16, h = (o >> 12) & 15, j = (o >> 6) & 63, i = o & 63;
                wt[o] = f2bf((g ? p.in[20] : p.in[18])[(size_t)(h * 64 + i) * 64 + j]); }
            if (blockIdx.x * 512 + tid < D) { const int ch = blockIdx.x * 512 + tid; ((float*)(p.ws + WS_LC))[ch] = -8.0f * log1pf(expf(-p.in[22][ch])); }
            for (int e = blockIdx.x * 512 + tid; e < NS * D; e += gridDim.x * 512) {
                const int sm = e >> 10, c = e & 1023;
                const float t0 = p.in[3][((size_t)sm * 3 + 0) * D + c], t1 = p.in[3][((size_t)sm * 3 + 1) * D + c], t2 = p.in[3][((size_t)sm * 3 + 2) * D + c];
                const float a0 = p.in[2][((size_t)sm * 2 + 0) * D + c], a1 = p.in[2][((size_t)sm * 2 + 1) * D + c];
                ((float*)(p.ws + WS_PCB))[e] = p.in[16][c] * t0 + p.in[16][D + c] * t1 + p.in[16][2 * D + c] * t2 + p.in[17][c];
                ((float*)(p.ws + WS_PCA))[e] = p.in[14][c] * a0 + p.in[14][D + c] * a1;
                p.out[O_CBS + ((size_t)sm * 3 + 0) * D + c] = t1; p.out[O_CBS + ((size_t)sm * 3 + 1) * D + c] = t2;
                p.out[O_CAS + ((size_t)sm * 2 + 0) * D + c] = a1;
            }
            norm_phase(p, 0, tid, dry, 0);
        } else if (ph == 1 || ph == 11) {
            pg8::Gemm g{(const bf16_t*)(p.ws + WS_H), (const bf16_t*)(p.ws + WS_WGU), M, 2 * DFF, D, 0, 0};
            pg8::StaticOrder S; S.init(M, 2 * DFF, D, gridDim.x, blockIdx.x);
            pg8::EpiGU E{(bf16_t*)(p.ws + WS_ACT), dry};
            pg8::gemm_phase(lds, g, S, E);
        } else if (ph == 2 || ph == 12 || ph == 9 || ph == 7) {
            const bool dn = (ph == 2 || ph == 12), oab = (ph == 7);
            pg8::Gemm g{dn ? (const bf16_t*)(p.ws + WS_ACT) : (oab ? (const bf16_t*)(p.ws + WS_U) : (const bf16_t*)p.out), (const bf16_t*)(p.ws + (dn ? WS_WD : (oab ? WS_WOAB : WS_WO))), M, D, dn ? DFF : D, SB, (size_t)1024 * 1024 * 2};
            pg8::SplitOrder S; S.init(oab ? 2 * D : D, dn ? DFF : D, gridDim.x, blockIdx.x, dn ? 11 : 4, 4);
            pg8::EpiBF E{(bf16_t*)(p.ws + (oab ? WS_U + 2 * SB : WS_Y)), SLOT, (float*)(p.ws + (oab ? WS_POAB : WS_PY)), oab ? 2 : 1};
            pg8::gemm_phase(lds, g, S, E);
            if (!dry && ph == 2) convert_set(p, 2, lds, tid, 44);
            if (!dry && ph == 9) convert_set(p, 1, lds, tid, 16);
        } else if (ph == 3) {
            norm_phase(p, 1, tid, dry, 11);
        } else if (ph == 4) {
            pg8::Gemm g{(const bf16_t*)(p.ws + WS_H), (const bf16_t*)(p.ws + WS_WIN), M, DIN, D, 0, 0};
            pg8::StaticOrder S; S.init(M, DIN, D, gridDim.x, blockIdx.x);
            pg8::EpiIN E{(bf16_t*)(p.ws + WS_U)};
            pg8::gemm_phase(lds, g, S, E);
        } else if (ph == 5) {
            scan_phase(p, lds, tid, dry);
        } else if (ph == 6) {
            fix_phase(p, lds, tid, dry);
            za_phase(p, tid, dry);
        } else if (ph == 8) {
            merge_phase(p, tid);
        } else if (ph == 10) {
            norm_phase(p, 2, tid, dry, 4);
        } else if (ph == 13) {
            norm_phase(p, 3, tid, dry, 11);
        }
        if (ph2 + 1 < ph_hi * 2) { if (ph_hi > NPHASE) grid.sync(); else xcd_barrier(xb); }
    }
}

extern "C" void kernel_launch(void* const* d_in, const int* in_sizes, int n_in, void* d_out, int out_size, void* d_ws, size_t ws_size, hipStream_t stream) {
    if (n_in != 30 || ws_size < WS_END) { fprintf(stderr, "kernel_launch: unexpected n_in %d / ws_size %zu (need %zu)\n", n_in, ws_size, (size_t)WS_END); return; }
    Params p{};
    for (int i = 0; i < 30; ++i) p.in[i] = (const float*)d_in[i];
    p.out = (float*)d_out; p.ws = (unsigned char*)d_ws;
    (void)hipFuncSetAttribute((const void*)mk_fwd, hipFuncAttributeMaxDynamicSharedMemorySize, LDS_BYTES);
    static int grid_blocks = 0;
    if (!grid_blocks) {
        int dev = 0, cus = 0, per_cu = 0;
        (void)hipGetDevice(&dev);
        (void)hipDeviceGetAttribute(&cus, hipDeviceAttributeMultiprocessorCount, dev);
        (void)hipOccupancyMaxActiveBlocksPerMultiprocessor(&per_cu, (const void*)mk_fwd, 512, LDS_BYTES);
        if (per_cu < 1) { fprintf(stderr, "kernel_launch: occupancy query says %d blocks/CU\n", per_cu); per_cu = 1; }
        grid_blocks = cus;
    }
    (void)hipMemsetAsync((unsigned char*)d_ws + WS_BAR, 0, 16384, stream);
#if SINGLE_LAUNCH
    int lo = 0, hi = NPHASE;
    void* args[] = {&p, &lo, &hi};
    hipError_t e = hipLaunchCooperativeKernel((const void*)mk_fwd, dim3(grid_blocks), dim3(512), args, LDS_BYTES, stream);
    if (e != hipSuccess) fprintf(stderr, "cooperative launch failed: %s (grid %d)\n", hipGetErrorString(e), grid_blocks);
#else
    for (int ph = 0; ph < NPHASE; ++ph) hipLaunchKernelGGL(mk_fwd, dim3(grid_blocks), dim3(512), LDS_BYTES, stream, p, ph, ph + 1);
#endif
}
```

```cpp
#include <hip/hip_runtime.h>
#include <hip/hip_cooperative_groups.h>
#include <cstdio>
namespace cg = cooperative_groups;

#ifndef REP_MASK
#define REP_MASK 0
#endif
#ifndef SINGLE_LAUNCH
#define SINGLE_LAUNCH 1
#endif

#define LAS __attribute__((address_space(3)))
typedef unsigned short bf16_t;
typedef short bf16x8 __attribute__((ext_vector_type(8)));
typedef float f32x4 __attribute__((ext_vector_type(4)));
typedef unsigned u32x4 __attribute__((ext_vector_type(4)));
typedef unsigned u32x2 __attribute__((ext_vector_type(2)));
typedef float f32x2 __attribute__((ext_vector_type(2)));

constexpr int D = 1024, DFF = 2816, DIN = 7168;
constexpr int NB = 8, SEQ = 2048, NMETA = 16, TP = SEQ + NMETA;
constexpr int MP = NB * TP;
constexpr int NS = 128;
constexpr int M = MP + NS;
constexpr int CHUNK = 48, NCH = TP / CHUNK;
constexpr float EPS = 1e-6f;

constexpr size_t O_YP = 0, O_YS = 16777216, O_CAP = O_YS + 131072, O_CBP = O_CAP + 16384, O_RGP = O_CBP + 24576,
                 O_CAS = O_RGP + 8192, O_CBS = O_CAS + 262144, O_RGS = O_CBS + 393216;

constexpr size_t SLOT = (size_t)M * D;
constexpr size_t SB = SLOT * 2;
constexpr size_t WS_U = 0;
constexpr size_t WS_ACT = 0;
constexpr size_t WS_Y = 3 * SB;
constexpr size_t WS_PY = 4 * SB;
constexpr int MAINR = 64 * 256;
constexpr size_t WS_WGU = 5 * SB;
constexpr size_t WS_WD = WS_WGU + (size_t)5632 * 1024 * 2;
constexpr size_t WS_H = 6 * SB;
constexpr size_t WS_WIN = 7 * SB;
constexpr size_t WS_POAB = WS_WIN;
constexpr size_t WS_WOAB = WS_WIN + (size_t)7168 * 1024 * 2;
constexpr size_t WS_WO = WS_WOAB + (size_t)2 * 1024 * 1024 * 2;
constexpr size_t WS_WRG = WS_WO + (size_t)1024 * 1024 * 2;
constexpr size_t WS_SUMM = WS_WRG + (size_t)2 * 16 * 64 * 64 * 2;
constexpr size_t WS_SC = WS_SUMM + (size_t)NB * NCH * D * 2 * 4;
constexpr size_t WS_LC = WS_SC + 98304;
constexpr size_t WS_BAR = WS_SC + 131072;
constexpr size_t WS_PCB = WS_BAR + 16384;
constexpr size_t WS_PCA = WS_PCB + (size_t)NS * D * 4;
constexpr size_t WS_END = WS_PCA + (size_t)NS * D * 4;
static_assert(WS_END <= (size_t)256 * 1024 * 1024, "workspace");

struct Params { const float* in[30]; float* out; unsigned char* ws; };

__device__ __forceinline__ unsigned cvt_pk_bf16(float lo, float hi) { unsigned r; asm volatile("v_cvt_pk_bf16_f32 %0, %1, %2" : "=v"(r) : "v"(lo), "v"(hi)); return r; }
__device__ __forceinline__ bf16_t f2bf(float f) { return (bf16_t)(cvt_pk_bf16(f, 0.f) & 0xffffu); }
__device__ __forceinline__ float bf2f(bf16_t b) { return __uint_as_float(((unsigned)b) << 16); }
__device__ __forceinline__ float bflo(unsigned w) { return __uint_as_float(w << 16); }
__device__ __forceinline__ float bfhi(unsigned w) { return __uint_as_float(w & 0xffff0000u); }
__device__ __forceinline__ float sigm(float x) { return __builtin_amdgcn_rcpf(1.0f + __expf(-x)); }
__device__ __forceinline__ float gelu_tanh(float x) { const float t = 1.5957691216057308f * (x + 0.044715f * x * x * x); return x * sigm(t); }
__device__ __forceinline__ float wave_sum(float v, int lane) {
#pragma unroll
    for (int o = 32; o >= 1; o >>= 1) v += __int_as_float(__builtin_amdgcn_ds_bpermute((lane ^ o) << 2, __float_as_int(v)));
    return v;
}
__device__ __forceinline__ const float* x0row(const Params& p, int r) {
    if (r >= MP) return p.in[1] + (size_t)(r - MP) * D;
    const int b = r / TP, t = r - b * TP;
    if (t < NMETA) return p.in[5] + (size_t)t * D;
    return p.in[0] + ((size_t)b * SEQ + (t - NMETA)) * D;
}

namespace pg8 {
constexpr int BM = 256, BK = 64, HALF = 128, HTB = HALF * BK * 2, STAGE_BYTES = 8 * HTB, NXCD = 8, WGM = 8;
__host__ __device__ __forceinline__ int lds_byte(int r, int c) { const int st = (r >> 4) * 2 + (c >> 5), rr = r & 15, cc = c & 31, ob = rr * 64 + cc * 2; return st * 1024 + (ob ^ (((ob >> 9) & 1) << 5)); }
__host__ __device__ __forceinline__ void stage_rc(int b, int& R, int& C) { const int st = b / 1024, sb = b % 1024, swz = sb ^ (((sb >> 9) & 1) << 5); R = (st >> 1) * 16 + swz / 64; C = (st & 1) * 32 + (swz % 64) / 2; }
__host__ __device__ __forceinline__ int perm32(int rho) { const int n = rho >> 4, i = rho & 15; return 8 * (i >> 2) + 4 * n + (i & 3); }

struct Unit { int pm, pn, z, k0, nk, part; };
struct Gemm { const bf16_t* A; const bf16_t* Bt; int M, N, K; size_t zA, zB; };

struct StaticOrder {
    int nM, nN, nwg, G, c, ntf;
    __device__ void init(int M_, int N_, int K_, int G_, int c_) { nM = M_ / BM; nN = N_ / BM; nwg = nM * nN; G = G_; c = c_; ntf = K_ / BK; }
    __device__ bool map(long L, Unit& u) const {
        if (L >= nwg) return false;
        int wgid = (int)L; { const int q = nwg / NXCD, r = nwg % NXCD, xcd = wgid % NXCD, off = wgid / NXCD; wgid = (xcd < r ? xcd * (q + 1) : r * (q + 1) + (xcd - r) * q) + off; }
        const int nig = WGM * nN, gid = wgid / nig, fm = gid * WGM, gsz = (nM - fm) < WGM ? (nM - fm) : WGM;
        u.pm = fm + ((wgid % nig) % gsz); u.pn = (wgid % nig) / gsz; u.z = 0; u.k0 = 0; u.nk = ntf; u.part = -1; return true;
    }
    __device__ bool next(int i, Unit& u) const { return map((long)i * G + c, u); }
};
struct SplitOrder : StaticOrder {
    int nsplit, nkm;
    __device__ void init(int N_, int K_, int G_, int c_, int nsplit_, int nkm_) { StaticOrder::init(64 * BM, N_, K_, G_, c_); nsplit = nsplit_; nkm = nkm_; }
    __device__ bool next(int i, Unit& u) const {
        const long L = (long)i * G + c; bool ok;
        if (L < nwg) ok = map(L, u);
        else { const int L2 = (int)(L - nwg); ok = L2 < nN * nsplit; const int ks = L2 / nN; u.pm = 64; u.pn = L2 - ks * nN; u.k0 = ks * nkm; u.nk = nkm; u.part = ks; }
        u.z = u.pn >> 2; u.pn &= 3; return ok;
    }
};

template <class Epi, class Sched>
__device__ __forceinline__ void gemm_phase(LAS unsigned char* lds, const Gemm g, const Sched& S, const Epi& E) {
    int tid_ = threadIdx.x; asm volatile("" : "+v"(tid_));
    const int tid = tid_, wid = __builtin_amdgcn_readfirstlane(tid >> 6), lane = tid & 63, wr = wid >> 2, wc = wid & 3, fr = lane & 15, fq = lane >> 4;
    const int K = g.K;
    unsigned voffA[2], voffB[2];
#pragma unroll
    for (int i = 0; i < 2; ++i) { int R, C; stage_rc(tid * 16 + i * 8192, R, C); const int Rb = Epi::PERM ? ((R & ~31) + perm32(R & 31)) : R;
        voffA[i] = (unsigned)(R * K + C) * 2u; voffB[i] = (unsigned)(Rb * K + C) * 2u; }
    const size_t kstep = (size_t)(BK * 2);
    const size_t hstep = (size_t)HALF * K * 2;
    const size_t tstep = 2 * hstep;
    const unsigned ldsw = (unsigned)wid * 1024u;
    const int aoff = lds_byte(wr * 64 + fr, fq * 8), boff = lds_byte(wc * 32 + fr, fq * 8);
#define PG8_SA(b, h) (((b) * 2 + (h)) * HTB)
#define PG8_SB(b, h) ((4 + (b) * 2 + (h)) * HTB)
#define PG8_STAGE(bufoff, gbase, voff) do { _Pragma("unroll") for (int _i = 0; _i < 2; ++_i) \
        __builtin_amdgcn_global_load_lds((const unsigned*)((const char*)(gbase) + (voff)[_i]), (LAS unsigned*)(lds + (bufoff) + ldsw + _i * 8192), 16, 0, 0); } while (0)
#define PG8_LDA(dst, b, h) do { _Pragma("unroll") for (int m = 0; m < 4; ++m) _Pragma("unroll") for (int k = 0; k < 2; ++k) dst[m][k] = *(const LAS bf16x8*)(lds + PG8_SA(b, h) + aoff + m * 2048 + k * 1024); } while (0)
#define PG8_LDB(dst, b, h) do { _Pragma("unroll") for (int n = 0; n < 2; ++n) _Pragma("unroll") for (int k = 0; k < 2; ++k) dst[n][k] = *(const LAS bf16x8*)(lds + PG8_SB(b, h) + boff + n * 2048 + k * 1024); } while (0)
#define PG8_MMA(ai, bj, At, Bt) do { __builtin_amdgcn_s_setprio(1); _Pragma("unroll") for (int m = 0; m < 4; ++m) _Pragma("unroll") for (int n = 0; n < 2; ++n) _Pragma("unroll") for (int k = 0; k < 2; ++k) \
        acc[ai][bj][m][n] = __builtin_amdgcn_mfma_f32_16x16x32_bf16(Bt[n][k], At[m][k], acc[ai][bj][m][n], 0, 0, 0); __builtin_amdgcn_s_setprio(0); } while (0)
#define PG8_WAIT_V(n) asm volatile("s_waitcnt vmcnt(" #n ")" ::: "memory")
#define PG8_WAIT_L(n) asm volatile("s_waitcnt lgkmcnt(" #n ")" ::: "memory")
#define PG8_BAR __builtin_amdgcn_s_barrier()
#define PG8_SCHED __builtin_amdgcn_sched_barrier(0)
    Unit cur, nxt; int ui = 0;
    if (!S.next(0, cur)) return;
    f32x4 acc[2][2][4][2];
#pragma unroll
    for (int a = 0; a < 2; ++a)
#pragma unroll
        for (int b = 0; b < 2; ++b)
#pragma unroll
            for (int m = 0; m < 4; ++m)
#pragma unroll
                for (int n = 0; n < 2; ++n) acc[a][b][m][n] = (f32x4){0.f, 0.f, 0.f, 0.f};
    bf16x8 At[4][2], B0[2][2], B1[2][2];
    const char* cA = (const char*)g.A + (size_t)cur.z * g.zA + (size_t)cur.pm * tstep + (size_t)cur.k0 * kstep; const char* cB = (const char*)g.Bt + (size_t)cur.z * g.zB + (size_t)cur.pn * tstep + (size_t)cur.k0 * kstep;
    int nt = cur.nk;
    PG8_STAGE(PG8_SB(0, 0), cB, voffB); PG8_STAGE(PG8_SA(0, 0), cA, voffA); PG8_STAGE(PG8_SB(0, 1), cB + hstep, voffB); PG8_STAGE(PG8_SA(0, 1), cA + hstep, voffA);
    if (wr == 1) PG8_BAR;
    PG8_WAIT_V(4); PG8_BAR;
    PG8_STAGE(PG8_SB(1, 0), cB + kstep, voffB); PG8_STAGE(PG8_SA(1, 0), cA + kstep, voffA); PG8_STAGE(PG8_SB(1, 1), cB + hstep + kstep, voffB);
    PG8_WAIT_V(6); PG8_BAR;
    for (;;) {
        const bool has_next = S.next(ui + 1, nxt);
        const char* nA = has_next ? (const char*)g.A + (size_t)nxt.z * g.zA + (size_t)nxt.pm * tstep + (size_t)nxt.k0 * kstep : cA; const char* nB = has_next ? (const char*)g.Bt + (size_t)nxt.z * g.zB + (size_t)nxt.pn * tstep + (size_t)nxt.k0 * kstep : cB;
        for (int t = 0; t < nt; t += 2) {
            const bool last = (t == nt - 2);
            const char* a1 = cA + (size_t)(t + 1) * kstep;
            const char* a2 = last ? nA : cA + (size_t)(t + 2) * kstep; const char* b2 = last ? nB : cB + (size_t)(t + 2) * kstep;
            const char* a3 = a2 + kstep; const char* b3 = b2 + kstep;
            PG8_LDB(B0, 0, 0); PG8_SCHED; PG8_LDA(At, 0, 0); PG8_STAGE(PG8_SA(1, 1), a1 + hstep, voffA);
            PG8_WAIT_L(8); PG8_BAR; PG8_WAIT_L(0); PG8_MMA(0, 0, At, B0); PG8_BAR; PG8_SCHED;
            PG8_LDB(B1, 0, 1); PG8_STAGE(PG8_SB(0, 0), b2, voffB);
            PG8_BAR; PG8_WAIT_L(0); PG8_MMA(0, 1, At, B1); PG8_BAR;
            PG8_LDA(At, 0, 1); PG8_STAGE(PG8_SA(0, 0), a2, voffA);
            PG8_BAR; PG8_WAIT_L(0); PG8_MMA(1, 0, At, B0); PG8_BAR; PG8_SCHED;
            PG8_STAGE(PG8_SB(0, 1), b2 + hstep, voffB);
            PG8_WAIT_V(6); PG8_BAR; PG8_MMA(1, 1, At, B1); PG8_BAR;
            PG8_LDB(B0, 1, 0); PG8_SCHED; PG8_LDA(At, 1, 0); PG8_STAGE(PG8_SA(0, 1), a2 + hstep, voffA);
            PG8_WAIT_L(8); PG8_BAR; PG8_WAIT_L(0); PG8_MMA(0, 0, At, B0); PG8_BAR; PG8_SCHED;
            PG8_LDB(B1, 1, 1); PG8_STAGE(PG8_SB(1, 0), b3, voffB);
            PG8_BAR; PG8_WAIT_L(0); PG8_MMA(0, 1, At, B1); PG8_BAR;
            PG8_LDA(At, 1, 1); PG8_STAGE(PG8_SA(1, 0), a3, voffA);
            PG8_BAR; PG8_WAIT_L(0); PG8_MMA(1, 0, At, B0); PG8_BAR; PG8_SCHED;
            PG8_STAGE(PG8_SB(1, 1), b3 + hstep, voffB);
            PG8_WAIT_V(6); PG8_BAR; PG8_MMA(1, 1, At, B1); PG8_BAR;
        }
        E(acc, cur, wr, wc, fr, fq);
        if (!has_next) break;
#pragma unroll
        for (int a = 0; a < 2; ++a)
#pragma unroll
            for (int b = 0; b < 2; ++b)
#pragma unroll
                for (int m = 0; m < 4; ++m)
#pragma unroll
                    for (int n = 0; n < 2; ++n) acc[a][b][m][n] = (f32x4){0.f, 0.f, 0.f, 0.f};
        cur = nxt; cA = nA; cB = nB; nt = cur.nk; ++ui;
    }
    PG8_WAIT_V(0);
    if (wr == 0) PG8_BAR;
    PG8_BAR;
#undef PG8_SA
#undef PG8_SB
#undef PG8_STAGE
#undef PG8_LDA
#undef PG8_LDB
#undef PG8_MMA
#undef PG8_WAIT_V
#undef PG8_WAIT_L
#undef PG8_BAR
#undef PG8_SCHED
}

struct EpiBF {
    static constexpr bool PERM = true;
    bf16_t* O; size_t zO; bf16_t* P; int nz;
    __device__ __forceinline__ void operator()(const f32x4 (&acc)[2][2][4][2], const Unit& u, int wr, int wc, int fr, int fq) const {
        const int col0 = u.pn * BM + wc * 32 + 8 * fq;
        const int row0 = (u.part < 0 ? u.pm * BM : 0) + wr * 64 + fr;
        bf16_t* base = u.part < 0 ? O + (size_t)u.z * zO : P + (size_t)(u.part * nz + u.z) * (BM * D);
#pragma unroll
        for (int ai = 0; ai < 2; ++ai)
#pragma unroll
            for (int m = 0; m < 4; ++m) { bf16_t* rowp = base + (size_t)(row0 + ai * HALF + m * 16) * D + col0;
#pragma unroll
                for (int bj = 0; bj < 2; ++bj) { const f32x4 v0 = acc[ai][bj][m][0], v1 = acc[ai][bj][m][1];
                    u32x4 w; w.x = cvt_pk_bf16(v0[0], v0[1]); w.y = cvt_pk_bf16(v0[2], v0[3]); w.z = cvt_pk_bf16(v1[0], v1[1]); w.w = cvt_pk_bf16(v1[2], v1[3]);
                    *(u32x4*)(rowp + bj * HALF) = w; } }
    }
};
struct EpiGU {
    static constexpr bool PERM = true;
    bf16_t* O; bool dry;
    __device__ __forceinline__ void operator()(const f32x4 (&acc)[2][2][4][2], const Unit& u, int wr, int wc, int fr, int fq) const {
        if (dry) return;
        const int row0 = u.pm * BM + wr * 64 + fr, col0 = u.pn * HALF + wc * 32 + 8 * fq;
#pragma unroll
        for (int ai = 0; ai < 2; ++ai)
#pragma unroll
            for (int m = 0; m < 4; ++m) { bf16_t* rowp = O + (size_t)(row0 + ai * HALF + m * 16) * DFF + col0;
                unsigned wv[4];
#pragma unroll
                for (int n = 0; n < 2; ++n)
#pragma unroll
                    for (int jp = 0; jp < 2; ++jp) {
                        const f32x2 gt = {acc[ai][0][m][n][2 * jp], acc[ai][0][m][n][2 * jp + 1]}, up = {acc[ai][1][m][n][2 * jp], acc[ai][1][m][n][2 * jp + 1]};
                        const f32x2 t = gt * (-1.44269504089f);
                        f32x2 e; e.x = __builtin_amdgcn_exp2f(t.x); e.y = __builtin_amdgcn_exp2f(t.y);
                        const f32x2 d = e + 1.0f;
                        f32x2 r; r.x = __builtin_amdgcn_rcpf(d.x); r.y = __builtin_amdgcn_rcpf(d.y);
                        const f32x2 o = (gt * up) * r;
                        wv[n * 2 + jp] = cvt_pk_bf16(o.x, o.y);
                    }
                u32x4 w; w.x = wv[0]; w.y = wv[1]; w.z = wv[2]; w.w = wv[3];
                *(u32x4*)rowp = w; }
    }
};
struct EpiIN {
    static constexpr bool PERM = true;
    bf16_t* U;
    __device__ __forceinline__ void operator()(const f32x4 (&acc)[2][2][4][2], const Unit& u, int wr, int wc, int fr, int fq) const {
        const int row0 = u.pm * BM + wr * 64 + fr;
        if (u.pn >= 4 && u.pn < 12) {
            const int col0 = (u.pn - 4) * HALF + wc * 32 + 8 * fq; bf16_t* base = U + 2 * SLOT;
#pragma unroll
            for (int ai = 0; ai < 2; ++ai)
#pragma unroll
                for (int m = 0; m < 4; ++m) { bf16_t* rowp = base + (size_t)(row0 + ai * HALF + m * 16) * D + col0;
                    const f32x4 v0 = acc[ai][0][m][0] * acc[ai][1][m][0], v1 = acc[ai][0][m][1] * acc[ai][1][m][1];
                    u32x4 w; w.x = cvt_pk_bf16(v0[0], v0[1]); w.y = cvt_pk_bf16(v0[2], v0[3]); w.z = cvt_pk_bf16(v1[0], v1[1]); w.w = cvt_pk_bf16(v1[2], v1[3]);
                    *(u32x4*)rowp = w; }
        } else {
            int slot, ct; if (u.pn < 4) { slot = 0; ct = u.pn; } else { const int sg = (u.pn - 12) >> 2; slot = sg == 0 ? 3 : (sg == 1 ? 1 : sg + 2); ct = (u.pn - 12) & 3; }
            const int col0 = ct * BM + wc * 32 + 8 * fq; bf16_t* base = U + (size_t)slot * SLOT;
#pragma unroll
            for (int ai = 0; ai < 2; ++ai)
#pragma unroll
                for (int m = 0; m < 4; ++m) { bf16_t* rowp = base + (size_t)(row0 + ai * HALF + m * 16) * D + col0;
#pragma unroll
                    for (int bj = 0; bj < 2; ++bj) { const f32x4 v0 = acc[ai][bj][m][0], v1 = acc[ai][bj][m][1];
                        u32x4 w; w.x = cvt_pk_bf16(v0[0], v0[1]); w.y = cvt_pk_bf16(v0[2], v0[3]); w.z = cvt_pk_bf16(v1[0], v1[1]); w.w = cvt_pk_bf16(v1[2], v1[3]);
                        *(u32x4*)(rowp + bj * HALF) = w; } }
        }
    }
};
}

__device__ __forceinline__ int conv_map(int mode, int n) {
    if (mode == 0) return n;
    if (mode == 1) return 256 * (n >> 7) + (n & 127);
    if (mode == 2) return 256 * (n >> 7) + 128 + (n & 127);
    const int seg = n >> 10, j = n & 1023;
    if (seg == 0) return j;
    if (seg == 1) return 1024 + 256 * (j >> 7) + (j & 127);
    if (seg == 2) return 1024 + 256 * (j >> 7) + 128 + (j & 127);
    return 3072 + (seg - 3) * 1024 + j;
}
struct ConvE { const float* src; bf16_t* dst; const float* gk; int K, N, mode, t; };
__device__ __forceinline__ bool conv_decode(const Params& p, int set, int T, ConvE& e) {
    if (set < 2) {
        const int a = set ? 27 : 8; const float* gk = p.in[set ? 25 : 6];
        if (T < 704)       { e.src = p.in[a];     e.dst = (bf16_t*)(p.ws + WS_WGU); e.gk = gk;      e.K = 1024; e.N = 2816; e.mode = 1; e.t = T; }
        else if (T < 1408) { e.src = p.in[a + 1]; e.dst = (bf16_t*)(p.ws + WS_WGU); e.gk = gk;      e.K = 1024; e.N = 2816; e.mode = 2; e.t = T - 704; }
        else if (T < 2112) { e.src = p.in[a + 2]; e.dst = (bf16_t*)(p.ws + WS_WD);  e.gk = nullptr; e.K = 2816; e.N = 1024; e.mode = 0; e.t = T - 1408; }
        else return false;
    } else {
        if (T < 1792)      { e.src = p.in[13]; e.dst = (bf16_t*)(p.ws + WS_WIN); e.gk = p.in[11]; e.K = 1024; e.N = 7168; e.mode = 3; e.t = T; }
        else if (T < 2048) { e.src = p.in[15]; e.dst = (bf16_t*)(p.ws + WS_WOAB); e.gk = nullptr; e.K = 1024; e.N = 1024; e.mode = 0; e.t = T - 1792; }
        else if (T < 2304) { e.src = p.in[23]; e.dst = (bf16_t*)(p.ws + WS_WOAB + (size_t)1024 * 1024 * 2); e.gk = nullptr; e.K = 1024; e.N = 1024; e.mode = 0; e.t = T - 2048; }
        else if (T < 2560) { e.src = p.in[24]; e.dst = (bf16_t*)(p.ws + WS_WO);  e.gk = nullptr;  e.K = 1024; e.N = 1024; e.mode = 0; e.t = T - 2304; }
        else return false;
    }
    return true;
}
__device__ __forceinline__ void conv_load(const ConvE& e, int tid, f32x4& v0, f32x4& v1) {
    const int ntn = e.N >> 6; const int tk = e.t / ntn, tn = e.t - tk * ntn;
    const float* s0 = e.src + (size_t)(tk * 64 + (tid >> 4)) * e.N + tn * 64 + (tid & 15) * 4;
    v0 = *(const f32x4*)s0; v1 = *(const f32x4*)(s0 + (size_t)32 * e.N);
}
__device__ __forceinline__ void conv_emit(const ConvE& e, int tid, const f32x4& v0, const f32x4& v1, LAS float* sl) {
    const int ntn = e.N >> 6; const int tk = e.t / ntn, tn = e.t - tk * ntn; const int k0 = tk * 64, n0 = tn * 64;
    { LAS float* d = sl + (tid >> 4) * 65 + (tid & 15) * 4; d[0] = v0[0]; d[1] = v0[1]; d[2] = v0[2]; d[3] = v0[3]; d += 32 * 65; d[0] = v1[0]; d[1] = v1[1]; d[2] = v1[2]; d[3] = v1[3]; }
    __syncthreads();
    const int n = tid >> 3, ko = (tid & 7) * 8;
    float f[8];
#pragma unroll
    for (int i = 0; i < 8; ++i) f[i] = sl[(ko + i) * 65 + n];
    if (e.gk) {
        const f32x4 g0 = *(const f32x4*)(e.gk + k0 + ko), g1 = *(const f32x4*)(e.gk + k0 + ko + 4);
#pragma unroll
        for (int i = 0; i < 4; ++i) { f[i] *= g0[i]; f[4 + i] *= g1[i]; }
    }
    u32x4 w; w.x = cvt_pk_bf16(f[0], f[1]); w.y = cvt_pk_bf16(f[2], f[3]); w.z = cvt_pk_bf16(f[4], f[5]); w.w = cvt_pk_bf16(f[6], f[7]);
    *(u32x4*)(e.dst + (size_t)conv_map(e.mode, n0 + n) * e.K + k0 + ko) = w;
    __syncthreads();
}
__device__ __forceinline__ void convert_set(const Params& p, int set, LAS unsigned char* lds, int tid, int skip, int T0, int T1) {
    ConvE e, en; f32x4 v0, v1, n0 = {0.f, 0.f, 0.f, 0.f}, n1 = {0.f, 0.f, 0.f, 0.f};
    if ((int)blockIdx.x < skip) return;
    int T = T0 + (int)blockIdx.x - skip; const int stride = gridDim.x - skip;
    bool have = T < T1 && conv_decode(p, set, T, e);
    if (have) conv_load(e, tid, v0, v1);
    while (have) {
        T += stride;
        const bool hn = T < T1 && conv_decode(p, set, T, en);
        if (hn) conv_load(en, tid, n0, n1);
        conv_emit(e, tid, v0, v1, (LAS float*)lds);
        e = en; v0 = n0; v1 = n1; have = hn;
    }
}

__device__ __forceinline__ void norm_phase(const Params& p, int mode, int tid, bool dry, int nsplit) {
    const int lane = tid & 63, gw = blockIdx.x * 8 + (tid >> 6), nw = gridDim.x * 8;
    const float* gpost = mode == 1 ? p.in[7] : (mode == 2 ? p.in[12] : p.in[26]);
    const float cc = mode == 2 ? 1.0f : 0.5f;
    const bf16_t* Yb = (const bf16_t*)(p.ws + WS_Y); const bf16_t* PY = (const bf16_t*)(p.ws + WS_PY); bf16_t* H = (bf16_t*)(p.ws + WS_H); float* SC = (float*)(p.ws + WS_SC);
    for (int r = gw; r < M; r += nw) {
        f32x4 xv[4];
        if (mode == 0) {
            const float* xin = x0row(p, r);
#pragma unroll
            for (int q = 0; q < 4; ++q) xv[q] = *(const f32x4*)(xin + lane * 4 + 256 * q);
        } else {
            const float sc = SC[r];
#pragma unroll
            for (int q = 0; q < 4; ++q) { const u32x2 w = *(const u32x2*)(H + (size_t)r * D + lane * 4 + 256 * q); xv[q] = (f32x4){bflo(w.x), bfhi(w.x), bflo(w.y), bfhi(w.y)} * sc; }
            f32x4 yv[4]; float ss = 0.f;
            if (r < MAINR) {
#pragma unroll
                for (int q = 0; q < 4; ++q) { const u32x2 w = *(const u32x2*)(Yb + (size_t)r * D + lane * 4 + 256 * q); yv[q] = (f32x4){bflo(w.x), bfhi(w.x), bflo(w.y), bfhi(w.y)}; }
            } else {
#pragma unroll
                for (int q = 0; q < 4; ++q) yv[q] = (f32x4){0.f, 0.f, 0.f, 0.f};
                for (int ks0 = 0; ks0 < nsplit; ks0 += 4) {
                    f32x4 pv[4][4];
#pragma unroll
                    for (int k = 0; k < 4; ++k) { const int ks = (ks0 + k < nsplit) ? ks0 + k : ks0;
#pragma unroll
                        for (int q = 0; q < 4; ++q) { const u32x2 w = *(const u32x2*)(PY + ((size_t)ks * 256 + (r - MAINR)) * D + lane * 4 + 256 * q); pv[k][q] = (f32x4){bflo(w.x), bfhi(w.x), bflo(w.y), bfhi(w.y)}; } }
#pragma unroll
                    for (int k = 0; k < 4; ++k) { const float m = (ks0 + k < nsplit) ? 1.0f : 0.0f;
#pragma unroll
                        for (int q = 0; q < 4; ++q) yv[q] += pv[k][q] * m; }
                }
            }
#pragma unroll
            for (int q = 0; q < 4; ++q) ss += yv[q][0] * yv[q][0] + yv[q][1] * yv[q][1] + yv[q][2] * yv[q][2] + yv[q][3] * yv[q][3];
            ss = wave_sum(ss, lane);
            const float rs = cc * rsqrtf(ss * (1.0f / D) + EPS);
#pragma unroll
            for (int q = 0; q < 4; ++q) xv[q] += yv[q] * rs * *(const f32x4*)(gpost + lane * 4 + 256 * q);
        }
        if (mode == 3) {
            float* xo;
            if (r >= MP) xo = p.out + O_YS + (size_t)(r - MP) * D;
            else { const int b = r / TP, t = r - b * TP; if (t < NMETA) continue; xo = p.out + O_YP + ((size_t)b * SEQ + (t - NMETA)) * D; }
#pragma unroll
            for (int q = 0; q < 4; ++q) *(f32x4*)(xo + lane * 4 + 256 * q) = xv[q];
        } else {
            float ss = 0.f;
#pragma unroll
            for (int q = 0; q < 4; ++q) ss += xv[q][0] * xv[q][0] + xv[q][1] * xv[q][1] + xv[q][2] * xv[q][2] + xv[q][3] * xv[q][3];
            ss = wave_sum(ss, lane);
            const float ms = ss * (1.0f / D) + EPS; const float rs = rsqrtf(ms);
            if (!dry) {
#pragma unroll
                for (int q = 0; q < 4; ++q) { const f32x4 hv = xv[q] * rs; u32x2 w; w.x = cvt_pk_bf16(hv[0], hv[1]); w.y = cvt_pk_bf16(hv[2], hv[3]);
                    *(u32x2*)(H + (size_t)r * D + lane * 4 + 256 * q) = w; }
                if (lane == 0) SC[r] = ms * rs;
            }
        }
    }
}

constexpr int WL_BYTES = 11264;
__device__ __forceinline__ void scan_item(const Params& p, int b, int j, int h, LAS unsigned char* wl, const LAS unsigned char* wlds, int lane, bool dry) {
    bf16_t* U = (bf16_t*)(p.ws + WS_U);
    const bf16_t* bx = U + 3 * SLOT; bf16_t* bg = U + 1 * SLOT; bf16_t* pp = (bf16_t*)p.out;
    float* summ = (float*)(p.ws + WS_SUMM);
    const int c = h * 64 + lane, fr = lane & 15, fq = lane >> 4;
    const size_t row0 = (size_t)b * TP + (size_t)j * CHUNK;
    const bf16_t* bx0 = bx + row0 * D; bf16_t* bg0 = bg + row0 * D; bf16_t* pp0 = pp + row0 * D;
    const LAS unsigned char* wq = wlds + fr * 144 + fq * 16;
    float brv[4], biv[4], lcv[4];
#pragma unroll
    for (int nt = 0; nt < 4; ++nt) { const int ch = h * 64 + nt * 16 + fr; brv[nt] = p.in[19][ch]; biv[nt] = p.in[21][ch]; lcv[nt] = ((const float*)(p.ws + WS_LC))[ch]; }
    const float w0 = p.in[16][c], w1 = p.in[16][D + c], w2 = p.in[16][2 * D + c], w3 = p.in[16][3 * D + c], cbias = p.in[17][c];
    float xm3 = 0.f, xm2 = 0.f, xm1 = 0.f;
    if (j > 0) { xm3 = bf2f(bx0[-3 * D + c]); xm2 = bf2f(bx0[-2 * D + c]); xm1 = bf2f(bx0[-1 * D + c]); }
    float hh = 0.f, ap = 1.f;
    LAS unsigned short* cbT = (LAS unsigned short*)wl;
    LAS float* xu = (LAS float*)(wl + 2304);
    LAS float* aS = (LAS float*)(wl + 2304 + 4352);
    bf16_t xr[16], gr[16], xn[16], gn[16];
#pragma unroll
    for (int tt = 0; tt < 16; ++tt) { xr[tt] = bx0[tt * D + c]; gr[tt] = bg0[tt * D + c]; }
#pragma unroll
    for (int g = 0; g < 3; ++g) {
        const int r0 = g * 16;
        if (g < 2) {
#pragma unroll
            for (int tt = 0; tt < 16; ++tt) { xn[tt] = bx0[(r0 + 16 + tt) * D + c]; gn[tt] = bg0[(r0 + 16 + tt) * D + c]; }
        }
#pragma unroll
        for (int tt = 0; tt < 16; ++tt) { const float x = bf2f(xr[tt]); const float cb = w0 * xm3 + w1 * xm2 + w2 * xm1 + w3 * x + cbias; xm3 = xm2; xm2 = xm1; xm1 = x;
            cbT[tt * 72 + lane] = f2bf(cb); xu[tt * 68 + lane] = cb; }
        __builtin_amdgcn_wave_barrier();
        const bf16x8 a0 = *(const LAS bf16x8*)(cbT + fr * 72 + fq * 8), a1 = *(const LAS bf16x8*)(cbT + fr * 72 + 32 + fq * 8);
        f32x4 accR[4], accI[4];
#pragma unroll
        for (int nt = 0; nt < 4; ++nt) {
            const bf16x8 r0w = *(const LAS bf16x8*)(wq + nt * 2304), r1w = *(const LAS bf16x8*)(wq + nt * 2304 + 64);
            const bf16x8 i0w = *(const LAS bf16x8*)(wq + 9216 + nt * 2304), i1w = *(const LAS bf16x8*)(wq + 9216 + nt * 2304 + 64);
            accR[nt] = __builtin_amdgcn_mfma_f32_16x16x32_bf16(a0, r0w, (f32x4){0.f, 0.f, 0.f, 0.f}, 0, 0, 0);
            accR[nt] = __builtin_amdgcn_mfma_f32_16x16x32_bf16(a1, r1w, accR[nt], 0, 0, 0);
            accI[nt] = __builtin_amdgcn_mfma_f32_16x16x32_bf16(a0, i0w, (f32x4){0.f, 0.f, 0.f, 0.f}, 0, 0, 0);
            accI[nt] = __builtin_amdgcn_mfma_f32_16x16x32_bf16(a1, i1w, accI[nt], 0, 0, 0);
        }
#pragma unroll
        for (int nt = 0; nt < 4; ++nt)
#pragma unroll
            for (int ip = 0; ip < 2; ++ip) {
                const int idx0 = (fq * 4 + 2 * ip) * 68 + nt * 16 + fr, idx1 = idx0 + 68;
                const f32x2 tr = ((f32x2){accR[nt][2 * ip], accR[nt][2 * ip + 1]} + brv[nt]) * (-1.44269504089f), ti = ((f32x2){accI[nt][2 * ip], accI[nt][2 * ip + 1]} + biv[nt]) * (-1.44269504089f);
                f32x2 er, ei; er.x = __builtin_amdgcn_exp2f(tr.x); er.y = __builtin_amdgcn_exp2f(tr.y); ei.x = __builtin_amdgcn_exp2f(ti.x); ei.y = __builtin_amdgcn_exp2f(ti.y);
                const f32x2 dr = er + 1.0f, di = ei + 1.0f;
                f32x2 r, ig; r.x = __builtin_amdgcn_rcpf(dr.x); r.y = __builtin_amdgcn_rcpf(dr.y); ig.x = __builtin_amdgcn_rcpf(di.x); ig.y = __builtin_amdgcn_rcpf(di.y);
                const f32x2 la = r * lcv[nt]; const f32x2 tl = la * 1.44269504089f;
                f32x2 a; a.x = __builtin_amdgcn_exp2f(tl.x); a.y = __builtin_amdgcn_exp2f(tl.y);
                const f32x2 z2 = la + la;
                const f32x2 m2s = -z2 * (z2 * (z2 * (z2 * (z2 * (z2 * 0.0013888889f + 0.0083333338f) + 0.041666668f) + 0.16666667f) + 0.5f) + 1.0f);
                const f32x2 m2b = 1.0f - a * a;
                f32x2 sq; sq.x = __builtin_amdgcn_sqrtf(z2.x > -0.25f ? m2s.x : m2b.x); sq.y = __builtin_amdgcn_sqrtf(z2.y > -0.25f ? m2s.y : m2b.y);
                const f32x2 uo = sq * ig * (f32x2){xu[idx0], xu[idx1]};
                xu[idx0] = uo.x; xu[idx1] = uo.y; aS[idx0] = a.x; aS[idx1] = a.y; }
        __builtin_amdgcn_wave_barrier();
        f32x2 glv[8];
#pragma unroll
        for (int tp = 0; tp < 8; ++tp) { const f32x2 x = {bf2f(gr[2 * tp]), bf2f(gr[2 * tp + 1])};
            const f32x2 t = x * (x * x * (-0.10294324f) + (-2.30220819f));
            f32x2 e; e.x = __builtin_amdgcn_exp2f(t.x); e.y = __builtin_amdgcn_exp2f(t.y);
            const f32x2 d = e + 1.0f;
            f32x2 rr; rr.x = __builtin_amdgcn_rcpf(d.x); rr.y = __builtin_amdgcn_rcpf(d.y);
            glv[tp] = x * rr; }
#pragma unroll
        for (int tt = 0; tt < 16; ++tt) { const float a = aS[tt * 68 + lane], uu = xu[tt * 68 + lane]; hh = a * hh + uu; ap *= a;
            const f32x2 o = (f32x2){hh, ap} * ((tt & 1) ? glv[tt >> 1].y : glv[tt >> 1].x);
            const unsigned w = cvt_pk_bf16(o.x, o.y);
            if (!dry) bg0[(r0 + tt) * D + c] = (bf16_t)(w & 0xffffu);
            pp0[(r0 + tt) * D + c] = (bf16_t)(w >> 16); }
        __builtin_amdgcn_wave_barrier();
        if (g < 2) {
#pragma unroll
            for (int tt = 0; tt < 16; ++tt) { xr[tt] = xn[tt]; gr[tt] = gn[tt]; }
        }
    }
    *(float2*)(summ + (((size_t)b * NCH + j) * D + c) * 2) = make_float2(ap, hh);
    if (j == NCH - 1) { p.out[O_CBP + ((size_t)b * 3 + 0) * D + c] = xm3; p.out[O_CBP + ((size_t)b * 3 + 1) * D + c] = xm2; p.out[O_CBP + ((size_t)b * 3 + 2) * D + c] = xm1; }
}
__device__ __forceinline__ void sample_item(const Params& p, int k, int h, LAS unsigned char* wl, const LAS unsigned char* wlds, int lane) {
    bf16_t* U = (bf16_t*)(p.ws + WS_U);
    const int c = h * 64 + lane, fr = lane & 15, fq = lane >> 4;
    const size_t row0 = (size_t)MP + (size_t)k * 16; const int s0 = k * 16;
    const bf16_t* bx0 = U + 3 * SLOT + row0 * D; bf16_t* bg0 = U + 1 * SLOT + row0 * D;
    const LAS unsigned char* wq = wlds + fr * 144 + fq * 16;
    float brv[4], biv[4], lcv[4];
#pragma unroll
    for (int nt = 0; nt < 4; ++nt) { const int ch = h * 64 + nt * 16 + fr; brv[nt] = p.in[19][ch]; biv[nt] = p.in[21][ch]; lcv[nt] = ((const float*)(p.ws + WS_LC))[ch]; }
    const float w3 = p.in[16][3 * D + c];
    LAS unsigned short* cbT = (LAS unsigned short*)wl;
    LAS float* xu = (LAS float*)(wl + 2304);
    LAS float* aS = (LAS float*)(wl + 2304 + 4352);
    const float* pcb = (const float*)(p.ws + WS_PCB) + (size_t)s0 * D + c;
    {
        bf16_t xr[16]; float pc[16];
#pragma unroll
        for (int tt = 0; tt < 16; ++tt) { xr[tt] = bx0[tt * D + c]; pc[tt] = pcb[tt * D]; }
#pragma unroll
        for (int tt = 0; tt < 16; ++tt) { const float x = bf2f(xr[tt]); const float cb = pc[tt] + w3 * x;
            p.out[O_CBS + ((size_t)(s0 + tt) * 3 + 2) * D + c] = x;
            cbT[tt * 72 + lane] = f2bf(cb); xu[tt * 68 + lane] = cb; }
    }
    __builtin_amdgcn_wave_barrier();
    const bf16x8 a0 = *(const LAS bf16x8*)(cbT + fr * 72 + fq * 8), a1 = *(const LAS bf16x8*)(cbT + fr * 72 + 32 + fq * 8);
    f32x4 accR[4], accI[4];
#pragma unroll
    for (int nt = 0; nt < 4; ++nt) {
        const bf16x8 r0w = *(const LAS bf16x8*)(wq + nt * 2304), r1w = *(const LAS bf16x8*)(wq + nt * 2304 + 64);
        const bf16x8 i0w = *(const LAS bf16x8*)(wq + 9216 + nt * 2304), i1w = *(const LAS bf16x8*)(wq + 9216 + nt * 2304 + 64);
        accR[nt] = __builtin_amdgcn_mfma_f32_16x16x32_bf16(a0, r0w, (f32x4){0.f, 0.f, 0.f, 0.f}, 0, 0, 0);
        accR[nt] = __builtin_amdgcn_mfma_f32_16x16x32_bf16(a1, r1w, accR[nt], 0, 0, 0);
        accI[nt] = __builtin_amdgcn_mfma_f32_16x16x32_bf16(a0, i0w, (f32x4){0.f, 0.f, 0.f, 0.f}, 0, 0, 0);
        accI[nt] = __builtin_amdgcn_mfma_f32_16x16x32_bf16(a1, i1w, accI[nt], 0, 0, 0);
    }
#pragma unroll
    for (int nt = 0; nt < 4; ++nt)
#pragma unroll
        for (int ip = 0; ip < 2; ++ip) {
                const int idx0 = (fq * 4 + 2 * ip) * 68 + nt * 16 + fr, idx1 = idx0 + 68;
                const f32x2 tr = ((f32x2){accR[nt][2 * ip], accR[nt][2 * ip + 1]} + brv[nt]) * (-1.44269504089f), ti = ((f32x2){accI[nt][2 * ip], accI[nt][2 * ip + 1]} + biv[nt]) * (-1.44269504089f);
                f32x2 er, ei; er.x = __builtin_amdgcn_exp2f(tr.x); er.y = __builtin_amdgcn_exp2f(tr.y); ei.x = __builtin_amdgcn_exp2f(ti.x); ei.y = __builtin_amdgcn_exp2f(ti.y);
                const f32x2 dr = er + 1.0f, di = ei + 1.0f;
                f32x2 r, ig; r.x = __builtin_amdgcn_rcpf(dr.x); r.y = __builtin_amdgcn_rcpf(dr.y); ig.x = __builtin_amdgcn_rcpf(di.x); ig.y = __builtin_amdgcn_rcpf(di.y);
                const f32x2 la = r * lcv[nt]; const f32x2 tl = la * 1.44269504089f;
                f32x2 a; a.x = __builtin_amdgcn_exp2f(tl.x); a.y = __builtin_amdgcn_exp2f(tl.y);
                const f32x2 z2 = la + la;
                const f32x2 m2s = -z2 * (z2 * (z2 * (z2 * (z2 * (z2 * 0.0013888889f + 0.0083333338f) + 0.041666668f) + 0.16666667f) + 0.5f) + 1.0f);
                const f32x2 m2b = 1.0f - a * a;
                f32x2 sq; sq.x = __builtin_amdgcn_sqrtf(z2.x > -0.25f ? m2s.x : m2b.x); sq.y = __builtin_amdgcn_sqrtf(z2.y > -0.25f ? m2s.y : m2b.y);
                const f32x2 uo = sq * ig * (f32x2){xu[idx0], xu[idx1]};
                xu[idx0] = uo.x; xu[idx1] = uo.y; aS[idx0] = a.x; aS[idx1] = a.y; }
    __builtin_amdgcn_wave_barrier();
    {
        float h0[16]; bf16_t gq[16];
#pragma unroll
        for (int tt = 0; tt < 16; ++tt) { h0[tt] = p.in[4][(size_t)(s0 + tt) * D + c]; gq[tt] = bg0[tt * D + c]; }
#pragma unroll
        for (int tt = 0; tt < 16; ++tt) {
            const float hn = aS[tt * 68 + lane] * h0[tt] + xu[tt * 68 + lane];
            p.out[O_RGS + (size_t)(s0 + tt) * D + c] = hn;
            bg0[tt * D + c] = f2bf(gelu_tanh(bf2f(gq[tt])) * hn);
        }
    }
    __builtin_amdgcn_wave_barrier();
}
__device__ __forceinline__ void scan_phase(const Params& p, LAS unsigned char* lds, int tid, bool dry) {
    const int wid = __builtin_amdgcn_readfirstlane(tid >> 6), lane = tid & 63;
    LAS unsigned char* wl = lds + wid * WL_BYTES;
    LAS unsigned char* wlds = lds + 8 * WL_BYTES;
    const int h = blockIdx.x & 15;
    {
        const bf16_t* wt = (const bf16_t*)(p.ws + WS_WRG);
#pragma unroll
        for (int q = 0; q < 2; ++q) { const int e = tid + q * 512, g = e >> 9, jrow = (e >> 3) & 63, pc = e & 7;
            *(LAS u32x4*)(wlds + g * 9216 + jrow * 144 + pc * 16) = *(const u32x4*)(wt + (size_t)g * 65536 + (size_t)(h * 64 + jrow) * 64 + pc * 8); }
    }
    __syncthreads();
    const int nbh = gridDim.x >> 4;
    for (int it = (blockIdx.x >> 4) * 8 + wid; it < NB * NCH; it += nbh * 8) scan_item(p, it / NCH, it % NCH, h, wl, wlds, lane, dry);
    if (!dry && wid < 2 && (int)(blockIdx.x >> 4) >= nbh - 4) {
        const int k = ((int)(blockIdx.x >> 4) - (nbh - 4)) * 2 + wid;
        if (k < NS / 16) sample_item(p, k, h, wl, wlds, lane);
    }
    __syncthreads();
}
__device__ __forceinline__ void fix_phase(const Params& p, LAS unsigned char* lds, int tid, bool dry) {
    bf16_t* zb = (bf16_t*)(p.ws + WS_U) + 1 * SLOT; const bf16_t* pp = (const bf16_t*)p.out;
    const float* summ = (const float*)(p.ws + WS_SUMM);
    LAS float* cs = (LAS float*)lds;
    for (int it = blockIdx.x; it < NB * (NCH - 1); it += gridDim.x) {
        const int b = it / (NCH - 1), j = it % (NCH - 1) + 1;
#pragma unroll
        for (int cq = 0; cq < 2; ++cq) {
            const int c = tid + cq * 512; const float* sp = summ + ((size_t)b * NCH * D + c) * 2; float hh = 0.f;
            for (int i0 = 0; i0 < j; i0 += 16) {
                float va[16], vh[16];
#pragma unroll
                for (int k = 0; k < 16; ++k) { if (i0 + k < j) { const float2 v = *(const float2*)(sp + (size_t)(i0 + k) * D * 2); va[k] = v.x; vh[k] = v.y; } else { va[k] = 1.f; vh[k] = 0.f; } }
#pragma unroll
                for (int k = 0; k < 16; ++k) hh = va[k] * hh + vh[k];
            }
            cs[c] = hh;
            if (j == NCH - 1) { const float2 v = *(const float2*)(sp + (size_t)j * D * 2); p.out[O_RGP + (size_t)b * D + c] = v.x * hh + v.y; }
        }
        __syncthreads();
        const size_t row0 = (size_t)b * TP + (size_t)j * CHUNK;
        for (int q0 = 0; q0 < CHUNK * 128 / 512; q0 += 4) {
            u32x4 zq[4], pq[4];
#pragma unroll
            for (int k = 0; k < 4; ++k) { const int e = tid + (q0 + k) * 512, tt = e >> 7, vc = e & 127; const size_t o = (row0 + tt) * D + vc * 8; zq[k] = *(const u32x4*)(zb + o); pq[k] = *(const u32x4*)(pp + o); }
#pragma unroll
            for (int k = 0; k < 4; ++k) { const int e = tid + (q0 + k) * 512, tt = e >> 7, vc = e & 127; const size_t o = (row0 + tt) * D + vc * 8;
                const f32x4 c0 = *(const LAS f32x4*)(cs + vc * 8), c1 = *(const LAS f32x4*)(cs + vc * 8 + 4);
                u32x4 w;
                w.x = cvt_pk_bf16(bflo(zq[k].x) + bflo(pq[k].x) * c0[0], bfhi(zq[k].x) + bfhi(pq[k].x) * c0[1]); w.y = cvt_pk_bf16(bflo(zq[k].y) + bflo(pq[k].y) * c0[2], bfhi(zq[k].y) + bfhi(pq[k].y) * c0[3]);
                w.z = cvt_pk_bf16(bflo(zq[k].z) + bflo(pq[k].z) * c1[0], bfhi(zq[k].z) + bfhi(pq[k].z) * c1[1]); w.w = cvt_pk_bf16(bflo(zq[k].w) + bflo(pq[k].w) * c1[2], bfhi(zq[k].w) + bfhi(pq[k].w) * c1[3]);
                if (!dry) *(u32x4*)(zb + o) = w; }
        }
        __syncthreads();
    }
}
__device__ __forceinline__ void za_phase(const Params& p, int tid, bool dry) {
    bf16_t* U = (bf16_t*)(p.ws + WS_U); bf16_t* ab = U; const bf16_t* ca = U + 2 * SLOT;
    const float* cw = p.in[14];
    for (int idx = blockIdx.x * 512 + tid; idx < NB * 129 * 128; idx += gridDim.x * 512) {
        const int vc = idx & 127, tb = (idx >> 7) % 129, b = idx / (128 * 129); const int c0 = vc * 8;
        float w[3][8];
#pragma unroll
        for (int k = 0; k < 3; ++k) { const f32x4 a = *(const f32x4*)(cw + k * D + c0), bq = *(const f32x4*)(cw + k * D + c0 + 4);
#pragma unroll
            for (int e = 0; e < 4; ++e) { w[k][e] = a[e]; w[k][4 + e] = bq[e]; } }
        const size_t r0 = (size_t)b * TP + (size_t)tb * 16;
        float p2[8], p1[8];
        if (tb > 0) { const u32x4 q2 = *(const u32x4*)(ca + (r0 - 2) * D + c0), q1 = *(const u32x4*)(ca + (r0 - 1) * D + c0);
#pragma unroll
            for (int e = 0; e < 4; ++e) { p2[2 * e] = bflo(q2[e]); p2[2 * e + 1] = bfhi(q2[e]); p1[2 * e] = bflo(q1[e]); p1[2 * e + 1] = bfhi(q1[e]); } }
        else {
#pragma unroll
            for (int e = 0; e < 8; ++e) { p2[e] = 0.f; p1[e] = 0.f; } }
        for (int t4 = 0; t4 < 16; t4 += 4) {
            u32x4 qcs[4], qas[4];
#pragma unroll
            for (int k = 0; k < 4; ++k) { qcs[k] = *(const u32x4*)(ca + (r0 + t4 + k) * D + c0); qas[k] = *(const u32x4*)(ab + (r0 + t4 + k) * D + c0); }
#pragma unroll
            for (int k = 0; k < 4; ++k) {
                const u32x4 qc = qcs[k], qa = qas[k];
                float cv[8], av[8], zv[8];
#pragma unroll
                for (int e = 0; e < 4; ++e) { cv[2 * e] = bflo(qc[e]); cv[2 * e + 1] = bfhi(qc[e]); av[2 * e] = bflo(qa[e]); av[2 * e + 1] = bfhi(qa[e]); }
#pragma unroll
                for (int e = 0; e < 8; ++e) { zv[e] = av[e] * (w[0][e] * p2[e] + w[1][e] * p1[e] + w[2][e] * cv[e]); p2[e] = p1[e]; p1[e] = cv[e]; }
                u32x4 o; o.x = cvt_pk_bf16(zv[0], zv[1]); o.y = cvt_pk_bf16(zv[2], zv[3]); o.z = cvt_pk_bf16(zv[4], zv[5]); o.w = cvt_pk_bf16(zv[6], zv[7]);
                if (!dry) *(u32x4*)(ab + (r0 + t4 + k) * D + c0) = o;
            }
        }
        if (tb == 128) {
            float* o2 = p.out + O_CAP + ((size_t)b * 2 + 0) * D + c0; float* o1 = p.out + O_CAP + ((size_t)b * 2 + 1) * D + c0;
            *(f32x4*)o2 = (f32x4){p2[0], p2[1], p2[2], p2[3]}; *(f32x4*)(o2 + 4) = (f32x4){p2[4], p2[5], p2[6], p2[7]};
            *(f32x4*)o1 = (f32x4){p1[0], p1[1], p1[2], p1[3]}; *(f32x4*)(o1 + 4) = (f32x4){p1[4], p1[5], p1[6], p1[7]};
        }
    }
    if (!dry) {
        for (int idx = blockIdx.x * 512 + tid; idx < NS * 128; idx += gridDim.x * 512) {
            const int vc = idx & 127, sm = idx >> 7, c0 = vc * 8; const size_t ro = (size_t)(MP + sm) * D + c0;
            const u32x4 qc = *(const u32x4*)(ca + ro), qa = *(const u32x4*)(ab + ro);
            const float* pca = (const float*)(p.ws + WS_PCA) + (size_t)sm * D + c0;
            float hp[8], cv[8], zv[8];
            { const f32x4 a0 = *(const f32x4*)pca, a1 = *(const f32x4*)(pca + 4);
#pragma unroll
              for (int e = 0; e < 4; ++e) { hp[e] = a0[e]; hp[4 + e] = a1[e]; } }
#pragma unroll
            for (int e = 0; e < 4; ++e) { cv[2 * e] = bflo(qc[e]); cv[2 * e + 1] = bfhi(qc[e]); }
#pragma unroll
            for (int e = 0; e < 8; ++e) { const float av = (e & 1) ? bfhi(qa[e >> 1]) : bflo(qa[e >> 1]); zv[e] = av * (hp[e] + cw[2 * D + c0 + e] * cv[e]); }
            u32x4 o; o.x = cvt_pk_bf16(zv[0], zv[1]); o.y = cvt_pk_bf16(zv[2], zv[3]); o.z = cvt_pk_bf16(zv[4], zv[5]); o.w = cvt_pk_bf16(zv[6], zv[7]);
            *(u32x4*)(ab + ro) = o;
            float* o1 = p.out + O_CAS + ((size_t)sm * 2 + 1) * D + c0;
            *(f32x4*)o1 = (f32x4){cv[0], cv[1], cv[2], cv[3]}; *(f32x4*)(o1 + 4) = (f32x4){cv[4], cv[5], cv[6], cv[7]};
        }
    }
}

__device__ __forceinline__ u32x4 merge_math(const u32x4& ga, const u32x4& gb, const float (&ya)[8], const float (&yb)[8]) {
    u32x4 o4;
#pragma unroll
    for (int e = 0; e < 4; ++e) { const float lo = sigm(bflo(ga[e])) * ya[2 * e] + sigm(bflo(gb[e])) * yb[2 * e], hi = sigm(bfhi(ga[e])) * ya[2 * e + 1] + sigm(bfhi(gb[e])) * yb[2 * e + 1]; o4[e] = cvt_pk_bf16(lo, hi); }
    return o4;
}
__device__ __forceinline__ void merge_phase(const Params& p, int tid) {
    const bf16_t* U = (const bf16_t*)(p.ws + WS_U); bf16_t* H = (bf16_t*)p.out; const bf16_t* PO = (const bf16_t*)(p.ws + WS_POAB);
    const size_t G = (size_t)gridDim.x * 512, NMAIN = (size_t)MAINR * 128;
    for (size_t i0 = (size_t)blockIdx.x * 512 + tid; i0 < NMAIN; i0 += 4 * G) {
        u32x4 ga[4], gb[4], a[4], b[4];
#pragma unroll
        for (int k = 0; k < 4; ++k) { const size_t i = i0 + k * G; if (i < NMAIN) { ga[k] = *(const u32x4*)(U + 4 * SLOT + i * 8); gb[k] = *(const u32x4*)(U + 5 * SLOT + i * 8); a[k] = *(const u32x4*)(U + 2 * SLOT + i * 8); b[k] = *(const u32x4*)(U + 3 * SLOT + i * 8); } }
#pragma unroll
        for (int k = 0; k < 4; ++k) { const size_t i = i0 + k * G; if (i < NMAIN) {
            float ya[8], yb[8];
#pragma unroll
            for (int e = 0; e < 4; ++e) { ya[2 * e] = bflo(a[k][e]); ya[2 * e + 1] = bfhi(a[k][e]); yb[2 * e] = bflo(b[k][e]); yb[2 * e + 1] = bfhi(b[k][e]); }
            *(u32x4*)(H + i * 8) = merge_math(ga[k], gb[k], ya, yb); } }
    }
    for (size_t i = NMAIN + (size_t)blockIdx.x * 512 + tid; i < SLOT / 8; i += G) {
        const u32x4 ga = *(const u32x4*)(U + 4 * SLOT + i * 8), gb = *(const u32x4*)(U + 5 * SLOT + i * 8);
        float ya[8], yb[8];
        const int row = (int)(i >> 7);
        const size_t o = (size_t)(row - MAINR) * D + (size_t)(i & 127) * 8;
#pragma unroll
        for (int e = 0; e < 8; ++e) { ya[e] = 0.f; yb[e] = 0.f; }
#pragma unroll
        for (int ks = 0; ks < 4; ++ks) {
            const u32x4 a0 = *(const u32x4*)(PO + (size_t)(ks * 2 + 0) * (256 * D) + o), b0 = *(const u32x4*)(PO + (size_t)(ks * 2 + 1) * (256 * D) + o);
#pragma unroll
            for (int e = 0; e < 4; ++e) { ya[2 * e] += bflo(a0[e]); ya[2 * e + 1] += bfhi(a0[e]); yb[2 * e] += bflo(b0[e]); yb[2 * e + 1] += bfhi(b0[e]); }
        }
        *(u32x4*)(H + i * 8) = merge_math(ga, gb, ya, yb);
    }
}

#define XB_TMO      128
#define XB_XCNT(j)  (256  + 64 * (j))
#define XB_XSUB(j)  (1280 + 64 * (j))
#define XB_XGEN(j)  (2304 + 64 * (j))
#define XB_TOP      3328
#define XB_TOPGEN   3392
#define XCD_BAR_WORDS 3456
#define XB_SPIN_CAP (1u << 18)
__device__ __forceinline__ unsigned xb_ld(unsigned* p)              { return __hip_atomic_load(p, __ATOMIC_RELAXED, __HIP_MEMORY_SCOPE_AGENT); }
__device__ __forceinline__ unsigned xb_add(unsigned* p, unsigned v) { return __hip_atomic_fetch_add(p, v, __ATOMIC_RELAXED, __HIP_MEMORY_SCOPE_AGENT); }
__device__ __forceinline__ unsigned xb_xcc_id() { return (unsigned)__builtin_amdgcn_s_getreg((3 << 11) | 20) & 0xFu; }
#define XB_SPIN(cond, bar) do { unsigned _sp = 0; while (cond) { __builtin_amdgcn_s_sleep(1); \
    if ((++_sp & 255u) == 0u) { if (xb_ld(&(bar)[XB_TMO])) break; if (_sp > XB_SPIN_CAP) { atomicAdd(&(bar)[XB_TMO], 1u); break; } } } } while (0)
struct XcdBarrier { unsigned* bar; unsigned x; volatile LAS unsigned* st; };
__device__ __forceinline__ XcdBarrier xcd_barrier_post(unsigned* bar, volatile LAS unsigned* st) {
    XcdBarrier b; b.bar = bar; b.x = xb_xcc_id(); b.st = st;
    if (threadIdx.x == 0) (void)xb_add(&bar[XB_XCNT(b.x)], 1u);
    return b;
}
__device__ __forceinline__ void xcd_barrier_complete(unsigned* bar, unsigned x, unsigned& nloc, unsigned& nx) {
    const unsigned G = gridDim.x * gridDim.y * gridDim.z;
    unsigned sum, cnt, mine, sp = 0u;
    for (;;) {
        sum = 0u; cnt = 0u; mine = 0u;
#pragma unroll
        for (unsigned j = 0; j < 16; ++j) { const unsigned c = xb_ld(&bar[XB_XCNT(j)]); sum += c; cnt += (c > 0u) ? 1u : 0u; mine = (j == x) ? c : mine; }
        if (sum == G) break;
        __builtin_amdgcn_s_sleep(1);
        if ((++sp & 255u) == 0u) { if (xb_ld(&bar[XB_TMO])) break; if (sp > XB_SPIN_CAP) { atomicAdd(&bar[XB_TMO], 1u); break; } }
    }
    nloc = mine > 0u ? mine : 1u; nx = cnt > 0u ? cnt : 1u;
}
__device__ __forceinline__ void xcd_barrier(const XcdBarrier& b) {
    asm volatile("s_waitcnt vmcnt(0)" ::: "memory");
    __syncthreads();
    if (threadIdx.x == 0) {
        unsigned* bar = b.bar;
        __builtin_amdgcn_s_waitcnt(0);
        unsigned nloc = b.st[0], nx = b.st[1];
        if (nloc == 0u) { xcd_barrier_complete(bar, b.x, nloc, nx); b.st[0] = nloc; b.st[1] = nx; }
        const unsigned old = xb_add(&bar[XB_XSUB(b.x)], 1u);
        const unsigned gen = old / nloc;
        if (old + 1u == (gen + 1u) * nloc) {
            __builtin_amdgcn_fence(__ATOMIC_RELEASE, "agent");
            asm volatile("s_waitcnt vmcnt(0)" ::: "memory");
            const unsigned og = xb_add(&bar[XB_TOP], 1u);
            const unsigned tg = og / nx;
            if (og + 1u == (tg + 1u) * nx) xb_add(&bar[XB_TOPGEN], 1u);
            else XB_SPIN(xb_ld(&bar[XB_TOPGEN]) == tg, bar);
            __builtin_amdgcn_fence(__ATOMIC_ACQUIRE, "agent");
            xb_add(&bar[XB_XGEN(b.x)], 1u);
            asm volatile("s_waitcnt vmcnt(0)" ::: "memory");
        } else {
            XB_SPIN(xb_ld(&bar[XB_XGEN(b.x)]) == gen, bar);
            __builtin_amdgcn_fence(__ATOMIC_ACQUIRE, "agent");
            asm volatile("s_waitcnt vmcnt(0)" ::: "memory");
        }
    }
    __syncthreads();
}

constexpr int NPHASE = 14;
constexpr int LDS_BYTES = 131072 + 16;
__global__ void __launch_bounds__(512, 2) mk_fwd(Params p, int ph_lo, int ph_hi) {
    extern __shared__ __attribute__((aligned(16))) unsigned char shm[];
    LAS unsigned char* lds = (LAS unsigned char*)shm;
    cg::grid_group grid = cg::this_grid();
    if (threadIdx.x == 0) { *(LAS u32x4*)(lds + 131072) = (u32x4){0u, 0u, 0u, 0u}; }
    __syncthreads();
    const XcdBarrier xb = xcd_barrier_post((unsigned*)(p.ws + WS_BAR), (volatile LAS unsigned*)(lds + 131072));
    for (int ph2 = ph_lo * 2; ph2 < ph_hi * 2; ++ph2) {
        const int ph = ph2 >> 1; const bool dry = !(ph2 & 1);
        if (dry && !((REP_MASK >> ph) & 1)) continue;
        int tid = threadIdx.x; asm volatile("" : "+v"(tid));
        if (ph == 0) {
            convert_set(p, 0, lds, tid, 0, 0, 1408);
            bf16_t* wt = (bf16_t*)(p.ws + WS_WRG);
            for (int o = blockIdx.x * 512 + tid; o < 2 * 65536; o += gridDim.x * 512) { const int g = o >> 16, h = (o >> 12) & 15, j = (o >> 6) & 63, i = o & 63;
                wt[o] = f2bf((g ? p.in[20] : p.in[18])[(size_t)(h * 64 + i) * 64 + j]); }
            if (blockIdx.x * 512 + tid < D) { const int ch = blockIdx.x * 512 + tid; ((float*)(p.ws + WS_LC))[ch] = -8.0f * log1pf(expf(-p.in[22][ch])); }
            for (int e = blockIdx.x * 512 + tid; e < NS * D; e += gridDim.x * 512) {
                const int sm = e >> 10, c = e & 1023;
                const float t0 = p.in[3][((size_t)sm * 3 + 0) * D + c], t1 = p.in[3][((size_t)sm * 3 + 1) * D + c], t2 = p.in[3][((size_t)sm * 3 + 2) * D + c];
                const float a0 = p.in[2][((size_t)sm * 2 + 0) * D + c], a1 = p.in[2][((size_t)sm * 2 + 1) * D + c];
                ((float*)(p.ws + WS_PCB))[e] = p.in[16][c] * t0 + p.in[16][D + c] * t1 + p.in[16][2 * D + c] * t2 + p.in[17][c];
                ((float*)(p.ws + WS_PCA))[e] = p.in[14][c] * a0 + p.in[14][D + c] * a1;
                p.out[O_CBS + ((size_t)sm * 3 + 0) * D + c] = t1; p.out[O_CBS + ((size_t)sm * 3 + 1) * D + c] = t2;
                p.out[O_CAS + ((size_t)sm * 2 + 0) * D + c] = a1;
            }
            norm_phase(p, 0, tid, dry, 0);
        } else if (ph == 1 || ph == 11) {
            pg8::Gemm g{(const bf16_t*)(p.ws + WS_H), (const bf16_t*)(p.ws + WS_WGU), M, 2 * DFF, D, 0, 0};
            pg8::StaticOrder S; S.init(M, 2 * DFF, D, gridDim.x, blockIdx.x);
            pg8::EpiGU E{(bf16_t*)(p.ws + WS_ACT), dry};
            pg8::gemm_phase(lds, g, S, E);
            if (!dry && ph == 1) { convert_set(p, 0, lds, tid, 150, 1408, 2112); convert_set(p, 2, lds, tid, 150, 0, 1088); }
        } else if (ph == 2 || ph == 12 || ph == 9 || ph == 7) {
            const bool dn = (ph == 2 || ph == 12), oab = (ph == 7);
            pg8::Gemm g{dn ? (const bf16_t*)(p.ws + WS_ACT) : (oab ? (const bf16_t*)(p.ws + WS_U) : (const bf16_t*)p.out), (const bf16_t*)(p.ws + (dn ? WS_WD : (oab ? WS_WOAB : WS_WO))), M, D, dn ? DFF : D, SB, (size_t)1024 * 1024 * 2};
            pg8::SplitOrder S; S.init(oab ? 2 * D : D, dn ? DFF : D, gridDim.x, blockIdx.x, dn ? 11 : 4, 4);
            pg8::EpiBF E{(bf16_t*)(p.ws + (oab ? WS_U + 2 * SB : WS_Y)), SLOT, (bf16_t*)(p.ws + (oab ? WS_POAB : WS_PY)), oab ? 2 : 1};
            pg8::gemm_phase(lds, g, S, E);
            if (!dry && ph == 2) convert_set(p, 2, lds, tid, 44, 1088, 1 << 30);
            if (!dry && ph == 9) convert_set(p, 1, lds, tid, 16, 0, 1 << 30);
        } else if (ph == 3) {
            norm_phase(p, 1, tid, dry, 11);
        } else if (ph == 4) {
            pg8::Gemm g{(const bf16_t*)(p.ws + WS_H), (const bf16_t*)(p.ws + WS_WIN), M, DIN, D, 0, 0};
            pg8::StaticOrder S; S.init(M, DIN, D, gridDim.x, blockIdx.x);
            pg8::EpiIN E{(bf16_t*)(p.ws + WS_U)};
            pg8::gemm_phase(lds, g, S, E);
        } else if (ph == 5) {
            scan_phase(p, lds, tid, dry);
        } else if (ph == 6) {
            fix_phase(p, lds, tid, dry);
            za_phase(p, tid, dry);
        } else if (ph == 8) {
            merge_phase(p, tid);
        } else if (ph == 10) {
            norm_phase(p, 2, tid, dry, 4);
        } else if (ph == 13) {
            norm_phase(p, 3, tid, dry, 11);
        }
        if (ph2 + 1 < ph_hi * 2) { if (ph_hi > NPHASE) grid.sync(); else xcd_barrier(xb); }
    }
}

extern "C" void kernel_launch(void* const* d_in, const int* in_sizes, int n_in, void* d_out, int out_size, void* d_ws, size_t ws_size, hipStream_t stream) {
    if (n_in != 30 || ws_size < WS_END) { fprintf(stderr, "kernel_launch: unexpected n_in %d / ws_size %zu (need %zu)\n", n_in, ws_size, (size_t)WS_END); return; }
    Params p{};
    for (int i = 0; i < 30; ++i) p.in[i] = (const float*)d_in[i];
    p.out = (float*)d_out; p.ws = (unsigned char*)d_ws;
    (void)hipFuncSetAttribute((const void*)mk_fwd, hipFuncAttributeMaxDynamicSharedMemorySize, LDS_BYTES);
    static int grid_blocks = 0;
    if (!grid_blocks) {
        int dev = 0, cus = 0, per_cu = 0;
        (void)hipGetDevice(&dev);
        (void)hipDeviceGetAttribute(&cus, hipDeviceAttributeMultiprocessorCount, dev);
        (void)hipOccupancyMaxActiveBlocksPerMultiprocessor(&per_cu, (const void*)mk_fwd, 512, LDS_BYTES);
        if (per_cu < 1) { fprintf(stderr, "kernel_launch: occupancy query says %d blocks/CU\n", per_cu); per_cu = 1; }
        grid_blocks = cus;
    }
    (void)hipMemsetAsync((unsigned char*)d_ws + WS_BAR, 0, 16384, stream);
#if SINGLE_LAUNCH
    int lo = 0, hi = NPHASE;
    void* args[] = {&p, &lo, &hi};
    hipError_t e = hipLaunchCooperativeKernel((const void*)mk_fwd, dim3(grid_blocks), dim3(512), args, LDS_BYTES, stream);
    if (e != hipSuccess) fprintf(stderr, "cooperative launch failed: %s (grid %d)\n", hipGetErrorString(e), grid_blocks);
#else
    for (int ph = 0; ph < NPHASE; ++ph) hipLaunchKernelGGL(mk_fwd, dim3(grid_blocks), dim3(512), LDS_BYTES, stream, p, ph, ph + 1);
#endif
}
```

```cpp
#include <hip/hip_runtime.h>
#include <hip/hip_cooperative_groups.h>
#include <cstdio>
namespace cg = cooperative_groups;

#ifndef REP_MASK
#define REP_MASK 0
#endif
#ifndef SINGLE_LAUNCH
#define SINGLE_LAUNCH 1
#endif

#define LAS __attribute__((address_space(3)))
typedef unsigned short bf16_t;
typedef short bf16x8 __attribute__((ext_vector_type(8)));
typedef float f32x4 __attribute__((ext_vector_type(4)));
typedef unsigned u32x4 __attribute__((ext_vector_type(4)));
typedef unsigned u32x2 __attribute__((ext_vector_type(2)));
typedef float f32x2 __attribute__((ext_vector_type(2)));

constexpr int D = 1024, DFF = 2816, DIN = 7168;
constexpr int NB = 8, SEQ = 2048, NMETA = 16, TP = SEQ + NMETA;
constexpr int MP = NB * TP;
constexpr int NS = 128;
constexpr int M = MP + NS;
constexpr int CHUNK = 48, NCH = TP / CHUNK;
constexpr float EPS = 1e-6f;

constexpr size_t O_YP = 0, O_YS = 16777216, O_CAP = O_YS + 131072, O_CBP = O_CAP + 16384, O_RGP = O_CBP + 24576,
                 O_CAS = O_RGP + 8192, O_CBS = O_CAS + 262144, O_RGS = O_CBS + 393216;

constexpr size_t SLOT = (size_t)M * D;
constexpr size_t SB = SLOT * 2;
constexpr size_t WS_U = 0;
constexpr size_t WS_ACT = 0;
constexpr size_t WS_Y = 3 * SB;
constexpr size_t WS_PY = 4 * SB;
constexpr int MAINR = 64 * 256;
constexpr size_t WS_WGU = 5 * SB;
constexpr size_t WS_WD = WS_WGU + (size_t)5632 * 1024 * 2;
constexpr size_t WS_H = 6 * SB;
constexpr size_t WS_WIN = 7 * SB;
constexpr size_t WS_POAB = WS_WIN;
constexpr size_t WS_WOAB = WS_WIN + (size_t)7168 * 1024 * 2;
constexpr size_t WS_WO = WS_WOAB + (size_t)2 * 1024 * 1024 * 2;
constexpr size_t WS_WRG = WS_WO + (size_t)1024 * 1024 * 2;
constexpr size_t WS_SUMM = WS_WRG + (size_t)2 * 16 * 64 * 64 * 2;
constexpr size_t WS_SC = WS_SUMM + (size_t)NB * NCH * D * 2 * 4;
constexpr size_t WS_LC = WS_SC + 98304;
constexpr size_t WS_BAR = WS_SC + 131072;
constexpr size_t WS_PCB = WS_BAR + 16384;
constexpr size_t WS_PCA = WS_PCB + (size_t)NS * D * 4;
constexpr size_t WS_END = WS_PCA + (size_t)NS * D * 4;
static_assert(WS_END <= (size_t)256 * 1024 * 1024, "workspace");

struct Params { const float* in[30]; float* out; unsigned char* ws; };

__device__ __forceinline__ unsigned cvt_pk_bf16(float lo, float hi) { unsigned r; asm volatile("v_cvt_pk_bf16_f32 %0, %1, %2" : "=v"(r) : "v"(lo), "v"(hi)); return r; }
__device__ __forceinline__ bf16_t f2bf(float f) { return (bf16_t)(cvt_pk_bf16(f, 0.f) & 0xffffu); }
__device__ __forceinline__ float bf2f(bf16_t b) { return __uint_as_float(((unsigned)b) << 16); }
__device__ __forceinline__ float bflo(unsigned w) { return __uint_as_float(w << 16); }
__device__ __forceinline__ float bfhi(unsigned w) { return __uint_as_float(w & 0xffff0000u); }
__device__ __forceinline__ float sigm(float x) { return __builtin_amdgcn_rcpf(1.0f + __expf(-x)); }
__device__ __forceinline__ float gelu_tanh(float x) { const float t = 1.5957691216057308f * (x + 0.044715f * x * x * x); return x * sigm(t); }
__device__ __forceinline__ float wave_sum(float v, int lane) {
#pragma unroll
    for (int o = 32; o >= 1; o >>= 1) v += __int_as_float(__builtin_amdgcn_ds_bpermute((lane ^ o) << 2, __float_as_int(v)));
    return v;
}
__device__ __forceinline__ const float* x0row(const Params& p, int r) {
    if (r >= MP) return p.in[1] + (size_t)(r - MP) * D;
    const int b = r / TP, t = r - b * TP;
    if (t < NMETA) return p.in[5] + (size_t)t * D;
    return p.in[0] + ((size_t)b * SEQ + (t - NMETA)) * D;
}

namespace pg8 {
constexpr int BM = 256, BK = 64, HALF = 128, HTB = HALF * BK * 2, STAGE_BYTES = 8 * HTB, NXCD = 8, WGM = 8;
__host__ __device__ __forceinline__ int lds_byte(int r, int c) { const int st = (r >> 4) * 2 + (c >> 5), rr = r & 15, cc = c & 31, ob = rr * 64 + cc * 2; return st * 1024 + (ob ^ (((ob >> 9) & 1) << 5)); }
__host__ __device__ __forceinline__ void stage_rc(int b, int& R, int& C) { const int st = b / 1024, sb = b % 1024, swz = sb ^ (((sb >> 9) & 1) << 5); R = (st >> 1) * 16 + swz / 64; C = (st & 1) * 32 + (swz % 64) / 2; }
__host__ __device__ __forceinline__ int perm32(int rho) { const int n = rho >> 4, i = rho & 15; return 8 * (i >> 2) + 4 * n + (i & 3); }

struct Unit { int pm, pn, z, k0, nk, part; };
struct Gemm { const bf16_t* A; const bf16_t* Bt; int M, N, K; size_t zA, zB; };

struct StaticOrder {
    int nM, nN, nwg, G, c, ntf;
    __device__ void init(int M_, int N_, int K_, int G_, int c_) { nM = M_ / BM; nN = N_ / BM; nwg = nM * nN; G = G_; c = c_; ntf = K_ / BK; }
    __device__ bool map(long L, Unit& u) const {
        if (L >= nwg) return false;
        int wgid = (int)L; { const int q = nwg / NXCD, r = nwg % NXCD, xcd = wgid % NXCD, off = wgid / NXCD; wgid = (xcd < r ? xcd * (q + 1) : r * (q + 1) + (xcd - r) * q) + off; }
        const int nig = WGM * nN, gid = wgid / nig, fm = gid * WGM, gsz = (nM - fm) < WGM ? (nM - fm) : WGM;
        u.pm = fm + ((wgid % nig) % gsz); u.pn = (wgid % nig) / gsz; u.z = 0; u.k0 = 0; u.nk = ntf; u.part = -1; return true;
    }
    __device__ bool next(int i, Unit& u) const { return map((long)i * G + c, u); }
};
struct SplitOrder : StaticOrder {
    int nsplit, nkm;
    __device__ void init(int N_, int K_, int G_, int c_, int nsplit_, int nkm_) { StaticOrder::init(64 * BM, N_, K_, G_, c_); nsplit = nsplit_; nkm = nkm_; }
    __device__ bool next(int i, Unit& u) const {
        const long L = (long)i * G + c; bool ok;
        if (L < nwg) ok = map(L, u);
        else { const int L2 = (int)(L - nwg); ok = L2 < nN * nsplit; const int ks = L2 / nN; u.pm = 64; u.pn = L2 - ks * nN; u.k0 = ks * nkm; u.nk = nkm; u.part = ks; }
        u.z = u.pn >> 2; u.pn &= 3; return ok;
    }
};

template <class Epi, class Sched>
__device__ __forceinline__ void gemm_phase(LAS unsigned char* lds, const Gemm g, const Sched& S, const Epi& E) {
    int tid_ = threadIdx.x; asm volatile("" : "+v"(tid_));
    const int tid = tid_, wid = __builtin_amdgcn_readfirstlane(tid >> 6), lane = tid & 63, wr = wid >> 2, wc = wid & 3, fr = lane & 15, fq = lane >> 4;
    const int K = g.K;
    unsigned voffA[2], voffB[2];
#pragma unroll
    for (int i = 0; i < 2; ++i) { int R, C; stage_rc(tid * 16 + i * 8192, R, C); const int Rb = Epi::PERM ? ((R & ~31) + perm32(R & 31)) : R;
        voffA[i] = (unsigned)(R * K + C) * 2u; voffB[i] = (unsigned)(Rb * K + C) * 2u; }
    const size_t kstep = (size_t)(BK * 2);
    const size_t hstep = (size_t)HALF * K * 2;
    const size_t tstep = 2 * hstep;
    const unsigned ldsw = (unsigned)wid * 1024u;
    const int aoff = lds_byte(wr * 64 + fr, fq * 8), boff = lds_byte(wc * 32 + fr, fq * 8);
#define PG8_SA(b, h) (((b) * 2 + (h)) * HTB)
#define PG8_SB(b, h) ((4 + (b) * 2 + (h)) * HTB)
#define PG8_STAGE(bufoff, gbase, voff) do { _Pragma("unroll") for (int _i = 0; _i < 2; ++_i) \
        __builtin_amdgcn_global_load_lds((const unsigned*)((const char*)(gbase) + (voff)[_i]), (LAS unsigned*)(lds + (bufoff) + ldsw + _i * 8192), 16, 0, 0); } while (0)
#define PG8_LDA(dst, b, h) do { _Pragma("unroll") for (int m = 0; m < 4; ++m) _Pragma("unroll") for (int k = 0; k < 2; ++k) dst[m][k] = *(const LAS bf16x8*)(lds + PG8_SA(b, h) + aoff + m * 2048 + k * 1024); } while (0)
#define PG8_LDB(dst, b, h) do { _Pragma("unroll") for (int n = 0; n < 2; ++n) _Pragma("unroll") for (int k = 0; k < 2; ++k) dst[n][k] = *(const LAS bf16x8*)(lds + PG8_SB(b, h) + boff + n * 2048 + k * 1024); } while (0)
#define PG8_MMA(ai, bj, At, Bt) do { __builtin_amdgcn_s_setprio(1); _Pragma("unroll") for (int m = 0; m < 4; ++m) _Pragma("unroll") for (int n = 0; n < 2; ++n) _Pragma("unroll") for (int k = 0; k < 2; ++k) \
        acc[ai][bj][m][n] = __builtin_amdgcn_mfma_f32_16x16x32_bf16(Bt[n][k], At[m][k], acc[ai][bj][m][n], 0, 0, 0); __builtin_amdgcn_s_setprio(0); } while (0)
#define PG8_WAIT_V(n) asm volatile("s_waitcnt vmcnt(" #n ")" ::: "memory")
#define PG8_WAIT_L(n) asm volatile("s_waitcnt lgkmcnt(" #n ")" ::: "memory")
#define PG8_BAR __builtin_amdgcn_s_barrier()
#define PG8_SCHED __builtin_amdgcn_sched_barrier(0)
    Unit cur, nxt; int ui = 0;
    if (!S.next(0, cur)) return;
    f32x4 acc[2][2][4][2];
#pragma unroll
    for (int a = 0; a < 2; ++a)
#pragma unroll
        for (int b = 0; b < 2; ++b)
#pragma unroll
            for (int m = 0; m < 4; ++m)
#pragma unroll
                for (int n = 0; n < 2; ++n) acc[a][b][m][n] = (f32x4){0.f, 0.f, 0.f, 0.f};
    bf16x8 At[4][2], B0[2][2], B1[2][2];
    const char* cA = (const char*)g.A + (size_t)cur.z * g.zA + (size_t)cur.pm * tstep + (size_t)cur.k0 * kstep; const char* cB = (const char*)g.Bt + (size_t)cur.z * g.zB + (size_t)cur.pn * tstep + (size_t)cur.k0 * kstep;
    int nt = cur.nk;
    PG8_STAGE(PG8_SB(0, 0), cB, voffB); PG8_STAGE(PG8_SA(0, 0), cA, voffA); PG8_STAGE(PG8_SB(0, 1), cB + hstep, voffB); PG8_STAGE(PG8_SA(0, 1), cA + hstep, voffA);
    if (wr == 1) PG8_BAR;
    PG8_WAIT_V(4); PG8_BAR;
    PG8_STAGE(PG8_SB(1, 0), cB + kstep, voffB); PG8_STAGE(PG8_SA(1, 0), cA + kstep, voffA); PG8_STAGE(PG8_SB(1, 1), cB + hstep + kstep, voffB);
    PG8_WAIT_V(6); PG8_BAR;
    for (;;) {
        const bool has_next = S.next(ui + 1, nxt);
        const char* nA = has_next ? (const char*)g.A + (size_t)nxt.z * g.zA + (size_t)nxt.pm * tstep + (size_t)nxt.k0 * kstep : cA; const char* nB = has_next ? (const char*)g.Bt + (size_t)nxt.z * g.zB + (size_t)nxt.pn * tstep + (size_t)nxt.k0 * kstep : cB;
        for (int t = 0; t < nt; t += 2) {
            const bool last = (t == nt - 2);
            const char* a1 = cA + (size_t)(t + 1) * kstep;
            const char* a2 = last ? nA : cA + (size_t)(t + 2) * kstep; const char* b2 = last ? nB : cB + (size_t)(t + 2) * kstep;
            const char* a3 = a2 + kstep; const char* b3 = b2 + kstep;
            PG8_LDB(B0, 0, 0); PG8_SCHED; PG8_LDA(At, 0, 0); PG8_STAGE(PG8_SA(1, 1), a1 + hstep, voffA);
            PG8_WAIT_L(8); PG8_BAR; PG8_WAIT_L(0); PG8_MMA(0, 0, At, B0); PG8_BAR; PG8_SCHED;
            PG8_LDB(B1, 0, 1); PG8_STAGE(PG8_SB(0, 0), b2, voffB);
            PG8_BAR; PG8_WAIT_L(0); PG8_MMA(0, 1, At, B1); PG8_BAR;
            PG8_LDA(At, 0, 1); PG8_STAGE(PG8_SA(0, 0), a2, voffA);
            PG8_BAR; PG8_WAIT_L(0); PG8_MMA(1, 0, At, B0); PG8_BAR; PG8_SCHED;
            PG8_STAGE(PG8_SB(0, 1), b2 + hstep, voffB);
            PG8_WAIT_V(6); PG8_BAR; PG8_MMA(1, 1, At, B1); PG8_BAR;
            PG8_LDB(B0, 1, 0); PG8_SCHED; PG8_LDA(At, 1, 0); PG8_STAGE(PG8_SA(0, 1), a2 + hstep, voffA);
            PG8_WAIT_L(8); PG8_BAR; PG8_WAIT_L(0); PG8_MMA(0, 0, At, B0); PG8_BAR; PG8_SCHED;
            PG8_LDB(B1, 1, 1); PG8_STAGE(PG8_SB(1, 0), b3, voffB);
            PG8_BAR; PG8_WAIT_L(0); PG8_MMA(0, 1, At, B1); PG8_BAR;
            PG8_LDA(At, 1, 1); PG8_STAGE(PG8_SA(1, 0), a3, voffA);
            PG8_BAR; PG8_WAIT_L(0); PG8_MMA(1, 0, At, B0); PG8_BAR; PG8_SCHED;
            PG8_STAGE(PG8_SB(1, 1), b3 + hstep, voffB);
            PG8_WAIT_V(6); PG8_BAR; PG8_MMA(1, 1, At, B1); PG8_BAR;
        }
        E(acc, cur, wr, wc, fr, fq);
        if (!has_next) break;
#pragma unroll
        for (int a = 0; a < 2; ++a)
#pragma unroll
            for (int b = 0; b < 2; ++b)
#pragma unroll
                for (int m = 0; m < 4; ++m)
#pragma unroll
                    for (int n = 0; n < 2; ++n) acc[a][b][m][n] = (f32x4){0.f, 0.f, 0.f, 0.f};
        cur = nxt; cA = nA; cB = nB; nt = cur.nk; ++ui;
    }
    PG8_WAIT_V(0);
    if (wr == 0) PG8_BAR;
    PG8_BAR;
#undef PG8_SA
#undef PG8_SB
#undef PG8_STAGE
#undef PG8_LDA
#undef PG8_LDB
#undef PG8_MMA
#undef PG8_WAIT_V
#undef PG8_WAIT_L
#undef PG8_BAR
#undef PG8_SCHED
}

struct EpiBF {
    static constexpr bool PERM = true;
    bf16_t* O; size_t zO; bf16_t* P; int nz;
    __device__ __forceinline__ void operator()(const f32x4 (&acc)[2][2][4][2], const Unit& u, int wr, int wc, int fr, int fq) const {
        const int col0 = u.pn * BM + wc * 32 + 8 * fq;
        const int row0 = (u.part < 0 ? u.pm * BM : 0) + wr * 64 + fr;
        bf16_t* base = u.part < 0 ? O + (size_t)u.z * zO : P + (size_t)(u.part * nz + u.z) * (BM * D);
#pragma unroll
        for (int ai = 0; ai < 2; ++ai)
#pragma unroll
            for (int m = 0; m < 4; ++m) { bf16_t* rowp = base + (size_t)(row0 + ai * HALF + m * 16) * D + col0;
#pragma unroll
                for (int bj = 0; bj < 2; ++bj) { const f32x4 v0 = acc[ai][bj][m][0], v1 = acc[ai][bj][m][1];
                    u32x4 w; w.x = cvt_pk_bf16(v0[0], v0[1]); w.y = cvt_pk_bf16(v0[2], v0[3]); w.z = cvt_pk_bf16(v1[0], v1[1]); w.w = cvt_pk_bf16(v1[2], v1[3]);
                    *(u32x4*)(rowp + bj * HALF) = w; } }
    }
};
struct EpiGU {
    static constexpr bool PERM = true;
    bf16_t* O; bool dry;
    __device__ __forceinline__ void operator()(const f32x4 (&acc)[2][2][4][2], const Unit& u, int wr, int wc, int fr, int fq) const {
        if (dry) return;
        const int row0 = u.pm * BM + wr * 64 + fr, col0 = u.pn * HALF + wc * 32 + 8 * fq;
#pragma unroll
        for (int ai = 0; ai < 2; ++ai)
#pragma unroll
            for (int m = 0; m < 4; ++m) { bf16_t* rowp = O + (size_t)(row0 + ai * HALF + m * 16) * DFF + col0;
                unsigned wv[4];
#pragma unroll
                for (int n = 0; n < 2; ++n)
#pragma unroll
                    for (int jp = 0; jp < 2; ++jp) {
                        const f32x2 gt = {acc[ai][0][m][n][2 * jp], acc[ai][0][m][n][2 * jp + 1]}, up = {acc[ai][1][m][n][2 * jp], acc[ai][1][m][n][2 * jp + 1]};
                        const f32x2 t = gt * (-1.44269504089f);
                        f32x2 e; e.x = __builtin_amdgcn_exp2f(t.x); e.y = __builtin_amdgcn_exp2f(t.y);
                        const f32x2 d = e + 1.0f;
                        f32x2 r; r.x = __builtin_amdgcn_rcpf(d.x); r.y = __builtin_amdgcn_rcpf(d.y);
                        const f32x2 o = (gt * up) * r;
                        wv[n * 2 + jp] = cvt_pk_bf16(o.x, o.y);
                    }
                u32x4 w; w.x = wv[0]; w.y = wv[1]; w.z = wv[2]; w.w = wv[3];
                *(u32x4*)rowp = w; }
    }
};
struct EpiIN {
    static constexpr bool PERM = true;
    bf16_t* U;
    __device__ __forceinline__ void operator()(const f32x4 (&acc)[2][2][4][2], const Unit& u, int wr, int wc, int fr, int fq) const {
        const int row0 = u.pm * BM + wr * 64 + fr;
        if (u.pn >= 4 && u.pn < 12) {
            const int col0 = (u.pn - 4) * HALF + wc * 32 + 8 * fq; bf16_t* base = U + 2 * SLOT;
#pragma unroll
            for (int ai = 0; ai < 2; ++ai)
#pragma unroll
                for (int m = 0; m < 4; ++m) { bf16_t* rowp = base + (size_t)(row0 + ai * HALF + m * 16) * D + col0;
                    const f32x4 v0 = acc[ai][0][m][0] * acc[ai][1][m][0], v1 = acc[ai][0][m][1] * acc[ai][1][m][1];
                    u32x4 w; w.x = cvt_pk_bf16(v0[0], v0[1]); w.y = cvt_pk_bf16(v0[2], v0[3]); w.z = cvt_pk_bf16(v1[0], v1[1]); w.w = cvt_pk_bf16(v1[2], v1[3]);
                    *(u32x4*)rowp = w; }
        } else {
            int slot, ct; if (u.pn < 4) { slot = 0; ct = u.pn; } else { const int sg = (u.pn - 12) >> 2; slot = sg == 0 ? 3 : (sg == 1 ? 1 : sg + 2); ct = (u.pn - 12) & 3; }
            const int col0 = ct * BM + wc * 32 + 8 * fq; bf16_t* base = U + (size_t)slot * SLOT;
#pragma unroll
            for (int ai = 0; ai < 2; ++ai)
#pragma unroll
                for (int m = 0; m < 4; ++m) { bf16_t* rowp = base + (size_t)(row0 + ai * HALF + m * 16) * D + col0;
#pragma unroll
                    for (int bj = 0; bj < 2; ++bj) { const f32x4 v0 = acc[ai][bj][m][0], v1 = acc[ai][bj][m][1];
                        u32x4 w; w.x = cvt_pk_bf16(v0[0], v0[1]); w.y = cvt_pk_bf16(v0[2], v0[3]); w.z = cvt_pk_bf16(v1[0], v1[1]); w.w = cvt_pk_bf16(v1[2], v1[3]);
                        *(u32x4*)(rowp + bj * HALF) = w; } }
        }
    }
};
}

__device__ __forceinline__ int conv_map(int mode, int n) {
    if (mode == 0) return n;
    if (mode == 1) return 256 * (n >> 7) + (n & 127);
    if (mode == 2) return 256 * (n >> 7) + 128 + (n & 127);
    const int seg = n >> 10, j = n & 1023;
    if (seg == 0) return j;
    if (seg == 1) return 1024 + 256 * (j >> 7) + (j & 127);
    if (seg == 2) return 1024 + 256 * (j >> 7) + 128 + (j & 127);
    return 3072 + (seg - 3) * 1024 + j;
}
struct ConvE { const float* src; bf16_t* dst; const float* gk; int K, N, mode, t; };
__device__ __forceinline__ bool conv_decode(const Params& p, int set, int T, ConvE& e) {
    if (set < 2) {
        const int a = set ? 27 : 8; const float* gk = p.in[set ? 25 : 6];
        if (T < 704)       { e.src = p.in[a];     e.dst = (bf16_t*)(p.ws + WS_WGU); e.gk = gk;      e.K = 1024; e.N = 2816; e.mode = 1; e.t = T; }
        else if (T < 1408) { e.src = p.in[a + 1]; e.dst = (bf16_t*)(p.ws + WS_WGU); e.gk = gk;      e.K = 1024; e.N = 2816; e.mode = 2; e.t = T - 704; }
        else if (T < 2112) { e.src = p.in[a + 2]; e.dst = (bf16_t*)(p.ws + WS_WD);  e.gk = nullptr; e.K = 2816; e.N = 1024; e.mode = 0; e.t = T - 1408; }
        else return false;
    } else {
        if (T < 1792)      { e.src = p.in[13]; e.dst = (bf16_t*)(p.ws + WS_WIN); e.gk = p.in[11]; e.K = 1024; e.N = 7168; e.mode = 3; e.t = T; }
        else if (T < 2048) { e.src = p.in[15]; e.dst = (bf16_t*)(p.ws + WS_WOAB); e.gk = nullptr; e.K = 1024; e.N = 1024; e.mode = 0; e.t = T - 1792; }
        else if (T < 2304) { e.src = p.in[23]; e.dst = (bf16_t*)(p.ws + WS_WOAB + (size_t)1024 * 1024 * 2); e.gk = nullptr; e.K = 1024; e.N = 1024; e.mode = 0; e.t = T - 2048; }
        else if (T < 2560) { e.src = p.in[24]; e.dst = (bf16_t*)(p.ws + WS_WO);  e.gk = nullptr;  e.K = 1024; e.N = 1024; e.mode = 0; e.t = T - 2304; }
        else return false;
    }
    return true;
}
__device__ __forceinline__ void conv_load(const ConvE& e, int tid, f32x4& v0, f32x4& v1) {
    const int ntn = e.N >> 6; const int tk = e.t / ntn, tn = e.t - tk * ntn;
    const float* s0 = e.src + (size_t)(tk * 64 + (tid >> 4)) * e.N + tn * 64 + (tid & 15) * 4;
    v0 = *(const f32x4*)s0; v1 = *(const f32x4*)(s0 + (size_t)32 * e.N);
}
__device__ __forceinline__ void conv_emit(const ConvE& e, int tid, const f32x4& v0, const f32x4& v1, LAS float* sl) {
    const int ntn = e.N >> 6; const int tk = e.t / ntn, tn = e.t - tk * ntn; const int k0 = tk * 64, n0 = tn * 64;
    { LAS float* d = sl + (tid >> 4) * 65 + (tid & 15) * 4; d[0] = v0[0]; d[1] = v0[1]; d[2] = v0[2]; d[3] = v0[3]; d += 32 * 65; d[0] = v1[0]; d[1] = v1[1]; d[2] = v1[2]; d[3] = v1[3]; }
    __syncthreads();
    const int n = tid >> 3, ko = (tid & 7) * 8;
    float f[8];
#pragma unroll
    for (int i = 0; i < 8; ++i) f[i] = sl[(ko + i) * 65 + n];
    if (e.gk) {
        const f32x4 g0 = *(const f32x4*)(e.gk + k0 + ko), g1 = *(const f32x4*)(e.gk + k0 + ko + 4);
#pragma unroll
        for (int i = 0; i < 4; ++i) { f[i] *= g0[i]; f[4 + i] *= g1[i]; }
    }
    u32x4 w; w.x = cvt_pk_bf16(f[0], f[1]); w.y = cvt_pk_bf16(f[2], f[3]); w.z = cvt_pk_bf16(f[4], f[5]); w.w = cvt_pk_bf16(f[6], f[7]);
    *(u32x4*)(e.dst + (size_t)conv_map(e.mode, n0 + n) * e.K + k0 + ko) = w;
    __syncthreads();
}
__device__ __forceinline__ void convert_set(const Params& p, int set, LAS unsigned char* lds, int tid, int skip, int T0, int T1) {
    ConvE e, en; f32x4 v0, v1, n0 = {0.f, 0.f, 0.f, 0.f}, n1 = {0.f, 0.f, 0.f, 0.f};
    if ((int)blockIdx.x < skip) return;
    int T = T0 + (int)blockIdx.x - skip; const int stride = gridDim.x - skip;
    bool have = T < T1 && conv_decode(p, set, T, e);
    if (have) conv_load(e, tid, v0, v1);
    while (have) {
        T += stride;
        const bool hn = T < T1 && conv_decode(p, set, T, en);
        if (hn) conv_load(en, tid, n0, n1);
        conv_emit(e, tid, v0, v1, (LAS float*)lds);
        e = en; v0 = n0; v1 = n1; have = hn;
    }
}

__device__ __forceinline__ void norm_phase(const Params& p, int mode, int tid, bool dry, int nsplit) {
    const int lane = tid & 63, gw = blockIdx.x * 8 + (tid >> 6), nw = gridDim.x * 8;
    const float* gpost = mode == 1 ? p.in[7] : (mode == 2 ? p.in[12] : p.in[26]);
    const float cc = mode == 2 ? 1.0f : 0.5f;
    const bf16_t* Yb = (const bf16_t*)(p.ws + WS_Y); const bf16_t* PY = (const bf16_t*)(p.ws + WS_PY); bf16_t* H = (bf16_t*)(p.ws + WS_H); float* SC = (float*)(p.ws + WS_SC);
    for (int r = gw; r < M; r += nw) {
        f32x4 xv[4];
        if (mode == 0) {
            const float* xin = x0row(p, r);
#pragma unroll
            for (int q = 0; q < 4; ++q) xv[q] = *(const f32x4*)(xin + lane * 4 + 256 * q);
        } else {
            const float sc = SC[r];
#pragma unroll
            for (int q = 0; q < 4; ++q) { const u32x2 w = *(const u32x2*)(H + (size_t)r * D + lane * 4 + 256 * q); xv[q] = (f32x4){bflo(w.x), bfhi(w.x), bflo(w.y), bfhi(w.y)} * sc; }
            f32x4 yv[4]; float ss = 0.f;
            if (r < MAINR) {
#pragma unroll
                for (int q = 0; q < 4; ++q) { const u32x2 w = *(const u32x2*)(Yb + (size_t)r * D + lane * 4 + 256 * q); yv[q] = (f32x4){bflo(w.x), bfhi(w.x), bflo(w.y), bfhi(w.y)}; }
            } else {
#pragma unroll
                for (int q = 0; q < 4; ++q) yv[q] = (f32x4){0.f, 0.f, 0.f, 0.f};
                for (int ks0 = 0; ks0 < nsplit; ks0 += 4) {
                    f32x4 pv[4][4];
#pragma unroll
                    for (int k = 0; k < 4; ++k) { const int ks = (ks0 + k < nsplit) ? ks0 + k : ks0;
#pragma unroll
                        for (int q = 0; q < 4; ++q) { const u32x2 w = *(const u32x2*)(PY + ((size_t)ks * 256 + (r - MAINR)) * D + lane * 4 + 256 * q); pv[k][q] = (f32x4){bflo(w.x), bfhi(w.x), bflo(w.y), bfhi(w.y)}; } }
#pragma unroll
                    for (int k = 0; k < 4; ++k) { const float m = (ks0 + k < nsplit) ? 1.0f : 0.0f;
#pragma unroll
                        for (int q = 0; q < 4; ++q) yv[q] += pv[k][q] * m; }
                }
            }
#pragma unroll
            for (int q = 0; q < 4; ++q) ss += yv[q][0] * yv[q][0] + yv[q][1] * yv[q][1] + yv[q][2] * yv[q][2] + yv[q][3] * yv[q][3];
            ss = wave_sum(ss, lane);
            const float rs = cc * rsqrtf(ss * (1.0f / D) + EPS);
#pragma unroll
            for (int q = 0; q < 4; ++q) xv[q] += yv[q] * rs * *(const f32x4*)(gpost + lane * 4 + 256 * q);
        }
        if (mode == 3) {
            float* xo;
            if (r >= MP) xo = p.out + O_YS + (size_t)(r - MP) * D;
            else { const int b = r / TP, t = r - b * TP; if (t < NMETA) continue; xo = p.out + O_YP + ((size_t)b * SEQ + (t - NMETA)) * D; }
#pragma unroll
            for (int q = 0; q < 4; ++q) *(f32x4*)(xo + lane * 4 + 256 * q) = xv[q];
        } else {
            float ss = 0.f;
#pragma unroll
            for (int q = 0; q < 4; ++q) ss += xv[q][0] * xv[q][0] + xv[q][1] * xv[q][1] + xv[q][2] * xv[q][2] + xv[q][3] * xv[q][3];
            ss = wave_sum(ss, lane);
            const float ms = ss * (1.0f / D) + EPS; const float rs = rsqrtf(ms);
            if (!dry) {
#pragma unroll
                for (int q = 0; q < 4; ++q) { const f32x4 hv = xv[q] * rs; u32x2 w; w.x = cvt_pk_bf16(hv[0], hv[1]); w.y = cvt_pk_bf16(hv[2], hv[3]);
                    *(u32x2*)(H + (size_t)r * D + lane * 4 + 256 * q) = w; }
                if (lane == 0) SC[r] = ms * rs;
            }
        }
    }
}

constexpr int WL_BYTES = 11264;
__device__ __forceinline__ void scan_item(const Params& p, int b, int j, int h, LAS unsigned char* wl, const LAS unsigned char* wlds, int lane, bool dry) {
    bf16_t* U = (bf16_t*)(p.ws + WS_U);
    const bf16_t* bx = U + 3 * SLOT; bf16_t* bg = U + 1 * SLOT; bf16_t* pp = (bf16_t*)p.out;
    float* summ = (float*)(p.ws + WS_SUMM);
    const int c = h * 64 + lane, fr = lane & 15, fq = lane >> 4;
    const size_t row0 = (size_t)b * TP + (size_t)j * CHUNK;
    const bf16_t* bx0 = bx + row0 * D; bf16_t* bg0 = bg + row0 * D; bf16_t* pp0 = pp + row0 * D;
    const LAS unsigned char* wq = wlds + fr * 144 + fq * 16;
    float brv[4], biv[4], lcv[4];
#pragma unroll
    for (int nt = 0; nt < 4; ++nt) { const int ch = h * 64 + nt * 16 + fr; brv[nt] = p.in[19][ch]; biv[nt] = p.in[21][ch]; lcv[nt] = ((const float*)(p.ws + WS_LC))[ch]; }
    const float w0 = p.in[16][c], w1 = p.in[16][D + c], w2 = p.in[16][2 * D + c], w3 = p.in[16][3 * D + c], cbias = p.in[17][c];
    float xm3 = 0.f, xm2 = 0.f, xm1 = 0.f;
    if (j > 0) { xm3 = bf2f(bx0[-3 * D + c]); xm2 = bf2f(bx0[-2 * D + c]); xm1 = bf2f(bx0[-1 * D + c]); }
    float hh = 0.f, ap = 1.f;
    LAS unsigned short* cbT = (LAS unsigned short*)wl;
    LAS float* xu = (LAS float*)(wl + 2304);
    LAS float* aS = (LAS float*)(wl + 2304 + 4352);
    bf16_t xr[16], gr[16], xn[16], gn[16];
#pragma unroll
    for (int tt = 0; tt < 16; ++tt) { xr[tt] = bx0[tt * D + c]; gr[tt] = bg0[tt * D + c]; }
#pragma unroll
    for (int g = 0; g < 3; ++g) {
        const int r0 = g * 16;
        if (g < 2) {
#pragma unroll
            for (int tt = 0; tt < 16; ++tt) { xn[tt] = bx0[(r0 + 16 + tt) * D + c]; gn[tt] = bg0[(r0 + 16 + tt) * D + c]; }
        }
#pragma unroll
        for (int tt = 0; tt < 16; ++tt) { const float x = bf2f(xr[tt]); const float cb = w0 * xm3 + w1 * xm2 + w2 * xm1 + w3 * x + cbias; xm3 = xm2; xm2 = xm1; xm1 = x;
            cbT[tt * 72 + lane] = f2bf(cb); xu[tt * 68 + lane] = cb; }
        __builtin_amdgcn_wave_barrier();
        const bf16x8 a0 = *(const LAS bf16x8*)(cbT + fr * 72 + fq * 8), a1 = *(const LAS bf16x8*)(cbT + fr * 72 + 32 + fq * 8);
        f32x4 accR[4], accI[4];
#pragma unroll
        for (int nt = 0; nt < 4; ++nt) {
            const bf16x8 r0w = *(const LAS bf16x8*)(wq + nt * 2304), r1w = *(const LAS bf16x8*)(wq + nt * 2304 + 64);
            const bf16x8 i0w = *(const LAS bf16x8*)(wq + 9216 + nt * 2304), i1w = *(const LAS bf16x8*)(wq + 9216 + nt * 2304 + 64);
            accR[nt] = __builtin_amdgcn_mfma_f32_16x16x32_bf16(a0, r0w, (f32x4){0.f, 0.f, 0.f, 0.f}, 0, 0, 0);
            accR[nt] = __builtin_amdgcn_mfma_f32_16x16x32_bf16(a1, r1w, accR[nt], 0, 0, 0);
            accI[nt] = __builtin_amdgcn_mfma_f32_16x16x32_bf16(a0, i0w, (f32x4){0.f, 0.f, 0.f, 0.f}, 0, 0, 0);
            accI[nt] = __builtin_amdgcn_mfma_f32_16x16x32_bf16(a1, i1w, accI[nt], 0, 0, 0);
        }
#pragma unroll
        for (int nt = 0; nt < 4; ++nt)
#pragma unroll
            for (int ip = 0; ip < 2; ++ip) {
                const int idx0 = (fq * 4 + 2 * ip) * 68 + nt * 16 + fr, idx1 = idx0 + 68;
                const f32x2 tr = ((f32x2){accR[nt][2 * ip], accR[nt][2 * ip + 1]} + brv[nt]) * (-1.44269504089f), ti = ((f32x2){accI[nt][2 * ip], accI[nt][2 * ip + 1]} + biv[nt]) * (-1.44269504089f);
                f32x2 er, ei; er.x = __builtin_amdgcn_exp2f(tr.x); er.y = __builtin_amdgcn_exp2f(tr.y); ei.x = __builtin_amdgcn_exp2f(ti.x); ei.y = __builtin_amdgcn_exp2f(ti.y);
                const f32x2 dr = er + 1.0f, di = ei + 1.0f;
                f32x2 r, ig; r.x = __builtin_amdgcn_rcpf(dr.x); r.y = __builtin_amdgcn_rcpf(dr.y); ig.x = __builtin_amdgcn_rcpf(di.x); ig.y = __builtin_amdgcn_rcpf(di.y);
                const f32x2 la = r * lcv[nt]; const f32x2 tl = la * 1.44269504089f;
                f32x2 a; a.x = __builtin_amdgcn_exp2f(tl.x); a.y = __builtin_amdgcn_exp2f(tl.y);
                const f32x2 z2 = la + la;
                const f32x2 m2s = -z2 * (z2 * (z2 * (z2 * (z2 * (z2 * 0.0013888889f + 0.0083333338f) + 0.041666668f) + 0.16666667f) + 0.5f) + 1.0f);
                const f32x2 m2b = 1.0f - a * a;
                f32x2 sq; sq.x = __builtin_amdgcn_sqrtf(z2.x > -0.25f ? m2s.x : m2b.x); sq.y = __builtin_amdgcn_sqrtf(z2.y > -0.25f ? m2s.y : m2b.y);
                const f32x2 uo = sq * ig * (f32x2){xu[idx0], xu[idx1]};
                xu[idx0] = uo.x; xu[idx1] = uo.y; aS[idx0] = a.x; aS[idx1] = a.y; }
        __builtin_amdgcn_wave_barrier();
        f32x2 glv[8];
#pragma unroll
        for (int tp = 0; tp < 8; ++tp) { const f32x2 x = {bf2f(gr[2 * tp]), bf2f(gr[2 * tp + 1])};
            const f32x2 t = x * (x * x * (-0.10294324f) + (-2.30220819f));
            f32x2 e; e.x = __builtin_amdgcn_exp2f(t.x); e.y = __builtin_amdgcn_exp2f(t.y);
            const f32x2 d = e + 1.0f;
            f32x2 rr; rr.x = __builtin_amdgcn_rcpf(d.x); rr.y = __builtin_amdgcn_rcpf(d.y);
            glv[tp] = x * rr; }
#pragma unroll
        for (int tt = 0; tt < 16; ++tt) { const float a = aS[tt * 68 + lane], uu = xu[tt * 68 + lane]; hh = a * hh + uu; ap *= a;
            const f32x2 o = (f32x2){hh, ap} * ((tt & 1) ? glv[tt >> 1].y : glv[tt >> 1].x);
            const unsigned w = cvt_pk_bf16(o.x, o.y);
            if (!dry) bg0[(r0 + tt) * D + c] = (bf16_t)(w & 0xffffu);
            pp0[(r0 + tt) * D + c] = (bf16_t)(w >> 16); }
        __builtin_amdgcn_wave_barrier();
        if (g < 2) {
#pragma unroll
            for (int tt = 0; tt < 16; ++tt) { xr[tt] = xn[tt]; gr[tt] = gn[tt]; }
        }
    }
    *(float2*)(summ + (((size_t)b * NCH + j) * D + c) * 2) = make_float2(ap, hh);
    if (j == NCH - 1) { p.out[O_CBP + ((size_t)b * 3 + 0) * D + c] = xm3; p.out[O_CBP + ((size_t)b * 3 + 1) * D + c] = xm2; p.out[O_CBP + ((size_t)b * 3 + 2) * D + c] = xm1; }
}
__device__ __forceinline__ void sample_item(const Params& p, int k, int h, LAS unsigned char* wl, const LAS unsigned char* wlds, int lane) {
    bf16_t* U = (bf16_t*)(p.ws + WS_U);
    const int c = h * 64 + lane, fr = lane & 15, fq = lane >> 4;
    const size_t row0 = (size_t)MP + (size_t)k * 16; const int s0 = k * 16;
    const bf16_t* bx0 = U + 3 * SLOT + row0 * D; bf16_t* bg0 = U + 1 * SLOT + row0 * D;
    const LAS unsigned char* wq = wlds + fr * 144 + fq * 16;
    float brv[4], biv[4], lcv[4];
#pragma unroll
    for (int nt = 0; nt < 4; ++nt) { const int ch = h * 64 + nt * 16 + fr; brv[nt] = p.in[19][ch]; biv[nt] = p.in[21][ch]; lcv[nt] = ((const float*)(p.ws + WS_LC))[ch]; }
    const float w3 = p.in[16][3 * D + c];
    LAS unsigned short* cbT = (LAS unsigned short*)wl;
    LAS float* xu = (LAS float*)(wl + 2304);
    LAS float* aS = (LAS float*)(wl + 2304 + 4352);
    const float* pcb = (const float*)(p.ws + WS_PCB) + (size_t)s0 * D + c;
    {
        bf16_t xr[16]; float pc[16];
#pragma unroll
        for (int tt = 0; tt < 16; ++tt) { xr[tt] = bx0[tt * D + c]; pc[tt] = pcb[tt * D]; }
#pragma unroll
        for (int tt = 0; tt < 16; ++tt) { const float x = bf2f(xr[tt]); const float cb = pc[tt] + w3 * x;
            p.out[O_CBS + ((size_t)(s0 + tt) * 3 + 2) * D + c] = x;
            cbT[tt * 72 + lane] = f2bf(cb); xu[tt * 68 + lane] = cb; }
    }
    __builtin_amdgcn_wave_barrier();
    const bf16x8 a0 = *(const LAS bf16x8*)(cbT + fr * 72 + fq * 8), a1 = *(const LAS bf16x8*)(cbT + fr * 72 + 32 + fq * 8);
    f32x4 accR[4], accI[4];
#pragma unroll
    for (int nt = 0; nt < 4; ++nt) {
        const bf16x8 r0w = *(const LAS bf16x8*)(wq + nt * 2304), r1w = *(const LAS bf16x8*)(wq + nt * 2304 + 64);
        const bf16x8 i0w = *(const LAS bf16x8*)(wq + 9216 + nt * 2304), i1w = *(const LAS bf16x8*)(wq + 9216 + nt * 2304 + 64);
        accR[nt] = __builtin_amdgcn_mfma_f32_16x16x32_bf16(a0, r0w, (f32x4){0.f, 0.f, 0.f, 0.f}, 0, 0, 0);
        accR[nt] = __builtin_amdgcn_mfma_f32_16x16x32_bf16(a1, r1w, accR[nt], 0, 0, 0);
        accI[nt] = __builtin_amdgcn_mfma_f32_16x16x32_bf16(a0, i0w, (f32x4){0.f, 0.f, 0.f, 0.f}, 0, 0, 0);
        accI[nt] = __builtin_amdgcn_mfma_f32_16x16x32_bf16(a1, i1w, accI[nt], 0, 0, 0);
    }
#pragma unroll
    for (int nt = 0; nt < 4; ++nt)
#pragma unroll
        for (int ip = 0; ip < 2; ++ip) {
                const int idx0 = (fq * 4 + 2 * ip) * 68 + nt * 16 + fr, idx1 = idx0 + 68;
                const f32x2 tr = ((f32x2){accR[nt][2 * ip], accR[nt][2 * ip + 1]} + brv[nt]) * (-1.44269504089f), ti = ((f32x2){accI[nt][2 * ip], accI[nt][2 * ip + 1]} + biv[nt]) * (-1.44269504089f);
                f32x2 er, ei; er.x = __builtin_amdgcn_exp2f(tr.x); er.y = __builtin_amdgcn_exp2f(tr.y); ei.x = __builtin_amdgcn_exp2f(ti.x); ei.y = __builtin_amdgcn_exp2f(ti.y);
                const f32x2 dr = er + 1.0f, di = ei + 1.0f;
                f32x2 r, ig; r.x = __builtin_amdgcn_rcpf(dr.x); r.y = __builtin_amdgcn_rcpf(dr.y); ig.x = __builtin_amdgcn_rcpf(di.x); ig.y = __builtin_amdgcn_rcpf(di.y);
                const f32x2 la = r * lcv[nt]; const f32x2 tl = la * 1.44269504089f;
                f32x2 a; a.x = __builtin_amdgcn_exp2f(tl.x); a.y = __builtin_amdgcn_exp2f(tl.y);
                const f32x2 z2 = la + la;
                const f32x2 m2s = -z2 * (z2 * (z2 * (z2 * (z2 * (z2 * 0.0013888889f + 0.0083333338f) + 0.041666668f) + 0.16666667f) + 0.5f) + 1.0f);
                const f32x2 m2b = 1.0f - a * a;
                f32x2 sq; sq.x = __builtin_amdgcn_sqrtf(z2.x > -0.25f ? m2s.x : m2b.x); sq.y = __builtin_amdgcn_sqrtf(z2.y > -0.25f ? m2s.y : m2b.y);
                const f32x2 uo = sq * ig * (f32x2){xu[idx0], xu[idx1]};
                xu[idx0] = uo.x; xu[idx1] = uo.y; aS[idx0] = a.x; aS[idx1] = a.y; }
    __builtin_amdgcn_wave_barrier();
    {
        float h0[16]; bf16_t gq[16];
#pragma unroll
        for (int tt = 0; tt < 16; ++tt) { h0[tt] = p.in[4][(size_t)(s0 + tt) * D + c]; gq[tt] = bg0[tt * D + c]; }
#pragma unroll
        for (int tt = 0; tt < 16; ++tt) {
            const float hn = aS[tt * 68 + lane] * h0[tt] + xu[tt * 68 + lane];
            p.out[O_RGS + (size_t)(s0 + tt) * D + c] = hn;
            bg0[tt * D + c] = f2bf(gelu_tanh(bf2f(gq[tt])) * hn);
        }
    }
    __builtin_amdgcn_wave_barrier();
}
__device__ __forceinline__ void scan_phase(const Params& p, LAS unsigned char* lds, int tid, bool dry) {
    const int wid = __builtin_amdgcn_readfirstlane(tid >> 6), lane = tid & 63;
    LAS unsigned char* wl = lds + wid * WL_BYTES;
    LAS unsigned char* wlds = lds + 8 * WL_BYTES;
    const int h = blockIdx.x & 15;
    {
        const bf16_t* wt = (const bf16_t*)(p.ws + WS_WRG);
#pragma unroll
        for (int q = 0; q < 2; ++q) { const int e = tid + q * 512, g = e >> 9, jrow = (e >> 3) & 63, pc = e & 7;
            *(LAS u32x4*)(wlds + g * 9216 + jrow * 144 + pc * 16) = *(const u32x4*)(wt + (size_t)g * 65536 + (size_t)(h * 64 + jrow) * 64 + pc * 8); }
    }
    __syncthreads();
    const int nbh = gridDim.x >> 4;
    for (int it = (blockIdx.x >> 4) * 8 + wid; it < NB * NCH; it += nbh * 8) scan_item(p, it / NCH, it % NCH, h, wl, wlds, lane, dry);
    if (!dry && wid < 2 && (int)(blockIdx.x >> 4) >= nbh - 4) {
        const int k = ((int)(blockIdx.x >> 4) - (nbh - 4)) * 2 + wid;
        if (k < NS / 16) sample_item(p, k, h, wl, wlds, lane);
    }
    __syncthreads();
}
__device__ __forceinline__ void fix_phase(const Params& p, LAS unsigned char* lds, int tid, bool dry) {
    bf16_t* zb = (bf16_t*)(p.ws + WS_U) + 1 * SLOT; const bf16_t* pp = (const bf16_t*)p.out;
    const float* summ = (const float*)(p.ws + WS_SUMM);
    LAS float* cs = (LAS float*)lds;
    for (int it = blockIdx.x; it < NB * (NCH - 1); it += gridDim.x) {
        const int b = it / (NCH - 1), j = it % (NCH - 1) + 1;
#pragma unroll
        for (int cq = 0; cq < 2; ++cq) {
            const int c = tid + cq * 512; const float* sp = summ + ((size_t)b * NCH * D + c) * 2; float hh = 0.f;
            for (int i0 = 0; i0 < j; i0 += 16) {
                float va[16], vh[16];
#pragma unroll
                for (int k = 0; k < 16; ++k) { if (i0 + k < j) { const float2 v = *(const float2*)(sp + (size_t)(i0 + k) * D * 2); va[k] = v.x; vh[k] = v.y; } else { va[k] = 1.f; vh[k] = 0.f; } }
#pragma unroll
                for (int k = 0; k < 16; ++k) hh = va[k] * hh + vh[k];
            }
            cs[c] = hh;
            if (j == NCH - 1) { const float2 v = *(const float2*)(sp + (size_t)j * D * 2); p.out[O_RGP + (size_t)b * D + c] = v.x * hh + v.y; }
        }
        __syncthreads();
        const size_t row0 = (size_t)b * TP + (size_t)j * CHUNK;
        for (int q0 = 0; q0 < CHUNK * 128 / 512; q0 += 4) {
            u32x4 zq[4], pq[4];
#pragma unroll
            for (int k = 0; k < 4; ++k) { const int e = tid + (q0 + k) * 512, tt = e >> 7, vc = e & 127; const size_t o = (row0 + tt) * D + vc * 8; zq[k] = *(const u32x4*)(zb + o); pq[k] = *(const u32x4*)(pp + o); }
#pragma unroll
            for (int k = 0; k < 4; ++k) { const int e = tid + (q0 + k) * 512, tt = e >> 7, vc = e & 127; const size_t o = (row0 + tt) * D + vc * 8;
                const f32x4 c0 = *(const LAS f32x4*)(cs + vc * 8), c1 = *(const LAS f32x4*)(cs + vc * 8 + 4);
                u32x4 w;
                w.x = cvt_pk_bf16(bflo(zq[k].x) + bflo(pq[k].x) * c0[0], bfhi(zq[k].x) + bfhi(pq[k].x) * c0[1]); w.y = cvt_pk_bf16(bflo(zq[k].y) + bflo(pq[k].y) * c0[2], bfhi(zq[k].y) + bfhi(pq[k].y) * c0[3]);
                w.z = cvt_pk_bf16(bflo(zq[k].z) + bflo(pq[k].z) * c1[0], bfhi(zq[k].z) + bfhi(pq[k].z) * c1[1]); w.w = cvt_pk_bf16(bflo(zq[k].w) + bflo(pq[k].w) * c1[2], bfhi(zq[k].w) + bfhi(pq[k].w) * c1[3]);
                if (!dry) *(u32x4*)(zb + o) = w; }
        }
        __syncthreads();
    }
}
__device__ __forceinline__ void za_phase(const Params& p, int tid, bool dry) {
    bf16_t* U = (bf16_t*)(p.ws + WS_U); bf16_t* ab = U; const bf16_t* ca = U + 2 * SLOT;
    const float* cw = p.in[14];
    for (int idx = blockIdx.x * 512 + tid; idx < NB * 129 * 128; idx += gridDim.x * 512) {
        const int vc = idx & 127, tb = (idx >> 7) % 129, b = idx / (128 * 129); const int c0 = vc * 8;
        float w[3][8];
#pragma unroll
        for (int k = 0; k < 3; ++k) { const f32x4 a = *(const f32x4*)(cw + k * D + c0), bq = *(const f32x4*)(cw + k * D + c0 + 4);
#pragma unroll
            for (int e = 0; e < 4; ++e) { w[k][e] = a[e]; w[k][4 + e] = bq[e]; } }
        const size_t r0 = (size_t)b * TP + (size_t)tb * 16;
        float p2[8], p1[8];
        if (tb > 0) { const u32x4 q2 = *(const u32x4*)(ca + (r0 - 2) * D + c0), q1 = *(const u32x4*)(ca + (r0 - 1) * D + c0);
#pragma unroll
            for (int e = 0; e < 4; ++e) { p2[2 * e] = bflo(q2[e]); p2[2 * e + 1] = bfhi(q2[e]); p1[2 * e] = bflo(q1[e]); p1[2 * e + 1] = bfhi(q1[e]); } }
        else {
#pragma unroll
            for (int e = 0; e < 8; ++e) { p2[e] = 0.f; p1[e] = 0.f; } }
        for (int t4 = 0; t4 < 16; t4 += 4) {
            u32x4 qcs[4], qas[4];
#pragma unroll
            for (int k = 0; k < 4; ++k) { qcs[k] = *(const u32x4*)(ca + (r0 + t4 + k) * D + c0); qas[k] = *(const u32x4*)(ab + (r0 + t4 + k) * D + c0); }
#pragma unroll
            for (int k = 0; k < 4; ++k) {
                const u32x4 qc = qcs[k], qa = qas[k];
                float cv[8], av[8], zv[8];
#pragma unroll
                for (int e = 0; e < 4; ++e) { cv[2 * e] = bflo(qc[e]); cv[2 * e + 1] = bfhi(qc[e]); av[2 * e] = bflo(qa[e]); av[2 * e + 1] = bfhi(qa[e]); }
#pragma unroll
                for (int e = 0; e < 8; ++e) { zv[e] = av[e] * (w[0][e] * p2[e] + w[1][e] * p1[e] + w[2][e] * cv[e]); p2[e] = p1[e]; p1[e] = cv[e]; }
                u32x4 o; o.x = cvt_pk_bf16(zv[0], zv[1]); o.y = cvt_pk_bf16(zv[2], zv[3]); o.z = cvt_pk_bf16(zv[4], zv[5]); o.w = cvt_pk_bf16(zv[6], zv[7]);
                if (!dry) *(u32x4*)(ab + (r0 + t4 + k) * D + c0) = o;
            }
        }
        if (tb == 128) {
            float* o2 = p.out + O_CAP + ((size_t)b * 2 + 0) * D + c0; float* o1 = p.out + O_CAP + ((size_t)b * 2 + 1) * D + c0;
            *(f32x4*)o2 = (f32x4){p2[0], p2[1], p2[2], p2[3]}; *(f32x4*)(o2 + 4) = (f32x4){p2[4], p2[5], p2[6], p2[7]};
            *(f32x4*)o1 = (f32x4){p1[0], p1[1], p1[2], p1[3]}; *(f32x4*)(o1 + 4) = (f32x4){p1[4], p1[5], p1[6], p1[7]};
        }
    }
    if (!dry) {
        for (int idx = blockIdx.x * 512 + tid; idx < NS * 128; idx += gridDim.x * 512) {
            const int vc = idx & 127, sm = idx >> 7, c0 = vc * 8; const size_t ro = (size_t)(MP + sm) * D + c0;
            const u32x4 qc = *(const u32x4*)(ca + ro), qa = *(const u32x4*)(ab + ro);
            const float* pca = (const float*)(p.ws + WS_PCA) + (size_t)sm * D + c0;
            float hp[8], cv[8], zv[8];
            { const f32x4 a0 = *(const f32x4*)pca, a1 = *(const f32x4*)(pca + 4);
#pragma unroll
              for (int e = 0; e < 4; ++e) { hp[e] = a0[e]; hp[4 + e] = a1[e]; } }
#pragma unroll
            for (int e = 0; e < 4; ++e) { cv[2 * e] = bflo(qc[e]); cv[2 * e + 1] = bfhi(qc[e]); }
#pragma unroll
            for (int e = 0; e < 8; ++e) { const float av = (e & 1) ? bfhi(qa[e >> 1]) : bflo(qa[e >> 1]); zv[e] = av * (hp[e] + cw[2 * D + c0 + e] * cv[e]); }
            u32x4 o; o.x = cvt_pk_bf16(zv[0], zv[1]); o.y = cvt_pk_bf16(zv[2], zv[3]); o.z = cvt_pk_bf16(zv[4], zv[5]); o.w = cvt_pk_bf16(zv[6], zv[7]);
            *(u32x4*)(ab + ro) = o;
            float* o1 = p.out + O_CAS + ((size_t)sm * 2 + 1) * D + c0;
            *(f32x4*)o1 = (f32x4){cv[0], cv[1], cv[2], cv[3]}; *(f32x4*)(o1 + 4) = (f32x4){cv[4], cv[5], cv[6], cv[7]};
        }
    }
}

__device__ __forceinline__ u32x4 merge_math(const u32x4& ga, const u32x4& gb, const float (&ya)[8], const float (&yb)[8]) {
    u32x4 o4;
#pragma unroll
    for (int e = 0; e < 4; ++e) { const float lo = sigm(bflo(ga[e])) * ya[2 * e] + sigm(bflo(gb[e])) * yb[2 * e], hi = sigm(bfhi(ga[e])) * ya[2 * e + 1] + sigm(bfhi(gb[e])) * yb[2 * e + 1]; o4[e] = cvt_pk_bf16(lo, hi); }
    return o4;
}
__device__ __forceinline__ void merge_phase(const Params& p, int tid) {
    const bf16_t* U = (const bf16_t*)(p.ws + WS_U); bf16_t* H = (bf16_t*)p.out; const bf16_t* PO = (const bf16_t*)(p.ws + WS_POAB);
    const size_t G = (size_t)gridDim.x * 512, NMAIN = (size_t)MAINR * 128;
    for (size_t i0 = (size_t)blockIdx.x * 512 + tid; i0 < NMAIN; i0 += 4 * G) {
        u32x4 ga[4], gb[4], a[4], b[4];
#pragma unroll
        for (int k = 0; k < 4; ++k) { const size_t i = i0 + k * G; if (i < NMAIN) { ga[k] = __builtin_nontemporal_load((const u32x4*)(U + 4 * SLOT + i * 8)); gb[k] = __builtin_nontemporal_load((const u32x4*)(U + 5 * SLOT + i * 8)); a[k] = __builtin_nontemporal_load((const u32x4*)(U + 2 * SLOT + i * 8)); b[k] = __builtin_nontemporal_load((const u32x4*)(U + 3 * SLOT + i * 8)); } }
#pragma unroll
        for (int k = 0; k < 4; ++k) { const size_t i = i0 + k * G; if (i < NMAIN) {
            float ya[8], yb[8];
#pragma unroll
            for (int e = 0; e < 4; ++e) { ya[2 * e] = bflo(a[k][e]); ya[2 * e + 1] = bfhi(a[k][e]); yb[2 * e] = bflo(b[k][e]); yb[2 * e + 1] = bfhi(b[k][e]); }
            *(u32x4*)(H + i * 8) = merge_math(ga[k], gb[k], ya, yb); } }
    }
    for (size_t i = NMAIN + (size_t)blockIdx.x * 512 + tid; i < SLOT / 8; i += G) {
        const u32x4 ga = *(const u32x4*)(U + 4 * SLOT + i * 8), gb = *(const u32x4*)(U + 5 * SLOT + i * 8);
        float ya[8], yb[8];
        const int row = (int)(i >> 7);
        const size_t o = (size_t)(row - MAINR) * D + (size_t)(i & 127) * 8;
#pragma unroll
        for (int e = 0; e < 8; ++e) { ya[e] = 0.f; yb[e] = 0.f; }
#pragma unroll
        for (int ks = 0; ks < 4; ++ks) {
            const u32x4 a0 = *(const u32x4*)(PO + (size_t)(ks * 2 + 0) * (256 * D) + o), b0 = *(const u32x4*)(PO + (size_t)(ks * 2 + 1) * (256 * D) + o);
#pragma unroll
            for (int e = 0; e < 4; ++e) { ya[2 * e] += bflo(a0[e]); ya[2 * e + 1] += bfhi(a0[e]); yb[2 * e] += bflo(b0[e]); yb[2 * e + 1] += bfhi(b0[e]); }
        }
        *(u32x4*)(H + i * 8) = merge_math(ga, gb, ya, yb);
    }
}

#define XB_TMO      128
#define XB_XCNT(j)  (256  + 64 * (j))
#define XB_XSUB(j)  (1280 + 64 * (j))
#define XB_XGEN(j)  (2304 + 64 * (j))
#define XB_TOP      3328
#define XB_TOPGEN   3392
#define XCD_BAR_WORDS 3456
#define XB_SPIN_CAP (1u << 18)
__device__ __forceinline__ unsigned xb_ld(unsigned* p)              { return __hip_atomic_load(p, __ATOMIC_RELAXED, __HIP_MEMORY_SCOPE_AGENT); }
__device__ __forceinline__ unsigned xb_add(unsigned* p, unsigned v) { return __hip_atomic_fetch_add(p, v, __ATOMIC_RELAXED, __HIP_MEMORY_SCOPE_AGENT); }
__device__ __forceinline__ unsigned xb_xcc_id() { return (unsigned)__builtin_amdgcn_s_getreg((3 << 11) | 20) & 0xFu; }
#define XB_SPIN(cond, bar) do { unsigned _sp = 0; while (cond) { __builtin_amdgcn_s_sleep(1); \
    if ((++_sp & 255u) == 0u) { if (xb_ld(&(bar)[XB_TMO])) break; if (_sp > XB_SPIN_CAP) { atomicAdd(&(bar)[XB_TMO], 1u); break; } } } } while (0)
struct XcdBarrier { unsigned* bar; unsigned x; volatile LAS unsigned* st; };
__device__ __forceinline__ XcdBarrier xcd_barrier_post(unsigned* bar, volatile LAS unsigned* st) {
    XcdBarrier b; b.bar = bar; b.x = xb_xcc_id(); b.st = st;
    if (threadIdx.x == 0) (void)xb_add(&bar[XB_XCNT(b.x)], 1u);
    return b;
}
__device__ __forceinline__ void xcd_barrier_complete(unsigned* bar, unsigned x, unsigned& nloc, unsigned& nx) {
    const unsigned G = gridDim.x * gridDim.y * gridDim.z;
    unsigned sum, cnt, mine, sp = 0u;
    for (;;) {
        sum = 0u; cnt = 0u; mine = 0u;
#pragma unroll
        for (unsigned j = 0; j < 16; ++j) { const unsigned c = xb_ld(&bar[XB_XCNT(j)]); sum += c; cnt += (c > 0u) ? 1u : 0u; mine = (j == x) ? c : mine; }
        if (sum == G) break;
        __builtin_amdgcn_s_sleep(1);
        if ((++sp & 255u) == 0u) { if (xb_ld(&bar[XB_TMO])) break; if (sp > XB_SPIN_CAP) { atomicAdd(&bar[XB_TMO], 1u); break; } }
    }
    nloc = mine > 0u ? mine : 1u; nx = cnt > 0u ? cnt : 1u;
}
__device__ __forceinline__ void xcd_barrier(const XcdBarrier& b) {
    asm volatile("s_waitcnt vmcnt(0)" ::: "memory");
    __syncthreads();
    if (threadIdx.x == 0) {
        unsigned* bar = b.bar;
        __builtin_amdgcn_s_waitcnt(0);
        unsigned nloc = b.st[0], nx = b.st[1];
        if (nloc == 0u) { xcd_barrier_complete(bar, b.x, nloc, nx); b.st[0] = nloc; b.st[1] = nx; }
        const unsigned old = xb_add(&bar[XB_XSUB(b.x)], 1u);
        const unsigned gen = old / nloc;
        if (old + 1u == (gen + 1u) * nloc) {
            __builtin_amdgcn_fence(__ATOMIC_RELEASE, "agent");
            asm volatile("s_waitcnt vmcnt(0)" ::: "memory");
            const unsigned og = xb_add(&bar[XB_TOP], 1u);
            const unsigned tg = og / nx;
            if (og + 1u == (tg + 1u) * nx) xb_add(&bar[XB_TOPGEN], 1u);
            else XB_SPIN(xb_ld(&bar[XB_TOPGEN]) == tg, bar);
            __builtin_amdgcn_fence(__ATOMIC_ACQUIRE, "agent");
            xb_add(&bar[XB_XGEN(b.x)], 1u);
            asm volatile("s_waitcnt vmcnt(0)" ::: "memory");
        } else {
            XB_SPIN(xb_ld(&bar[XB_XGEN(b.x)]) == gen, bar);
            __builtin_amdgcn_fence(__ATOMIC_ACQUIRE, "agent");
            asm volatile("s_waitcnt vmcnt(0)" ::: "memory");
        }
    }
    __syncthreads();
}

constexpr int NPHASE = 14;
constexpr int LDS_BYTES = 131072 + 16;
__global__ void __launch_bounds__(512, 2) mk_fwd(Params p, int ph_lo, int ph_hi) {
    extern __shared__ __attribute__((aligned(16))) unsigned char shm[];
    LAS unsigned char* lds = (LAS unsigned char*)shm;
    cg::grid_group grid = cg::this_grid();
    if (threadIdx.x == 0) { *(LAS u32x4*)(lds + 131072) = (u32x4){0u, 0u, 0u, 0u}; }
    __syncthreads();
    const XcdBarrier xb = xcd_barrier_post((unsigned*)(p.ws + WS_BAR), (volatile LAS unsigned*)(lds + 131072));
    for (int ph2 = ph_lo * 2; ph2 < ph_hi * 2; ++ph2) {
        const int ph = ph2 >> 1; const bool dry = !(ph2 & 1);
        if (dry && !((REP_MASK >> ph) & 1)) continue;
        int tid = threadIdx.x; asm volatile("" : "+v"(tid));
        if (ph == 0) {
            convert_set(p, 0, lds, tid, 0, 0, 1408);
            bf16_t* wt = (bf16_t*)(p.ws + WS_WRG);
            for (int o = blockIdx.x * 512 + tid; o < 2 * 65536; o += gridDim.x * 512) { const int g = o >> 16, h = (o >> 12) & 15, j = (o >> 6) & 63, i = o & 63;
                wt[o] = f2bf((g ? p.in[20] : p.in[18])[(size_t)(h * 64 + i) * 64 + j]); }
            if (blockIdx.x * 512 + tid < D) { const int ch = blockIdx.x * 512 + tid; ((float*)(p.ws + WS_LC))[ch] = -8.0f * log1pf(expf(-p.in[22][ch])); }
            for (int e = blockIdx.x * 512 + tid; e < NS * D; e += gridDim.x * 512) {
                const int sm = e >> 10, c = e & 1023;
                const float t0 = p.in[3][((size_t)sm * 3 + 0) * D + c], t1 = p.in[3][((size_t)sm * 3 + 1) * D + c], t2 = p.in[3][((size_t)sm * 3 + 2) * D + c];
                const float a0 = p.in[2][((size_t)sm * 2 + 0) * D + c], a1 = p.in[2][((size_t)sm * 2 + 1) * D + c];
                ((float*)(p.ws + WS_PCB))[e] = p.in[16][c] * t0 + p.in[16][D + c] * t1 + p.in[16][2 * D + c] * t2 + p.in[17][c];
                ((float*)(p.ws + WS_PCA))[e] = p.in[14][c] * a0 + p.in[14][D + c] * a1;
                p.out[O_CBS + ((size_t)sm * 3 + 0) * D + c] = t1; p.out[O_CBS + ((size_t)sm * 3 + 1) * D + c] = t2;
                p.out[O_CAS + ((size_t)sm * 2 + 0) * D + c] = a1;
            }
            norm_phase(p, 0, tid, dry, 0);
        } else if (ph == 1 || ph == 11) {
            pg8::Gemm g{(const bf16_t*)(p.ws + WS_H), (const bf16_t*)(p.ws + WS_WGU), M, 2 * DFF, D, 0, 0};
            pg8::StaticOrder S; S.init(M, 2 * DFF, D, gridDim.x, blockIdx.x);
            pg8::EpiGU E{(bf16_t*)(p.ws + WS_ACT), dry};
            pg8::gemm_phase(lds, g, S, E);
            if (!dry && ph == 1) { convert_set(p, 0, lds, tid, 150, 1408, 2112); convert_set(p, 2, lds, tid, 150, 0, 1088); }
        } else if (ph == 2 || ph == 12 || ph == 9 || ph == 7) {
            const bool dn = (ph == 2 || ph == 12), oab = (ph == 7);
            pg8::Gemm g{dn ? (const bf16_t*)(p.ws + WS_ACT) : (oab ? (const bf16_t*)(p.ws + WS_U) : (const bf16_t*)p.out), (const bf16_t*)(p.ws + (dn ? WS_WD : (oab ? WS_WOAB : WS_WO))), M, D, dn ? DFF : D, SB, (size_t)1024 * 1024 * 2};
            pg8::SplitOrder S; S.init(oab ? 2 * D : D, dn ? DFF : D, gridDim.x, blockIdx.x, dn ? 11 : 4, 4);
            pg8::EpiBF E{(bf16_t*)(p.ws + (oab ? WS_U + 2 * SB : WS_Y)), SLOT, (bf16_t*)(p.ws + (oab ? WS_POAB : WS_PY)), oab ? 2 : 1};
            pg8::gemm_phase(lds, g, S, E);
            if (!dry && ph == 2) convert_set(p, 2, lds, tid, 44, 1088, 1 << 30);
            if (!dry && ph == 9) convert_set(p, 1, lds, tid, 16, 0, 1 << 30);
        } else if (ph == 3) {
            norm_phase(p, 1, tid, dry, 11);
        } else if (ph == 4) {
            pg8::Gemm g{(const bf16_t*)(p.ws + WS_H), (const bf16_t*)(p.ws + WS_WIN), M, DIN, D, 0, 0};
            pg8::StaticOrder S; S.init(M, DIN, D, gridDim.x, blockIdx.x);
            pg8::EpiIN E{(bf16_t*)(p.ws + WS_U)};
            pg8::gemm_phase(lds, g, S, E);
        } else if (ph == 5) {
            scan_phase(p, lds, tid, dry);
        } else if (ph == 6) {
            fix_phase(p, lds, tid, dry);
            za_phase(p, tid, dry);
        } else if (ph == 8) {
            merge_phase(p, tid);
        } else if (ph == 10) {
            norm_phase(p, 2, tid, dry, 4);
        } else if (ph == 13) {
            norm_phase(p, 3, tid, dry, 11);
        }
        if (ph2 + 1 < ph_hi * 2) { if (ph_hi > NPHASE) grid.sync(); else xcd_barrier(xb); }
    }
}

extern "C" void kernel_launch(void* const* d_in, const int* in_sizes, int n_in, void* d_out, int out_size, void* d_ws, size_t ws_size, hipStream_t stream) {
    if (n_in != 30 || ws_size < WS_END) { fprintf(stderr, "kernel_launch: unexpected n_in %d / ws_size %zu (need %zu)\n", n_in, ws_size, (size_t)WS_END); return; }
    Params p{};
    for (int i = 0; i < 30; ++i) p.in[i] = (const float*)d_in[i];
    p.out = (float*)d_out; p.ws = (unsigned char*)d_ws;
    (void)hipFuncSetAttribute((const void*)mk_fwd, hipFuncAttributeMaxDynamicSharedMemorySize, LDS_BYTES);
    static int grid_blocks = 0;
    if (!grid_blocks) {
        int dev = 0, cus = 0, per_cu = 0;
        (void)hipGetDevice(&dev);
        (void)hipDeviceGetAttribute(&cus, hipDeviceAttributeMultiprocessorCount, dev);
        (void)hipOccupancyMaxActiveBlocksPerMultiprocessor(&per_cu, (const void*)mk_fwd, 512, LDS_BYTES);
        if (per_cu < 1) { fprintf(stderr, "kernel_launch: occupancy query says %d blocks/CU\n", per_cu); per_cu = 1; }
        grid_blocks = cus;
    }
    (void)hipMemsetAsync((unsigned char*)d_ws + WS_BAR, 0, 16384, stream);
#if SINGLE_LAUNCH
    int lo = 0, hi = NPHASE;
    void* args[] = {&p, &lo, &hi};
    hipError_t e = hipLaunchCooperativeKernel((const void*)mk_fwd, dim3(grid_blocks), dim3(512), args, LDS_BYTES, stream);
    if (e != hipSuccess) fprintf(stderr, "cooperative launch failed: %s (grid %d)\n", hipGetErrorString(e), grid_blocks);
#else
    for (int ph = 0; ph < NPHASE; ++ph) hipLaunchKernelGGL(mk_fwd, dim3(grid_blocks), dim3(512), LDS_BYTES, stream, p, ph, ph + 1);
#endif
}
```

```cpp
#include <hip/hip_runtime.h>
#include <hip/hip_cooperative_groups.h>
#include <cstdio>
namespace cg = cooperative_groups;

#ifndef REP_MASK
#define REP_MASK 0
#endif
#ifndef SINGLE_LAUNCH
#define SINGLE_LAUNCH 1
#endif

#define LAS __attribute__((address_space(3)))
typedef unsigned short bf16_t;
typedef short bf16x8 __attribute__((ext_vector_type(8)));
typedef float f32x4 __attribute__((ext_vector_type(4)));
typedef unsigned u32x4 __attribute__((ext_vector_type(4)));
typedef unsigned u32x2 __attribute__((ext_vector_type(2)));
typedef float f32x2 __attribute__((ext_vector_type(2)));

constexpr int D = 1024, DFF = 2816, DIN = 7168;
constexpr int NB = 8, SEQ = 2048, NMETA = 16, TP = SEQ + NMETA;
constexpr int MP = NB * TP;
constexpr int NS = 128;
constexpr int M = MP + NS;
constexpr int CHUNK = 48, NCH = TP / CHUNK;
constexpr float EPS = 1e-6f;

constexpr size_t O_YP = 0, O_YS = 16777216, O_CAP = O_YS + 131072, O_CBP = O_CAP + 16384, O_RGP = O_CBP + 24576,
                 O_CAS = O_RGP + 8192, O_CBS = O_CAS + 262144, O_RGS = O_CBS + 393216;

constexpr size_t SLOT = (size_t)M * D;
constexpr size_t SB = SLOT * 2;
constexpr size_t WS_U = 0;
constexpr size_t WS_ACT = 0;
constexpr size_t WS_Y = 3 * SB;
constexpr size_t WS_PY = 4 * SB;
constexpr int MAINR = 64 * 256;
constexpr size_t WS_WGU = 5 * SB;
constexpr size_t WS_WD = WS_WGU + (size_t)5632 * 1024 * 2;
constexpr size_t WS_H = 6 * SB;
constexpr size_t WS_WIN = 7 * SB;
constexpr size_t WS_POAB = WS_WIN;
constexpr size_t WS_WOAB = WS_WIN + (size_t)7168 * 1024 * 2;
constexpr size_t WS_WO = WS_WOAB + (size_t)2 * 1024 * 1024 * 2;
constexpr size_t WS_WRG = WS_WO + (size_t)1024 * 1024 * 2;
constexpr size_t WS_SUMM = WS_WRG + (size_t)2 * 16 * 64 * 64 * 2;
constexpr size_t WS_SC = WS_SUMM + (size_t)NB * NCH * D * 2 * 4;
constexpr size_t WS_LC = WS_SC + 98304;
constexpr size_t WS_BAR = WS_SC + 131072;
constexpr size_t WS_PCB = WS_BAR + 16384;
constexpr size_t WS_PCA = WS_PCB + (size_t)NS * D * 4;
constexpr size_t WS_END = WS_PCA + (size_t)NS * D * 4;
static_assert(WS_END <= (size_t)256 * 1024 * 1024, "workspace");

struct Params { const float* in[30]; float* out; unsigned char* ws; };

__device__ __forceinline__ unsigned cvt_pk_bf16(float lo, float hi) { unsigned r; asm volatile("v_cvt_pk_bf16_f32 %0, %1, %2" : "=v"(r) : "v"(lo), "v"(hi)); return r; }
__device__ __forceinline__ bf16_t f2bf(float f) { return (bf16_t)(cvt_pk_bf16(f, 0.f) & 0xffffu); }
__device__ __forceinline__ float bf2f(bf16_t b) { return __uint_as_float(((unsigned)b) << 16); }
__device__ __forceinline__ float bflo(unsigned w) { return __uint_as_float(w << 16); }
__device__ __forceinline__ float bfhi(unsigned w) { return __uint_as_float(w & 0xffff0000u); }
__device__ __forceinline__ float sigm(float x) { return __builtin_amdgcn_rcpf(1.0f + __expf(-x)); }
__device__ __forceinline__ float gelu_tanh(float x) { const float t = 1.5957691216057308f * (x + 0.044715f * x * x * x); return x * sigm(t); }
__device__ __forceinline__ float wave_sum(float v, int lane) {
#pragma unroll
    for (int o = 32; o >= 1; o >>= 1) v += __int_as_float(__builtin_amdgcn_ds_bpermute((lane ^ o) << 2, __float_as_int(v)));
    return v;
}
__device__ __forceinline__ const float* x0row(const Params& p, int r) {
    if (r >= MP) return p.in[1] + (size_t)(r - MP) * D;
    const int b = r / TP, t = r - b * TP;
    if (t < NMETA) return p.in[5] + (size_t)t * D;
    return p.in[0] + ((size_t)b * SEQ + (t - NMETA)) * D;
}

namespace pg8 {
constexpr int BM = 256, BK = 64, HALF = 128, HTB = HALF * BK * 2, STAGE_BYTES = 8 * HTB, NXCD = 8, WGM = 8;
__host__ __device__ __forceinline__ int lds_byte(int r, int c) { const int st = (r >> 4) * 2 + (c >> 5), rr = r & 15, cc = c & 31, ob = rr * 64 + cc * 2; return st * 1024 + (ob ^ (((ob >> 9) & 1) << 5)); }
__host__ __device__ __forceinline__ void stage_rc(int b, int& R, int& C) { const int st = b / 1024, sb = b % 1024, swz = sb ^ (((sb >> 9) & 1) << 5); R = (st >> 1) * 16 + swz / 64; C = (st & 1) * 32 + (swz % 64) / 2; }
__host__ __device__ __forceinline__ int perm32(int rho) { const int n = rho >> 4, i = rho & 15; return 8 * (i >> 2) + 4 * n + (i & 3); }

struct Unit { int pm, pn, z, k0, nk, part; };
struct Gemm { const bf16_t* A; const bf16_t* Bt; int M, N, K; size_t zA, zB; };

struct StaticOrder {
    int nM, nN, nwg, G, c, ntf;
    __device__ void init(int M_, int N_, int K_, int G_, int c_) { nM = M_ / BM; nN = N_ / BM; nwg = nM * nN; G = G_; c = c_; ntf = K_ / BK; }
    __device__ bool map(long L, Unit& u) const {
        if (L >= nwg) return false;
        int wgid = (int)L; { const int q = nwg / NXCD, r = nwg % NXCD, xcd = wgid % NXCD, off = wgid / NXCD; wgid = (xcd < r ? xcd * (q + 1) : r * (q + 1) + (xcd - r) * q) + off; }
        const int nig = WGM * nN, gid = wgid / nig, fm = gid * WGM, gsz = (nM - fm) < WGM ? (nM - fm) : WGM;
        u.pm = fm + ((wgid % nig) % gsz); u.pn = (wgid % nig) / gsz; u.z = 0; u.k0 = 0; u.nk = ntf; u.part = -1; return true;
    }
    __device__ bool next(int i, Unit& u) const { return map((long)i * G + c, u); }
};
struct SplitOrder : StaticOrder {
    int nsplit, nkm;
    __device__ void init(int N_, int K_, int G_, int c_, int nsplit_, int nkm_) { StaticOrder::init(64 * BM, N_, K_, G_, c_); nsplit = nsplit_; nkm = nkm_; }
    __device__ bool next(int i, Unit& u) const {
        const long L = (long)i * G + c; bool ok;
        if (L < nwg) ok = map(L, u);
        else { const int L2 = (int)(L - nwg); ok = L2 < nN * nsplit; const int ks = L2 / nN; u.pm = 64; u.pn = L2 - ks * nN; u.k0 = ks * nkm; u.nk = nkm; u.part = ks; }
        u.z = u.pn >> 2; u.pn &= 3; return ok;
    }
};

template <class Epi, class Sched>
__device__ __forceinline__ void gemm_phase(LAS unsigned char* lds, const Gemm g, const Sched& S, const Epi& E) {
    int tid_ = threadIdx.x; asm volatile("" : "+v"(tid_));
    const int tid = tid_, wid = __builtin_amdgcn_readfirstlane(tid >> 6), lane = tid & 63, wr = wid >> 2, wc = wid & 3, fr = lane & 15, fq = lane >> 4;
    const int K = g.K;
    unsigned voffA[2], voffB[2];
#pragma unroll
    for (int i = 0; i < 2; ++i) { int R, C; stage_rc(tid * 16 + i * 8192, R, C); const int Rb = Epi::PERM ? ((R & ~31) + perm32(R & 31)) : R;
        voffA[i] = (unsigned)(R * K + C) * 2u; voffB[i] = (unsigned)(Rb * K + C) * 2u; }
    const size_t kstep = (size_t)(BK * 2);
    const size_t hstep = (size_t)HALF * K * 2;
    const size_t tstep = 2 * hstep;
    const unsigned ldsw = (unsigned)wid * 1024u;
    const int aoff = lds_byte(wr * 64 + fr, fq * 8), boff = lds_byte(wc * 32 + fr, fq * 8);
#define PG8_SA(b, h) (((b) * 2 + (h)) * HTB)
#define PG8_SB(b, h) ((4 + (b) * 2 + (h)) * HTB)
#define PG8_STAGE(bufoff, gbase, voff) do { _Pragma("unroll") for (int _i = 0; _i < 2; ++_i) \
        __builtin_amdgcn_global_load_lds((const unsigned*)((const char*)(gbase) + (voff)[_i]), (LAS unsigned*)(lds + (bufoff) + ldsw + _i * 8192), 16, 0, 0); } while (0)
#define PG8_LDA(dst, b, h) do { _Pragma("unroll") for (int m = 0; m < 4; ++m) _Pragma("unroll") for (int k = 0; k < 2; ++k) dst[m][k] = *(const LAS bf16x8*)(lds + PG8_SA(b, h) + aoff + m * 2048 + k * 1024); } while (0)
#define PG8_LDB(dst, b, h) do { _Pragma("unroll") for (int n = 0; n < 2; ++n) _Pragma("unroll") for (int k = 0; k < 2; ++k) dst[n][k] = *(const LAS bf16x8*)(lds + PG8_SB(b, h) + boff + n * 2048 + k * 1024); } while (0)
#define PG8_MMA(ai, bj, At, Bt) do { __builtin_amdgcn_s_setprio(1); _Pragma("unroll") for (int m = 0; m < 4; ++m) _Pragma("unroll") for (int n = 0; n < 2; ++n) _Pragma("unroll") for (int k = 0; k < 2; ++k) \
        acc[ai][bj][m][n] = __builtin_amdgcn_mfma_f32_16x16x32_bf16(Bt[n][k], At[m][k], acc[ai][bj][m][n], 0, 0, 0); __builtin_amdgcn_s_setprio(0); } while (0)
#define PG8_WAIT_V(n) asm volatile("s_waitcnt vmcnt(" #n ")" ::: "memory")
#define PG8_WAIT_L(n) asm volatile("s_waitcnt lgkmcnt(" #n ")" ::: "memory")
#define PG8_BAR __builtin_amdgcn_s_barrier()
#define PG8_SCHED __builtin_amdgcn_sched_barrier(0)
    Unit cur, nxt; int ui = 0;
    if (!S.next(0, cur)) return;
    f32x4 acc[2][2][4][2];
#pragma unroll
    for (int a = 0; a < 2; ++a)
#pragma unroll
        for (int b = 0; b < 2; ++b)
#pragma unroll
            for (int m = 0; m < 4; ++m)
#pragma unroll
                for (int n = 0; n < 2; ++n) acc[a][b][m][n] = (f32x4){0.f, 0.f, 0.f, 0.f};
    bf16x8 At[4][2], B0[2][2], B1[2][2];
    const char* cA = (const char*)g.A + (size_t)cur.z * g.zA + (size_t)cur.pm * tstep + (size_t)cur.k0 * kstep; const char* cB = (const char*)g.Bt + (size_t)cur.z * g.zB + (size_t)cur.pn * tstep + (size_t)cur.k0 * kstep;
    int nt = cur.nk;
    PG8_STAGE(PG8_SB(0, 0), cB, voffB); PG8_STAGE(PG8_SA(0, 0), cA, voffA); PG8_STAGE(PG8_SB(0, 1), cB + hstep, voffB); PG8_STAGE(PG8_SA(0, 1), cA + hstep, voffA);
    if (wr == 1) PG8_BAR;
    PG8_WAIT_V(4); PG8_BAR;
    PG8_STAGE(PG8_SB(1, 0), cB + kstep, voffB); PG8_STAGE(PG8_SA(1, 0), cA + kstep, voffA); PG8_STAGE(PG8_SB(1, 1), cB + hstep + kstep, voffB);
    PG8_WAIT_V(6); PG8_BAR;
    for (;;) {
        const bool has_next = S.next(ui + 1, nxt);
        const char* nA = has_next ? (const char*)g.A + (size_t)nxt.z * g.zA + (size_t)nxt.pm * tstep + (size_t)nxt.k0 * kstep : cA; const char* nB = has_next ? (const char*)g.Bt + (size_t)nxt.z * g.zB + (size_t)nxt.pn * tstep + (size_t)nxt.k0 * kstep : cB;
        for (int t = 0; t < nt; t += 2) {
            const bool last = (t == nt - 2);
            const char* a1 = cA + (size_t)(t + 1) * kstep;
            const char* a2 = last ? nA : cA + (size_t)(t + 2) * kstep; const char* b2 = last ? nB : cB + (size_t)(t + 2) * kstep;
            const char* a3 = a2 + kstep; const char* b3 = b2 + kstep;
            PG8_LDB(B0, 0, 0); PG8_SCHED; PG8_LDA(At, 0, 0); PG8_STAGE(PG8_SA(1, 1), a1 + hstep, voffA);
            PG8_WAIT_L(8); PG8_BAR; PG8_WAIT_L(0); PG8_MMA(0, 0, At, B0); PG8_BAR; PG8_SCHED;
            PG8_LDB(B1, 0, 1); PG8_STAGE(PG8_SB(0, 0), b2, voffB);
            PG8_BAR; PG8_WAIT_L(0); PG8_MMA(0, 1, At, B1); PG8_BAR;
            PG8_LDA(At, 0, 1); PG8_STAGE(PG8_SA(0, 0), a2, voffA);
            PG8_BAR; PG8_WAIT_L(0); PG8_MMA(1, 0, At, B0); PG8_BAR; PG8_SCHED;
            PG8_STAGE(PG8_SB(0, 1), b2 + hstep, voffB);
            PG8_WAIT_V(6); PG8_BAR; PG8_MMA(1, 1, At, B1); PG8_BAR;
            PG8_LDB(B0, 1, 0); PG8_SCHED; PG8_LDA(At, 1, 0); PG8_STAGE(PG8_SA(0, 1), a2 + hstep, voffA);
            PG8_WAIT_L(8); PG8_BAR; PG8_WAIT_L(0); PG8_MMA(0, 0, At, B0); PG8_BAR; PG8_SCHED;
            PG8_LDB(B1, 1, 1); PG8_STAGE(PG8_SB(1, 0), b3, voffB);
            PG8_BAR; PG8_WAIT_L(0); PG8_MMA(0, 1, At, B1); PG8_BAR;
            PG8_LDA(At, 1, 1); PG8_STAGE(PG8_SA(1, 0), a3, voffA);
            PG8_BAR; PG8_WAIT_L(0); PG8_MMA(1, 0, At, B0); PG8_BAR; PG8_SCHED;
            PG8_STAGE(PG8_SB(1, 1), b3 + hstep, voffB);
            PG8_WAIT_V(6); PG8_BAR; PG8_MMA(1, 1, At, B1); PG8_BAR;
        }
        E(acc, cur, wr, wc, fr, fq);
        if (!has_next) break;
#pragma unroll
        for (int a = 0; a < 2; ++a)
#pragma unroll
            for (int b = 0; b < 2; ++b)
#pragma unroll
                for (int m = 0; m < 4; ++m)
#pragma unroll
                    for (int n = 0; n < 2; ++n) acc[a][b][m][n] = (f32x4){0.f, 0.f, 0.f, 0.f};
        cur = nxt; cA = nA; cB = nB; nt = cur.nk; ++ui;
    }
    PG8_WAIT_V(0);
    if (wr == 0) PG8_BAR;
    PG8_BAR;
#undef PG8_SA
#undef PG8_SB
#undef PG8_STAGE
#undef PG8_LDA
#undef PG8_LDB
#undef PG8_MMA
#undef PG8_WAIT_V
#undef PG8_WAIT_L
#undef PG8_BAR
#undef PG8_SCHED
}

struct EpiBF {
    static constexpr bool PERM = true;
    bf16_t* O; size_t zO; bf16_t* P; int nz;
    __device__ __forceinline__ void operator()(const f32x4 (&acc)[2][2][4][2], const Unit& u, int wr, int wc, int fr, int fq) const {
        const int col0 = u.pn * BM + wc * 32 + 8 * fq;
        const int row0 = (u.part < 0 ? u.pm * BM : 0) + wr * 64 + fr;
        bf16_t* base = u.part < 0 ? O + (size_t)u.z * zO : P + (size_t)(u.part * nz + u.z) * (BM * D);
#pragma unroll
        for (int ai = 0; ai < 2; ++ai)
#pragma unroll
            for (int m = 0; m < 4; ++m) { bf16_t* rowp = base + (size_t)(row0 + ai * HALF + m * 16) * D + col0;
#pragma unroll
                for (int bj = 0; bj < 2; ++bj) { const f32x4 v0 = acc[ai][bj][m][0], v1 = acc[ai][bj][m][1];
                    u32x4 w; w.x = cvt_pk_bf16(v0[0], v0[1]); w.y = cvt_pk_bf16(v0[2], v0[3]); w.z = cvt_pk_bf16(v1[0], v1[1]); w.w = cvt_pk_bf16(v1[2], v1[3]);
                    *(u32x4*)(rowp + bj * HALF) = w; } }
    }
};
struct EpiGU {
    static constexpr bool PERM = true;
    bf16_t* O; bool dry;
    __device__ __forceinline__ void operator()(const f32x4 (&acc)[2][2][4][2], const Unit& u, int wr, int wc, int fr, int fq) const {
        if (dry) return;
        const int row0 = u.pm * BM + wr * 64 + fr, col0 = u.pn * HALF + wc * 32 + 8 * fq;
#pragma unroll
        for (int ai = 0; ai < 2; ++ai)
#pragma unroll
            for (int m = 0; m < 4; ++m) { bf16_t* rowp = O + (size_t)(row0 + ai * HALF + m * 16) * DFF + col0;
                unsigned wv[4];
#pragma unroll
                for (int n = 0; n < 2; ++n)
#pragma unroll
                    for (int jp = 0; jp < 2; ++jp) {
                        const f32x2 gt = {acc[ai][0][m][n][2 * jp], acc[ai][0][m][n][2 * jp + 1]}, up = {acc[ai][1][m][n][2 * jp], acc[ai][1][m][n][2 * jp + 1]};
                        const f32x2 t = gt * (-1.44269504089f);
                        f32x2 e; e.x = __builtin_amdgcn_exp2f(t.x); e.y = __builtin_amdgcn_exp2f(t.y);
                        const f32x2 d = e + 1.0f;
                        f32x2 r; r.x = __builtin_amdgcn_rcpf(d.x); r.y = __builtin_amdgcn_rcpf(d.y);
                        const f32x2 o = (gt * up) * r;
                        wv[n * 2 + jp] = cvt_pk_bf16(o.x, o.y);
                    }
                u32x4 w; w.x = wv[0]; w.y = wv[1]; w.z = wv[2]; w.w = wv[3];
                *(u32x4*)rowp = w; }
    }
};
struct EpiIN {
    static constexpr bool PERM = true;
    bf16_t* U;
    __device__ __forceinline__ void operator()(const f32x4 (&acc)[2][2][4][2], const Unit& u, int wr, int wc, int fr, int fq) const {
        const int row0 = u.pm * BM + wr * 64 + fr;
        if (u.pn >= 4 && u.pn < 12) {
            const int col0 = (u.pn - 4) * HALF + wc * 32 + 8 * fq; bf16_t* base = U + 2 * SLOT;
#pragma unroll
            for (int ai = 0; ai < 2; ++ai)
#pragma unroll
                for (int m = 0; m < 4; ++m) { bf16_t* rowp = base + (size_t)(row0 + ai * HALF + m * 16) * D + col0;
                    const f32x4 v0 = acc[ai][0][m][0] * acc[ai][1][m][0], v1 = acc[ai][0][m][1] * acc[ai][1][m][1];
                    u32x4 w; w.x = cvt_pk_bf16(v0[0], v0[1]); w.y = cvt_pk_bf16(v0[2], v0[3]); w.z = cvt_pk_bf16(v1[0], v1[1]); w.w = cvt_pk_bf16(v1[2], v1[3]);
                    *(u32x4*)rowp = w; }
        } else {
            int slot, ct; if (u.pn < 4) { slot = 0; ct = u.pn; } else { const int sg = (u.pn - 12) >> 2; slot = sg == 0 ? 3 : (sg == 1 ? 1 : sg + 2); ct = (u.pn - 12) & 3; }
            const int col0 = ct * BM + wc * 32 + 8 * fq; bf16_t* base = U + (size_t)slot * SLOT;
#pragma unroll
            for (int ai = 0; ai < 2; ++ai)
#pragma unroll
                for (int m = 0; m < 4; ++m) { bf16_t* rowp = base + (size_t)(row0 + ai * HALF + m * 16) * D + col0;
#pragma unroll
                    for (int bj = 0; bj < 2; ++bj) { const f32x4 v0 = acc[ai][bj][m][0], v1 = acc[ai][bj][m][1];
                        u32x4 w; w.x = cvt_pk_bf16(v0[0], v0[1]); w.y = cvt_pk_bf16(v0[2], v0[3]); w.z = cvt_pk_bf16(v1[0], v1[1]); w.w = cvt_pk_bf16(v1[2], v1[3]);
                        *(u32x4*)(rowp + bj * HALF) = w; } }
        }
    }
};
}

__device__ __forceinline__ int conv_map(int mode, int n) {
    if (mode == 0) return n;
    if (mode == 1) return 256 * (n >> 7) + (n & 127);
    if (mode == 2) return 256 * (n >> 7) + 128 + (n & 127);
    const int seg = n >> 10, j = n & 1023;
    if (seg == 0) return j;
    if (seg == 1) return 1024 + 256 * (j >> 7) + (j & 127);
    if (seg == 2) return 1024 + 256 * (j >> 7) + 128 + (j & 127);
    return 3072 + (seg - 3) * 1024 + j;
}
struct ConvE { const float* src; bf16_t* dst; const float* gk; int K, N, mode, t; };
__device__ __forceinline__ bool conv_decode(const Params& p, int set, int T, ConvE& e) {
    if (set < 2) {
        const int a = set ? 27 : 8; const float* gk = p.in[set ? 25 : 6];
        if (T < 704)       { e.src = p.in[a];     e.dst = (bf16_t*)(p.ws + WS_WGU); e.gk = gk;      e.K = 1024; e.N = 2816; e.mode = 1; e.t = T; }
        else if (T < 1408) { e.src = p.in[a + 1]; e.dst = (bf16_t*)(p.ws + WS_WGU); e.gk = gk;      e.K = 1024; e.N = 2816; e.mode = 2; e.t = T - 704; }
        else if (T < 2112) { e.src = p.in[a + 2]; e.dst = (bf16_t*)(p.ws + WS_WD);  e.gk = nullptr; e.K = 2816; e.N = 1024; e.mode = 0; e.t = T - 1408; }
        else return false;
    } else {
        if (T < 1792)      { e.src = p.in[13]; e.dst = (bf16_t*)(p.ws + WS_WIN); e.gk = p.in[11]; e.K = 1024; e.N = 7168; e.mode = 3; e.t = T; }
        else if (T < 2048) { e.src = p.in[15]; e.dst = (bf16_t*)(p.ws + WS_WOAB); e.gk = nullptr; e.K = 1024; e.N = 1024; e.mode = 0; e.t = T - 1792; }
        else if (T < 2304) { e.src = p.in[23]; e.dst = (bf16_t*)(p.ws + WS_WOAB + (size_t)1024 * 1024 * 2); e.gk = nullptr; e.K = 1024; e.N = 1024; e.mode = 0; e.t = T - 2048; }
        else if (T < 2560) { e.src = p.in[24]; e.dst = (bf16_t*)(p.ws + WS_WO);  e.gk = nullptr;  e.K = 1024; e.N = 1024; e.mode = 0; e.t = T - 2304; }
        else return false;
    }
    return true;
}
__device__ __forceinline__ void conv_load(const ConvE& e, int tid, f32x4& v0, f32x4& v1) {
    const int ntn = e.N >> 6; const int tk = e.t / ntn, tn = e.t - tk * ntn;
    const float* s0 = e.src + (size_t)(tk * 64 + (tid >> 4)) * e.N + tn * 64 + (tid & 15) * 4;
    v0 = __builtin_nontemporal_load((const f32x4*)s0); v1 = __builtin_nontemporal_load((const f32x4*)(s0 + (size_t)32 * e.N));
}
__device__ __forceinline__ void conv_emit(const ConvE& e, int tid, const f32x4& v0, const f32x4& v1, LAS float* sl) {
    const int ntn = e.N >> 6; const int tk = e.t / ntn, tn = e.t - tk * ntn; const int k0 = tk * 64, n0 = tn * 64;
    { LAS float* d = sl + (tid >> 4) * 65 + (tid & 15) * 4; d[0] = v0[0]; d[1] = v0[1]; d[2] = v0[2]; d[3] = v0[3]; d += 32 * 65; d[0] = v1[0]; d[1] = v1[1]; d[2] = v1[2]; d[3] = v1[3]; }
    __syncthreads();
    const int n = tid >> 3, ko = (tid & 7) * 8;
    float f[8];
#pragma unroll
    for (int i = 0; i < 8; ++i) f[i] = sl[(ko + i) * 65 + n];
    if (e.gk) {
        const f32x4 g0 = *(const f32x4*)(e.gk + k0 + ko), g1 = *(const f32x4*)(e.gk + k0 + ko + 4);
#pragma unroll
        for (int i = 0; i < 4; ++i) { f[i] *= g0[i]; f[4 + i] *= g1[i]; }
    }
    u32x4 w; w.x = cvt_pk_bf16(f[0], f[1]); w.y = cvt_pk_bf16(f[2], f[3]); w.z = cvt_pk_bf16(f[4], f[5]); w.w = cvt_pk_bf16(f[6], f[7]);
    *(u32x4*)(e.dst + (size_t)conv_map(e.mode, n0 + n) * e.K + k0 + ko) = w;
    __syncthreads();
}
__device__ __forceinline__ void convert_set(const Params& p, int set, LAS unsigned char* lds, int tid, int skip, int T0, int T1) {
    ConvE e, en; f32x4 v0, v1, n0 = {0.f, 0.f, 0.f, 0.f}, n1 = {0.f, 0.f, 0.f, 0.f};
    if ((int)blockIdx.x < skip) return;
    int T = T0 + (int)blockIdx.x - skip; const int stride = gridDim.x - skip;
    bool have = T < T1 && conv_decode(p, set, T, e);
    if (have) conv_load(e, tid, v0, v1);
    while (have) {
        T += stride;
        const bool hn = T < T1 && conv_decode(p, set, T, en);
        if (hn) conv_load(en, tid, n0, n1);
        conv_emit(e, tid, v0, v1, (LAS float*)lds);
        e = en; v0 = n0; v1 = n1; have = hn;
    }
}

__device__ __forceinline__ void norm_phase(const Params& p, int mode, int tid, bool dry, int nsplit) {
    const int lane = tid & 63, gw = blockIdx.x * 8 + (tid >> 6), nw = gridDim.x * 8;
    const float* gpost = mode == 1 ? p.in[7] : (mode == 2 ? p.in[12] : p.in[26]);
    const float cc = mode == 2 ? 1.0f : 0.5f;
    const bf16_t* Yb = (const bf16_t*)(p.ws + WS_Y); const bf16_t* PY = (const bf16_t*)(p.ws + WS_PY); bf16_t* H = (bf16_t*)(p.ws + WS_H); float* SC = (float*)(p.ws + WS_SC);
    for (int r = gw; r < M; r += nw) {
        f32x4 xv[4];
        if (mode == 0) {
            const float* xin = x0row(p, r);
#pragma unroll
            for (int q = 0; q < 4; ++q) xv[q] = __builtin_nontemporal_load((const f32x4*)(xin + lane * 4 + 256 * q));
        } else {
            const float sc = SC[r];
#pragma unroll
            for (int q = 0; q < 4; ++q) { const u32x2 w = *(const u32x2*)(H + (size_t)r * D + lane * 4 + 256 * q); xv[q] = (f32x4){bflo(w.x), bfhi(w.x), bflo(w.y), bfhi(w.y)} * sc; }
            f32x4 yv[4]; float ss = 0.f;
            if (r < MAINR) {
#pragma unroll
                for (int q = 0; q < 4; ++q) { const u32x2 w = *(const u32x2*)(Yb + (size_t)r * D + lane * 4 + 256 * q); yv[q] = (f32x4){bflo(w.x), bfhi(w.x), bflo(w.y), bfhi(w.y)}; }
            } else {
#pragma unroll
                for (int q = 0; q < 4; ++q) yv[q] = (f32x4){0.f, 0.f, 0.f, 0.f};
                for (int ks0 = 0; ks0 < nsplit; ks0 += 4) {
                    f32x4 pv[4][4];
#pragma unroll
                    for (int k = 0; k < 4; ++k) { const int ks = (ks0 + k < nsplit) ? ks0 + k : ks0;
#pragma unroll
                        for (int q = 0; q < 4; ++q) { const u32x2 w = *(const u32x2*)(PY + ((size_t)ks * 256 + (r - MAINR)) * D + lane * 4 + 256 * q); pv[k][q] = (f32x4){bflo(w.x), bfhi(w.x), bflo(w.y), bfhi(w.y)}; } }
#pragma unroll
                    for (int k = 0; k < 4; ++k) { const float m = (ks0 + k < nsplit) ? 1.0f : 0.0f;
#pragma unroll
                        for (int q = 0; q < 4; ++q) yv[q] += pv[k][q] * m; }
                }
            }
#pragma unroll
            for (int q = 0; q < 4; ++q) ss += yv[q][0] * yv[q][0] + yv[q][1] * yv[q][1] + yv[q][2] * yv[q][2] + yv[q][3] * yv[q][3];
            ss = wave_sum(ss, lane);
            const float rs = cc * rsqrtf(ss * (1.0f / D) + EPS);
#pragma unroll
            for (int q = 0; q < 4; ++q) xv[q] += yv[q] * rs * *(const f32x4*)(gpost + lane * 4 + 256 * q);
        }
        if (mode == 3) {
            float* xo;
            if (r >= MP) xo = p.out + O_YS + (size_t)(r - MP) * D;
            else { const int b = r / TP, t = r - b * TP; if (t < NMETA) continue; xo = p.out + O_YP + ((size_t)b * SEQ + (t - NMETA)) * D; }
#pragma unroll
            for (int q = 0; q < 4; ++q) *(f32x4*)(xo + lane * 4 + 256 * q) = xv[q];
        } else {
            float ss = 0.f;
#pragma unroll
            for (int q = 0; q < 4; ++q) ss += xv[q][0] * xv[q][0] + xv[q][1] * xv[q][1] + xv[q][2] * xv[q][2] + xv[q][3] * xv[q][3];
            ss = wave_sum(ss, lane);
            const float ms = ss * (1.0f / D) + EPS; const float rs = rsqrtf(ms);
            if (!dry) {
#pragma unroll
                for (int q = 0; q < 4; ++q) { const f32x4 hv = xv[q] * rs; u32x2 w; w.x = cvt_pk_bf16(hv[0], hv[1]); w.y = cvt_pk_bf16(hv[2], hv[3]);
                    *(u32x2*)(H + (size_t)r * D + lane * 4 + 256 * q) = w; }
                if (lane == 0) SC[r] = ms * rs;
            }
        }
    }
}

constexpr int WL_BYTES = 11264;
__device__ __forceinline__ void scan_item(const Params& p, int b, int j, int h, LAS unsigned char* wl, const LAS unsigned char* wlds, int lane, bool dry) {
    bf16_t* U = (bf16_t*)(p.ws + WS_U);
    const bf16_t* bx = U + 3 * SLOT; bf16_t* bg = U + 1 * SLOT; bf16_t* pp = (bf16_t*)p.out;
    float* summ = (float*)(p.ws + WS_SUMM);
    const int c = h * 64 + lane, fr = lane & 15, fq = lane >> 4;
    const size_t row0 = (size_t)b * TP + (size_t)j * CHUNK;
    const bf16_t* bx0 = bx + row0 * D; bf16_t* bg0 = bg + row0 * D; bf16_t* pp0 = pp + row0 * D;
    const LAS unsigned char* wq = wlds + fr * 144 + fq * 16;
    float brv[4], biv[4], lcv[4];
#pragma unroll
    for (int nt = 0; nt < 4; ++nt) { const int ch = h * 64 + nt * 16 + fr; brv[nt] = p.in[19][ch]; biv[nt] = p.in[21][ch]; lcv[nt] = ((const float*)(p.ws + WS_LC))[ch]; }
    const float w0 = p.in[16][c], w1 = p.in[16][D + c], w2 = p.in[16][2 * D + c], w3 = p.in[16][3 * D + c], cbias = p.in[17][c];
    float xm3 = 0.f, xm2 = 0.f, xm1 = 0.f;
    if (j > 0) { xm3 = bf2f(bx0[-3 * D + c]); xm2 = bf2f(bx0[-2 * D + c]); xm1 = bf2f(bx0[-1 * D + c]); }
    float hh = 0.f, ap = 1.f;
    LAS unsigned short* cbT = (LAS unsigned short*)wl;
    LAS float* xu = (LAS float*)(wl + 2304);
    LAS float* aS = (LAS float*)(wl + 2304 + 4352);
    bf16_t xr[16], gr[16], xn[16], gn[16];
#pragma unroll
    for (int tt = 0; tt < 16; ++tt) { xr[tt] = bx0[tt * D + c]; gr[tt] = bg0[tt * D + c]; }
#pragma unroll
    for (int g = 0; g < 3; ++g) {
        const int r0 = g * 16;
        if (g < 2) {
#pragma unroll
            for (int tt = 0; tt < 16; ++tt) { xn[tt] = bx0[(r0 + 16 + tt) * D + c]; gn[tt] = bg0[(r0 + 16 + tt) * D + c]; }
        }
#pragma unroll
        for (int tt = 0; tt < 16; ++tt) { const float x = bf2f(xr[tt]); const float cb = w0 * xm3 + w1 * xm2 + w2 * xm1 + w3 * x + cbias; xm3 = xm2; xm2 = xm1; xm1 = x;
            cbT[tt * 72 + lane] = f2bf(cb); xu[tt * 68 + lane] = cb; }
        __builtin_amdgcn_wave_barrier();
        const bf16x8 a0 = *(const LAS bf16x8*)(cbT + fr * 72 + fq * 8), a1 = *(const LAS bf16x8*)(cbT + fr * 72 + 32 + fq * 8);
        f32x4 accR[4], accI[4];
#pragma unroll
        for (int nt = 0; nt < 4; ++nt) {
            const bf16x8 r0w = *(const LAS bf16x8*)(wq + nt * 2304), r1w = *(const LAS bf16x8*)(wq + nt * 2304 + 64);
            const bf16x8 i0w = *(const LAS bf16x8*)(wq + 9216 + nt * 2304), i1w = *(const LAS bf16x8*)(wq + 9216 + nt * 2304 + 64);
            accR[nt] = __builtin_amdgcn_mfma_f32_16x16x32_bf16(a0, r0w, (f32x4){0.f, 0.f, 0.f, 0.f}, 0, 0, 0);
            accR[nt] = __builtin_amdgcn_mfma_f32_16x16x32_bf16(a1, r1w, accR[nt], 0, 0, 0);
            accI[nt] = __builtin_amdgcn_mfma_f32_16x16x32_bf16(a0, i0w, (f32x4){0.f, 0.f, 0.f, 0.f}, 0, 0, 0);
            accI[nt] = __builtin_amdgcn_mfma_f32_16x16x32_bf16(a1, i1w, accI[nt], 0, 0, 0);
        }
#pragma unroll
        for (int nt = 0; nt < 4; ++nt)
#pragma unroll
            for (int ip = 0; ip < 2; ++ip) {
                const int idx0 = (fq * 4 + 2 * ip) * 68 + nt * 16 + fr, idx1 = idx0 + 68;
                const f32x2 tr = ((f32x2){accR[nt][2 * ip], accR[nt][2 * ip + 1]} + brv[nt]) * (-1.44269504089f), ti = ((f32x2){accI[nt][2 * ip], accI[nt][2 * ip + 1]} + biv[nt]) * (-1.44269504089f);
                f32x2 er, ei; er.x = __builtin_amdgcn_exp2f(tr.x); er.y = __builtin_amdgcn_exp2f(tr.y); ei.x = __builtin_amdgcn_exp2f(ti.x); ei.y = __builtin_amdgcn_exp2f(ti.y);
                const f32x2 dr = er + 1.0f, di = ei + 1.0f;
                f32x2 r, ig; r.x = __builtin_amdgcn_rcpf(dr.x); r.y = __builtin_amdgcn_rcpf(dr.y); ig.x = __builtin_amdgcn_rcpf(di.x); ig.y = __builtin_amdgcn_rcpf(di.y);
                const f32x2 la = r * lcv[nt]; const f32x2 tl = la * 1.44269504089f;
                f32x2 a; a.x = __builtin_amdgcn_exp2f(tl.x); a.y = __builtin_amdgcn_exp2f(tl.y);
                const f32x2 z2 = la + la;
                const f32x2 m2s = -z2 * (z2 * (z2 * (z2 * (z2 * (z2 * 0.0013888889f + 0.0083333338f) + 0.041666668f) + 0.16666667f) + 0.5f) + 1.0f);
                const f32x2 m2b = 1.0f - a * a;
                f32x2 sq; sq.x = __builtin_amdgcn_sqrtf(z2.x > -0.25f ? m2s.x : m2b.x); sq.y = __builtin_amdgcn_sqrtf(z2.y > -0.25f ? m2s.y : m2b.y);
                const f32x2 uo = sq * ig * (f32x2){xu[idx0], xu[idx1]};
                xu[idx0] = uo.x; xu[idx1] = uo.y; aS[idx0] = a.x; aS[idx1] = a.y; }
        __builtin_amdgcn_wave_barrier();
        f32x2 glv[8];
#pragma unroll
        for (int tp = 0; tp < 8; ++tp) { const f32x2 x = {bf2f(gr[2 * tp]), bf2f(gr[2 * tp + 1])};
            const f32x2 t = x * (x * x * (-0.10294324f) + (-2.30220819f));
            f32x2 e; e.x = __builtin_amdgcn_exp2f(t.x); e.y = __builtin_amdgcn_exp2f(t.y);
            const f32x2 d = e + 1.0f;
            f32x2 rr; rr.x = __builtin_amdgcn_rcpf(d.x); rr.y = __builtin_amdgcn_rcpf(d.y);
            glv[tp] = x * rr; }
#pragma unroll
        for (int tt = 0; tt < 16; ++tt) { const float a = aS[tt * 68 + lane], uu = xu[tt * 68 + lane]; hh = a * hh + uu; ap *= a;
            const f32x2 o = (f32x2){hh, ap} * ((tt & 1) ? glv[tt >> 1].y : glv[tt >> 1].x);
            const unsigned w = cvt_pk_bf16(o.x, o.y);
            if (!dry) bg0[(r0 + tt) * D + c] = (bf16_t)(w & 0xffffu);
            pp0[(r0 + tt) * D + c] = (bf16_t)(w >> 16); }
        __builtin_amdgcn_wave_barrier();
        if (g < 2) {
#pragma unroll
            for (int tt = 0; tt < 16; ++tt) { xr[tt] = xn[tt]; gr[tt] = gn[tt]; }
        }
    }
    *(float2*)(summ + (((size_t)b * NCH + j) * D + c) * 2) = make_float2(ap, hh);
    if (j == NCH - 1) { p.out[O_CBP + ((size_t)b * 3 + 0) * D + c] = xm3; p.out[O_CBP + ((size_t)b * 3 + 1) * D + c] = xm2; p.out[O_CBP + ((size_t)b * 3 + 2) * D + c] = xm1; }
}
__device__ __forceinline__ void sample_item(const Params& p, int k, int h, LAS unsigned char* wl, const LAS unsigned char* wlds, int lane) {
    bf16_t* U = (bf16_t*)(p.ws + WS_U);
    const int c = h * 64 + lane, fr = lane & 15, fq = lane >> 4;
    const size_t row0 = (size_t)MP + (size_t)k * 16; const int s0 = k * 16;
    const bf16_t* bx0 = U + 3 * SLOT + row0 * D; bf16_t* bg0 = U + 1 * SLOT + row0 * D;
    const LAS unsigned char* wq = wlds + fr * 144 + fq * 16;
    float brv[4], biv[4], lcv[4];
#pragma unroll
    for (int nt = 0; nt < 4; ++nt) { const int ch = h * 64 + nt * 16 + fr; brv[nt] = p.in[19][ch]; biv[nt] = p.in[21][ch]; lcv[nt] = ((const float*)(p.ws + WS_LC))[ch]; }
    const float w3 = p.in[16][3 * D + c];
    LAS unsigned short* cbT = (LAS unsigned short*)wl;
    LAS float* xu = (LAS float*)(wl + 2304);
    LAS float* aS = (LAS float*)(wl + 2304 + 4352);
    const float* pcb = (const float*)(p.ws + WS_PCB) + (size_t)s0 * D + c;
    {
        bf16_t xr[16]; float pc[16];
#pragma unroll
        for (int tt = 0; tt < 16; ++tt) { xr[tt] = bx0[tt * D + c]; pc[tt] = pcb[tt * D]; }
#pragma unroll
        for (int tt = 0; tt < 16; ++tt) { const float x = bf2f(xr[tt]); const float cb = pc[tt] + w3 * x;
            p.out[O_CBS + ((size_t)(s0 + tt) * 3 + 2) * D + c] = x;
            cbT[tt * 72 + lane] = f2bf(cb); xu[tt * 68 + lane] = cb; }
    }
    __builtin_amdgcn_wave_barrier();
    const bf16x8 a0 = *(const LAS bf16x8*)(cbT + fr * 72 + fq * 8), a1 = *(const LAS bf16x8*)(cbT + fr * 72 + 32 + fq * 8);
    f32x4 accR[4], accI[4];
#pragma unroll
    for (int nt = 0; nt < 4; ++nt) {
        const bf16x8 r0w = *(const LAS bf16x8*)(wq + nt * 2304), r1w = *(const LAS bf16x8*)(wq + nt * 2304 + 64);
        const bf16x8 i0w = *(const LAS bf16x8*)(wq + 9216 + nt * 2304), i1w = *(const LAS bf16x8*)(wq + 9216 + nt * 2304 + 64);
        accR[nt] = __builtin_amdgcn_mfma_f32_16x16x32_bf16(a0, r0w, (f32x4){0.f, 0.f, 0.f, 0.f}, 0, 0, 0);
        accR[nt] = __builtin_amdgcn_mfma_f32_16x16x32_bf16(a1, r1w, accR[nt], 0, 0, 0);
        accI[nt] = __builtin_amdgcn_mfma_f32_16x16x32_bf16(a0, i0w, (f32x4){0.f, 0.f, 0.f, 0.f}, 0, 0, 0);
        accI[nt] = __builtin_amdgcn_mfma_f32_16x16x32_bf16(a1, i1w, accI[nt], 0, 0, 0);
    }
#pragma unroll
    for (int nt = 0; nt < 4; ++nt)
#pragma unroll
        for (int ip = 0; ip < 2; ++ip) {
                const int idx0 = (fq * 4 + 2 * ip) * 68 + nt * 16 + fr, idx1 = idx0 + 68;
                const f32x2 tr = ((f32x2){accR[nt][2 * ip], accR[nt][2 * ip + 1]} + brv[nt]) * (-1.44269504089f), ti = ((f32x2){accI[nt][2 * ip], accI[nt][2 * ip + 1]} + biv[nt]) * (-1.44269504089f);
                f32x2 er, ei; er.x = __builtin_amdgcn_exp2f(tr.x); er.y = __builtin_amdgcn_exp2f(tr.y); ei.x = __builtin_amdgcn_exp2f(ti.x); ei.y = __builtin_amdgcn_exp2f(ti.y);
                const f32x2 dr = er + 1.0f, di = ei + 1.0f;
                f32x2 r, ig; r.x = __builtin_amdgcn_rcpf(dr.x); r.y = __builtin_amdgcn_rcpf(dr.y); ig.x = __builtin_amdgcn_rcpf(di.x); ig.y = __builtin_amdgcn_rcpf(di.y);
                const f32x2 la = r * lcv[nt]; const f32x2 tl = la * 1.44269504089f;
                f32x2 a; a.x = __builtin_amdgcn_exp2f(tl.x); a.y = __builtin_amdgcn_exp2f(tl.y);
                const f32x2 z2 = la + la;
                const f32x2 m2s = -z2 * (z2 * (z2 * (z2 * (z2 * (z2 * 0.0013888889f + 0.0083333338f) + 0.041666668f) + 0.16666667f) + 0.5f) + 1.0f);
                const f32x2 m2b = 1.0f - a * a;
                f32x2 sq; sq.x = __builtin_amdgcn_sqrtf(z2.x > -0.25f ? m2s.x : m2b.x); sq.y = __builtin_amdgcn_sqrtf(z2.y > -0.25f ? m2s.y : m2b.y);
                const f32x2 uo = sq * ig * (f32x2){xu[idx0], xu[idx1]};
                xu[idx0] = uo.x; xu[idx1] = uo.y; aS[idx0] = a.x; aS[idx1] = a.y; }
    __builtin_amdgcn_wave_barrier();
    {
        float h0[16]; bf16_t gq[16];
#pragma unroll
        for (int tt = 0; tt < 16; ++tt) { h0[tt] = p.in[4][(size_t)(s0 + tt) * D + c]; gq[tt] = bg0[tt * D + c]; }
#pragma unroll
        for (int tt = 0; tt < 16; ++tt) {
            const float hn = aS[tt * 68 + lane] * h0[tt] + xu[tt * 68 + lane];
            p.out[O_RGS + (size_t)(s0 + tt) * D + c] = hn;
            bg0[tt * D + c] = f2bf(gelu_tanh(bf2f(gq[tt])) * hn);
        }
    }
    __builtin_amdgcn_wave_barrier();
}
__device__ __forceinline__ void scan_phase(const Params& p, LAS unsigned char* lds, int tid, bool dry) {
    const int wid = __builtin_amdgcn_readfirstlane(tid >> 6), lane = tid & 63;
    LAS unsigned char* wl = lds + wid * WL_BYTES;
    LAS unsigned char* wlds = lds + 8 * WL_BYTES;
    const int h = blockIdx.x & 15;
    {
        const bf16_t* wt = (const bf16_t*)(p.ws + WS_WRG);
#pragma unroll
        for (int q = 0; q < 2; ++q) { const int e = tid + q * 512, g = e >> 9, jrow = (e >> 3) & 63, pc = e & 7;
            *(LAS u32x4*)(wlds + g * 9216 + jrow * 144 + pc * 16) = *(const u32x4*)(wt + (size_t)g * 65536 + (size_t)(h * 64 + jrow) * 64 + pc * 8); }
    }
    __syncthreads();
    const int nbh = gridDim.x >> 4;
    for (int it = (blockIdx.x >> 4) * 8 + wid; it < NB * NCH; it += nbh * 8) scan_item(p, it / NCH, it % NCH, h, wl, wlds, lane, dry);
    if (!dry && wid < 2 && (int)(blockIdx.x >> 4) >= nbh - 4) {
        const int k = ((int)(blockIdx.x >> 4) - (nbh - 4)) * 2 + wid;
        if (k < NS / 16) sample_item(p, k, h, wl, wlds, lane);
    }
    __syncthreads();
}
__device__ __forceinline__ void fix_phase(const Params& p, LAS unsigned char* lds, int tid, bool dry) {
    bf16_t* zb = (bf16_t*)(p.ws + WS_U) + 1 * SLOT; const bf16_t* pp = (const bf16_t*)p.out;
    const float* summ = (const float*)(p.ws + WS_SUMM);
    LAS float* cs = (LAS float*)lds;
    for (int it = blockIdx.x; it < NB * (NCH - 1); it += gridDim.x) {
        const int b = it / (NCH - 1), j = it % (NCH - 1) + 1;
#pragma unroll
        for (int cq = 0; cq < 2; ++cq) {
            const int c = tid + cq * 512; const float* sp = summ + ((size_t)b * NCH * D + c) * 2; float hh = 0.f;
            for (int i0 = 0; i0 < j; i0 += 16) {
                float va[16], vh[16];
#pragma unroll
                for (int k = 0; k < 16; ++k) { if (i0 + k < j) { const float2 v = *(const float2*)(sp + (size_t)(i0 + k) * D * 2); va[k] = v.x; vh[k] = v.y; } else { va[k] = 1.f; vh[k] = 0.f; } }
#pragma unroll
                for (int k = 0; k < 16; ++k) hh = va[k] * hh + vh[k];
            }
            cs[c] = hh;
            if (j == NCH - 1) { const float2 v = *(const float2*)(sp + (size_t)j * D * 2); p.out[O_RGP + (size_t)b * D + c] = v.x * hh + v.y; }
        }
        __syncthreads();
        const size_t row0 = (size_t)b * TP + (size_t)j * CHUNK;
        for (int q0 = 0; q0 < CHUNK * 128 / 512; q0 += 4) {
            u32x4 zq[4], pq[4];
#pragma unroll
            for (int k = 0; k < 4; ++k) { const int e = tid + (q0 + k) * 512, tt = e >> 7, vc = e & 127; const size_t o = (row0 + tt) * D + vc * 8; zq[k] = *(const u32x4*)(zb + o); pq[k] = *(const u32x4*)(pp + o); }
#pragma unroll
            for (int k = 0; k < 4; ++k) { const int e = tid + (q0 + k) * 512, tt = e >> 7, vc = e & 127; const size_t o = (row0 + tt) * D + vc * 8;
                const f32x4 c0 = *(const LAS f32x4*)(cs + vc * 8), c1 = *(const LAS f32x4*)(cs + vc * 8 + 4);
                u32x4 w;
                w.x = cvt_pk_bf16(bflo(zq[k].x) + bflo(pq[k].x) * c0[0], bfhi(zq[k].x) + bfhi(pq[k].x) * c0[1]); w.y = cvt_pk_bf16(bflo(zq[k].y) + bflo(pq[k].y) * c0[2], bfhi(zq[k].y) + bfhi(pq[k].y) * c0[3]);
                w.z = cvt_pk_bf16(bflo(zq[k].z) + bflo(pq[k].z) * c1[0], bfhi(zq[k].z) + bfhi(pq[k].z) * c1[1]); w.w = cvt_pk_bf16(bflo(zq[k].w) + bflo(pq[k].w) * c1[2], bfhi(zq[k].w) + bfhi(pq[k].w) * c1[3]);
                if (!dry) *(u32x4*)(zb + o) = w; }
        }
        __syncthreads();
    }
}
__device__ __forceinline__ void za_phase(const Params& p, int tid, bool dry) {
    bf16_t* U = (bf16_t*)(p.ws + WS_U); bf16_t* ab = U; const bf16_t* ca = U + 2 * SLOT;
    const float* cw = p.in[14];
    for (int idx = blockIdx.x * 512 + tid; idx < NB * 129 * 128; idx += gridDim.x * 512) {
        const int vc = idx & 127, tb = (idx >> 7) % 129, b = idx / (128 * 129); const int c0 = vc * 8;
        float w[3][8];
#pragma unroll
        for (int k = 0; k < 3; ++k) { const f32x4 a = *(const f32x4*)(cw + k * D + c0), bq = *(const f32x4*)(cw + k * D + c0 + 4);
#pragma unroll
            for (int e = 0; e < 4; ++e) { w[k][e] = a[e]; w[k][4 + e] = bq[e]; } }
        const size_t r0 = (size_t)b * TP + (size_t)tb * 16;
        float p2[8], p1[8];
        if (tb > 0) { const u32x4 q2 = *(const u32x4*)(ca + (r0 - 2) * D + c0), q1 = *(const u32x4*)(ca + (r0 - 1) * D + c0);
#pragma unroll
            for (int e = 0; e < 4; ++e) { p2[2 * e] = bflo(q2[e]); p2[2 * e + 1] = bfhi(q2[e]); p1[2 * e] = bflo(q1[e]); p1[2 * e + 1] = bfhi(q1[e]); } }
        else {
#pragma unroll
            for (int e = 0; e < 8; ++e) { p2[e] = 0.f; p1[e] = 0.f; } }
        for (int t4 = 0; t4 < 16; t4 += 4) {
            u32x4 qcs[4], qas[4];
#pragma unroll
            for (int k = 0; k < 4; ++k) { qcs[k] = *(const u32x4*)(ca + (r0 + t4 + k) * D + c0); qas[k] = *(const u32x4*)(ab + (r0 + t4 + k) * D + c0); }
#pragma unroll
            for (int k = 0; k < 4; ++k) {
                const u32x4 qc = qcs[k], qa = qas[k];
                float cv[8], av[8], zv[8];
#pragma unroll
                for (int e = 0; e < 4; ++e) { cv[2 * e] = bflo(qc[e]); cv[2 * e + 1] = bfhi(qc[e]); av[2 * e] = bflo(qa[e]); av[2 * e + 1] = bfhi(qa[e]); }
#pragma unroll
                for (int e = 0; e < 8; ++e) { zv[e] = av[e] * (w[0][e] * p2[e] + w[1][e] * p1[e] + w[2][e] * cv[e]); p2[e] = p1[e]; p1[e] = cv[e]; }
                u32x4 o; o.x = cvt_pk_bf16(zv[0], zv[1]); o.y = cvt_pk_bf16(zv[2], zv[3]); o.z = cvt_pk_bf16(zv[4], zv[5]); o.w = cvt_pk_bf16(zv[6], zv[7]);
                if (!dry) *(u32x4*)(ab + (r0 + t4 + k) * D + c0) = o;
            }
        }
        if (tb == 128) {
            float* o2 = p.out + O_CAP + ((size_t)b * 2 + 0) * D + c0; float* o1 = p.out + O_CAP + ((size_t)b * 2 + 1) * D + c0;
            *(f32x4*)o2 = (f32x4){p2[0], p2[1], p2[2], p2[3]}; *(f32x4*)(o2 + 4) = (f32x4){p2[4], p2[5], p2[6], p2[7]};
            *(f32x4*)o1 = (f32x4){p1[0], p1[1], p1[2], p1[3]}; *(f32x4*)(o1 + 4) = (f32x4){p1[4], p1[5], p1[6], p1[7]};
        }
    }
    if (!dry) {
        for (int idx = blockIdx.x * 512 + tid; idx < NS * 128; idx += gridDim.x * 512) {
            const int vc = idx & 127, sm = idx >> 7, c0 = vc * 8; const size_t ro = (size_t)(MP + sm) * D + c0;
            const u32x4 qc = *(const u32x4*)(ca + ro), qa = *(const u32x4*)(ab + ro);
            const float* pca = (const float*)(p.ws + WS_PCA) + (size_t)sm * D + c0;
            float hp[8], cv[8], zv[8];
            { const f32x4 a0 = *(const f32x4*)pca, a1 = *(const f32x4*)(pca + 4);
#pragma unroll
              for (int e = 0; e < 4; ++e) { hp[e] = a0[e]; hp[4 + e] = a1[e]; } }
#pragma unroll
            for (int e = 0; e < 4; ++e) { cv[2 * e] = bflo(qc[e]); cv[2 * e + 1] = bfhi(qc[e]); }
#pragma unroll
            for (int e = 0; e < 8; ++e) { const float av = (e & 1) ? bfhi(qa[e >> 1]) : bflo(qa[e >> 1]); zv[e] = av * (hp[e] + cw[2 * D + c0 + e] * cv[e]); }
            u32x4 o; o.x = cvt_pk_bf16(zv[0], zv[1]); o.y = cvt_pk_bf16(zv[2], zv[3]); o.z = cvt_pk_bf16(zv[4], zv[5]); o.w = cvt_pk_bf16(zv[6], zv[7]);
            *(u32x4*)(ab + ro) = o;
            float* o1 = p.out + O_CAS + ((size_t)sm * 2 + 1) * D + c0;
            *(f32x4*)o1 = (f32x4){cv[0], cv[1], cv[2], cv[3]}; *(f32x4*)(o1 + 4) = (f32x4){cv[4], cv[5], cv[6], cv[7]};
        }
    }
}

__device__ __forceinline__ u32x4 merge_math(const u32x4& ga, const u32x4& gb, const float (&ya)[8], const float (&yb)[8]) {
    u32x4 o4;
#pragma unroll
    for (int e = 0; e < 4; ++e) { const float lo = sigm(bflo(ga[e])) * ya[2 * e] + sigm(bflo(gb[e])) * yb[2 * e], hi = sigm(bfhi(ga[e])) * ya[2 * e + 1] + sigm(bfhi(gb[e])) * yb[2 * e + 1]; o4[e] = cvt_pk_bf16(lo, hi); }
    return o4;
}
__device__ __forceinline__ void merge_phase(const Params& p, int tid) {
    const bf16_t* U = (const bf16_t*)(p.ws + WS_U); bf16_t* H = (bf16_t*)p.out; const bf16_t* PO = (const bf16_t*)(p.ws + WS_POAB);
    const size_t G = (size_t)gridDim.x * 512, NMAIN = (size_t)MAINR * 128;
    for (size_t i0 = (size_t)blockIdx.x * 512 + tid; i0 < NMAIN; i0 += 4 * G) {
        u32x4 ga[4], gb[4], a[4], b[4];
#pragma unroll
        for (int k = 0; k < 4; ++k) { const size_t i = i0 + k * G; if (i < NMAIN) { ga[k] = __builtin_nontemporal_load((const u32x4*)(U + 4 * SLOT + i * 8)); gb[k] = __builtin_nontemporal_load((const u32x4*)(U + 5 * SLOT + i * 8)); a[k] = __builtin_nontemporal_load((const u32x4*)(U + 2 * SLOT + i * 8)); b[k] = __builtin_nontemporal_load((const u32x4*)(U + 3 * SLOT + i * 8)); } }
#pragma unroll
        for (int k = 0; k < 4; ++k) { const size_t i = i0 + k * G; if (i < NMAIN) {
            float ya[8], yb[8];
#pragma unroll
            for (int e = 0; e < 4; ++e) { ya[2 * e] = bflo(a[k][e]); ya[2 * e + 1] = bfhi(a[k][e]); yb[2 * e] = bflo(b[k][e]); yb[2 * e + 1] = bfhi(b[k][e]); }
            *(u32x4*)(H + i * 8) = merge_math(ga[k], gb[k], ya, yb); } }
    }
    for (size_t i = NMAIN + (size_t)blockIdx.x * 512 + tid; i < SLOT / 8; i += G) {
        const u32x4 ga = *(const u32x4*)(U + 4 * SLOT + i * 8), gb = *(const u32x4*)(U + 5 * SLOT + i * 8);
        float ya[8], yb[8];
        const int row = (int)(i >> 7);
        const size_t o = (size_t)(row - MAINR) * D + (size_t)(i & 127) * 8;
#pragma unroll
        for (int e = 0; e < 8; ++e) { ya[e] = 0.f; yb[e] = 0.f; }
#pragma unroll
        for (int ks = 0; ks < 4; ++ks) {
            const u32x4 a0 = *(const u32x4*)(PO + (size_t)(ks * 2 + 0) * (256 * D) + o), b0 = *(const u32x4*)(PO + (size_t)(ks * 2 + 1) * (256 * D) + o);
#pragma unroll
            for (int e = 0; e < 4; ++e) { ya[2 * e] += bflo(a0[e]); ya[2 * e + 1] += bfhi(a0[e]); yb[2 * e] += bflo(b0[e]); yb[2 * e + 1] += bfhi(b0[e]); }
        }
        *(u32x4*)(H + i * 8) = merge_math(ga, gb, ya, yb);
    }
}

#define XB_TMO      128
#define XB_XCNT(j)  (256  + 64 * (j))
#define XB_XSUB(j)  (1280 + 64 * (j))
#define XB_XGEN(j)  (2304 + 64 * (j))
#define XB_TOP      3328
#define XB_TOPGEN   3392
#define XCD_BAR_WORDS 3456
#define XB_SPIN_CAP (1u << 18)
__device__ __forceinline__ unsigned xb_ld(unsigned* p)              { return __hip_atomic_load(p, __ATOMIC_RELAXED, __HIP_MEMORY_SCOPE_AGENT); }
__device__ __forceinline__ unsigned xb_add(unsigned* p, unsigned v) { return __hip_atomic_fetch_add(p, v, __ATOMIC_RELAXED, __HIP_MEMORY_SCOPE_AGENT); }
__device__ __forceinline__ unsigned xb_xcc_id() { return (unsigned)__builtin_amdgcn_s_getreg((3 << 11) | 20) & 0xFu; }
#define XB_SPIN(cond, bar) do { unsigned _sp = 0; while (cond) { __builtin_amdgcn_s_sleep(1); \
    if ((++_sp & 255u) == 0u) { if (xb_ld(&(bar)[XB_TMO])) break; if (_sp > XB_SPIN_CAP) { atomicAdd(&(bar)[XB_TMO], 1u); break; } } } } while (0)
struct XcdBarrier { unsigned* bar; unsigned x; volatile LAS unsigned* st; };
__device__ __forceinline__ XcdBarrier xcd_barrier_post(unsigned* bar, volatile LAS unsigned* st) {
    XcdBarrier b; b.bar = bar; b.x = xb_xcc_id(); b.st = st;
    if (threadIdx.x == 0) (void)xb_add(&bar[XB_XCNT(b.x)], 1u);
    return b;
}
__device__ __forceinline__ void xcd_barrier_complete(unsigned* bar, unsigned x, unsigned& nloc, unsigned& nx) {
    const unsigned G = gridDim.x * gridDim.y * gridDim.z;
    unsigned sum, cnt, mine, sp = 0u;
    for (;;) {
        sum = 0u; cnt = 0u; mine = 0u;
#pragma unroll
        for (unsigned j = 0; j < 16; ++j) { const unsigned c = xb_ld(&bar[XB_XCNT(j)]); sum += c; cnt += (c > 0u) ? 1u : 0u; mine = (j == x) ? c : mine; }
        if (sum == G) break;
        __builtin_amdgcn_s_sleep(1);
        if ((++sp & 255u) == 0u) { if (xb_ld(&bar[XB_TMO])) break; if (sp > XB_SPIN_CAP) { atomicAdd(&bar[XB_TMO], 1u); break; } }
    }
    nloc = mine > 0u ? mine : 1u; nx = cnt > 0u ? cnt : 1u;
}
__device__ __forceinline__ void xcd_barrier(const XcdBarrier& b) {
    asm volatile("s_waitcnt vmcnt(0)" ::: "memory");
    __syncthreads();
    if (threadIdx.x == 0) {
        unsigned* bar = b.bar;
        __builtin_amdgcn_s_waitcnt(0);
        unsigned nloc = b.st[0], nx = b.st[1];
        if (nloc == 0u) { xcd_barrier_complete(bar, b.x, nloc, nx); b.st[0] = nloc; b.st[1] = nx; }
        const unsigned old = xb_add(&bar[XB_XSUB(b.x)], 1u);
        const unsigned gen = old / nloc;
        if (old + 1u == (gen + 1u) * nloc) {
            __builtin_amdgcn_fence(__ATOMIC_RELEASE, "agent");
            asm volatile("s_waitcnt vmcnt(0)" ::: "memory");
            const unsigned og = xb_add(&bar[XB_TOP], 1u);
            const unsigned tg = og / nx;
            if (og + 1u == (tg + 1u) * nx) xb_add(&bar[XB_TOPGEN], 1u);
            else XB_SPIN(xb_ld(&bar[XB_TOPGEN]) == tg, bar);
            __builtin_amdgcn_fence(__ATOMIC_ACQUIRE, "agent");
            xb_add(&bar[XB_XGEN(b.x)], 1u);
            asm volatile("s_waitcnt vmcnt(0)" ::: "memory");
        } else {
            XB_SPIN(xb_ld(&bar[XB_XGEN(b.x)]) == gen, bar);
            __builtin_amdgcn_fence(__ATOMIC_ACQUIRE, "agent");
            asm volatile("s_waitcnt vmcnt(0)" ::: "memory");
        }
    }
    __syncthreads();
}

constexpr int NPHASE = 14;
constexpr int LDS_BYTES = 131072 + 16;
__global__ void __launch_bounds__(512, 2) mk_fwd(Params p, int ph_lo, int ph_hi) {
    extern __shared__ __attribute__((aligned(16))) unsigned char shm[];
    LAS unsigned char* lds = (LAS unsigned char*)shm;
    cg::grid_group grid = cg::this_grid();
    if (threadIdx.x == 0) { *(LAS u32x4*)(lds + 131072) = (u32x4){0u, 0u, 0u, 0u}; }
    __syncthreads();
    const XcdBarrier xb = xcd_barrier_post((unsigned*)(p.ws + WS_BAR), (volatile LAS unsigned*)(lds + 131072));
    for (int ph2 = ph_lo * 2; ph2 < ph_hi * 2; ++ph2) {
        const int ph = ph2 >> 1; const bool dry = !(ph2 & 1);
        if (dry && !((REP_MASK >> ph) & 1)) continue;
        int tid = threadIdx.x; asm volatile("" : "+v"(tid));
        if (ph == 0) {
            convert_set(p, 0, lds, tid, 0, 0, 1408);
            bf16_t* wt = (bf16_t*)(p.ws + WS_WRG);
            for (int o = blockIdx.x * 512 + tid; o < 2 * 65536; o += gridDim.x * 512) { const int g = o >> 16, h = (o >> 12) & 15, j = (o >> 6) & 63, i = o & 63;
                wt[o] = f2bf((g ? p.in[20] : p.in[18])[(size_t)(h * 64 + i) * 64 + j]); }
            if (blockIdx.x * 512 + tid < D) { const int ch = blockIdx.x * 512 + tid; ((float*)(p.ws + WS_LC))[ch] = -8.0f * log1pf(expf(-p.in[22][ch])); }
            for (int e = blockIdx.x * 512 + tid; e < NS * D; e += gridDim.x * 512) {
                const int sm = e >> 10, c = e & 1023;
                const float t0 = p.in[3][((size_t)sm * 3 + 0) * D + c], t1 = p.in[3][((size_t)sm * 3 + 1) * D + c], t2 = p.in[3][((size_t)sm * 3 + 2) * D + c];
                const float a0 = p.in[2][((size_t)sm * 2 + 0) * D + c], a1 = p.in[2][((size_t)sm * 2 + 1) * D + c];
                ((float*)(p.ws + WS_PCB))[e] = p.in[16][c] * t0 + p.in[16][D + c] * t1 + p.in[16][2 * D + c] * t2 + p.in[17][c];
                ((float*)(p.ws + WS_PCA))[e] = p.in[14][c] * a0 + p.in[14][D + c] * a1;
                p.out[O_CBS + ((size_t)sm * 3 + 0) * D + c] = t1; p.out[O_CBS + ((size_t)sm * 3 + 1) * D + c] = t2;
                p.out[O_CAS + ((size_t)sm * 2 + 0) * D + c] = a1;
            }
            norm_phase(p, 0, tid, dry, 0);
        } else if (ph == 1 || ph == 11) {
            pg8::Gemm g{(const bf16_t*)(p.ws + WS_H), (const bf16_t*)(p.ws + WS_WGU), M, 2 * DFF, D, 0, 0};
            pg8::StaticOrder S; S.init(M, 2 * DFF, D, gridDim.x, blockIdx.x);
            pg8::EpiGU E{(bf16_t*)(p.ws + WS_ACT), dry};
            pg8::gemm_phase(lds, g, S, E);
            if (!dry && ph == 1) { convert_set(p, 0, lds, tid, 150, 1408, 2112); convert_set(p, 2, lds, tid, 150, 0, 1088); }
        } else if (ph == 2 || ph == 12 || ph == 9 || ph == 7) {
            const bool dn = (ph == 2 || ph == 12), oab = (ph == 7);
            pg8::Gemm g{dn ? (const bf16_t*)(p.ws + WS_ACT) : (oab ? (const bf16_t*)(p.ws + WS_U) : (const bf16_t*)p.out), (const bf16_t*)(p.ws + (dn ? WS_WD : (oab ? WS_WOAB : WS_WO))), M, D, dn ? DFF : D, SB, (size_t)1024 * 1024 * 2};
            pg8::SplitOrder S; S.init(oab ? 2 * D : D, dn ? DFF : D, gridDim.x, blockIdx.x, dn ? 11 : 4, 4);
            pg8::EpiBF E{(bf16_t*)(p.ws + (oab ? WS_U + 2 * SB : WS_Y)), SLOT, (bf16_t*)(p.ws + (oab ? WS_POAB : WS_PY)), oab ? 2 : 1};
            pg8::gemm_phase(lds, g, S, E);
            if (!dry && ph == 2) convert_set(p, 2, lds, tid, 44, 1088, 1 << 30);
            if (!dry && ph == 9) convert_set(p, 1, lds, tid, 16, 0, 1 << 30);
        } else if (ph == 3) {
            norm_phase(p, 1, tid, dry, 11);
        } else if (ph == 4) {
            pg8::Gemm g{(const bf16_t*)(p.ws + WS_H), (const bf16_t*)(p.ws + WS_WIN), M, DIN, D, 0, 0};
            pg8::StaticOrder S; S.init(M, DIN, D, gridDim.x, blockIdx.x);
            pg8::EpiIN E{(bf16_t*)(p.ws + WS_U)};
            pg8::gemm_phase(lds, g, S, E);
        } else if (ph == 5) {
            scan_phase(p, lds, tid, dry);
        } else if (ph == 6) {
            fix_phase(p, lds, tid, dry);
            za_phase(p, tid, dry);
        } else if (ph == 8) {
            merge_phase(p, tid);
        } else if (ph == 10) {
            norm_phase(p, 2, tid, dry, 4);
        } else if (ph == 13) {
            norm_phase(p, 3, tid, dry, 11);
        }
        if (ph2 + 1 < ph_hi * 2) { if (ph_hi > NPHASE) grid.sync(); else xcd_barrier(xb); }
    }
}

extern "C" void kernel_launch(void* const* d_in, const int* in_sizes, int n_in, void* d_out, int out_size, void* d_ws, size_t ws_size, hipStream_t stream) {
    if (n_in != 30 || ws_size < WS_END) { fprintf(stderr, "kernel_launch: unexpected n_in %d / ws_size %zu (need %zu)\n", n_in, ws_size, (size_t)WS_END); return; }
    Params p{};
    for (int i = 0; i < 30; ++i) p.in[i] = (const float*)d_in[i];
    p.out = (float*)d_out; p.ws = (unsigned char*)d_ws;
    (void)hipFuncSetAttribute((const void*)mk_fwd, hipFuncAttributeMaxDynamicSharedMemorySize, LDS_BYTES);
    static int grid_blocks = 0;
    if (!grid_blocks) {
        int dev = 0, cus = 0, per_cu = 0;
        (void)hipGetDevice(&dev);
        (void)hipDeviceGetAttribute(&cus, hipDeviceAttributeMultiprocessorCount, dev);
        (void)hipOccupancyMaxActiveBlocksPerMultiprocessor(&per_cu, (const void*)mk_fwd, 512, LDS_BYTES);
        if (per_cu < 1) { fprintf(stderr, "kernel_launch: occupancy query says %d blocks/CU\n", per_cu); per_cu = 1; }
        grid_blocks = cus;
    }
    (void)hipMemsetAsync((unsigned char*)d_ws + WS_BAR, 0, 16384, stream);
#if SINGLE_LAUNCH
    int lo = 0, hi = NPHASE;
    void* args[] = {&p, &lo, &hi};
    hipError_t e = hipLaunchCooperativeKernel((const void*)mk_fwd, dim3(grid_blocks), dim3(512), args, LDS_BYTES, stream);
    if (e != hipSuccess) fprintf(stderr, "cooperative launch failed: %s (grid %d)\n", hipGetErrorString(e), grid_blocks);
#else
    for (int ph = 0; ph < NPHASE; ++ph) hipLaunchKernelGGL(mk_fwd, dim3(grid_blocks), dim3(512), LDS_BYTES, stream, p, ph, ph + 1);
#endif
}
```

```cpp
#include <hip/hip_runtime.h>
#include <hip/hip_cooperative_groups.h>
#include <cstdio>
namespace cg = cooperative_groups;

#ifndef REP_MASK
#define REP_MASK 0
#endif
#ifndef SINGLE_LAUNCH
#define SINGLE_LAUNCH 1
#endif

#define LAS __attribute__((address_space(3)))
typedef unsigned short bf16_t;
typedef short bf16x8 __attribute__((ext_vector_type(8)));
typedef float f32x4 __attribute__((ext_vector_type(4)));
typedef unsigned u32x4 __attribute__((ext_vector_type(4)));
typedef unsigned u32x2 __attribute__((ext_vector_type(2)));
typedef float f32x2 __attribute__((ext_vector_type(2)));

constexpr int D = 1024, DFF = 2816, DIN = 7168;
constexpr int NB = 8, SEQ = 2048, NMETA = 16, TP = SEQ + NMETA;
constexpr int MP = NB * TP;
constexpr int NS = 128;
constexpr int M = MP + NS;
constexpr int CHUNK = 48, NCH = TP / CHUNK;
constexpr float EPS = 1e-6f;

constexpr size_t O_YP = 0, O_YS = 16777216, O_CAP = O_YS + 131072, O_CBP = O_CAP + 16384, O_RGP = O_CBP + 24576,
                 O_CAS = O_RGP + 8192, O_CBS = O_CAS + 262144, O_RGS = O_CBS + 393216;

constexpr size_t SLOT = (size_t)M * D;
constexpr size_t SB = SLOT * 2;
constexpr size_t WS_U = 0;
constexpr size_t WS_ACT = 0;
constexpr size_t WS_Y = 3 * SB;
constexpr size_t WS_PY = 4 * SB;
constexpr int MAINR = 64 * 256;
constexpr size_t WS_WGU = 5 * SB;
constexpr size_t WS_WD = WS_WGU + (size_t)5632 * 1024 * 2;
constexpr size_t WS_H = 6 * SB;
constexpr size_t WS_WIN = 7 * SB;
constexpr size_t WS_POAB = WS_WIN;
constexpr size_t WS_WOAB = WS_WIN + (size_t)7168 * 1024 * 2;
constexpr size_t WS_WO = WS_WOAB + (size_t)2 * 1024 * 1024 * 2;
constexpr size_t WS_WRG = WS_WO + (size_t)1024 * 1024 * 2;
constexpr size_t WS_SUMM = WS_WRG + (size_t)2 * 16 * 64 * 64 * 2;
constexpr size_t WS_SC = WS_SUMM + (size_t)NB * NCH * D * 2 * 4;
constexpr size_t WS_LC = WS_SC + 98304;
constexpr size_t WS_BAR = WS_SC + 131072;
constexpr size_t WS_PCB = WS_BAR + 16384;
constexpr size_t WS_PCA = WS_PCB + (size_t)NS * D * 4;
constexpr size_t WS_END = WS_PCA + (size_t)NS * D * 4;
static_assert(WS_END <= (size_t)256 * 1024 * 1024, "workspace");

struct Params { const float* in[30]; float* out; unsigned char* ws; };

__device__ __forceinline__ unsigned cvt_pk_bf16(float lo, float hi) { unsigned r; asm volatile("v_cvt_pk_bf16_f32 %0, %1, %2" : "=v"(r) : "v"(lo), "v"(hi)); return r; }
__device__ __forceinline__ bf16_t f2bf(float f) { return (bf16_t)(cvt_pk_bf16(f, 0.f) & 0xffffu); }
__device__ __forceinline__ float bf2f(bf16_t b) { return __uint_as_float(((unsigned)b) << 16); }
__device__ __forceinline__ float bflo(unsigned w) { return __uint_as_float(w << 16); }
__device__ __forceinline__ float bfhi(unsigned w) { return __uint_as_float(w & 0xffff0000u); }
__device__ __forceinline__ float sigm(float x) { return __builtin_amdgcn_rcpf(1.0f + __expf(-x)); }
__device__ __forceinline__ float gelu_tanh(float x) { const float t = 1.5957691216057308f * (x + 0.044715f * x * x * x); return x * sigm(t); }
__device__ __forceinline__ float wave_sum(float v, int lane) {
#pragma unroll
    for (int o = 32; o >= 1; o >>= 1) v += __int_as_float(__builtin_amdgcn_ds_bpermute((lane ^ o) << 2, __float_as_int(v)));
    return v;
}
__device__ __forceinline__ const float* x0row(const Params& p, int r) {
    if (r >= MP) return p.in[1] + (size_t)(r - MP) * D;
    const int b = r / TP, t = r - b * TP;
    if (t < NMETA) return p.in[5] + (size_t)t * D;
    return p.in[0] + ((size_t)b * SEQ + (t - NMETA)) * D;
}

namespace pg8 {
constexpr int BM = 256, BK = 64, HALF = 128, HTB = HALF * BK * 2, STAGE_BYTES = 8 * HTB, NXCD = 8, WGM = 8;
__host__ __device__ __forceinline__ int lds_byte(int r, int c) { const int st = (r >> 4) * 2 + (c >> 5), rr = r & 15, cc = c & 31, ob = rr * 64 + cc * 2; return st * 1024 + (ob ^ (((ob >> 9) & 1) << 5)); }
__host__ __device__ __forceinline__ void stage_rc(int b, int& R, int& C) { const int st = b / 1024, sb = b % 1024, swz = sb ^ (((sb >> 9) & 1) << 5); R = (st >> 1) * 16 + swz / 64; C = (st & 1) * 32 + (swz % 64) / 2; }
__host__ __device__ __forceinline__ int perm32(int rho) { const int n = rho >> 4, i = rho & 15; return 8 * (i >> 2) + 4 * n + (i & 3); }

struct Unit { int pm, pn, z, k0, nk, part; };
struct Gemm { const bf16_t* A; const bf16_t* Bt; int M, N, K; size_t zA, zB; };

struct StaticOrder {
    int nM, nN, nwg, G, c, ntf;
    __device__ void init(int M_, int N_, int K_, int G_, int c_) { nM = M_ / BM; nN = N_ / BM; nwg = nM * nN; G = G_; c = c_; ntf = K_ / BK; }
    __device__ bool map(long L, Unit& u) const {
        if (L >= nwg) return false;
        int wgid = (int)L; { const int q = nwg / NXCD, r = nwg % NXCD, xcd = wgid % NXCD, off = wgid / NXCD; wgid = (xcd < r ? xcd * (q + 1) : r * (q + 1) + (xcd - r) * q) + off; }
        const int nig = WGM * nN, gid = wgid / nig, fm = gid * WGM, gsz = (nM - fm) < WGM ? (nM - fm) : WGM;
        u.pm = fm + ((wgid % nig) % gsz); u.pn = (wgid % nig) / gsz; u.z = 0; u.k0 = 0; u.nk = ntf; u.part = -1; return true;
    }
    __device__ bool next(int i, Unit& u) const { return map((long)i * G + c, u); }
};
struct SplitOrder : StaticOrder {
    int nsplit, nkm;
    __device__ void init(int N_, int K_, int G_, int c_, int nsplit_, int nkm_) { StaticOrder::init(64 * BM, N_, K_, G_, c_); nsplit = nsplit_; nkm = nkm_; }
    __device__ bool next(int i, Unit& u) const {
        const long L = (long)i * G + c; bool ok;
        if (L < nwg) ok = map(L, u);
        else { const int L2 = (int)(L - nwg); ok = L2 < nN * nsplit; const int ks = L2 / nN; u.pm = 64; u.pn = L2 - ks * nN; u.k0 = ks * nkm; u.nk = nkm; u.part = ks; }
        u.z = u.pn >> 2; u.pn &= 3; return ok;
    }
};

template <class Epi, class Sched>
__device__ __forceinline__ void gemm_phase(LAS unsigned char* lds, const Gemm g, const Sched& S, const Epi& E) {
    int tid_ = threadIdx.x; asm volatile("" : "+v"(tid_));
    const int tid = tid_, wid = __builtin_amdgcn_readfirstlane(tid >> 6), lane = tid & 63, wr = wid >> 2, wc = wid & 3, fr = lane & 15, fq = lane >> 4;
    const int K = g.K;
    unsigned voffA[2], voffB[2];
#pragma unroll
    for (int i = 0; i < 2; ++i) { int R, C; stage_rc(tid * 16 + i * 8192, R, C); const int Rb = Epi::PERM ? ((R & ~31) + perm32(R & 31)) : R;
        voffA[i] = (unsigned)(R * K + C) * 2u; voffB[i] = (unsigned)(Rb * K + C) * 2u; }
    const size_t kstep = (size_t)(BK * 2);
    const size_t hstep = (size_t)HALF * K * 2;
    const size_t tstep = 2 * hstep;
    const unsigned ldsw = (unsigned)wid * 1024u;
    const int aoff = lds_byte(wr * 64 + fr, fq * 8), boff = lds_byte(wc * 32 + fr, fq * 8);
#define PG8_SA(b, h) (((b) * 2 + (h)) * HTB)
#define PG8_SB(b, h) ((4 + (b) * 2 + (h)) * HTB)
#define PG8_STAGE(bufoff, gbase, voff) do { _Pragma("unroll") for (int _i = 0; _i < 2; ++_i) \
        __builtin_amdgcn_global_load_lds((const unsigned*)((const char*)(gbase) + (voff)[_i]), (LAS unsigned*)(lds + (bufoff) + ldsw + _i * 8192), 16, 0, 0); } while (0)
#define PG8_LDA(dst, b, h) do { _Pragma("unroll") for (int m = 0; m < 4; ++m) _Pragma("unroll") for (int k = 0; k < 2; ++k) dst[m][k] = *(const LAS bf16x8*)(lds + PG8_SA(b, h) + aoff + m * 2048 + k * 1024); } while (0)
#define PG8_LDB(dst, b, h) do { _Pragma("unroll") for (int n = 0; n < 2; ++n) _Pragma("unroll") for (int k = 0; k < 2; ++k) dst[n][k] = *(const LAS bf16x8*)(lds + PG8_SB(b, h) + boff + n * 2048 + k * 1024); } while (0)
#define PG8_MMA(ai, bj, At, Bt) do { __builtin_amdgcn_s_setprio(1); _Pragma("unroll") for (int m = 0; m < 4; ++m) _Pragma("unroll") for (int n = 0; n < 2; ++n) _Pragma("unroll") for (int k = 0; k < 2; ++k) \
        acc[ai][bj][m][n] = __builtin_amdgcn_mfma_f32_16x16x32_bf16(Bt[n][k], At[m][k], acc[ai][bj][m][n], 0, 0, 0); __builtin_amdgcn_s_setprio(0); } while (0)
#define PG8_WAIT_V(n) asm volatile("s_waitcnt vmcnt(" #n ")" ::: "memory")
#define PG8_WAIT_L(n) asm volatile("s_waitcnt lgkmcnt(" #n ")" ::: "memory")
#define PG8_BAR __builtin_amdgcn_s_barrier()
#define PG8_SCHED __builtin_amdgcn_sched_barrier(0)
    Unit cur, nxt; int ui = 0;
    if (!S.next(0, cur)) return;
    f32x4 acc[2][2][4][2];
#pragma unroll
    for (int a = 0; a < 2; ++a)
#pragma unroll
        for (int b = 0; b < 2; ++b)
#pragma unroll
            for (int m = 0; m < 4; ++m)
#pragma unroll
                for (int n = 0; n < 2; ++n) acc[a][b][m][n] = (f32x4){0.f, 0.f, 0.f, 0.f};
    bf16x8 At[4][2], B0[2][2], B1[2][2];
    const char* cA = (const char*)g.A + (size_t)cur.z * g.zA + (size_t)cur.pm * tstep + (size_t)cur.k0 * kstep; const char* cB = (const char*)g.Bt + (size_t)cur.z * g.zB + (size_t)cur.pn * tstep + (size_t)cur.k0 * kstep;
    int nt = cur.nk;
    PG8_STAGE(PG8_SB(0, 0), cB, voffB); PG8_STAGE(PG8_SA(0, 0), cA, voffA); PG8_STAGE(PG8_SB(0, 1), cB + hstep, voffB); PG8_STAGE(PG8_SA(0, 1), cA + hstep, voffA);
    if (wr == 1) PG8_BAR;
    PG8_WAIT_V(4); PG8_BAR;
    PG8_STAGE(PG8_SB(1, 0), cB + kstep, voffB); PG8_STAGE(PG8_SA(1, 0), cA + kstep, voffA); PG8_STAGE(PG8_SB(1, 1), cB + hstep + kstep, voffB);
    PG8_WAIT_V(6); PG8_BAR;
    for (;;) {
        const bool has_next = S.next(ui + 1, nxt);
        const char* nA = has_next ? (const char*)g.A + (size_t)nxt.z * g.zA + (size_t)nxt.pm * tstep + (size_t)nxt.k0 * kstep : cA; const char* nB = has_next ? (const char*)g.Bt + (size_t)nxt.z * g.zB + (size_t)nxt.pn * tstep + (size_t)nxt.k0 * kstep : cB;
        for (int t = 0; t < nt; t += 2) {
            const bool last = (t == nt - 2);
            const char* a1 = cA + (size_t)(t + 1) * kstep;
            const char* a2 = last ? nA : cA + (size_t)(t + 2) * kstep; const char* b2 = last ? nB : cB + (size_t)(t + 2) * kstep;
            const char* a3 = a2 + kstep; const char* b3 = b2 + kstep;
            PG8_LDB(B0, 0, 0); PG8_SCHED; PG8_LDA(At, 0, 0); PG8_STAGE(PG8_SA(1, 1), a1 + hstep, voffA);
            PG8_WAIT_L(8); PG8_BAR; PG8_WAIT_L(0); PG8_MMA(0, 0, At, B0); PG8_BAR; PG8_SCHED;
            PG8_LDB(B1, 0, 1); PG8_STAGE(PG8_SB(0, 0), b2, voffB);
            PG8_BAR; PG8_WAIT_L(0); PG8_MMA(0, 1, At, B1); PG8_BAR;
            PG8_LDA(At, 0, 1); PG8_STAGE(PG8_SA(0, 0), a2, voffA);
            PG8_BAR; PG8_WAIT_L(0); PG8_MMA(1, 0, At, B0); PG8_BAR; PG8_SCHED;
            PG8_STAGE(PG8_SB(0, 1), b2 + hstep, voffB);
            PG8_WAIT_V(6); PG8_BAR; PG8_MMA(1, 1, At, B1); PG8_BAR;
            PG8_LDB(B0, 1, 0); PG8_SCHED; PG8_LDA(At, 1, 0); PG8_STAGE(PG8_SA(0, 1), a2 + hstep, voffA);
            PG8_WAIT_L(8); PG8_BAR; PG8_WAIT_L(0); PG8_MMA(0, 0, At, B0); PG8_BAR; PG8_SCHED;
            PG8_LDB(B1, 1, 1); PG8_STAGE(PG8_SB(1, 0), b3, voffB);
            PG8_BAR; PG8_WAIT_L(0); PG8_MMA(0, 1, At, B1); PG8_BAR;
            PG8_LDA(At, 1, 1); PG8_STAGE(PG8_SA(1, 0), a3, voffA);
            PG8_BAR; PG8_WAIT_L(0); PG8_MMA(1, 0, At, B0); PG8_BAR; PG8_SCHED;
            PG8_STAGE(PG8_SB(1, 1), b3 + hstep, voffB);
            PG8_WAIT_V(6); PG8_BAR; PG8_MMA(1, 1, At, B1); PG8_BAR;
        }
        E(acc, cur, wr, wc, fr, fq);
        if (!has_next) break;
#pragma unroll
        for (int a = 0; a < 2; ++a)
#pragma unroll
            for (int b = 0; b < 2; ++b)
#pragma unroll
                for (int m = 0; m < 4; ++m)
#pragma unroll
                    for (int n = 0; n < 2; ++n) acc[a][b][m][n] = (f32x4){0.f, 0.f, 0.f, 0.f};
        cur = nxt; cA = nA; cB = nB; nt = cur.nk; ++ui;
    }
    PG8_WAIT_V(0);
    if (wr == 0) PG8_BAR;
    PG8_BAR;
#undef PG8_SA
#undef PG8_SB
#undef PG8_STAGE
#undef PG8_LDA
#undef PG8_LDB
#undef PG8_MMA
#undef PG8_WAIT_V
#undef PG8_WAIT_L
#undef PG8_BAR
#undef PG8_SCHED
}

struct EpiBF {
    static constexpr bool PERM = true;
    bf16_t* O; size_t zO; bf16_t* P; int nz;
    __device__ __forceinline__ void operator()(const f32x4 (&acc)[2][2][4][2], const Unit& u, int wr, int wc, int fr, int fq) const {
        const int col0 = u.pn * BM + wc * 32 + 8 * fq;
        const int row0 = (u.part < 0 ? u.pm * BM : 0) + wr * 64 + fr;
        bf16_t* base = u.part < 0 ? O + (size_t)u.z * zO : P + (size_t)(u.part * nz + u.z) * (BM * D);
#pragma unroll
        for (int ai = 0; ai < 2; ++ai)
#pragma unroll
            for (int m = 0; m < 4; ++m) { bf16_t* rowp = base + (size_t)(row0 + ai * HALF + m * 16) * D + col0;
#pragma unroll
                for (int bj = 0; bj < 2; ++bj) { const f32x4 v0 = acc[ai][bj][m][0], v1 = acc[ai][bj][m][1];
                    u32x4 w; w.x = cvt_pk_bf16(v0[0], v0[1]); w.y = cvt_pk_bf16(v0[2], v0[3]); w.z = cvt_pk_bf16(v1[0], v1[1]); w.w = cvt_pk_bf16(v1[2], v1[3]);
                    *(u32x4*)(rowp + bj * HALF) = w; } }
    }
};
struct EpiGU {
    static constexpr bool PERM = true;
    bf16_t* O; bool dry;
    __device__ __forceinline__ void operator()(const f32x4 (&acc)[2][2][4][2], const Unit& u, int wr, int wc, int fr, int fq) const {
        if (dry) return;
        const int row0 = u.pm * BM + wr * 64 + fr, col0 = u.pn * HALF + wc * 32 + 8 * fq;
#pragma unroll
        for (int ai = 0; ai < 2; ++ai)
#pragma unroll
            for (int m = 0; m < 4; ++m) { bf16_t* rowp = O + (size_t)(row0 + ai * HALF + m * 16) * DFF + col0;
                unsigned wv[4];
#pragma unroll
                for (int n = 0; n < 2; ++n)
#pragma unroll
                    for (int jp = 0; jp < 2; ++jp) {
                        const f32x2 gt = {acc[ai][0][m][n][2 * jp], acc[ai][0][m][n][2 * jp + 1]}, up = {acc[ai][1][m][n][2 * jp], acc[ai][1][m][n][2 * jp + 1]};
                        const f32x2 t = gt * (-1.44269504089f);
                        f32x2 e; e.x = __builtin_amdgcn_exp2f(t.x); e.y = __builtin_amdgcn_exp2f(t.y);
                        const f32x2 d = e + 1.0f;
                        f32x2 r; r.x = __builtin_amdgcn_rcpf(d.x); r.y = __builtin_amdgcn_rcpf(d.y);
                        const f32x2 o = (gt * up) * r;
                        wv[n * 2 + jp] = cvt_pk_bf16(o.x, o.y);
                    }
                u32x4 w; w.x = wv[0]; w.y = wv[1]; w.z = wv[2]; w.w = wv[3];
                *(u32x4*)rowp = w; }
    }
};
struct EpiIN {
    static constexpr bool PERM = true;
    bf16_t* U;
    __device__ __forceinline__ void operator()(const f32x4 (&acc)[2][2][4][2], const Unit& u, int wr, int wc, int fr, int fq) const {
        const int row0 = u.pm * BM + wr * 64 + fr;
        if (u.pn >= 4 && u.pn < 12) {
            const int col0 = (u.pn - 4) * HALF + wc * 32 + 8 * fq; bf16_t* base = U + 2 * SLOT;
#pragma unroll
            for (int ai = 0; ai < 2; ++ai)
#pragma unroll
                for (int m = 0; m < 4; ++m) { bf16_t* rowp = base + (size_t)(row0 + ai * HALF + m * 16) * D + col0;
                    const f32x4 v0 = acc[ai][0][m][0] * acc[ai][1][m][0], v1 = acc[ai][0][m][1] * acc[ai][1][m][1];
                    u32x4 w; w.x = cvt_pk_bf16(v0[0], v0[1]); w.y = cvt_pk_bf16(v0[2], v0[3]); w.z = cvt_pk_bf16(v1[0], v1[1]); w.w = cvt_pk_bf16(v1[2], v1[3]);
                    *(u32x4*)rowp = w; }
        } else {
            int slot, ct; if (u.pn < 4) { slot = 0; ct = u.pn; } else { const int sg = (u.pn - 12) >> 2; slot = sg == 0 ? 3 : (sg == 1 ? 1 : sg + 2); ct = (u.pn - 12) & 3; }
            const int col0 = ct * BM + wc * 32 + 8 * fq; bf16_t* base = U + (size_t)slot * SLOT;
#pragma unroll
            for (int ai = 0; ai < 2; ++ai)
#pragma unroll
                for (int m = 0; m < 4; ++m) { bf16_t* rowp = base + (size_t)(row0 + ai * HALF + m * 16) * D + col0;
#pragma unroll
                    for (int bj = 0; bj < 2; ++bj) { const f32x4 v0 = acc[ai][bj][m][0], v1 = acc[ai][bj][m][1];
                        u32x4 w; w.x = cvt_pk_bf16(v0[0], v0[1]); w.y = cvt_pk_bf16(v0[2], v0[3]); w.z = cvt_pk_bf16(v1[0], v1[1]); w.w = cvt_pk_bf16(v1[2], v1[3]);
                        *(u32x4*)(rowp + bj * HALF) = w; } }
        }
    }
};
}

__device__ __forceinline__ int conv_map(int mode, int n) {
    if (mode == 0) return n;
    if (mode == 1) return 256 * (n >> 7) + (n & 127);
    if (mode == 2) return 256 * (n >> 7) + 128 + (n & 127);
    const int seg = n >> 10, j = n & 1023;
    if (seg == 0) return j;
    if (seg == 1) return 1024 + 256 * (j >> 7) + (j & 127);
    if (seg == 2) return 1024 + 256 * (j >> 7) + 128 + (j & 127);
    return 3072 + (seg - 3) * 1024 + j;
}
struct ConvE { const float* src; bf16_t* dst; const float* gk; int K, N, mode, t; };
__device__ __forceinline__ bool conv_decode(const Params& p, int set, int T, ConvE& e) {
    if (set < 2) {
        const int a = set ? 27 : 8; const float* gk = p.in[set ? 25 : 6];
        if (T < 704)       { e.src = p.in[a];     e.dst = (bf16_t*)(p.ws + WS_WGU); e.gk = gk;      e.K = 1024; e.N = 2816; e.mode = 1; e.t = T; }
        else if (T < 1408) { e.src = p.in[a + 1]; e.dst = (bf16_t*)(p.ws + WS_WGU); e.gk = gk;      e.K = 1024; e.N = 2816; e.mode = 2; e.t = T - 704; }
        else if (T < 2112) { e.src = p.in[a + 2]; e.dst = (bf16_t*)(p.ws + WS_WD);  e.gk = nullptr; e.K = 2816; e.N = 1024; e.mode = 0; e.t = T - 1408; }
        else return false;
    } else {
        if (T < 1792)      { e.src = p.in[13]; e.dst = (bf16_t*)(p.ws + WS_WIN); e.gk = p.in[11]; e.K = 1024; e.N = 7168; e.mode = 3; e.t = T; }
        else if (T < 2048) { e.src = p.in[15]; e.dst = (bf16_t*)(p.ws + WS_WOAB); e.gk = nullptr; e.K = 1024; e.N = 1024; e.mode = 0; e.t = T - 1792; }
        else if (T < 2304) { e.src = p.in[23]; e.dst = (bf16_t*)(p.ws + WS_WOAB + (size_t)1024 * 1024 * 2); e.gk = nullptr; e.K = 1024; e.N = 1024; e.mode = 0; e.t = T - 2048; }
        else if (T < 2560) { e.src = p.in[24]; e.dst = (bf16_t*)(p.ws + WS_WO);  e.gk = nullptr;  e.K = 1024; e.N = 1024; e.mode = 0; e.t = T - 2304; }
        else return false;
    }
    return true;
}
__device__ __forceinline__ void conv_load(const ConvE& e, int tid, f32x4& v0, f32x4& v1) {
    const int ntn = e.N >> 6; const int tk = e.t / ntn, tn = e.t - tk * ntn;
    const float* s0 = e.src + (size_t)(tk * 64 + (tid >> 4)) * e.N + tn * 64 + (tid & 15) * 4;
    v0 = __builtin_nontemporal_load((const f32x4*)s0); v1 = __builtin_nontemporal_load((const f32x4*)(s0 + (size_t)32 * e.N));
}
__device__ __forceinline__ void conv_emit(const ConvE& e, int tid, const f32x4& v0, const f32x4& v1, LAS float* sl) {
    const int ntn = e.N >> 6; const int tk = e.t / ntn, tn = e.t - tk * ntn; const int k0 = tk * 64, n0 = tn * 64;
    { LAS float* d = sl + (tid >> 4) * 65 + (tid & 15) * 4; d[0] = v0[0]; d[1] = v0[1]; d[2] = v0[2]; d[3] = v0[3]; d += 32 * 65; d[0] = v1[0]; d[1] = v1[1]; d[2] = v1[2]; d[3] = v1[3]; }
    __syncthreads();
    const int n = tid >> 3, ko = (tid & 7) * 8;
    float f[8];
#pragma unroll
    for (int i = 0; i < 8; ++i) f[i] = sl[(ko + i) * 65 + n];
    if (e.gk) {
        const f32x4 g0 = *(const f32x4*)(e.gk + k0 + ko), g1 = *(const f32x4*)(e.gk + k0 + ko + 4);
#pragma unroll
        for (int i = 0; i < 4; ++i) { f[i] *= g0[i]; f[4 + i] *= g1[i]; }
    }
    u32x4 w; w.x = cvt_pk_bf16(f[0], f[1]); w.y = cvt_pk_bf16(f[2], f[3]); w.z = cvt_pk_bf16(f[4], f[5]); w.w = cvt_pk_bf16(f[6], f[7]);
    *(u32x4*)(e.dst + (size_t)conv_map(e.mode, n0 + n) * e.K + k0 + ko) = w;
    __syncthreads();
}
__device__ __forceinline__ void convert_set(const Params& p, int set, LAS unsigned char* lds, int tid, int skip, int T0, int T1) {
    ConvE e, en; f32x4 v0, v1, n0 = {0.f, 0.f, 0.f, 0.f}, n1 = {0.f, 0.f, 0.f, 0.f};
    if ((int)blockIdx.x < skip) return;
    int T = T0 + (int)blockIdx.x - skip; const int stride = gridDim.x - skip;
    bool have = T < T1 && conv_decode(p, set, T, e);
    if (have) conv_load(e, tid, v0, v1);
    while (have) {
        T += stride;
        const bool hn = T < T1 && conv_decode(p, set, T, en);
        if (hn) conv_load(en, tid, n0, n1);
        conv_emit(e, tid, v0, v1, (LAS float*)lds);
        e = en; v0 = n0; v1 = n1; have = hn;
    }
}

__device__ __forceinline__ void norm_phase(const Params& p, int mode, int tid, bool dry, int nsplit) {
    const int lane = tid & 63, gw = blockIdx.x * 8 + (tid >> 6), nw = gridDim.x * 8;
    const float* gpost = mode == 1 ? p.in[7] : (mode == 2 ? p.in[12] : p.in[26]);
    const float cc = mode == 2 ? 1.0f : 0.5f;
    const bf16_t* Yb = (const bf16_t*)(p.ws + WS_Y); const bf16_t* PY = (const bf16_t*)(p.ws + WS_PY); bf16_t* H = (bf16_t*)(p.ws + WS_H); float* SC = (float*)(p.ws + WS_SC);
    for (int r = gw; r < M; r += nw) {
        f32x4 xv[4];
        if (mode == 0) {
            const float* xin = x0row(p, r);
#pragma unroll
            for (int q = 0; q < 4; ++q) xv[q] = __builtin_nontemporal_load((const f32x4*)(xin + lane * 4 + 256 * q));
        } else {
            const float sc = SC[r];
#pragma unroll
            for (int q = 0; q < 4; ++q) { const u32x2 w = *(const u32x2*)(H + (size_t)r * D + lane * 4 + 256 * q); xv[q] = (f32x4){bflo(w.x), bfhi(w.x), bflo(w.y), bfhi(w.y)} * sc; }
            f32x4 yv[4]; float ss = 0.f;
            if (r < MAINR) {
#pragma unroll
                for (int q = 0; q < 4; ++q) { const u32x2 w = *(const u32x2*)(Yb + (size_t)r * D + lane * 4 + 256 * q); yv[q] = (f32x4){bflo(w.x), bfhi(w.x), bflo(w.y), bfhi(w.y)}; }
            } else {
#pragma unroll
                for (int q = 0; q < 4; ++q) yv[q] = (f32x4){0.f, 0.f, 0.f, 0.f};
                for (int ks0 = 0; ks0 < nsplit; ks0 += 4) {
                    f32x4 pv[4][4];
#pragma unroll
                    for (int k = 0; k < 4; ++k) { const int ks = (ks0 + k < nsplit) ? ks0 + k : ks0;
#pragma unroll
                        for (int q = 0; q < 4; ++q) { const u32x2 w = *(const u32x2*)(PY + ((size_t)ks * 256 + (r - MAINR)) * D + lane * 4 + 256 * q); pv[k][q] = (f32x4){bflo(w.x), bfhi(w.x), bflo(w.y), bfhi(w.y)}; } }
#pragma unroll
                    for (int k = 0; k < 4; ++k) { const float m = (ks0 + k < nsplit) ? 1.0f : 0.0f;
#pragma unroll
                        for (int q = 0; q < 4; ++q) yv[q] += pv[k][q] * m; }
                }
            }
#pragma unroll
            for (int q = 0; q < 4; ++q) ss += yv[q][0] * yv[q][0] + yv[q][1] * yv[q][1] + yv[q][2] * yv[q][2] + yv[q][3] * yv[q][3];
            ss = wave_sum(ss, lane);
            const float rs = cc * rsqrtf(ss * (1.0f / D) + EPS);
#pragma unroll
            for (int q = 0; q < 4; ++q) xv[q] += yv[q] * rs * *(const f32x4*)(gpost + lane * 4 + 256 * q);
        }
        if (mode == 3) {
            float* xo;
            if (r >= MP) xo = p.out + O_YS + (size_t)(r - MP) * D;
            else { const int b = r / TP, t = r - b * TP; if (t < NMETA) continue; xo = p.out + O_YP + ((size_t)b * SEQ + (t - NMETA)) * D; }
#pragma unroll
            for (int q = 0; q < 4; ++q) __builtin_nontemporal_store(xv[q], (f32x4*)(xo + lane * 4 + 256 * q));
        } else {
            float ss = 0.f;
#pragma unroll
            for (int q = 0; q < 4; ++q) ss += xv[q][0] * xv[q][0] + xv[q][1] * xv[q][1] + xv[q][2] * xv[q][2] + xv[q][3] * xv[q][3];
            ss = wave_sum(ss, lane);
            const float ms = ss * (1.0f / D) + EPS; const float rs = rsqrtf(ms);
            if (!dry) {
#pragma unroll
                for (int q = 0; q < 4; ++q) { const f32x4 hv = xv[q] * rs; u32x2 w; w.x = cvt_pk_bf16(hv[0], hv[1]); w.y = cvt_pk_bf16(hv[2], hv[3]);
                    *(u32x2*)(H + (size_t)r * D + lane * 4 + 256 * q) = w; }
                if (lane == 0) SC[r] = ms * rs;
            }
        }
    }
}

constexpr int WL_BYTES = 11264;
__device__ __forceinline__ void scan_item(const Params& p, int b, int j, int h, LAS unsigned char* wl, const LAS unsigned char* wlds, int lane, bool dry) {
    bf16_t* U = (bf16_t*)(p.ws + WS_U);
    const bf16_t* bx = U + 3 * SLOT; bf16_t* bg = U + 1 * SLOT; bf16_t* pp = (bf16_t*)p.out;
    float* summ = (float*)(p.ws + WS_SUMM);
    const int c = h * 64 + lane, fr = lane & 15, fq = lane >> 4;
    const size_t row0 = (size_t)b * TP + (size_t)j * CHUNK;
    const bf16_t* bx0 = bx + row0 * D; bf16_t* bg0 = bg + row0 * D; bf16_t* pp0 = pp + row0 * D;
    const LAS unsigned char* wq = wlds + fr * 144 + fq * 16;
    float brv[4], biv[4], lcv[4];
#pragma unroll
    for (int nt = 0; nt < 4; ++nt) { const int ch = h * 64 + nt * 16 + fr; brv[nt] = p.in[19][ch]; biv[nt] = p.in[21][ch]; lcv[nt] = ((const float*)(p.ws + WS_LC))[ch]; }
    const float w0 = p.in[16][c], w1 = p.in[16][D + c], w2 = p.in[16][2 * D + c], w3 = p.in[16][3 * D + c], cbias = p.in[17][c];
    float xm3 = 0.f, xm2 = 0.f, xm1 = 0.f;
    if (j > 0) { xm3 = bf2f(bx0[-3 * D + c]); xm2 = bf2f(bx0[-2 * D + c]); xm1 = bf2f(bx0[-1 * D + c]); }
    float hh = 0.f, ap = 1.f;
    LAS unsigned short* cbT = (LAS unsigned short*)wl;
    LAS float* xu = (LAS float*)(wl + 2304);
    LAS float* aS = (LAS float*)(wl + 2304 + 4352);
    bf16_t xr[16], gr[16], xn[16], gn[16];
#pragma unroll
    for (int tt = 0; tt < 16; ++tt) { xr[tt] = bx0[tt * D + c]; gr[tt] = bg0[tt * D + c]; }
#pragma unroll
    for (int g = 0; g < 3; ++g) {
        const int r0 = g * 16;
        if (g < 2) {
#pragma unroll
            for (int tt = 0; tt < 16; ++tt) { xn[tt] = bx0[(r0 + 16 + tt) * D + c]; gn[tt] = bg0[(r0 + 16 + tt) * D + c]; }
        }
#pragma unroll
        for (int tt = 0; tt < 16; ++tt) { const float x = bf2f(xr[tt]); const float cb = w0 * xm3 + w1 * xm2 + w2 * xm1 + w3 * x + cbias; xm3 = xm2; xm2 = xm1; xm1 = x;
            cbT[tt * 72 + lane] = f2bf(cb); xu[tt * 68 + lane] = cb; }
        __builtin_amdgcn_wave_barrier();
        const bf16x8 a0 = *(const LAS bf16x8*)(cbT + fr * 72 + fq * 8), a1 = *(const LAS bf16x8*)(cbT + fr * 72 + 32 + fq * 8);
        f32x4 accR[4], accI[4];
#pragma unroll
        for (int nt = 0; nt < 4; ++nt) {
            const bf16x8 r0w = *(const LAS bf16x8*)(wq + nt * 2304), r1w = *(const LAS bf16x8*)(wq + nt * 2304 + 64);
            const bf16x8 i0w = *(const LAS bf16x8*)(wq + 9216 + nt * 2304), i1w = *(const LAS bf16x8*)(wq + 9216 + nt * 2304 + 64);
            accR[nt] = __builtin_amdgcn_mfma_f32_16x16x32_bf16(a0, r0w, (f32x4){0.f, 0.f, 0.f, 0.f}, 0, 0, 0);
            accR[nt] = __builtin_amdgcn_mfma_f32_16x16x32_bf16(a1, r1w, accR[nt], 0, 0, 0);
            accI[nt] = __builtin_amdgcn_mfma_f32_16x16x32_bf16(a0, i0w, (f32x4){0.f, 0.f, 0.f, 0.f}, 0, 0, 0);
            accI[nt] = __builtin_amdgcn_mfma_f32_16x16x32_bf16(a1, i1w, accI[nt], 0, 0, 0);
        }
#pragma unroll
        for (int nt = 0; nt < 4; ++nt)
#pragma unroll
            for (int ip = 0; ip < 2; ++ip) {
                const int idx0 = (fq * 4 + 2 * ip) * 68 + nt * 16 + fr, idx1 = idx0 + 68;
                const f32x2 tr = ((f32x2){accR[nt][2 * ip], accR[nt][2 * ip + 1]} + brv[nt]) * (-1.44269504089f), ti = ((f32x2){accI[nt][2 * ip], accI[nt][2 * ip + 1]} + biv[nt]) * (-1.44269504089f);
                f32x2 er, ei; er.x = __builtin_amdgcn_exp2f(tr.x); er.y = __builtin_amdgcn_exp2f(tr.y); ei.x = __builtin_amdgcn_exp2f(ti.x); ei.y = __builtin_amdgcn_exp2f(ti.y);
                const f32x2 dr = er + 1.0f, di = ei + 1.0f;
                f32x2 r, ig; r.x = __builtin_amdgcn_rcpf(dr.x); r.y = __builtin_amdgcn_rcpf(dr.y); ig.x = __builtin_amdgcn_rcpf(di.x); ig.y = __builtin_amdgcn_rcpf(di.y);
                const f32x2 la = r * lcv[nt]; const f32x2 tl = la * 1.44269504089f;
                f32x2 a; a.x = __builtin_amdgcn_exp2f(tl.x); a.y = __builtin_amdgcn_exp2f(tl.y);
                const f32x2 z2 = la + la;
                const f32x2 m2s = -z2 * (z2 * (z2 * (z2 * (z2 * (z2 * 0.0013888889f + 0.0083333338f) + 0.041666668f) + 0.16666667f) + 0.5f) + 1.0f);
                const f32x2 m2b = 1.0f - a * a;
                f32x2 sq; sq.x = __builtin_amdgcn_sqrtf(z2.x > -0.25f ? m2s.x : m2b.x); sq.y = __builtin_amdgcn_sqrtf(z2.y > -0.25f ? m2s.y : m2b.y);
                const f32x2 uo = sq * ig * (f32x2){xu[idx0], xu[idx1]};
                xu[idx0] = uo.x; xu[idx1] = uo.y; aS[idx0] = a.x; aS[idx1] = a.y; }
        __builtin_amdgcn_wave_barrier();
        f32x2 glv[8];
#pragma unroll
        for (int tp = 0; tp < 8; ++tp) { const f32x2 x = {bf2f(gr[2 * tp]), bf2f(gr[2 * tp + 1])};
            const f32x2 t = x * (x * x * (-0.10294324f) + (-2.30220819f));
            f32x2 e; e.x = __builtin_amdgcn_exp2f(t.x); e.y = __builtin_amdgcn_exp2f(t.y);
            const f32x2 d = e + 1.0f;
            f32x2 rr; rr.x = __builtin_amdgcn_rcpf(d.x); rr.y = __builtin_amdgcn_rcpf(d.y);
            glv[tp] = x * rr; }
#pragma unroll
        for (int tt = 0; tt < 16; ++tt) { const float a = aS[tt * 68 + lane], uu = xu[tt * 68 + lane]; hh = a * hh + uu; ap *= a;
            const f32x2 o = (f32x2){hh, ap} * ((tt & 1) ? glv[tt >> 1].y : glv[tt >> 1].x);
            const unsigned w = cvt_pk_bf16(o.x, o.y);
            if (!dry) bg0[(r0 + tt) * D + c] = (bf16_t)(w & 0xffffu);
            pp0[(r0 + tt) * D + c] = (bf16_t)(w >> 16); }
        __builtin_amdgcn_wave_barrier();
        if (g < 2) {
#pragma unroll
            for (int tt = 0; tt < 16; ++tt) { xr[tt] = xn[tt]; gr[tt] = gn[tt]; }
        }
    }
    *(float2*)(summ + (((size_t)b * NCH + j) * D + c) * 2) = make_float2(ap, hh);
    if (j == NCH - 1) { p.out[O_CBP + ((size_t)b * 3 + 0) * D + c] = xm3; p.out[O_CBP + ((size_t)b * 3 + 1) * D + c] = xm2; p.out[O_CBP + ((size_t)b * 3 + 2) * D + c] = xm1; }
}
__device__ __forceinline__ void sample_item(const Params& p, int k, int h, LAS unsigned char* wl, const LAS unsigned char* wlds, int lane) {
    bf16_t* U = (bf16_t*)(p.ws + WS_U);
    const int c = h * 64 + lane, fr = lane & 15, fq = lane >> 4;
    const size_t row0 = (size_t)MP + (size_t)k * 16; const int s0 = k * 16;
    const bf16_t* bx0 = U + 3 * SLOT + row0 * D; bf16_t* bg0 = U + 1 * SLOT + row0 * D;
    const LAS unsigned char* wq = wlds + fr * 144 + fq * 16;
    float brv[4], biv[4], lcv[4];
#pragma unroll
    for (int nt = 0; nt < 4; ++nt) { const int ch = h * 64 + nt * 16 + fr; brv[nt] = p.in[19][ch]; biv[nt] = p.in[21][ch]; lcv[nt] = ((const float*)(p.ws + WS_LC))[ch]; }
    const float w3 = p.in[16][3 * D + c];
    LAS unsigned short* cbT = (LAS unsigned short*)wl;
    LAS float* xu = (LAS float*)(wl + 2304);
    LAS float* aS = (LAS float*)(wl + 2304 + 4352);
    const float* pcb = (const float*)(p.ws + WS_PCB) + (size_t)s0 * D + c;
    {
        bf16_t xr[16]; float pc[16];
#pragma unroll
        for (int tt = 0; tt < 16; ++tt) { xr[tt] = bx0[tt * D + c]; pc[tt] = pcb[tt * D]; }
#pragma unroll
        for (int tt = 0; tt < 16; ++tt) { const float x = bf2f(xr[tt]); const float cb = pc[tt] + w3 * x;
            p.out[O_CBS + ((size_t)(s0 + tt) * 3 + 2) * D + c] = x;
            cbT[tt * 72 + lane] = f2bf(cb); xu[tt * 68 + lane] = cb; }
    }
    __builtin_amdgcn_wave_barrier();
    const bf16x8 a0 = *(const LAS bf16x8*)(cbT + fr * 72 + fq * 8), a1 = *(const LAS bf16x8*)(cbT + fr * 72 + 32 + fq * 8);
    f32x4 accR[4], accI[4];
#pragma unroll
    for (int nt = 0; nt < 4; ++nt) {
        const bf16x8 r0w = *(const LAS bf16x8*)(wq + nt * 2304), r1w = *(const LAS bf16x8*)(wq + nt * 2304 + 64);
        const bf16x8 i0w = *(const LAS bf16x8*)(wq + 9216 + nt * 2304), i1w = *(const LAS bf16x8*)(wq + 9216 + nt * 2304 + 64);
        accR[nt] = __builtin_amdgcn_mfma_f32_16x16x32_bf16(a0, r0w, (f32x4){0.f, 0.f, 0.f, 0.f}, 0, 0, 0);
        accR[nt] = __builtin_amdgcn_mfma_f32_16x16x32_bf16(a1, r1w, accR[nt], 0, 0, 0);
        accI[nt] = __builtin_amdgcn_mfma_f32_16x16x32_bf16(a0, i0w, (f32x4){0.f, 0.f, 0.f, 0.f}, 0, 0, 0);
        accI[nt] = __builtin_amdgcn_mfma_f32_16x16x32_bf16(a1, i1w, accI[nt], 0, 0, 0);
    }
#pragma unroll
    for (int nt = 0; nt < 4; ++nt)
#pragma unroll
        for (int ip = 0; ip < 2; ++ip) {
                const int idx0 = (fq * 4 + 2 * ip) * 68 + nt * 16 + fr, idx1 = idx0 + 68;
                const f32x2 tr = ((f32x2){accR[nt][2 * ip], accR[nt][2 * ip + 1]} + brv[nt]) * (-1.44269504089f), ti = ((f32x2){accI[nt][2 * ip], accI[nt][2 * ip + 1]} + biv[nt]) * (-1.44269504089f);
                f32x2 er, ei; er.x = __builtin_amdgcn_exp2f(tr.x); er.y = __builtin_amdgcn_exp2f(tr.y); ei.x = __builtin_amdgcn_exp2f(ti.x); ei.y = __builtin_amdgcn_exp2f(ti.y);
                const f32x2 dr = er + 1.0f, di = ei + 1.0f;
                f32x2 r, ig; r.x = __builtin_amdgcn_rcpf(dr.x); r.y = __builtin_amdgcn_rcpf(dr.y); ig.x = __builtin_amdgcn_rcpf(di.x); ig.y = __builtin_amdgcn_rcpf(di.y);
                const f32x2 la = r * lcv[nt]; const f32x2 tl = la * 1.44269504089f;
                f32x2 a; a.x = __builtin_amdgcn_exp2f(tl.x); a.y = __builtin_amdgcn_exp2f(tl.y);
                const f32x2 z2 = la + la;
                const f32x2 m2s = -z2 * (z2 * (z2 * (z2 * (z2 * (z2 * 0.0013888889f + 0.0083333338f) + 0.041666668f) + 0.16666667f) + 0.5f) + 1.0f);
                const f32x2 m2b = 1.0f - a * a;
                f32x2 sq; sq.x = __builtin_amdgcn_sqrtf(z2.x > -0.25f ? m2s.x : m2b.x); sq.y = __builtin_amdgcn_sqrtf(z2.y > -0.25f ? m2s.y : m2b.y);
                const f32x2 uo = sq * ig * (f32x2){xu[idx0], xu[idx1]};
                xu[idx0] = uo.x; xu[idx1] = uo.y; aS[idx0] = a.x; aS[idx1] = a.y; }
    __builtin_amdgcn_wave_barrier();
    {
        float h0[16]; bf16_t gq[16];
#pragma unroll
        for (int tt = 0; tt < 16; ++tt) { h0[tt] = p.in[4][(size_t)(s0 + tt) * D + c]; gq[tt] = bg0[tt * D + c]; }
#pragma unroll
        for (int tt = 0; tt < 16; ++tt) {
            const float hn = aS[tt * 68 + lane] * h0[tt] + xu[tt * 68 + lane];
            p.out[O_RGS + (size_t)(s0 + tt) * D + c] = hn;
            bg0[tt * D + c] = f2bf(gelu_tanh(bf2f(gq[tt])) * hn);
        }
    }
    __builtin_amdgcn_wave_barrier();
}
__device__ __forceinline__ void scan_phase(const Params& p, LAS unsigned char* lds, int tid, bool dry) {
    const int wid = __builtin_amdgcn_readfirstlane(tid >> 6), lane = tid & 63;
    LAS unsigned char* wl = lds + wid * WL_BYTES;
    LAS unsigned char* wlds = lds + 8 * WL_BYTES;
    const int h = blockIdx.x & 15;
    {
        const bf16_t* wt = (const bf16_t*)(p.ws + WS_WRG);
#pragma unroll
        for (int q = 0; q < 2; ++q) { const int e = tid + q * 512, g = e >> 9, jrow = (e >> 3) & 63, pc = e & 7;
            *(LAS u32x4*)(wlds + g * 9216 + jrow * 144 + pc * 16) = *(const u32x4*)(wt + (size_t)g * 65536 + (size_t)(h * 64 + jrow) * 64 + pc * 8); }
    }
    __syncthreads();
    const int nbh = gridDim.x >> 4;
    for (int it = (blockIdx.x >> 4) * 8 + wid; it < NB * NCH; it += nbh * 8) scan_item(p, it / NCH, it % NCH, h, wl, wlds, lane, dry);
    if (!dry && wid < 2 && (int)(blockIdx.x >> 4) >= nbh - 4) {
        const int k = ((int)(blockIdx.x >> 4) - (nbh - 4)) * 2 + wid;
        if (k < NS / 16) sample_item(p, k, h, wl, wlds, lane);
    }
    __syncthreads();
}
__device__ __forceinline__ void fix_phase(const Params& p, LAS unsigned char* lds, int tid, bool dry) {
    bf16_t* zb = (bf16_t*)(p.ws + WS_U) + 1 * SLOT; const bf16_t* pp = (const bf16_t*)p.out;
    const float* summ = (const float*)(p.ws + WS_SUMM);
    LAS float* cs = (LAS float*)lds;
    for (int it = blockIdx.x; it < NB * (NCH - 1); it += gridDim.x) {
        const int b = it / (NCH - 1), j = it % (NCH - 1) + 1;
#pragma unroll
        for (int cq = 0; cq < 2; ++cq) {
            const int c = tid + cq * 512; const float* sp = summ + ((size_t)b * NCH * D + c) * 2; float hh = 0.f;
            for (int i0 = 0; i0 < j; i0 += 16) {
                float va[16], vh[16];
#pragma unroll
                for (int k = 0; k < 16; ++k) { if (i0 + k < j) { const float2 v = *(const float2*)(sp + (size_t)(i0 + k) * D * 2); va[k] = v.x; vh[k] = v.y; } else { va[k] = 1.f; vh[k] = 0.f; } }
#pragma unroll
                for (int k = 0; k < 16; ++k) hh = va[k] * hh + vh[k];
            }
            cs[c] = hh;
            if (j == NCH - 1) { const float2 v = *(const float2*)(sp + (size_t)j * D * 2); p.out[O_RGP + (size_t)b * D + c] = v.x * hh + v.y; }
        }
        __syncthreads();
        const size_t row0 = (size_t)b * TP + (size_t)j * CHUNK;
        for (int q0 = 0; q0 < CHUNK * 128 / 512; q0 += 4) {
            u32x4 zq[4], pq[4];
#pragma unroll
            for (int k = 0; k < 4; ++k) { const int e = tid + (q0 + k) * 512, tt = e >> 7, vc = e & 127; const size_t o = (row0 + tt) * D + vc * 8; zq[k] = *(const u32x4*)(zb + o); pq[k] = *(const u32x4*)(pp + o); }
#pragma unroll
            for (int k = 0; k < 4; ++k) { const int e = tid + (q0 + k) * 512, tt = e >> 7, vc = e & 127; const size_t o = (row0 + tt) * D + vc * 8;
                const f32x4 c0 = *(const LAS f32x4*)(cs + vc * 8), c1 = *(const LAS f32x4*)(cs + vc * 8 + 4);
                u32x4 w;
                w.x = cvt_pk_bf16(bflo(zq[k].x) + bflo(pq[k].x) * c0[0], bfhi(zq[k].x) + bfhi(pq[k].x) * c0[1]); w.y = cvt_pk_bf16(bflo(zq[k].y) + bflo(pq[k].y) * c0[2], bfhi(zq[k].y) + bfhi(pq[k].y) * c0[3]);
                w.z = cvt_pk_bf16(bflo(zq[k].z) + bflo(pq[k].z) * c1[0], bfhi(zq[k].z) + bfhi(pq[k].z) * c1[1]); w.w = cvt_pk_bf16(bflo(zq[k].w) + bflo(pq[k].w) * c1[2], bfhi(zq[k].w) + bfhi(pq[k].w) * c1[3]);
                if (!dry) *(u32x4*)(zb + o) = w; }
        }
        __syncthreads();
    }
}
__device__ __forceinline__ void za_phase(const Params& p, int tid, bool dry) {
    bf16_t* U = (bf16_t*)(p.ws + WS_U); bf16_t* ab = U; const bf16_t* ca = U + 2 * SLOT;
    const float* cw = p.in[14];
    for (int idx = blockIdx.x * 512 + tid; idx < NB * 129 * 128; idx += gridDim.x * 512) {
        const int vc = idx & 127, tb = (idx >> 7) % 129, b = idx / (128 * 129); const int c0 = vc * 8;
        float w[3][8];
#pragma unroll
        for (int k = 0; k < 3; ++k) { const f32x4 a = *(const f32x4*)(cw + k * D + c0), bq = *(const f32x4*)(cw + k * D + c0 + 4);
#pragma unroll
            for (int e = 0; e < 4; ++e) { w[k][e] = a[e]; w[k][4 + e] = bq[e]; } }
        const size_t r0 = (size_t)b * TP + (size_t)tb * 16;
        float p2[8], p1[8];
        if (tb > 0) { const u32x4 q2 = *(const u32x4*)(ca + (r0 - 2) * D + c0), q1 = *(const u32x4*)(ca + (r0 - 1) * D + c0);
#pragma unroll
            for (int e = 0; e < 4; ++e) { p2[2 * e] = bflo(q2[e]); p2[2 * e + 1] = bfhi(q2[e]); p1[2 * e] = bflo(q1[e]); p1[2 * e + 1] = bfhi(q1[e]); } }
        else {
#pragma unroll
            for (int e = 0; e < 8; ++e) { p2[e] = 0.f; p1[e] = 0.f; } }
        for (int t4 = 0; t4 < 16; t4 += 4) {
            u32x4 qcs[4], qas[4];
#pragma unroll
            for (int k = 0; k < 4; ++k) { qcs[k] = *(const u32x4*)(ca + (r0 + t4 + k) * D + c0); qas[k] = *(const u32x4*)(ab + (r0 + t4 + k) * D + c0); }
#pragma unroll
            for (int k = 0; k < 4; ++k) {
                const u32x4 qc = qcs[k], qa = qas[k];
                float cv[8], av[8], zv[8];
#pragma unroll
                for (int e = 0; e < 4; ++e) { cv[2 * e] = bflo(qc[e]); cv[2 * e + 1] = bfhi(qc[e]); av[2 * e] = bflo(qa[e]); av[2 * e + 1] = bfhi(qa[e]); }
#pragma unroll
                for (int e = 0; e < 8; ++e) { zv[e] = av[e] * (w[0][e] * p2[e] + w[1][e] * p1[e] + w[2][e] * cv[e]); p2[e] = p1[e]; p1[e] = cv[e]; }
                u32x4 o; o.x = cvt_pk_bf16(zv[0], zv[1]); o.y = cvt_pk_bf16(zv[2], zv[3]); o.z = cvt_pk_bf16(zv[4], zv[5]); o.w = cvt_pk_bf16(zv[6], zv[7]);
                if (!dry) *(u32x4*)(ab + (r0 + t4 + k) * D + c0) = o;
            }
        }
        if (tb == 128) {
            float* o2 = p.out + O_CAP + ((size_t)b * 2 + 0) * D + c0; float* o1 = p.out + O_CAP + ((size_t)b * 2 + 1) * D + c0;
            *(f32x4*)o2 = (f32x4){p2[0], p2[1], p2[2], p2[3]}; *(f32x4*)(o2 + 4) = (f32x4){p2[4], p2[5], p2[6], p2[7]};
            *(f32x4*)o1 = (f32x4){p1[0], p1[1], p1[2], p1[3]}; *(f32x4*)(o1 + 4) = (f32x4){p1[4], p1[5], p1[6], p1[7]};
        }
    }
    if (!dry) {
        for (int idx = blockIdx.x * 512 + tid; idx < NS * 128; idx += gridDim.x * 512) {
            const int vc = idx & 127, sm = idx >> 7, c0 = vc * 8; const size_t ro = (size_t)(MP + sm) * D + c0;
            const u32x4 qc = *(const u32x4*)(ca + ro), qa = *(const u32x4*)(ab + ro);
            const float* pca = (const float*)(p.ws + WS_PCA) + (size_t)sm * D + c0;
            float hp[8], cv[8], zv[8];
            { const f32x4 a0 = *(const f32x4*)pca, a1 = *(const f32x4*)(pca + 4);
#pragma unroll
              for (int e = 0; e < 4; ++e) { hp[e] = a0[e]; hp[4 + e] = a1[e]; } }
#pragma unroll
            for (int e = 0; e < 4; ++e) { cv[2 * e] = bflo(qc[e]); cv[2 * e + 1] = bfhi(qc[e]); }
#pragma unroll
            for (int e = 0; e < 8; ++e) { const float av = (e & 1) ? bfhi(qa[e >> 1]) : bflo(qa[e >> 1]); zv[e] = av * (hp[e] + cw[2 * D + c0 + e] * cv[e]); }
            u32x4 o; o.x = cvt_pk_bf16(zv[0], zv[1]); o.y = cvt_pk_bf16(zv[2], zv[3]); o.z = cvt_pk_bf16(zv[4], zv[5]); o.w = cvt_pk_bf16(zv[6], zv[7]);
            *(u32x4*)(ab + ro) = o;
            float* o1 = p.out + O_CAS + ((size_t)sm * 2 + 1) * D + c0;
            *(f32x4*)o1 = (f32x4){cv[0], cv[1], cv[2], cv[3]}; *(f32x4*)(o1 + 4) = (f32x4){cv[4], cv[5], cv[6], cv[7]};
        }
    }
}

__device__ __forceinline__ u32x4 merge_math(const u32x4& ga, const u32x4& gb, const float (&ya)[8], const float (&yb)[8]) {
    u32x4 o4;
#pragma unroll
    for (int e = 0; e < 4; ++e) { const float lo = sigm(bflo(ga[e])) * ya[2 * e] + sigm(bflo(gb[e])) * yb[2 * e], hi = sigm(bfhi(ga[e])) * ya[2 * e + 1] + sigm(bfhi(gb[e])) * yb[2 * e + 1]; o4[e] = cvt_pk_bf16(lo, hi); }
    return o4;
}
__device__ __forceinline__ void merge_phase(const Params& p, int tid) {
    const bf16_t* U = (const bf16_t*)(p.ws + WS_U); bf16_t* H = (bf16_t*)p.out; const bf16_t* PO = (const bf16_t*)(p.ws + WS_POAB);
    const size_t G = (size_t)gridDim.x * 512, NMAIN = (size_t)MAINR * 128;
    for (size_t i0 = (size_t)blockIdx.x * 512 + tid; i0 < NMAIN; i0 += 4 * G) {
        u32x4 ga[4], gb[4], a[4], b[4];
#pragma unroll
        for (int k = 0; k < 4; ++k) { const size_t i = i0 + k * G; if (i < NMAIN) { ga[k] = __builtin_nontemporal_load((const u32x4*)(U + 4 * SLOT + i * 8)); gb[k] = __builtin_nontemporal_load((const u32x4*)(U + 5 * SLOT + i * 8)); a[k] = __builtin_nontemporal_load((const u32x4*)(U + 2 * SLOT + i * 8)); b[k] = __builtin_nontemporal_load((const u32x4*)(U + 3 * SLOT + i * 8)); } }
#pragma unroll
        for (int k = 0; k < 4; ++k) { const size_t i = i0 + k * G; if (i < NMAIN) {
            float ya[8], yb[8];
#pragma unroll
            for (int e = 0; e < 4; ++e) { ya[2 * e] = bflo(a[k][e]); ya[2 * e + 1] = bfhi(a[k][e]); yb[2 * e] = bflo(b[k][e]); yb[2 * e + 1] = bfhi(b[k][e]); }
            *(u32x4*)(H + i * 8) = merge_math(ga[k], gb[k], ya, yb); } }
    }
    for (size_t i = NMAIN + (size_t)blockIdx.x * 512 + tid; i < SLOT / 8; i += G) {
        const u32x4 ga = *(const u32x4*)(U + 4 * SLOT + i * 8), gb = *(const u32x4*)(U + 5 * SLOT + i * 8);
        float ya[8], yb[8];
        const int row = (int)(i >> 7);
        const size_t o = (size_t)(row - MAINR) * D + (size_t)(i & 127) * 8;
#pragma unroll
        for (int e = 0; e < 8; ++e) { ya[e] = 0.f; yb[e] = 0.f; }
#pragma unroll
        for (int ks = 0; ks < 4; ++ks) {
            const u32x4 a0 = *(const u32x4*)(PO + (size_t)(ks * 2 + 0) * (256 * D) + o), b0 = *(const u32x4*)(PO + (size_t)(ks * 2 + 1) * (256 * D) + o);
#pragma unroll
            for (int e = 0; e < 4; ++e) { ya[2 * e] += bflo(a0[e]); ya[2 * e + 1] += bfhi(a0[e]); yb[2 * e] += bflo(b0[e]); yb[2 * e + 1] += bfhi(b0[e]); }
        }
        *(u32x4*)(H + i * 8) = merge_math(ga, gb, ya, yb);
    }
}

#define XB_TMO      128
#define XB_XCNT(j)  (256  + 64 * (j))
#define XB_XSUB(j)  (1280 + 64 * (j))
#define XB_XGEN(j)  (2304 + 64 * (j))
#define XB_TOP      3328
#define XB_TOPGEN   3392
#define XCD_BAR_WORDS 3456
#define XB_SPIN_CAP (1u << 18)
__device__ __forceinline__ unsigned xb_ld(unsigned* p)              { return __hip_atomic_load(p, __ATOMIC_RELAXED, __HIP_MEMORY_SCOPE_AGENT); }
__device__ __forceinline__ unsigned xb_add(unsigned* p, unsigned v) { return __hip_atomic_fetch_add(p, v, __ATOMIC_RELAXED, __HIP_MEMORY_SCOPE_AGENT); }
__device__ __forceinline__ unsigned xb_xcc_id() { return (unsigned)__builtin_amdgcn_s_getreg((3 << 11) | 20) & 0xFu; }
#define XB_SPIN(cond, bar) do { unsigned _sp = 0; while (cond) { __builtin_amdgcn_s_sleep(1); \
    if ((++_sp & 255u) == 0u) { if (xb_ld(&(bar)[XB_TMO])) break; if (_sp > XB_SPIN_CAP) { atomicAdd(&(bar)[XB_TMO], 1u); break; } } } } while (0)
struct XcdBarrier { unsigned* bar; unsigned x; volatile LAS unsigned* st; };
__device__ __forceinline__ XcdBarrier xcd_barrier_post(unsigned* bar, volatile LAS unsigned* st) {
    XcdBarrier b; b.bar = bar; b.x = xb_xcc_id(); b.st = st;
    if (threadIdx.x == 0) (void)xb_add(&bar[XB_XCNT(b.x)], 1u);
    return b;
}
__device__ __forceinline__ void xcd_barrier_complete(unsigned* bar, unsigned x, unsigned& nloc, unsigned& nx) {
    const unsigned G = gridDim.x * gridDim.y * gridDim.z;
    unsigned sum, cnt, mine, sp = 0u;
    for (;;) {
        sum = 0u; cnt = 0u; mine = 0u;
#pragma unroll
        for (unsigned j = 0; j < 16; ++j) { const unsigned c = xb_ld(&bar[XB_XCNT(j)]); sum += c; cnt += (c > 0u) ? 1u : 0u; mine = (j == x) ? c : mine; }
        if (sum == G) break;
        __builtin_amdgcn_s_sleep(1);
        if ((++sp & 255u) == 0u) { if (xb_ld(&bar[XB_TMO])) break; if (sp > XB_SPIN_CAP) { atomicAdd(&bar[XB_TMO], 1u); break; } }
    }
    nloc = mine > 0u ? mine : 1u; nx = cnt > 0u ? cnt : 1u;
}
__device__ __forceinline__ void xcd_barrier(const XcdBarrier& b) {
    asm volatile("s_waitcnt vmcnt(0)" ::: "memory");
    __syncthreads();
    if (threadIdx.x == 0) {
        unsigned* bar = b.bar;
        __builtin_amdgcn_s_waitcnt(0);
        unsigned nloc = b.st[0], nx = b.st[1];
        if (nloc == 0u) { xcd_barrier_complete(bar, b.x, nloc, nx); b.st[0] = nloc; b.st[1] = nx; }
        const unsigned old = xb_add(&bar[XB_XSUB(b.x)], 1u);
        const unsigned gen = old / nloc;
        if (old + 1u == (gen + 1u) * nloc) {
            __builtin_amdgcn_fence(__ATOMIC_RELEASE, "agent");
            asm volatile("s_waitcnt vmcnt(0)" ::: "memory");
            const unsigned og = xb_add(&bar[XB_TOP], 1u);
            const unsigned tg = og / nx;
            if (og + 1u == (tg + 1u) * nx) xb_add(&bar[XB_TOPGEN], 1u);
            else XB_SPIN(xb_ld(&bar[XB_TOPGEN]) == tg, bar);
            __builtin_amdgcn_fence(__ATOMIC_ACQUIRE, "agent");
            xb_add(&bar[XB_XGEN(b.x)], 1u);
            asm volatile("s_waitcnt vmcnt(0)" ::: "memory");
        } else {
            XB_SPIN(xb_ld(&bar[XB_XGEN(b.x)]) == gen, bar);
            __builtin_amdgcn_fence(__ATOMIC_ACQUIRE, "agent");
            asm volatile("s_waitcnt vmcnt(0)" ::: "memory");
        }
    }
    __syncthreads();
}

constexpr int NPHASE = 14;
constexpr int LDS_BYTES = 131072 + 16;
__global__ void __launch_bounds__(512, 2) mk_fwd(Params p, int ph_lo, int ph_hi) {
    extern __shared__ __attribute__((aligned(16))) unsigned char shm[];
    LAS unsigned char* lds = (LAS unsigned char*)shm;
    cg::grid_group grid = cg::this_grid();
    if (threadIdx.x == 0) { *(LAS u32x4*)(lds + 131072) = (u32x4){0u, 0u, 0u, 0u}; }
    __syncthreads();
    const XcdBarrier xb = xcd_barrier_post((unsigned*)(p.ws + WS_BAR), (volatile LAS unsigned*)(lds + 131072));
    for (int ph2 = ph_lo * 2; ph2 < ph_hi * 2; ++ph2) {
        const int ph = ph2 >> 1; const bool dry = !(ph2 & 1);
        if (dry && !((REP_MASK >> ph) & 1)) continue;
        int tid = threadIdx.x; asm volatile("" : "+v"(tid));
        if (ph == 0) {
            convert_set(p, 0, lds, tid, 0, 0, 1408);
            bf16_t* wt = (bf16_t*)(p.ws + WS_WRG);
            for (int o = blockIdx.x * 512 + tid; o < 2 * 65536; o += gridDim.x * 512) { const int g = o >> 16, h = (o >> 12) & 15, j = (o >> 6) & 63, i = o & 63;
                wt[o] = f2bf((g ? p.in[20] : p.in[18])[(size_t)(h * 64 + i) * 64 + j]); }
            if (blockIdx.x * 512 + tid < D) { const int ch = blockIdx.x * 512 + tid; ((float*)(p.ws + WS_LC))[ch] = -8.0f * log1pf(expf(-p.in[22][ch])); }
            for (int e = blockIdx.x * 512 + tid; e < NS * D; e += gridDim.x * 512) {
                const int sm = e >> 10, c = e & 1023;
                const float t0 = p.in[3][((size_t)sm * 3 + 0) * D + c], t1 = p.in[3][((size_t)sm * 3 + 1) * D + c], t2 = p.in[3][((size_t)sm * 3 + 2) * D + c];
                const float a0 = p.in[2][((size_t)sm * 2 + 0) * D + c], a1 = p.in[2][((size_t)sm * 2 + 1) * D + c];
                ((float*)(p.ws + WS_PCB))[e] = p.in[16][c] * t0 + p.in[16][D + c] * t1 + p.in[16][2 * D + c] * t2 + p.in[17][c];
                ((float*)(p.ws + WS_PCA))[e] = p.in[14][c] * a0 + p.in[14][D + c] * a1;
                p.out[O_CBS + ((size_t)sm * 3 + 0) * D + c] = t1; p.out[O_CBS + ((size_t)sm * 3 + 1) * D + c] = t2;
                p.out[O_CAS + ((size_t)sm * 2 + 0) * D + c] = a1;
            }
            norm_phase(p, 0, tid, dry, 0);
        } else if (ph == 1 || ph == 11) {
            pg8::Gemm g{(const bf16_t*)(p.ws + WS_H), (const bf16_t*)(p.ws + WS_WGU), M, 2 * DFF, D, 0, 0};
            pg8::StaticOrder S; S.init(M, 2 * DFF, D, gridDim.x, blockIdx.x);
            pg8::EpiGU E{(bf16_t*)(p.ws + WS_ACT), dry};
            pg8::gemm_phase(lds, g, S, E);
            if (!dry && ph == 1) { convert_set(p, 0, lds, tid, 150, 1408, 2112); convert_set(p, 2, lds, tid, 150, 0, 1088); }
        } else if (ph == 2 || ph == 12 || ph == 9 || ph == 7) {
            const bool dn = (ph == 2 || ph == 12), oab = (ph == 7);
            pg8::Gemm g{dn ? (const bf16_t*)(p.ws + WS_ACT) : (oab ? (const bf16_t*)(p.ws + WS_U) : (const bf16_t*)p.out), (const bf16_t*)(p.ws + (dn ? WS_WD : (oab ? WS_WOAB : WS_WO))), M, D, dn ? DFF : D, SB, (size_t)1024 * 1024 * 2};
            pg8::SplitOrder S; S.init(oab ? 2 * D : D, dn ? DFF : D, gridDim.x, blockIdx.x, dn ? 11 : 4, 4);
            pg8::EpiBF E{(bf16_t*)(p.ws + (oab ? WS_U + 2 * SB : WS_Y)), SLOT, (bf16_t*)(p.ws + (oab ? WS_POAB : WS_PY)), oab ? 2 : 1};
            pg8::gemm_phase(lds, g, S, E);
            if (!dry && ph == 2) convert_set(p, 2, lds, tid, 44, 1088, 1 << 30);
            if (!dry && ph == 9) convert_set(p, 1, lds, tid, 16, 0, 1 << 30);
        } else if (ph == 3) {
            norm_phase(p, 1, tid, dry, 11);
        } else if (ph == 4) {
            pg8::Gemm g{(const bf16_t*)(p.ws + WS_H), (const bf16_t*)(p.ws + WS_WIN), M, DIN, D, 0, 0};
            pg8::StaticOrder S; S.init(M, DIN, D, gridDim.x, blockIdx.x);
            pg8::EpiIN E{(bf16_t*)(p.ws + WS_U)};
            pg8::gemm_phase(lds, g, S, E);
        } else if (ph == 5) {
            scan_phase(p, lds, tid, dry);
        } else if (ph == 6) {
            fix_phase(p, lds, tid, dry);
            za_phase(p, tid, dry);
        } else if (ph == 8) {
            merge_phase(p, tid);
        } else if (ph == 10) {
            norm_phase(p, 2, tid, dry, 4);
        } else if (ph == 13) {
            norm_phase(p, 3, tid, dry, 11);
        }
        if (ph2 + 1 < ph_hi * 2) { if (ph_hi > NPHASE) grid.sync(); else xcd_barrier(xb); }
    }
}

extern "C" void kernel_launch(void* const* d_in, const int* in_sizes, int n_in, void* d_out, int out_size, void* d_ws, size_t ws_size, hipStream_t stream) {
    if (n_in != 30 || ws_size < WS_END) { fprintf(stderr, "kernel_launch: unexpected n_in %d / ws_size %zu (need %zu)\n", n_in, ws_size, (size_t)WS_END); return; }
    Params p{};
    for (int i = 0; i < 30; ++i) p.in[i] = (const float*)d_in[i];
    p.out = (float*)d_out; p.ws = (unsigned char*)d_ws;
    (void)hipFuncSetAttribute((const void*)mk_fwd, hipFuncAttributeMaxDynamicSharedMemorySize, LDS_BYTES);
    static int grid_blocks = 0;
    if (!grid_blocks) {
        int dev = 0, cus = 0, per_cu = 0;
        (void)hipGetDevice(&dev);
        (void)hipDeviceGetAttribute(&cus, hipDeviceAttributeMultiprocessorCount, dev);
        (void)hipOccupancyMaxActiveBlocksPerMultiprocessor(&per_cu, (const void*)mk_fwd, 512, LDS_BYTES);
        if (per_cu < 1) { fprintf(stderr, "kernel_launch: occupancy query says %d blocks/CU\n", per_cu); per_cu = 1; }
        grid_blocks = cus;
    }
    (void)hipMemsetAsync((unsigned char*)d_ws + WS_BAR, 0, 16384, stream);
#if SINGLE_LAUNCH
    int lo = 0, hi = NPHASE;
    void* args[] = {&p, &lo, &hi};
    hipError_t e = hipLaunchCooperativeKernel((const void*)mk_fwd, dim3(grid_blocks), dim3(512), args, LDS_BYTES, stream);
    if (e != hipSuccess) fprintf(stderr, "cooperative launch failed: %s (grid %d)\n", hipGetErrorString(e), grid_blocks);
#else
    for (int ph = 0; ph < NPHASE; ++ph) hipLaunchKernelGGL(mk_fwd, dim3(grid_blocks), dim3(512), LDS_BYTES, stream, p, ph, ph + 1);
#endif
}
```

```cpp
#include <hip/hip_runtime.h>
#include <hip/hip_cooperative_groups.h>
#include <cstdio>
namespace cg = cooperative_groups;

#ifndef REP_MASK
#define REP_MASK 0
#endif
#ifndef SINGLE_LAUNCH
#define SINGLE_LAUNCH 1
#endif

#define LAS __attribute__((address_space(3)))
typedef unsigned short bf16_t;
typedef short bf16x8 __attribute__((ext_vector_type(8)));
typedef float f32x4 __attribute__((ext_vector_type(4)));
typedef unsigned u32x4 __attribute__((ext_vector_type(4)));
typedef unsigned u32x2 __attribute__((ext_vector_type(2)));
typedef float f32x2 __attribute__((ext_vector_type(2)));

constexpr int D = 1024, DFF = 2816, DIN = 7168;
constexpr int NB = 8, SEQ = 2048, NMETA = 16, TP = SEQ + NMETA;
constexpr int MP = NB * TP;
constexpr int NS = 128;
constexpr int M = MP + NS;
constexpr int CHUNK = 48, NCH = TP / CHUNK;
constexpr float EPS = 1e-6f;

constexpr size_t O_YP = 0, O_YS = 16777216, O_CAP = O_YS + 131072, O_CBP = O_CAP + 16384, O_RGP = O_CBP + 24576,
                 O_CAS = O_RGP + 8192, O_CBS = O_CAS + 262144, O_RGS = O_CBS + 393216;

constexpr size_t SLOT = (size_t)M * D;
constexpr size_t SB = SLOT * 2;
constexpr size_t WS_U = 0;
constexpr size_t WS_ACT = 0;
constexpr size_t WS_Y = 3 * SB;
constexpr size_t WS_PY = 4 * SB;
constexpr int MAINR = 64 * 256;
constexpr size_t WS_WGU = 5 * SB;
constexpr size_t WS_WD = WS_WGU + (size_t)5632 * 1024 * 2;
constexpr size_t WS_H = 6 * SB;
constexpr size_t WS_WIN = 7 * SB;
constexpr size_t WS_POAB = WS_WIN;
constexpr size_t WS_WOAB = WS_WIN + (size_t)7168 * 1024 * 2;
constexpr size_t WS_WO = WS_WOAB + (size_t)2 * 1024 * 1024 * 2;
constexpr size_t WS_WRG = WS_WO + (size_t)1024 * 1024 * 2;
constexpr size_t WS_SUMM = WS_WRG + (size_t)2 * 16 * 64 * 64 * 2;
constexpr size_t WS_SC = WS_SUMM + (size_t)NB * NCH * D * 2 * 4;
constexpr size_t WS_LC = WS_SC + 98304;
constexpr size_t WS_BAR = WS_SC + 131072;
constexpr size_t WS_PCB = WS_BAR + 16384;
constexpr size_t WS_PCA = WS_PCB + (size_t)NS * D * 4;
constexpr size_t WS_END = WS_PCA + (size_t)NS * D * 4;
static_assert(WS_END <= (size_t)256 * 1024 * 1024, "workspace");

struct Params { const float* in[30]; float* out; unsigned char* ws; };

__device__ __forceinline__ unsigned cvt_pk_bf16(float lo, float hi) { unsigned r; asm volatile("v_cvt_pk_bf16_f32 %0, %1, %2" : "=v"(r) : "v"(lo), "v"(hi)); return r; }
__device__ __forceinline__ bf16_t f2bf(float f) { return (bf16_t)(cvt_pk_bf16(f, 0.f) & 0xffffu); }
__device__ __forceinline__ float bf2f(bf16_t b) { return __uint_as_float(((unsigned)b) << 16); }
__device__ __forceinline__ float bflo(unsigned w) { return __uint_as_float(w << 16); }
__device__ __forceinline__ float bfhi(unsigned w) { return __uint_as_float(w & 0xffff0000u); }
__device__ __forceinline__ float sigm(float x) { return __builtin_amdgcn_rcpf(1.0f + __expf(-x)); }
__device__ __forceinline__ float gelu_tanh(float x) { const float t = 1.5957691216057308f * (x + 0.044715f * x * x * x); return x * sigm(t); }
__device__ __forceinline__ float wave_sum(float v, int lane) {
#pragma unroll
    for (int o = 32; o >= 1; o >>= 1) v += __int_as_float(__builtin_amdgcn_ds_bpermute((lane ^ o) << 2, __float_as_int(v)));
    return v;
}
__device__ __forceinline__ const float* x0row(const Params& p, int r) {
    if (r >= MP) return p.in[1] + (size_t)(r - MP) * D;
    const int b = r / TP, t = r - b * TP;
    if (t < NMETA) return p.in[5] + (size_t)t * D;
    return p.in[0] + ((size_t)b * SEQ + (t - NMETA)) * D;
}

namespace pg8 {
constexpr int BM = 256, BK = 64, HALF = 128, HTB = HALF * BK * 2, STAGE_BYTES = 8 * HTB, NXCD = 8, WGM = 8;
__host__ __device__ __forceinline__ int lds_byte(int r, int c) { const int st = (r >> 4) * 2 + (c >> 5), rr = r & 15, cc = c & 31, ob = rr * 64 + cc * 2; return st * 1024 + (ob ^ (((ob >> 9) & 1) << 5)); }
__host__ __device__ __forceinline__ void stage_rc(int b, int& R, int& C) { const int st = b / 1024, sb = b % 1024, swz = sb ^ (((sb >> 9) & 1) << 5); R = (st >> 1) * 16 + swz / 64; C = (st & 1) * 32 + (swz % 64) / 2; }
__host__ __device__ __forceinline__ int perm32(int rho) { const int n = rho >> 4, i = rho & 15; return 8 * (i >> 2) + 4 * n + (i & 3); }

struct Unit { int pm, pn, z, k0, nk, part; };
struct Gemm { const bf16_t* A; const bf16_t* Bt; int M, N, K; size_t zA, zB; };

struct StaticOrder {
    int nM, nN, nwg, G, c, ntf;
    __device__ void init(int M_, int N_, int K_, int G_, int c_) { nM = M_ / BM; nN = N_ / BM; nwg = nM * nN; G = G_; c = c_; ntf = K_ / BK; }
    __device__ bool map(long L, Unit& u) const {
        if (L >= nwg) return false;
        int wgid = (int)L; { const int q = nwg / NXCD, r = nwg % NXCD, xcd = wgid % NXCD, off = wgid / NXCD; wgid = (xcd < r ? xcd * (q + 1) : r * (q + 1) + (xcd - r) * q) + off; }
        const int nig = WGM * nN, gid = wgid / nig, fm = gid * WGM, gsz = (nM - fm) < WGM ? (nM - fm) : WGM;
        u.pm = fm + ((wgid % nig) % gsz); u.pn = (wgid % nig) / gsz; u.z = 0; u.k0 = 0; u.nk = ntf; u.part = -1; return true;
    }
    __device__ bool next(int i, Unit& u) const { return map((long)i * G + c, u); }
};
struct SplitOrder : StaticOrder {
    int nsplit, nkm;
    __device__ void init(int N_, int K_, int G_, int c_, int nsplit_, int nkm_) { StaticOrder::init(64 * BM, N_, K_, G_, c_); nsplit = nsplit_; nkm = nkm_; }
    __device__ bool next(int i, Unit& u) const {
        const long L = (long)i * G + c; bool ok;
        if (L < nwg) ok = map(L, u);
        else { const int L2 = (int)(L - nwg); ok = L2 < nN * nsplit; const int ks = L2 / nN; u.pm = 64; u.pn = L2 - ks * nN; u.k0 = ks * nkm; u.nk = nkm; u.part = ks; }
        u.z = u.pn >> 2; u.pn &= 3; return ok;
    }
};

template <class Epi, class Sched>
__device__ __forceinline__ void gemm_phase(LAS unsigned char* lds, const Gemm g, const Sched& S, const Epi& E) {
    int tid_ = threadIdx.x; asm volatile("" : "+v"(tid_));
    const int tid = tid_, wid = __builtin_amdgcn_readfirstlane(tid >> 6), lane = tid & 63, wr = wid >> 2, wc = wid & 3, fr = lane & 15, fq = lane >> 4;
    const int K = g.K;
    unsigned voffA[2], voffB[2];
#pragma unroll
    for (int i = 0; i < 2; ++i) { int R, C; stage_rc(tid * 16 + i * 8192, R, C); const int Rb = Epi::PERM ? ((R & ~31) + perm32(R & 31)) : R;
        voffA[i] = (unsigned)(R * K + C) * 2u; voffB[i] = (unsigned)(Rb * K + C) * 2u; }
    const size_t kstep = (size_t)(BK * 2);
    const size_t hstep = (size_t)HALF * K * 2;
    const size_t tstep = 2 * hstep;
    const unsigned ldsw = (unsigned)wid * 1024u;
    const int aoff = lds_byte(wr * 64 + fr, fq * 8), boff = lds_byte(wc * 32 + fr, fq * 8);
#define PG8_SA(b, h) (((b) * 2 + (h)) * HTB)
#define PG8_SB(b, h) ((4 + (b) * 2 + (h)) * HTB)
#define PG8_STAGE(bufoff, gbase, voff) do { _Pragma("unroll") for (int _i = 0; _i < 2; ++_i) \
        __builtin_amdgcn_global_load_lds((const unsigned*)((const char*)(gbase) + (voff)[_i]), (LAS unsigned*)(lds + (bufoff) + ldsw + _i * 8192), 16, 0, 0); } while (0)
#define PG8_LDA(dst, b, h) do { _Pragma("unroll") for (int m = 0; m < 4; ++m) _Pragma("unroll") for (int k = 0; k < 2; ++k) dst[m][k] = *(const LAS bf16x8*)(lds + PG8_SA(b, h) + aoff + m * 2048 + k * 1024); } while (0)
#define PG8_LDB(dst, b, h) do { _Pragma("unroll") for (int n = 0; n < 2; ++n) _Pragma("unroll") for (int k = 0; k < 2; ++k) dst[n][k] = *(const LAS bf16x8*)(lds + PG8_SB(b, h) + boff + n * 2048 + k * 1024); } while (0)
#define PG8_MMA(ai, bj, At, Bt) do { __builtin_amdgcn_s_setprio(1); _Pragma("unroll") for (int m = 0; m < 4; ++m) _Pragma("unroll") for (int n = 0; n < 2; ++n) _Pragma("unroll") for (int k = 0; k < 2; ++k) \
        acc[ai][bj][m][n] = __builtin_amdgcn_mfma_f32_16x16x32_bf16(Bt[n][k], At[m][k], acc[ai][bj][m][n], 0, 0, 0); __builtin_amdgcn_s_setprio(0); } while (0)
#define PG8_WAIT_V(n) asm volatile("s_waitcnt vmcnt(" #n ")" ::: "memory")
#define PG8_WAIT_L(n) asm volatile("s_waitcnt lgkmcnt(" #n ")" ::: "memory")
#define PG8_BAR __builtin_amdgcn_s_barrier()
#define PG8_SCHED __builtin_amdgcn_sched_barrier(0)
    Unit cur, nxt; int ui = 0;
    if (!S.next(0, cur)) return;
    f32x4 acc[2][2][4][2];
#pragma unroll
    for (int a = 0; a < 2; ++a)
#pragma unroll
        for (int b = 0; b < 2; ++b)
#pragma unroll
            for (int m = 0; m < 4; ++m)
#pragma unroll
                for (int n = 0; n < 2; ++n) acc[a][b][m][n] = (f32x4){0.f, 0.f, 0.f, 0.f};
    bf16x8 At[4][2], B0[2][2], B1[2][2];
    const char* cA = (const char*)g.A + (size_t)cur.z * g.zA + (size_t)cur.pm * tstep + (size_t)cur.k0 * kstep; const char* cB = (const char*)g.Bt + (size_t)cur.z * g.zB + (size_t)cur.pn * tstep + (size_t)cur.k0 * kstep;
    int nt = cur.nk;
    PG8_STAGE(PG8_SB(0, 0), cB, voffB); PG8_STAGE(PG8_SA(0, 0), cA, voffA); PG8_STAGE(PG8_SB(0, 1), cB + hstep, voffB); PG8_STAGE(PG8_SA(0, 1), cA + hstep, voffA);
    if (wr == 1) PG8_BAR;
    PG8_WAIT_V(4); PG8_BAR;
    PG8_STAGE(PG8_SB(1, 0), cB + kstep, voffB); PG8_STAGE(PG8_SA(1, 0), cA + kstep, voffA); PG8_STAGE(PG8_SB(1, 1), cB + hstep + kstep, voffB);
    PG8_WAIT_V(6); PG8_BAR;
    for (;;) {
        const bool has_next = S.next(ui + 1, nxt);
        const char* nA = has_next ? (const char*)g.A + (size_t)nxt.z * g.zA + (size_t)nxt.pm * tstep + (size_t)nxt.k0 * kstep : cA; const char* nB = has_next ? (const char*)g.Bt + (size_t)nxt.z * g.zB + (size_t)nxt.pn * tstep + (size_t)nxt.k0 * kstep : cB;
        for (int t = 0; t < nt; t += 2) {
            const bool last = (t == nt - 2);
            const char* a1 = cA + (size_t)(t + 1) * kstep;
            const char* a2 = last ? nA : cA + (size_t)(t + 2) * kstep; const char* b2 = last ? nB : cB + (size_t)(t + 2) * kstep;
            const char* a3 = a2 + kstep; const char* b3 = b2 + kstep;
            PG8_LDB(B0, 0, 0); PG8_SCHED; PG8_LDA(At, 0, 0); PG8_STAGE(PG8_SA(1, 1), a1 + hstep, voffA);
            PG8_WAIT_L(8); PG8_BAR; PG8_WAIT_L(0); PG8_MMA(0, 0, At, B0); PG8_BAR; PG8_SCHED;
            PG8_LDB(B1, 0, 1); PG8_STAGE(PG8_SB(0, 0), b2, voffB);
            PG8_BAR; PG8_WAIT_L(0); PG8_MMA(0, 1, At, B1); PG8_BAR;
            PG8_LDA(At, 0, 1); PG8_STAGE(PG8_SA(0, 0), a2, voffA);
            PG8_BAR; PG8_WAIT_L(0); PG8_MMA(1, 0, At, B0); PG8_BAR; PG8_SCHED;
            PG8_STAGE(PG8_SB(0, 1), b2 + hstep, voffB);
            PG8_WAIT_V(6); PG8_BAR; PG8_MMA(1, 1, At, B1); PG8_BAR;
            PG8_LDB(B0, 1, 0); PG8_SCHED; PG8_LDA(At, 1, 0); PG8_STAGE(PG8_SA(0, 1), a2 + hstep, voffA);
            PG8_WAIT_L(8); PG8_BAR; PG8_WAIT_L(0); PG8_MMA(0, 0, At, B0); PG8_BAR; PG8_SCHED;
            PG8_LDB(B1, 1, 1); PG8_STAGE(PG8_SB(1, 0), b3, voffB);
            PG8_BAR; PG8_WAIT_L(0); PG8_MMA(0, 1, At, B1); PG8_BAR;
            PG8_LDA(At, 1, 1); PG8_STAGE(PG8_SA(1, 0), a3, voffA);
            PG8_BAR; PG8_WAIT_L(0); PG8_MMA(1, 0, At, B0); PG8_BAR; PG8_SCHED;
            PG8_STAGE(PG8_SB(1, 1), b3 + hstep, voffB);
            PG8_WAIT_V(6); PG8_BAR; PG8_MMA(1, 1, At, B1); PG8_BAR;
        }
        E(acc, cur, wr, wc, fr, fq);
        if (!has_next) break;
#pragma unroll
        for (int a = 0; a < 2; ++a)
#pragma unroll
            for (int b = 0; b < 2; ++b)
#pragma unroll
                for (int m = 0; m < 4; ++m)
#pragma unroll
                    for (int n = 0; n < 2; ++n) acc[a][b][m][n] = (f32x4){0.f, 0.f, 0.f, 0.f};
        cur = nxt; cA = nA; cB = nB; nt = cur.nk; ++ui;
    }
    PG8_WAIT_V(0);
    if (wr == 0) PG8_BAR;
    PG8_BAR;
#undef PG8_SA
#undef PG8_SB
#undef PG8_STAGE
#undef PG8_LDA
#undef PG8_LDB
#undef PG8_MMA
#undef PG8_WAIT_V
#undef PG8_WAIT_L
#undef PG8_BAR
#undef PG8_SCHED
}

struct EpiBF {
    static constexpr bool PERM = true;
    bf16_t* O; size_t zO; bf16_t* P; int nz;
    __device__ __forceinline__ void operator()(const f32x4 (&acc)[2][2][4][2], const Unit& u, int wr, int wc, int fr, int fq) const {
        const int col0 = u.pn * BM + wc * 32 + 8 * fq;
        const int row0 = (u.part < 0 ? u.pm * BM : 0) + wr * 64 + fr;
        bf16_t* base = u.part < 0 ? O + (size_t)u.z * zO : P + (size_t)(u.part * nz + u.z) * (BM * D);
#pragma unroll
        for (int ai = 0; ai < 2; ++ai)
#pragma unroll
            for (int m = 0; m < 4; ++m) { bf16_t* rowp = base + (size_t)(row0 + ai * HALF + m * 16) * D + col0;
#pragma unroll
                for (int bj = 0; bj < 2; ++bj) { const f32x4 v0 = acc[ai][bj][m][0], v1 = acc[ai][bj][m][1];
                    u32x4 w; w.x = cvt_pk_bf16(v0[0], v0[1]); w.y = cvt_pk_bf16(v0[2], v0[3]); w.z = cvt_pk_bf16(v1[0], v1[1]); w.w = cvt_pk_bf16(v1[2], v1[3]);
                    *(u32x4*)(rowp + bj * HALF) = w; } }
    }
};
struct EpiGU {
    static constexpr bool PERM = true;
    bf16_t* O; bool dry;
    __device__ __forceinline__ void operator()(const f32x4 (&acc)[2][2][4][2], const Unit& u, int wr, int wc, int fr, int fq) const {
        if (dry) return;
        const int row0 = u.pm * BM + wr * 64 + fr, col0 = u.pn * HALF + wc * 32 + 8 * fq;
#pragma unroll
        for (int ai = 0; ai < 2; ++ai)
#pragma unroll
            for (int m = 0; m < 4; ++m) { bf16_t* rowp = O + (size_t)(row0 + ai * HALF + m * 16) * DFF + col0;
                unsigned wv[4];
#pragma unroll
                for (int n = 0; n < 2; ++n)
#pragma unroll
                    for (int jp = 0; jp < 2; ++jp) {
                        const f32x2 gt = {acc[ai][0][m][n][2 * jp], acc[ai][0][m][n][2 * jp + 1]}, up = {acc[ai][1][m][n][2 * jp], acc[ai][1][m][n][2 * jp + 1]};
                        const f32x2 t = gt * (-1.44269504089f);
                        f32x2 e; e.x = __builtin_amdgcn_exp2f(t.x); e.y = __builtin_amdgcn_exp2f(t.y);
                        const f32x2 d = e + 1.0f;
                        f32x2 r; r.x = __builtin_amdgcn_rcpf(d.x); r.y = __builtin_amdgcn_rcpf(d.y);
                        const f32x2 o = (gt * up) * r;
                        wv[n * 2 + jp] = cvt_pk_bf16(o.x, o.y);
                    }
                u32x4 w; w.x = wv[0]; w.y = wv[1]; w.z = wv[2]; w.w = wv[3];
                *(u32x4*)rowp = w; }
    }
};
struct EpiIN {
    static constexpr bool PERM = true;
    bf16_t* U;
    __device__ __forceinline__ void operator()(const f32x4 (&acc)[2][2][4][2], const Unit& u, int wr, int wc, int fr, int fq) const {
        const int row0 = u.pm * BM + wr * 64 + fr;
        if (u.pn >= 4 && u.pn < 12) {
            const int col0 = (u.pn - 4) * HALF + wc * 32 + 8 * fq; bf16_t* base = U + 2 * SLOT;
#pragma unroll
            for (int ai = 0; ai < 2; ++ai)
#pragma unroll
                for (int m = 0; m < 4; ++m) { bf16_t* rowp = base + (size_t)(row0 + ai * HALF + m * 16) * D + col0;
                    const f32x4 v0 = acc[ai][0][m][0] * acc[ai][1][m][0], v1 = acc[ai][0][m][1] * acc[ai][1][m][1];
                    u32x4 w; w.x = cvt_pk_bf16(v0[0], v0[1]); w.y = cvt_pk_bf16(v0[2], v0[3]); w.z = cvt_pk_bf16(v1[0], v1[1]); w.w = cvt_pk_bf16(v1[2], v1[3]);
                    *(u32x4*)rowp = w; }
        } else {
            int slot, ct; if (u.pn < 4) { slot = 0; ct = u.pn; } else { const int sg = (u.pn - 12) >> 2; slot = sg == 0 ? 3 : (sg == 1 ? 1 : sg + 2); ct = (u.pn - 12) & 3; }
            const int col0 = ct * BM + wc * 32 + 8 * fq; bf16_t* base = U + (size_t)slot * SLOT;
#pragma unroll
            for (int ai = 0; ai < 2; ++ai)
#pragma unroll
                for (int m = 0; m < 4; ++m) { bf16_t* rowp = base + (size_t)(row0 + ai * HALF + m * 16) * D + col0;
#pragma unroll
                    for (int bj = 0; bj < 2; ++bj) { const f32x4 v0 = acc[ai][bj][m][0], v1 = acc[ai][bj][m][1];
                        u32x4 w; w.x = cvt_pk_bf16(v0[0], v0[1]); w.y = cvt_pk_bf16(v0[2], v0[3]); w.z = cvt_pk_bf16(v1[0], v1[1]); w.w = cvt_pk_bf16(v1[2], v1[3]);
                        *(u32x4*)(rowp + bj * HALF) = w; } }
        }
    }
};
}

__device__ __forceinline__ int conv_map(int mode, int n) {
    if (mode == 0) return n;
    if (mode == 1) return 256 * (n >> 7) + (n & 127);
    if (mode == 2) return 256 * (n >> 7) + 128 + (n & 127);
    const int seg = n >> 10, j = n & 1023;
    if (seg == 0) return j;
    if (seg == 1) return 1024 + 256 * (j >> 7) + (j & 127);
    if (seg == 2) return 1024 + 256 * (j >> 7) + 128 + (j & 127);
    return 3072 + (seg - 3) * 1024 + j;
}
struct ConvE { const float* src; bf16_t* dst; const float* gk; int K, N, mode, t; };
__device__ __forceinline__ bool conv_decode(const Params& p, int set, int T, ConvE& e) {
    if (set < 2) {
        const int a = set ? 27 : 8; const float* gk = p.in[set ? 25 : 6];
        if (T < 704)       { e.src = p.in[a];     e.dst = (bf16_t*)(p.ws + WS_WGU); e.gk = gk;      e.K = 1024; e.N = 2816; e.mode = 1; e.t = T; }
        else if (T < 1408) { e.src = p.in[a + 1]; e.dst = (bf16_t*)(p.ws + WS_WGU); e.gk = gk;      e.K = 1024; e.N = 2816; e.mode = 2; e.t = T - 704; }
        else if (T < 2112) { e.src = p.in[a + 2]; e.dst = (bf16_t*)(p.ws + WS_WD);  e.gk = nullptr; e.K = 2816; e.N = 1024; e.mode = 0; e.t = T - 1408; }
        else return false;
    } else {
        if (T < 1792)      { e.src = p.in[13]; e.dst = (bf16_t*)(p.ws + WS_WIN); e.gk = p.in[11]; e.K = 1024; e.N = 7168; e.mode = 3; e.t = T; }
        else if (T < 2048) { e.src = p.in[15]; e.dst = (bf16_t*)(p.ws + WS_WOAB); e.gk = nullptr; e.K = 1024; e.N = 1024; e.mode = 0; e.t = T - 1792; }
        else if (T < 2304) { e.src = p.in[23]; e.dst = (bf16_t*)(p.ws + WS_WOAB + (size_t)1024 * 1024 * 2); e.gk = nullptr; e.K = 1024; e.N = 1024; e.mode = 0; e.t = T - 2048; }
        else if (T < 2560) { e.src = p.in[24]; e.dst = (bf16_t*)(p.ws + WS_WO);  e.gk = nullptr;  e.K = 1024; e.N = 1024; e.mode = 0; e.t = T - 2304; }
        else return false;
    }
    return true;
}
__device__ __forceinline__ void conv_load(const ConvE& e, int tid, f32x4& v0, f32x4& v1) {
    const int ntn = e.N >> 6; const int tk = e.t / ntn, tn = e.t - tk * ntn;
    const float* s0 = e.src + (size_t)(tk * 64 + (tid >> 4)) * e.N + tn * 64 + (tid & 15) * 4;
    v0 = __builtin_nontemporal_load((const f32x4*)s0); v1 = __builtin_nontemporal_load((const f32x4*)(s0 + (size_t)32 * e.N));
}
__device__ __forceinline__ void conv_emit(const ConvE& e, int tid, const f32x4& v0, const f32x4& v1, LAS float* sl) {
    const int ntn = e.N >> 6; const int tk = e.t / ntn, tn = e.t - tk * ntn; const int k0 = tk * 64, n0 = tn * 64;
    { LAS float* d = sl + (tid >> 4) * 65 + (tid & 15) * 4; d[0] = v0[0]; d[1] = v0[1]; d[2] = v0[2]; d[3] = v0[3]; d += 32 * 65; d[0] = v1[0]; d[1] = v1[1]; d[2] = v1[2]; d[3] = v1[3]; }
    __syncthreads();
    const int n = tid >> 3, ko = (tid & 7) * 8;
    float f[8];
#pragma unroll
    for (int i = 0; i < 8; ++i) f[i] = sl[(ko + i) * 65 + n];
    if (e.gk) {
        const f32x4 g0 = *(const f32x4*)(e.gk + k0 + ko), g1 = *(const f32x4*)(e.gk + k0 + ko + 4);
#pragma unroll
        for (int i = 0; i < 4; ++i) { f[i] *= g0[i]; f[4 + i] *= g1[i]; }
    }
    u32x4 w; w.x = cvt_pk_bf16(f[0], f[1]); w.y = cvt_pk_bf16(f[2], f[3]); w.z = cvt_pk_bf16(f[4], f[5]); w.w = cvt_pk_bf16(f[6], f[7]);
    *(u32x4*)(e.dst + (size_t)conv_map(e.mode, n0 + n) * e.K + k0 + ko) = w;
    __syncthreads();
}
__device__ __forceinline__ void convert_set(const Params& p, int set, LAS unsigned char* lds, int tid, int skip, int T0, int T1) {
    ConvE e, en; f32x4 v0, v1, n0 = {0.f, 0.f, 0.f, 0.f}, n1 = {0.f, 0.f, 0.f, 0.f};
    if ((int)blockIdx.x < skip) return;
    int T = T0 + (int)blockIdx.x - skip; const int stride = gridDim.x - skip;
    bool have = T < T1 && conv_decode(p, set, T, e);
    if (have) conv_load(e, tid, v0, v1);
    while (have) {
        T += stride;
        const bool hn = T < T1 && conv_decode(p, set, T, en);
        if (hn) conv_load(en, tid, n0, n1);
        conv_emit(e, tid, v0, v1, (LAS float*)lds);
        e = en; v0 = n0; v1 = n1; have = hn;
    }
}

__device__ __forceinline__ void norm_phase(const Params& p, int mode, int tid, bool dry, int nsplit) {
    const int lane = tid & 63, gw = blockIdx.x * 8 + (tid >> 6), nw = gridDim.x * 8;
    const float* gpost = mode == 1 ? p.in[7] : (mode == 2 ? p.in[12] : p.in[26]);
    const float cc = mode == 2 ? 1.0f : 0.5f;
    const bf16_t* Yb = (const bf16_t*)(p.ws + WS_Y); const bf16_t* PY = (const bf16_t*)(p.ws + WS_PY); bf16_t* H = (bf16_t*)(p.ws + WS_H); float* SC = (float*)(p.ws + WS_SC);
    for (int r = gw; r < M; r += nw) {
        f32x4 xv[4];
        if (mode == 0) {
            const float* xin = x0row(p, r);
#pragma unroll
            for (int q = 0; q < 4; ++q) xv[q] = __builtin_nontemporal_load((const f32x4*)(xin + lane * 4 + 256 * q));
        } else {
            const float sc = SC[r];
#pragma unroll
            for (int q = 0; q < 4; ++q) { const u32x2* hp = (const u32x2*)(H + (size_t)r * D + lane * 4 + 256 * q); const u32x2 w = mode == 3 ? __builtin_nontemporal_load(hp) : *hp; xv[q] = (f32x4){bflo(w.x), bfhi(w.x), bflo(w.y), bfhi(w.y)} * sc; }
            f32x4 yv[4]; float ss = 0.f;
            if (r < MAINR) {
#pragma unroll
                for (int q = 0; q < 4; ++q) { const u32x2* yp = (const u32x2*)(Yb + (size_t)r * D + lane * 4 + 256 * q); const u32x2 w = mode == 3 ? __builtin_nontemporal_load(yp) : *yp; yv[q] = (f32x4){bflo(w.x), bfhi(w.x), bflo(w.y), bfhi(w.y)}; }
            } else {
#pragma unroll
                for (int q = 0; q < 4; ++q) yv[q] = (f32x4){0.f, 0.f, 0.f, 0.f};
                for (int ks0 = 0; ks0 < nsplit; ks0 += 4) {
                    f32x4 pv[4][4];
#pragma unroll
                    for (int k = 0; k < 4; ++k) { const int ks = (ks0 + k < nsplit) ? ks0 + k : ks0;
#pragma unroll
                        for (int q = 0; q < 4; ++q) { const u32x2 w = *(const u32x2*)(PY + ((size_t)ks * 256 + (r - MAINR)) * D + lane * 4 + 256 * q); pv[k][q] = (f32x4){bflo(w.x), bfhi(w.x), bflo(w.y), bfhi(w.y)}; } }
#pragma unroll
                    for (int k = 0; k < 4; ++k) { const float m = (ks0 + k < nsplit) ? 1.0f : 0.0f;
#pragma unroll
                        for (int q = 0; q < 4; ++q) yv[q] += pv[k][q] * m; }
                }
            }
#pragma unroll
            for (int q = 0; q < 4; ++q) ss += yv[q][0] * yv[q][0] + yv[q][1] * yv[q][1] + yv[q][2] * yv[q][2] + yv[q][3] * yv[q][3];
            ss = wave_sum(ss, lane);
            const float rs = cc * rsqrtf(ss * (1.0f / D) + EPS);
#pragma unroll
            for (int q = 0; q < 4; ++q) xv[q] += yv[q] * rs * *(const f32x4*)(gpost + lane * 4 + 256 * q);
        }
        if (mode == 3) {
            float* xo;
            if (r >= MP) xo = p.out + O_YS + (size_t)(r - MP) * D;
            else { const int b = r / TP, t = r - b * TP; if (t < NMETA) continue; xo = p.out + O_YP + ((size_t)b * SEQ + (t - NMETA)) * D; }
#pragma unroll
            for (int q = 0; q < 4; ++q) __builtin_nontemporal_store(xv[q], (f32x4*)(xo + lane * 4 + 256 * q));
        } else {
            float ss = 0.f;
#pragma unroll
            for (int q = 0; q < 4; ++q) ss += xv[q][0] * xv[q][0] + xv[q][1] * xv[q][1] + xv[q][2] * xv[q][2] + xv[q][3] * xv[q][3];
            ss = wave_sum(ss, lane);
            const float ms = ss * (1.0f / D) + EPS; const float rs = rsqrtf(ms);
            if (!dry) {
#pragma unroll
                for (int q = 0; q < 4; ++q) { const f32x4 hv = xv[q] * rs; u32x2 w; w.x = cvt_pk_bf16(hv[0], hv[1]); w.y = cvt_pk_bf16(hv[2], hv[3]);
                    *(u32x2*)(H + (size_t)r * D + lane * 4 + 256 * q) = w; }
                if (lane == 0) SC[r] = ms * rs;
            }
        }
    }
}

constexpr int WL_BYTES = 11264;
__device__ __forceinline__ void scan_item(const Params& p, int b, int j, int h, LAS unsigned char* wl, const LAS unsigned char* wlds, int lane, bool dry) {
    bf16_t* U = (bf16_t*)(p.ws + WS_U);
    const bf16_t* bx = U + 3 * SLOT; bf16_t* bg = U + 1 * SLOT; bf16_t* pp = (bf16_t*)p.out;
    float* summ = (float*)(p.ws + WS_SUMM);
    const int c = h * 64 + lane, fr = lane & 15, fq = lane >> 4;
    const size_t row0 = (size_t)b * TP + (size_t)j * CHUNK;
    const bf16_t* bx0 = bx + row0 * D; bf16_t* bg0 = bg + row0 * D; bf16_t* pp0 = pp + row0 * D;
    const LAS unsigned char* wq = wlds + fr * 144 + fq * 16;
    float brv[4], biv[4], lcv[4];
#pragma unroll
    for (int nt = 0; nt < 4; ++nt) { const int ch = h * 64 + nt * 16 + fr; brv[nt] = p.in[19][ch]; biv[nt] = p.in[21][ch]; lcv[nt] = ((const float*)(p.ws + WS_LC))[ch]; }
    const float w0 = p.in[16][c], w1 = p.in[16][D + c], w2 = p.in[16][2 * D + c], w3 = p.in[16][3 * D + c], cbias = p.in[17][c];
    float xm3 = 0.f, xm2 = 0.f, xm1 = 0.f;
    if (j > 0) { xm3 = bf2f(bx0[-3 * D + c]); xm2 = bf2f(bx0[-2 * D + c]); xm1 = bf2f(bx0[-1 * D + c]); }
    float hh = 0.f, ap = 1.f;
    LAS unsigned short* cbT = (LAS unsigned short*)wl;
    LAS float* xu = (LAS float*)(wl + 2304);
    LAS float* aS = (LAS float*)(wl + 2304 + 4352);
    bf16_t xr[16], gr[16], xn[16], gn[16];
#pragma unroll
    for (int tt = 0; tt < 16; ++tt) { xr[tt] = bx0[tt * D + c]; gr[tt] = bg0[tt * D + c]; }
#pragma unroll
    for (int g = 0; g < 3; ++g) {
        const int r0 = g * 16;
        if (g < 2) {
#pragma unroll
            for (int tt = 0; tt < 16; ++tt) { xn[tt] = bx0[(r0 + 16 + tt) * D + c]; gn[tt] = bg0[(r0 + 16 + tt) * D + c]; }
        }
#pragma unroll
        for (int tt = 0; tt < 16; ++tt) { const float x = bf2f(xr[tt]); const float cb = w0 * xm3 + w1 * xm2 + w2 * xm1 + w3 * x + cbias; xm3 = xm2; xm2 = xm1; xm1 = x;
            cbT[tt * 72 + lane] = f2bf(cb); xu[tt * 68 + lane] = cb; }
        __builtin_amdgcn_wave_barrier();
        const bf16x8 a0 = *(const LAS bf16x8*)(cbT + fr * 72 + fq * 8), a1 = *(const LAS bf16x8*)(cbT + fr * 72 + 32 + fq * 8);
        f32x4 accR[4], accI[4];
#pragma unroll
        for (int nt = 0; nt < 4; ++nt) {
            const bf16x8 r0w = *(const LAS bf16x8*)(wq + nt * 2304), r1w = *(const LAS bf16x8*)(wq + nt * 2304 + 64);
            const bf16x8 i0w = *(const LAS bf16x8*)(wq + 9216 + nt * 2304), i1w = *(const LAS bf16x8*)(wq + 9216 + nt * 2304 + 64);
            accR[nt] = __builtin_amdgcn_mfma_f32_16x16x32_bf16(a0, r0w, (f32x4){0.f, 0.f, 0.f, 0.f}, 0, 0, 0);
            accR[nt] = __builtin_amdgcn_mfma_f32_16x16x32_bf16(a1, r1w, accR[nt], 0, 0, 0);
            accI[nt] = __builtin_amdgcn_mfma_f32_16x16x32_bf16(a0, i0w, (f32x4){0.f, 0.f, 0.f, 0.f}, 0, 0, 0);
            accI[nt] = __builtin_amdgcn_mfma_f32_16x16x32_bf16(a1, i1w, accI[nt], 0, 0, 0);
        }
#pragma unroll
        for (int nt = 0; nt < 4; ++nt)
#pragma unroll
            for (int ip = 0; ip < 2; ++ip) {
                const int idx0 = (fq * 4 + 2 * ip) * 68 + nt * 16 + fr, idx1 = idx0 + 68;
                const f32x2 tr = ((f32x2){accR[nt][2 * ip], accR[nt][2 * ip + 1]} + brv[nt]) * (-1.44269504089f), ti = ((f32x2){accI[nt][2 * ip], accI[nt][2 * ip + 1]} + biv[nt]) * (-1.44269504089f);
                f32x2 er, ei; er.x = __builtin_amdgcn_exp2f(tr.x); er.y = __builtin_amdgcn_exp2f(tr.y); ei.x = __builtin_amdgcn_exp2f(ti.x); ei.y = __builtin_amdgcn_exp2f(ti.y);
                const f32x2 dr = er + 1.0f, di = ei + 1.0f;
                f32x2 r, ig; r.x = __builtin_amdgcn_rcpf(dr.x); r.y = __builtin_amdgcn_rcpf(dr.y); ig.x = __builtin_amdgcn_rcpf(di.x); ig.y = __builtin_amdgcn_rcpf(di.y);
                const f32x2 la = r * lcv[nt]; const f32x2 tl = la * 1.44269504089f;
                f32x2 a; a.x = __builtin_amdgcn_exp2f(tl.x); a.y = __builtin_amdgcn_exp2f(tl.y);
                const f32x2 z2 = la + la;
                const f32x2 m2s = -z2 * (z2 * (z2 * (z2 * (z2 * (z2 * 0.0013888889f + 0.0083333338f) + 0.041666668f) + 0.16666667f) + 0.5f) + 1.0f);
                const f32x2 m2b = 1.0f - a * a;
                f32x2 sq; sq.x = __builtin_amdgcn_sqrtf(z2.x > -0.25f ? m2s.x : m2b.x); sq.y = __builtin_amdgcn_sqrtf(z2.y > -0.25f ? m2s.y : m2b.y);
                const f32x2 uo = sq * ig * (f32x2){xu[idx0], xu[idx1]};
                xu[idx0] = uo.x; xu[idx1] = uo.y; aS[idx0] = a.x; aS[idx1] = a.y; }
        __builtin_amdgcn_wave_barrier();
        f32x2 glv[8];
#pragma unroll
        for (int tp = 0; tp < 8; ++tp) { const f32x2 x = {bf2f(gr[2 * tp]), bf2f(gr[2 * tp + 1])};
            const f32x2 t = x * (x * x * (-0.10294324f) + (-2.30220819f));
            f32x2 e; e.x = __builtin_amdgcn_exp2f(t.x); e.y = __builtin_amdgcn_exp2f(t.y);
            const f32x2 d = e + 1.0f;
            f32x2 rr; rr.x = __builtin_amdgcn_rcpf(d.x); rr.y = __builtin_amdgcn_rcpf(d.y);
            glv[tp] = x * rr; }
#pragma unroll
        for (int tt = 0; tt < 16; ++tt) { const float a = aS[tt * 68 + lane], uu = xu[tt * 68 + lane]; hh = a * hh + uu; ap *= a;
            const f32x2 o = (f32x2){hh, ap} * ((tt & 1) ? glv[tt >> 1].y : glv[tt >> 1].x);
            const unsigned w = cvt_pk_bf16(o.x, o.y);
            if (!dry) bg0[(r0 + tt) * D + c] = (bf16_t)(w & 0xffffu);
            pp0[(r0 + tt) * D + c] = (bf16_t)(w >> 16); }
        __builtin_amdgcn_wave_barrier();
        if (g < 2) {
#pragma unroll
            for (int tt = 0; tt < 16; ++tt) { xr[tt] = xn[tt]; gr[tt] = gn[tt]; }
        }
    }
    *(float2*)(summ + (((size_t)b * NCH + j) * D + c) * 2) = make_float2(ap, hh);
    if (j == NCH - 1) { p.out[O_CBP + ((size_t)b * 3 + 0) * D + c] = xm3; p.out[O_CBP + ((size_t)b * 3 + 1) * D + c] = xm2; p.out[O_CBP + ((size_t)b * 3 + 2) * D + c] = xm1; }
}
__device__ __forceinline__ void sample_item(const Params& p, int k, int h, LAS unsigned char* wl, const LAS unsigned char* wlds, int lane) {
    bf16_t* U = (bf16_t*)(p.ws + WS_U);
    const int c = h * 64 + lane, fr = lane & 15, fq = lane >> 4;
    const size_t row0 = (size_t)MP + (size_t)k * 16; const int s0 = k * 16;
    const bf16_t* bx0 = U + 3 * SLOT + row0 * D; bf16_t* bg0 = U + 1 * SLOT + row0 * D;
    const LAS unsigned char* wq = wlds + fr * 144 + fq * 16;
    float brv[4], biv[4], lcv[4];
#pragma unroll
    for (int nt = 0; nt < 4; ++nt) { const int ch = h * 64 + nt * 16 + fr; brv[nt] = p.in[19][ch]; biv[nt] = p.in[21][ch]; lcv[nt] = ((const float*)(p.ws + WS_LC))[ch]; }
    const float w3 = p.in[16][3 * D + c];
    LAS unsigned short* cbT = (LAS unsigned short*)wl;
    LAS float* xu = (LAS float*)(wl + 2304);
    LAS float* aS = (LAS float*)(wl + 2304 + 4352);
    const float* pcb = (const float*)(p.ws + WS_PCB) + (size_t)s0 * D + c;
    {
        bf16_t xr[16]; float pc[16];
#pragma unroll
        for (int tt = 0; tt < 16; ++tt) { xr[tt] = bx0[tt * D + c]; pc[tt] = pcb[tt * D]; }
#pragma unroll
        for (int tt = 0; tt < 16; ++tt) { const float x = bf2f(xr[tt]); const float cb = pc[tt] + w3 * x;
            p.out[O_CBS + ((size_t)(s0 + tt) * 3 + 2) * D + c] = x;
            cbT[tt * 72 + lane] = f2bf(cb); xu[tt * 68 + lane] = cb; }
    }
    __builtin_amdgcn_wave_barrier();
    const bf16x8 a0 = *(const LAS bf16x8*)(cbT + fr * 72 + fq * 8), a1 = *(const LAS bf16x8*)(cbT + fr * 72 + 32 + fq * 8);
    f32x4 accR[4], accI[4];
#pragma unroll
    for (int nt = 0; nt < 4; ++nt) {
        const bf16x8 r0w = *(const LAS bf16x8*)(wq + nt * 2304), r1w = *(const LAS bf16x8*)(wq + nt * 2304 + 64);
        const bf16x8 i0w = *(const LAS bf16x8*)(wq + 9216 + nt * 2304), i1w = *(const LAS bf16x8*)(wq + 9216 + nt * 2304 + 64);
        accR[nt] = __builtin_amdgcn_mfma_f32_16x16x32_bf16(a0, r0w, (f32x4){0.f, 0.f, 0.f, 0.f}, 0, 0, 0);
        accR[nt] = __builtin_amdgcn_mfma_f32_16x16x32_bf16(a1, r1w, accR[nt], 0, 0, 0);
        accI[nt] = __builtin_amdgcn_mfma_f32_16x16x32_bf16(a0, i0w, (f32x4){0.f, 0.f, 0.f, 0.f}, 0, 0, 0);
        accI[nt] = __builtin_amdgcn_mfma_f32_16x16x32_bf16(a1, i1w, accI[nt], 0, 0, 0);
    }
#pragma unroll
    for (int nt = 0; nt < 4; ++nt)
#pragma unroll
        for (int ip = 0; ip < 2; ++ip) {
                const int idx0 = (fq * 4 + 2 * ip) * 68 + nt * 16 + fr, idx1 = idx0 + 68;
                const f32x2 tr = ((f32x2){accR[nt][2 * ip], accR[nt][2 * ip + 1]} + brv[nt]) * (-1.44269504089f), ti = ((f32x2){accI[nt][2 * ip], accI[nt][2 * ip + 1]} + biv[nt]) * (-1.44269504089f);
                f32x2 er, ei; er.x = __builtin_amdgcn_exp2f(tr.x); er.y = __builtin_amdgcn_exp2f(tr.y); ei.x = __builtin_amdgcn_exp2f(ti.x); ei.y = __builtin_amdgcn_exp2f(ti.y);
                const f32x2 dr = er + 1.0f, di = ei + 1.0f;
                f32x2 r, ig; r.x = __builtin_amdgcn_rcpf(dr.x); r.y = __builtin_amdgcn_rcpf(dr.y); ig.x = __builtin_amdgcn_rcpf(di.x); ig.y = __builtin_amdgcn_rcpf(di.y);
                const f32x2 la = r * lcv[nt]; const f32x2 tl = la * 1.44269504089f;
                f32x2 a; a.x = __builtin_amdgcn_exp2f(tl.x); a.y = __builtin_amdgcn_exp2f(tl.y);
                const f32x2 z2 = la + la;
                const f32x2 m2s = -z2 * (z2 * (z2 * (z2 * (z2 * (z2 * 0.0013888889f + 0.0083333338f) + 0.041666668f) + 0.16666667f) + 0.5f) + 1.0f);
                const f32x2 m2b = 1.0f - a * a;
                f32x2 sq; sq.x = __builtin_amdgcn_sqrtf(z2.x > -0.25f ? m2s.x : m2b.x); sq.y = __builtin_amdgcn_sqrtf(z2.y > -0.25f ? m2s.y : m2b.y);
                const f32x2 uo = sq * ig * (f32x2){xu[idx0], xu[idx1]};
                xu[idx0] = uo.x; xu[idx1] = uo.y; aS[idx0] = a.x; aS[idx1] = a.y; }
    __builtin_amdgcn_wave_barrier();
    {
        float h0[16]; bf16_t gq[16];
#pragma unroll
        for (int tt = 0; tt < 16; ++tt) { h0[tt] = p.in[4][(size_t)(s0 + tt) * D + c]; gq[tt] = bg0[tt * D + c]; }
#pragma unroll
        for (int tt = 0; tt < 16; ++tt) {
            const float hn = aS[tt * 68 + lane] * h0[tt] + xu[tt * 68 + lane];
            p.out[O_RGS + (size_t)(s0 + tt) * D + c] = hn;
            bg0[tt * D + c] = f2bf(gelu_tanh(bf2f(gq[tt])) * hn);
        }
    }
    __builtin_amdgcn_wave_barrier();
}
__device__ __forceinline__ void scan_phase(const Params& p, LAS unsigned char* lds, int tid, bool dry) {
    const int wid = __builtin_amdgcn_readfirstlane(tid >> 6), lane = tid & 63;
    LAS unsigned char* wl = lds + wid * WL_BYTES;
    LAS unsigned char* wlds = lds + 8 * WL_BYTES;
    const int h = blockIdx.x & 15;
    {
        const bf16_t* wt = (const bf16_t*)(p.ws + WS_WRG);
#pragma unroll
        for (int q = 0; q < 2; ++q) { const int e = tid + q * 512, g = e >> 9, jrow = (e >> 3) & 63, pc = e & 7;
            *(LAS u32x4*)(wlds + g * 9216 + jrow * 144 + pc * 16) = *(const u32x4*)(wt + (size_t)g * 65536 + (size_t)(h * 64 + jrow) * 64 + pc * 8); }
    }
    __syncthreads();
    const int nbh = gridDim.x >> 4;
    for (int it = (blockIdx.x >> 4) * 8 + wid; it < NB * NCH; it += nbh * 8) scan_item(p, it / NCH, it % NCH, h, wl, wlds, lane, dry);
    if (!dry && wid < 2 && (int)(blockIdx.x >> 4) >= nbh - 4) {
        const int k = ((int)(blockIdx.x >> 4) - (nbh - 4)) * 2 + wid;
        if (k < NS / 16) sample_item(p, k, h, wl, wlds, lane);
    }
    __syncthreads();
}
__device__ __forceinline__ void fix_phase(const Params& p, LAS unsigned char* lds, int tid, bool dry) {
    bf16_t* zb = (bf16_t*)(p.ws + WS_U) + 1 * SLOT; const bf16_t* pp = (const bf16_t*)p.out;
    const float* summ = (const float*)(p.ws + WS_SUMM);
    LAS float* cs = (LAS float*)lds;
    for (int it = blockIdx.x; it < NB * (NCH - 1); it += gridDim.x) {
        const int b = it / (NCH - 1), j = it % (NCH - 1) + 1;
#pragma unroll
        for (int cq = 0; cq < 2; ++cq) {
            const int c = tid + cq * 512; const float* sp = summ + ((size_t)b * NCH * D + c) * 2; float hh = 0.f;
            for (int i0 = 0; i0 < j; i0 += 16) {
                float va[16], vh[16];
#pragma unroll
                for (int k = 0; k < 16; ++k) { if (i0 + k < j) { const float2 v = *(const float2*)(sp + (size_t)(i0 + k) * D * 2); va[k] = v.x; vh[k] = v.y; } else { va[k] = 1.f; vh[k] = 0.f; } }
#pragma unroll
                for (int k = 0; k < 16; ++k) hh = va[k] * hh + vh[k];
            }
            cs[c] = hh;
            if (j == NCH - 1) { const float2 v = *(const float2*)(sp + (size_t)j * D * 2); p.out[O_RGP + (size_t)b * D + c] = v.x * hh + v.y; }
        }
        __syncthreads();
        const size_t row0 = (size_t)b * TP + (size_t)j * CHUNK;
        for (int q0 = 0; q0 < CHUNK * 128 / 512; q0 += 4) {
            u32x4 zq[4], pq[4];
#pragma unroll
            for (int k = 0; k < 4; ++k) { const int e = tid + (q0 + k) * 512, tt = e >> 7, vc = e & 127; const size_t o = (row0 + tt) * D + vc * 8; zq[k] = *(const u32x4*)(zb + o); pq[k] = *(const u32x4*)(pp + o); }
#pragma unroll
            for (int k = 0; k < 4; ++k) { const int e = tid + (q0 + k) * 512, tt = e >> 7, vc = e & 127; const size_t o = (row0 + tt) * D + vc * 8;
                const f32x4 c0 = *(const LAS f32x4*)(cs + vc * 8), c1 = *(const LAS f32x4*)(cs + vc * 8 + 4);
                u32x4 w;
                w.x = cvt_pk_bf16(bflo(zq[k].x) + bflo(pq[k].x) * c0[0], bfhi(zq[k].x) + bfhi(pq[k].x) * c0[1]); w.y = cvt_pk_bf16(bflo(zq[k].y) + bflo(pq[k].y) * c0[2], bfhi(zq[k].y) + bfhi(pq[k].y) * c0[3]);
                w.z = cvt_pk_bf16(bflo(zq[k].z) + bflo(pq[k].z) * c1[0], bfhi(zq[k].z) + bfhi(pq[k].z) * c1[1]); w.w = cvt_pk_bf16(bflo(zq[k].w) + bflo(pq[k].w) * c1[2], bfhi(zq[k].w) + bfhi(pq[k].w) * c1[3]);
                if (!dry) *(u32x4*)(zb + o) = w; }
        }
        __syncthreads();
    }
}
__device__ __forceinline__ void za_phase(const Params& p, int tid, bool dry) {
    bf16_t* U = (bf16_t*)(p.ws + WS_U); bf16_t* ab = U; const bf16_t* ca = U + 2 * SLOT;
    const float* cw = p.in[14];
    for (int idx = blockIdx.x * 512 + tid; idx < NB * 129 * 128; idx += gridDim.x * 512) {
        const int vc = idx & 127, tb = (idx >> 7) % 129, b = idx / (128 * 129); const int c0 = vc * 8;
        float w[3][8];
#pragma unroll
        for (int k = 0; k < 3; ++k) { const f32x4 a = *(const f32x4*)(cw + k * D + c0), bq = *(const f32x4*)(cw + k * D + c0 + 4);
#pragma unroll
            for (int e = 0; e < 4; ++e) { w[k][e] = a[e]; w[k][4 + e] = bq[e]; } }
        const size_t r0 = (size_t)b * TP + (size_t)tb * 16;
        float p2[8], p1[8];
        if (tb > 0) { const u32x4 q2 = *(const u32x4*)(ca + (r0 - 2) * D + c0), q1 = *(const u32x4*)(ca + (r0 - 1) * D + c0);
#pragma unroll
            for (int e = 0; e < 4; ++e) { p2[2 * e] = bflo(q2[e]); p2[2 * e + 1] = bfhi(q2[e]); p1[2 * e] = bflo(q1[e]); p1[2 * e + 1] = bfhi(q1[e]); } }
        else {
#pragma unroll
            for (int e = 0; e < 8; ++e) { p2[e] = 0.f; p1[e] = 0.f; } }
        for (int t4 = 0; t4 < 16; t4 += 4) {
            u32x4 qcs[4], qas[4];
#pragma unroll
            for (int k = 0; k < 4; ++k) { qcs[k] = *(const u32x4*)(ca + (r0 + t4 + k) * D + c0); qas[k] = *(const u32x4*)(ab + (r0 + t4 + k) * D + c0); }
#pragma unroll
            for (int k = 0; k < 4; ++k) {
                const u32x4 qc = qcs[k], qa = qas[k];
                float cv[8], av[8], zv[8];
#pragma unroll
                for (int e = 0; e < 4; ++e) { cv[2 * e] = bflo(qc[e]); cv[2 * e + 1] = bfhi(qc[e]); av[2 * e] = bflo(qa[e]); av[2 * e + 1] = bfhi(qa[e]); }
#pragma unroll
                for (int e = 0; e < 8; ++e) { zv[e] = av[e] * (w[0][e] * p2[e] + w[1][e] * p1[e] + w[2][e] * cv[e]); p2[e] = p1[e]; p1[e] = cv[e]; }
                u32x4 o; o.x = cvt_pk_bf16(zv[0], zv[1]); o.y = cvt_pk_bf16(zv[2], zv[3]); o.z = cvt_pk_bf16(zv[4], zv[5]); o.w = cvt_pk_bf16(zv[6], zv[7]);
                if (!dry) *(u32x4*)(ab + (r0 + t4 + k) * D + c0) = o;
            }
        }
        if (tb == 128) {
            float* o2 = p.out + O_CAP + ((size_t)b * 2 + 0) * D + c0; float* o1 = p.out + O_CAP + ((size_t)b * 2 + 1) * D + c0;
            *(f32x4*)o2 = (f32x4){p2[0], p2[1], p2[2], p2[3]}; *(f32x4*)(o2 + 4) = (f32x4){p2[4], p2[5], p2[6], p2[7]};
            *(f32x4*)o1 = (f32x4){p1[0], p1[1], p1[2], p1[3]}; *(f32x4*)(o1 + 4) = (f32x4){p1[4], p1[5], p1[6], p1[7]};
        }
    }
    if (!dry) {
        for (int idx = blockIdx.x * 512 + tid; idx < NS * 128; idx += gridDim.x * 512) {
            const int vc = idx & 127, sm = idx >> 7, c0 = vc * 8; const size_t ro = (size_t)(MP + sm) * D + c0;
            const u32x4 qc = *(const u32x4*)(ca + ro), qa = *(const u32x4*)(ab + ro);
            const float* pca = (const float*)(p.ws + WS_PCA) + (size_t)sm * D + c0;
            float hp[8], cv[8], zv[8];
            { const f32x4 a0 = *(const f32x4*)pca, a1 = *(const f32x4*)(pca + 4);
#pragma unroll
              for (int e = 0; e < 4; ++e) { hp[e] = a0[e]; hp[4 + e] = a1[e]; } }
#pragma unroll
            for (int e = 0; e < 4; ++e) { cv[2 * e] = bflo(qc[e]); cv[2 * e + 1] = bfhi(qc[e]); }
#pragma unroll
            for (int e = 0; e < 8; ++e) { const float av = (e & 1) ? bfhi(qa[e >> 1]) : bflo(qa[e >> 1]); zv[e] = av * (hp[e] + cw[2 * D + c0 + e] * cv[e]); }
            u32x4 o; o.x = cvt_pk_bf16(zv[0], zv[1]); o.y = cvt_pk_bf16(zv[2], zv[3]); o.z = cvt_pk_bf16(zv[4], zv[5]); o.w = cvt_pk_bf16(zv[6], zv[7]);
            *(u32x4*)(ab + ro) = o;
            float* o1 = p.out + O_CAS + ((size_t)sm * 2 + 1) * D + c0;
            *(f32x4*)o1 = (f32x4){cv[0], cv[1], cv[2], cv[3]}; *(f32x4*)(o1 + 4) = (f32x4){cv[4], cv[5], cv[6], cv[7]};
        }
    }
}

__device__ __forceinline__ u32x4 merge_math(const u32x4& ga, const u32x4& gb, const float (&ya)[8], const float (&yb)[8]) {
    u32x4 o4;
#pragma unroll
    for (int e = 0; e < 4; ++e) { const float lo = sigm(bflo(ga[e])) * ya[2 * e] + sigm(bflo(gb[e])) * yb[2 * e], hi = sigm(bfhi(ga[e])) * ya[2 * e + 1] + sigm(bfhi(gb[e])) * yb[2 * e + 1]; o4[e] = cvt_pk_bf16(lo, hi); }
    return o4;
}
__device__ __forceinline__ void merge_phase(const Params& p, int tid) {
    const bf16_t* U = (const bf16_t*)(p.ws + WS_U); bf16_t* H = (bf16_t*)p.out; const bf16_t* PO = (const bf16_t*)(p.ws + WS_POAB);
    const size_t G = (size_t)gridDim.x * 512, NMAIN = (size_t)MAINR * 128;
    for (size_t i0 = (size_t)blockIdx.x * 512 + tid; i0 < NMAIN; i0 += 4 * G) {
        u32x4 ga[4], gb[4], a[4], b[4];
#pragma unroll
        for (int k = 0; k < 4; ++k) { const size_t i = i0 + k * G; if (i < NMAIN) { ga[k] = __builtin_nontemporal_load((const u32x4*)(U + 4 * SLOT + i * 8)); gb[k] = __builtin_nontemporal_load((const u32x4*)(U + 5 * SLOT + i * 8)); a[k] = __builtin_nontemporal_load((const u32x4*)(U + 2 * SLOT + i * 8)); b[k] = __builtin_nontemporal_load((const u32x4*)(U + 3 * SLOT + i * 8)); } }
#pragma unroll
        for (int k = 0; k < 4; ++k) { const size_t i = i0 + k * G; if (i < NMAIN) {
            float ya[8], yb[8];
#pragma unroll
            for (int e = 0; e < 4; ++e) { ya[2 * e] = bflo(a[k][e]); ya[2 * e + 1] = bfhi(a[k][e]); yb[2 * e] = bflo(b[k][e]); yb[2 * e + 1] = bfhi(b[k][e]); }
            *(u32x4*)(H + i * 8) = merge_math(ga[k], gb[k], ya, yb); } }
    }
    for (size_t i = NMAIN + (size_t)blockIdx.x * 512 + tid; i < SLOT / 8; i += G) {
        const u32x4 ga = *(const u32x4*)(U + 4 * SLOT + i * 8), gb = *(const u32x4*)(U + 5 * SLOT + i * 8);
        float ya[8], yb[8];
        const int row = (int)(i >> 7);
        const size_t o = (size_t)(row - MAINR) * D + (size_t)(i & 127) * 8;
#pragma unroll
        for (int e = 0; e < 8; ++e) { ya[e] = 0.f; yb[e] = 0.f; }
#pragma unroll
        for (int ks = 0; ks < 4; ++ks) {
            const u32x4 a0 = *(const u32x4*)(PO + (size_t)(ks * 2 + 0) * (256 * D) + o), b0 = *(const u32x4*)(PO + (size_t)(ks * 2 + 1) * (256 * D) + o);
#pragma unroll
            for (int e = 0; e < 4; ++e) { ya[2 * e] += bflo(a0[e]); ya[2 * e + 1] += bfhi(a0[e]); yb[2 * e] += bflo(b0[e]); yb[2 * e + 1] += bfhi(b0[e]); }
        }
        *(u32x4*)(H + i * 8) = merge_math(ga, gb, ya, yb);
    }
}

#define XB_TMO      128
#define XB_XCNT(j)  (256  + 64 * (j))
#define XB_XSUB(j)  (1280 + 64 * (j))
#define XB_XGEN(j)  (2304 + 64 * (j))
#define XB_TOP      3328
#define XB_TOPGEN   3392
#define XCD_BAR_WORDS 3456
#define XB_SPIN_CAP (1u << 18)
__device__ __forceinline__ unsigned xb_ld(unsigned* p)              { return __hip_atomic_load(p, __ATOMIC_RELAXED, __HIP_MEMORY_SCOPE_AGENT); }
__device__ __forceinline__ unsigned xb_add(unsigned* p, unsigned v) { return __hip_atomic_fetch_add(p, v, __ATOMIC_RELAXED, __HIP_MEMORY_SCOPE_AGENT); }
__device__ __forceinline__ unsigned xb_xcc_id() { return (unsigned)__builtin_amdgcn_s_getreg((3 << 11) | 20) & 0xFu; }
#define XB_SPIN(cond, bar) do { unsigned _sp = 0; while (cond) { __builtin_amdgcn_s_sleep(1); \
    if ((++_sp & 255u) == 0u) { if (xb_ld(&(bar)[XB_TMO])) break; if (_sp > XB_SPIN_CAP) { atomicAdd(&(bar)[XB_TMO], 1u); break; } } } } while (0)
struct XcdBarrier { unsigned* bar; unsigned x; volatile LAS unsigned* st; };
__device__ __forceinline__ XcdBarrier xcd_barrier_post(unsigned* bar, volatile LAS unsigned* st) {
    XcdBarrier b; b.bar = bar; b.x = xb_xcc_id(); b.st = st;
    if (threadIdx.x == 0) (void)xb_add(&bar[XB_XCNT(b.x)], 1u);
    return b;
}
__device__ __forceinline__ void xcd_barrier_complete(unsigned* bar, unsigned x, unsigned& nloc, unsigned& nx) {
    const unsigned G = gridDim.x * gridDim.y * gridDim.z;
    unsigned sum, cnt, mine, sp = 0u;
    for (;;) {
        sum = 0u; cnt = 0u; mine = 0u;
#pragma unroll
        for (unsigned j = 0; j < 16; ++j) { const unsigned c = xb_ld(&bar[XB_XCNT(j)]); sum += c; cnt += (c > 0u) ? 1u : 0u; mine = (j == x) ? c : mine; }
        if (sum == G) break;
        __builtin_amdgcn_s_sleep(1);
        if ((++sp & 255u) == 0u) { if (xb_ld(&bar[XB_TMO])) break; if (sp > XB_SPIN_CAP) { atomicAdd(&bar[XB_TMO], 1u); break; } }
    }
    nloc = mine > 0u ? mine : 1u; nx = cnt > 0u ? cnt : 1u;
}
__device__ __forceinline__ void xcd_barrier(const XcdBarrier& b) {
    asm volatile("s_waitcnt vmcnt(0)" ::: "memory");
    __syncthreads();
    if (threadIdx.x == 0) {
        unsigned* bar = b.bar;
        __builtin_amdgcn_s_waitcnt(0);
        unsigned nloc = b.st[0], nx = b.st[1];
        if (nloc == 0u) { xcd_barrier_complete(bar, b.x, nloc, nx); b.st[0] = nloc; b.st[1] = nx; }
        const unsigned old = xb_add(&bar[XB_XSUB(b.x)], 1u);
        const unsigned gen = old / nloc;
        if (old + 1u == (gen + 1u) * nloc) {
            __builtin_amdgcn_fence(__ATOMIC_RELEASE, "agent");
            asm volatile("s_waitcnt vmcnt(0)" ::: "memory");
            const unsigned og = xb_add(&bar[XB_TOP], 1u);
            const unsigned tg = og / nx;
            if (og + 1u == (tg + 1u) * nx) xb_add(&bar[XB_TOPGEN], 1u);
            else XB_SPIN(xb_ld(&bar[XB_TOPGEN]) == tg, bar);
            __builtin_amdgcn_fence(__ATOMIC_ACQUIRE, "agent");
            xb_add(&bar[XB_XGEN(b.x)], 1u);
            asm volatile("s_waitcnt vmcnt(0)" ::: "memory");
        } else {
            XB_SPIN(xb_ld(&bar[XB_XGEN(b.x)]) == gen, bar);
            __builtin_amdgcn_fence(__ATOMIC_ACQUIRE, "agent");
            asm volatile("s_waitcnt vmcnt(0)" ::: "memory");
        }
    }
    __syncthreads();
}

constexpr int NPHASE = 14;
constexpr int LDS_BYTES = 131072 + 16;
__global__ void __launch_bounds__(512, 2) mk_fwd(Params p, int ph_lo, int ph_hi) {
    extern __shared__ __attribute__((aligned(16))) unsigned char shm[];
    LAS unsigned char* lds = (LAS unsigned char*)shm;
    cg::grid_group grid = cg::this_grid();
    if (threadIdx.x == 0) { *(LAS u32x4*)(lds + 131072) = (u32x4){0u, 0u, 0u, 0u}; }
    __syncthreads();
    const XcdBarrier xb = xcd_barrier_post((unsigned*)(p.ws + WS_BAR), (volatile LAS unsigned*)(lds + 131072));
    for (int ph2 = ph_lo * 2; ph2 < ph_hi * 2; ++ph2) {
        const int ph = ph2 >> 1; const bool dry = !(ph2 & 1);
        if (dry && !((REP_MASK >> ph) & 1)) continue;
        int tid = threadIdx.x; asm volatile("" : "+v"(tid));
        if (ph == 0) {
            convert_set(p, 0, lds, tid, 0, 0, 1408);
            bf16_t* wt = (bf16_t*)(p.ws + WS_WRG);
            for (int o = blockIdx.x * 512 + tid; o < 2 * 65536; o += gridDim.x * 512) { const int g = o >> 16, h = (o >> 12) & 15, j = (o >> 6) & 63, i = o & 63;
                wt[o] = f2bf((g ? p.in[20] : p.in[18])[(size_t)(h * 64 + i) * 64 + j]); }
            if (blockIdx.x * 512 + tid < D) { const int ch = blockIdx.x * 512 + tid; ((float*)(p.ws + WS_LC))[ch] = -8.0f * log1pf(expf(-p.in[22][ch])); }
            for (int e = blockIdx.x * 512 + tid; e < NS * D; e += gridDim.x * 512) {
                const int sm = e >> 10, c = e & 1023;
                const float t0 = p.in[3][((size_t)sm * 3 + 0) * D + c], t1 = p.in[3][((size_t)sm * 3 + 1) * D + c], t2 = p.in[3][((size_t)sm * 3 + 2) * D + c];
                const float a0 = p.in[2][((size_t)sm * 2 + 0) * D + c], a1 = p.in[2][((size_t)sm * 2 + 1) * D + c];
                ((float*)(p.ws + WS_PCB))[e] = p.in[16][c] * t0 + p.in[16][D + c] * t1 + p.in[16][2 * D + c] * t2 + p.in[17][c];
                ((float*)(p.ws + WS_PCA))[e] = p.in[14][c] * a0 + p.in[14][D + c] * a1;
                p.out[O_CBS + ((size_t)sm * 3 + 0) * D + c] = t1; p.out[O_CBS + ((size_t)sm * 3 + 1) * D + c] = t2;
                p.out[O_CAS + ((size_t)sm * 2 + 0) * D + c] = a1;
            }
            norm_phase(p, 0, tid, dry, 0);
        } else if (ph == 1 || ph == 11) {
            pg8::Gemm g{(const bf16_t*)(p.ws + WS_H), (const bf16_t*)(p.ws + WS_WGU), M, 2 * DFF, D, 0, 0};
            pg8::StaticOrder S; S.init(M, 2 * DFF, D, gridDim.x, blockIdx.x);
            pg8::EpiGU E{(bf16_t*)(p.ws + WS_ACT), dry};
            pg8::gemm_phase(lds, g, S, E);
            if (!dry && ph == 1) { convert_set(p, 0, lds, tid, 150, 1408, 2112); convert_set(p, 2, lds, tid, 150, 0, 1088); }
        } else if (ph == 2 || ph == 12 || ph == 9 || ph == 7) {
            const bool dn = (ph == 2 || ph == 12), oab = (ph == 7);
            pg8::Gemm g{dn ? (const bf16_t*)(p.ws + WS_ACT) : (oab ? (const bf16_t*)(p.ws + WS_U) : (const bf16_t*)p.out), (const bf16_t*)(p.ws + (dn ? WS_WD : (oab ? WS_WOAB : WS_WO))), M, D, dn ? DFF : D, SB, (size_t)1024 * 1024 * 2};
            pg8::SplitOrder S; S.init(oab ? 2 * D : D, dn ? DFF : D, gridDim.x, blockIdx.x, dn ? 11 : 4, 4);
            pg8::EpiBF E{(bf16_t*)(p.ws + (oab ? WS_U + 2 * SB : WS_Y)), SLOT, (bf16_t*)(p.ws + (oab ? WS_POAB : WS_PY)), oab ? 2 : 1};
            pg8::gemm_phase(lds, g, S, E);
            if (!dry && ph == 2) convert_set(p, 2, lds, tid, 44, 1088, 1 << 30);
            if (!dry && ph == 9) convert_set(p, 1, lds, tid, 16, 0, 1 << 30);
        } else if (ph == 3) {
            norm_phase(p, 1, tid, dry, 11);
        } else if (ph == 4) {
            pg8::Gemm g{(const bf16_t*)(p.ws + WS_H), (const bf16_t*)(p.ws + WS_WIN), M, DIN, D, 0, 0};
            pg8::StaticOrder S; S.init(M, DIN, D, gridDim.x, blockIdx.x);
            pg8::EpiIN E{(bf16_t*)(p.ws + WS_U)};
            pg8::gemm_phase(lds, g, S, E);
        } else if (ph == 5) {
            scan_phase(p, lds, tid, dry);
        } else if (ph == 6) {
            fix_phase(p, lds, tid, dry);
            za_phase(p, tid, dry);
        } else if (ph == 8) {
            merge_phase(p, tid);
        } else if (ph == 10) {
            norm_phase(p, 2, tid, dry, 4);
        } else if (ph == 13) {
            norm_phase(p, 3, tid, dry, 11);
        }
        if (ph2 + 1 < ph_hi * 2) { if (ph_hi > NPHASE) grid.sync(); else xcd_barrier(xb); }
    }
}

extern "C" void kernel_launch(void* const* d_in, const int* in_sizes, int n_in, void* d_out, int out_size, void* d_ws, size_t ws_size, hipStream_t stream) {
    if (n_in != 30 || ws_size < WS_END) { fprintf(stderr, "kernel_launch: unexpected n_in %d / ws_size %zu (need %zu)\n", n_in, ws_size, (size_t)WS_END); return; }
    Params p{};
    for (int i = 0; i < 30; ++i) p.in[i] = (const float*)d_in[i];
    p.out = (float*)d_out; p.ws = (unsigned char*)d_ws;
    (void)hipFuncSetAttribute((const void*)mk_fwd, hipFuncAttributeMaxDynamicSharedMemorySize, LDS_BYTES);
    static int grid_blocks = 0;
    if (!grid_blocks) {
        int dev = 0, cus = 0, per_cu = 0;
        (void)hipGetDevice(&dev);
        (void)hipDeviceGetAttribute(&cus, hipDeviceAttributeMultiprocessorCount, dev);
        (void)hipOccupancyMaxActiveBlocksPerMultiprocessor(&per_cu, (const void*)mk_fwd, 512, LDS_BYTES);
        if (per_cu < 1) { fprintf(stderr, "kernel_launch: occupancy query says %d blocks/CU\n", per_cu); per_cu = 1; }
        grid_blocks = cus;
    }
    (void)hipMemsetAsync((unsigned char*)d_ws + WS_BAR, 0, 16384, stream);
#if SINGLE_LAUNCH
    int lo = 0, hi = NPHASE;
    void* args[] = {&p, &lo, &hi};
    hipError_t e = hipLaunchCooperativeKernel((const void*)mk_fwd, dim3(grid_blocks), dim3(512), args, LDS_BYTES, stream);
    if (e != hipSuccess) fprintf(stderr, "cooperative launch failed: %s (grid %d)\n", hipGetErrorString(e), grid_blocks);
#else
    for (int ph = 0; ph < NPHASE; ++ph) hipLaunchKernelGGL(mk_fwd, dim3(grid_blocks), dim3(512), LDS_BYTES, stream, p, ph, ph + 1);
#endif
}
```
